# Optimizing an MI355X kernel written in HIP

```python
import jax, jax.numpy as jnp
from jax import lax
import numpy as np

D_MODEL = 1024
BATCH = 8
SEQ = 4096
DEPTH = 1

CHUNK = 64
N_MEM = 256
HEAD_DIM = 64
RWKV_HEADS = 8
RWKV_DIM = RWKV_HEADS * HEAD_DIM
DECAY_LORA = 64
ICLR_LORA = 64
GATE_LORA = 128
POOL_WINDOWS = (2, 4, 8, 16)
POOL_GROUPS = len(POOL_WINDOWS)
POOL_GROUP_DIM = 64
POOL_DIM = POOL_GROUPS * POOL_GROUP_DIM
MEM_HEADS = 4
MEM_DIM = MEM_HEADS * HEAD_DIM
N_BRANCH = 3
RWKV_IN = 3 * RWKV_DIM + DECAY_LORA + ICLR_LORA + GATE_LORA
MIX_IN = RWKV_IN + POOL_DIM + MEM_DIM
D_FF = 2816
CONV_W = 3
NORM_EPS = 1e-6
GN_EPS = 64e-5

kernel_name = "hybrid_rwkv7_pool_memxattn_convffn"


def rms_norm(x, g):
    xf = x.astype(jnp.float32)
    y = xf * lax.rsqrt(jnp.mean(xf * xf, axis=-1, keepdims=True) + NORM_EPS)
    return (y * g.astype(jnp.float32)).astype(x.dtype)


def shift_prev(p):
    return jnp.pad(p[:, :-1], ((0, 0), (1, 0), (0, 0)))


def rwkv7_scan(r, w, k, v, kk, a):
    B, T, H, N = r.shape
    xs = tuple(jnp.moveaxis(t, 1, 0) for t in (r, w, k, v, kk, a))

    def step(S, inp):
        r_t, w_t, k_t, v_t, kk_t, a_t = inp
        s_kk = jnp.einsum('bhvk,bhk->bhv', S, kk_t)
        S = (S * w_t[:, :, None, :]
             - jnp.einsum('bhv,bhk->bhvk', s_kk, kk_t * a_t)
             + jnp.einsum('bhv,bhk->bhvk', v_t, k_t))
        y_t = jnp.einsum('bhvk,bhk->bhv', S, r_t)
        return S, y_t

    S0 = jnp.zeros((B, H, N, N), jnp.float32)
    _, ys = lax.scan(step, S0, xs)
    return jnp.moveaxis(ys, 0, 1)


def rwkv7_branch(p, mu, w0, w_lora_b, a0, a_lora_b, g_lora_b, k_k, k_a, r_k, ln_w, ln_b):
    B, T, _ = p.shape
    f32 = jnp.float32
    p = p + (shift_prev(p) - p) * mu
    splits = [RWKV_DIM, 2 * RWKV_DIM, 3 * RWKV_DIM,
              3 * RWKV_DIM + DECAY_LORA, 3 * RWKV_DIM + DECAY_LORA + ICLR_LORA]
    r, k, v, wd, ad, gd = jnp.split(p, splits, axis=-1)
    w_log = -jax.nn.softplus(-(w0 + jnp.tanh(wd) @ w_lora_b).astype(f32)) - 0.5
    decay = jnp.exp(-jnp.exp(w_log))
    a = jax.nn.sigmoid((a0 + ad @ a_lora_b).astype(f32))
    g = jax.nn.sigmoid(gd) @ g_lora_b

    def heads(t):
        return t.astype(f32).reshape(B, T, RWKV_HEADS, HEAD_DIM)

    kk = heads(k * k_k)
    kk = kk * lax.rsqrt(jnp.sum(kk * kk, axis=-1, keepdims=True) + 1e-12)
    kf = k.astype(f32) * (1.0 + (a - 1.0) * k_a.astype(f32))
    rh, kh, vh, wh, ah = heads(r), heads(kf), heads(v), heads(decay), heads(a)
    y = rwkv7_scan(rh, wh, kh, vh, kk, ah)
    mean = jnp.mean(y, axis=-1, keepdims=True)
    var = jnp.mean(jnp.square(y - mean), axis=-1, keepdims=True)
    yn = ((y - mean) * lax.rsqrt(var + GN_EPS)).reshape(B, T, RWKV_DIM)
    yn = yn * ln_w.astype(f32) + ln_b.astype(f32)
    bonus = jnp.sum(rh * kh * r_k.astype(f32), axis=-1, keepdims=True) * vh
    out = (yn + bonus.reshape(B, T, RWKV_DIM)) * g.astype(f32)
    return out.astype(p.dtype)


def pool_branch(p, pool_w, pool_scale):
    B, T, _ = p.shape
    pf = p.astype(jnp.float32)
    pos = jnp.arange(1, T + 1)
    outs = []
    for gi, win in enumerate(POOL_WINDOWS):
        xg = pf[..., gi * POOL_GROUP_DIM:(gi + 1) * POOL_GROUP_DIM]
        cs = jnp.cumsum(xg, axis=1)
        cs_lag = jnp.pad(cs[:, :T - win], ((0, 0), (win, 0), (0, 0)))
        cnt = jnp.minimum(pos, win).astype(jnp.float32)[None, :, None]
        outs.append((cs - cs_lag) / cnt - xg)
    d = jnp.stack(outs, axis=2)
    y = jnp.einsum('btgc,gcd->btgd', d, pool_w.astype(jnp.float32)).reshape(B, T, POOL_DIM)
    return (y * pool_scale.astype(jnp.float32)).astype(p.dtype)


def memory_branch(q, mem_n, w_mem_kv):
    B, T, _ = q.shape
    M = mem_n.shape[1]
    k, v = jnp.split(mem_n @ w_mem_kv, 2, axis=-1)
    qh = q.reshape(B, T, MEM_HEADS, HEAD_DIM)
    kh = k.reshape(B, M, MEM_HEADS, HEAD_DIM)
    vh = v.reshape(B, M, MEM_HEADS, HEAD_DIM)
    s = jnp.einsum('bthd,bmhd->bhtm', qh, kh).astype(jnp.float32) * (HEAD_DIM ** -0.5)
    prob = jax.nn.softmax(s, axis=-1).astype(vh.dtype)
    o = jnp.einsum('bhtm,bmhd->bthd', prob, vh)
    return o.reshape(B, T, MEM_DIM)


def conv_ffn(h, w_in, conv_w, conv_b, w_out):
    u, gv = jnp.split(h @ w_in, 2, axis=-1)
    T = u.shape[1]
    up = jnp.pad(u, ((0, 0), (CONV_W - 1, 0), (0, 0)))
    uc = conv_w[0] * up[:, 0:T]
    for j in range(1, CONV_W):
        uc = uc + conv_w[j] * up[:, j:j + T]
    uc = uc + conv_b
    return (jax.nn.gelu(uc, approximate=False) * gv) @ w_out


def setup_inputs(seed: int = 0) -> dict:
    key = jax.random.key(seed)
    ks = jax.random.split(key, 32)
    L, D, F = DEPTH, D_MODEL, D_FF

    def nrm(k, shape, scale):
        return jax.random.normal(k, shape, jnp.float32) * scale

    def gain(k, shape, s=0.02):
        return 1.0 + nrm(k, shape, s)

    return {
        "x": nrm(ks[0], (BATCH, SEQ, D), 1.0),
        "mem": nrm(ks[1], (BATCH, N_MEM, D), 1.0),
        "norm_mix_g": gain(ks[2], (L, D)),
        "w_in_mix": nrm(ks[3], (L, D, MIX_IN), D ** -0.5),
        "mu_shift": jax.random.uniform(ks[4], (L, RWKV_IN), jnp.float32),
        "w0": jax.random.uniform(ks[5], (L, RWKV_DIM), jnp.float32, -4.0, 1.0),
        "w_lora_b": nrm(ks[6], (L, DECAY_LORA, RWKV_DIM), 0.5 * DECAY_LORA ** -0.5),
        "a0": nrm(ks[7], (L, RWKV_DIM), 0.1),
        "a_lora_b": nrm(ks[8], (L, ICLR_LORA, RWKV_DIM), ICLR_LORA ** -0.5),
        "g_lora_b": nrm(ks[9], (L, GATE_LORA, RWKV_DIM), GATE_LORA ** -0.5),
        "k_k": gain(ks[10], (L, RWKV_DIM), 0.1),
        "k_a": gain(ks[11], (L, RWKV_DIM), 0.1),
        "r_k": nrm(ks[12], (L, RWKV_HEADS, HEAD_DIM), 0.1),
        "ln_x_w": gain(ks[13], (L, RWKV_DIM)),
        "ln_x_b": nrm(ks[14], (L, RWKV_DIM), 0.02),
        "pool_w": nrm(ks[15], (L, POOL_GROUPS, POOL_GROUP_DIM, POOL_GROUP_DIM), POOL_GROUP_DIM ** -0.5),
        "pool_scale": gain(ks[16], (L, POOL_DIM), 0.1),
        "norm_mem_g": gain(ks[17], (L, D)),
        "w_mem_kv": nrm(ks[18], (L, D, 2 * MEM_DIM), D ** -0.5),
        "w_up_rwkv": nrm(ks[19], (L, RWKV_DIM, D), RWKV_DIM ** -0.5),
        "w_up_pool": nrm(ks[20], (L, POOL_DIM, D), POOL_DIM ** -0.5),
        "w_up_mem": nrm(ks[21], (L, MEM_DIM, D), MEM_DIM ** -0.5),
        "w_gate": nrm(ks[22], (L, D, N_BRANCH * D), D ** -0.5),
        "b_gate": nrm(ks[23], (L, N_BRANCH * D), 0.02),
        "w_o": nrm(ks[24], (L, D, D), D ** -0.5),
        "norm_ffn_g": gain(ks[25], (L, D)),
        "w_ffn_in": nrm(ks[26], (L, D, 2 * F), D ** -0.5),
        "ffn_conv_w": nrm(ks[27], (L, CONV_W, F), CONV_W ** -0.5),
        "ffn_conv_b": nrm(ks[28], (L, F), 0.02),
        "w_ffn_out": nrm(ks[29], (L, F, D), F ** -0.5),
        "norm_final_g": gain(ks[30], (D,)),
    }


def reference(x, mem, norm_mix_g, w_in_mix, mu_shift, w0, w_lora_b, a0, a_lora_b, g_lora_b,
              k_k, k_a, r_k, ln_x_w, ln_x_b, pool_w, pool_scale, norm_mem_g, w_mem_kv,
              w_up_rwkv, w_up_pool, w_up_mem, w_gate, b_gate, w_o, norm_ffn_g, w_ffn_in,
              ffn_conv_w, ffn_conv_b, w_ffn_out, norm_final_g):
    B, T, D = x.shape
    for l in range(DEPTH):
        h = rms_norm(x, norm_mix_g[l])
        p = h @ w_in_mix[l]
        p_rwkv = p[..., :RWKV_IN]
        p_pool = p[..., RWKV_IN:RWKV_IN + POOL_DIM]
        q_mem = p[..., RWKV_IN + POOL_DIM:]
        y_a = rwkv7_branch(p_rwkv, mu_shift[l], w0[l], w_lora_b[l], a0[l], a_lora_b[l],
                           g_lora_b[l], k_k[l], k_a[l], r_k[l], ln_x_w[l], ln_x_b[l])
        y_b = pool_branch(p_pool, pool_w[l], pool_scale[l])
        y_c = memory_branch(q_mem, rms_norm(mem, norm_mem_g[l]), w_mem_kv[l])
        gates = jax.nn.sigmoid((h @ w_gate[l] + b_gate[l]).astype(jnp.float32))
        gates = gates.astype(x.dtype).reshape(B, T, N_BRANCH, D)
        merged = (gates[:, :, 0] * (y_a @ w_up_rwkv[l])
                  + gates[:, :, 1] * (y_b @ w_up_pool[l])
                  + gates[:, :, 2] * (y_c @ w_up_mem[l]))
        x = x + merged @ w_o[l]
        x = x + conv_ffn(rms_norm(x, norm_ffn_g[l]), w_ffn_in[l], ffn_conv_w[l],
                         ffn_conv_b[l], w_ffn_out[l])
    return rms_norm(x, norm_final_g)
```

```cpp
#include <hip/hip_runtime.h>
#include <hip/hip_cooperative_groups.h>
#include <cstdio>
#include <cstdint>
namespace cg = cooperative_groups;

#ifndef ONE_LAUNCH
#define ONE_LAUNCH 0
#endif
#ifndef PH_MASK
#define PH_MASK 0xFFFFFFFFu
#endif
#define PH_ON(k) ((PH_MASK >> (k)) & 1u)

#define LAS __attribute__((address_space(3)))
typedef unsigned short bf16_t;
typedef short bf16x8 __attribute__((ext_vector_type(8)));
typedef float f32x4 __attribute__((ext_vector_type(4)));
typedef float f32x2 __attribute__((ext_vector_type(2)));
typedef unsigned u32x4 __attribute__((ext_vector_type(4)));
typedef unsigned u32x2 __attribute__((ext_vector_type(2)));

constexpr int BATCH = 8, SEQ = 4096, DM = 1024, MTOK = BATCH * SEQ;
constexpr int NMEM = 256, RD = 512, MIXIN = 2304, RWKVIN = 1792, FF = 2816, NG1 = MIXIN + 3 * DM;
constexpr int NWAVES = 8, NTHREADS = 512;
constexpr float NORM_EPS = 1e-6f, GN_EPS = 64e-5f;

constexpr size_t MiB = 1u << 20;
constexpr size_t WS_WG1T = 1 * MiB;
constexpr size_t WS_WKVT = WS_WG1T + (size_t)NG1 * DM * 2;
constexpr size_t WS_WUPT = WS_WKVT + (size_t)512 * DM * 2;
constexpr size_t WS_WOT = WS_WUPT + (size_t)DM * DM * 2;
constexpr size_t WS_WF1T = WS_WOT + (size_t)DM * DM * 2;
constexpr size_t WS_WF2T = WS_WF1T + (size_t)2 * FF * DM * 2;
constexpr size_t WS_WLWT = WS_WF2T + (size_t)DM * FF * 2;
constexpr size_t WS_WLAT = WS_WLWT + (size_t)RD * 64 * 2;
constexpr size_t WS_WLGT = WS_WLAT + (size_t)RD * 64 * 2;
constexpr size_t WS_WPT = WS_WLGT + (size_t)RD * 128 * 2;
constexpr size_t WS_WEND = WS_WPT + (size_t)4 * 64 * 64 * 2;
static_assert(WS_WEND <= 34 * MiB, "weights region");
constexpr size_t WS_BONUS = 34 * MiB;
constexpr size_t WS_RSTD2 = 35 * MiB;
constexpr size_t WS_KB = 36 * MiB;
constexpr size_t WS_VT = 37 * MiB;
constexpr size_t WS_MEMN = 38 * MiB;
constexpr size_t WS_H = 42 * MiB;
constexpr size_t WS_YCAT = 106 * MiB;
constexpr size_t WS_P = 170 * MiB;
constexpr size_t WS_W = 170 * MiB;
constexpr size_t WS_G = 234 * MiB;
constexpr size_t WS_AA = 266 * MiB;
constexpr size_t WS_KRAW = 314 * MiB;
constexpr size_t WS_YRAW = 266 * MiB;
constexpr size_t WS_R = 346 * MiB;
constexpr size_t WS_V = 378 * MiB;
constexpr size_t WS_LW = 410 * MiB;
constexpr size_t WS_LA = 414 * MiB;
constexpr size_t WS_LG = 418 * MiB;
constexpr size_t WS_DPOOL = 426 * MiB;
constexpr size_t WS_GATES = 170 * MiB;
constexpr size_t WS_MERGED = 362 * MiB;
constexpr size_t WS_X1B = 426 * MiB;
constexpr size_t WS_U = 42 * MiB;
constexpr size_t WS_GV = 130 * MiB;
constexpr size_t WS_ACT = 218 * MiB;
constexpr size_t WS_END = 490 * MiB;
constexpr size_t DO_KK = 0, DO_BB = 32 * MiB, DO_KF = 64 * MiB;

constexpr int LDS_BYTES = 147456;

__device__ __forceinline__ unsigned f2bf(float f) { unsigned u = __float_as_uint(f); return (u + 0x7fffu + ((u >> 16) & 1u)) >> 16; }
__device__ __forceinline__ float bf2f(unsigned h) { return __uint_as_float(h << 16); }
__device__ __forceinline__ unsigned pk2(float lo, float hi) { return f2bf(lo) | (f2bf(hi) << 16); }
__device__ __forceinline__ u32x2 pk4(f32x4 v) { u32x2 r; r.x = pk2(v[0], v[1]); r.y = pk2(v[2], v[3]); return r; }
__device__ __forceinline__ f32x4 unpk4(u32x2 u) { f32x4 r; r[0] = bf2f(u.x & 0xffffu); r[1] = bf2f(u.x >> 16); r[2] = bf2f(u.y & 0xffffu); r[3] = bf2f(u.y >> 16); return r; }
__device__ __forceinline__ float wave_sum(float v) {
#pragma unroll
    for (int o = 1; o < 64; o <<= 1) v += __shfl_xor(v, o);
    return v;
}
__device__ __forceinline__ float sigmoidf_(float x) { return 1.0f / (1.0f + __expf(-x)); }
template <int CTRL> __device__ __forceinline__ float dpp_f(float x) { return __builtin_bit_cast(float, __builtin_amdgcn_update_dpp(0, __builtin_bit_cast(int, x), CTRL, 0xF, 0xF, false)); }
__device__ __forceinline__ float row_sum16(float x) {
    x += dpp_f<0xB1>(x);
    x += dpp_f<0x4E>(x);
    x += dpp_f<0x141>(x);
    x += dpp_f<0x140>(x);
    return x;
}

struct Params { const float* in[31]; float* out; unsigned char* ws; int ph_lo, ph_hi; };
enum { I_X = 0, I_MEM, I_NMIXG, I_WINMIX, I_MU, I_W0, I_WLORAB, I_A0, I_ALORAB, I_GLORAB, I_KK, I_KA, I_RK, I_LNW, I_LNB, I_POOLW, I_POOLS, I_NMEMG, I_WMEMKV,
       I_WUPR, I_WUPP, I_WUPM, I_WGATE, I_BGATE, I_WO, I_NFFNG, I_WFFNIN, I_CONVW, I_CONVB, I_WFFNOUT, I_NFING };

struct Ctx { int tid, lane, wave, fr, fq, gw, ngw; LAS unsigned char* lds; };

__device__ __forceinline__ int rowmap(int mode, int n) {
    if (mode == 0) return n;
    const int half = n >= FF ? 1 : 0, c = n - half * FF;
    return (c >> 7) * 256 + half * 128 + (c & 127);
}
__device__ __forceinline__ void transpose_item(const float* W, int K, int N, bf16_t* WT, int ldd, int koff, int mode, const float* kscale, LAS float* scr, int item, int lane) {
    const int nblk = N / 32, kb = item / nblk, nb = item % nblk, k0 = 64 * kb, n0 = 32 * nb;
#pragma unroll 8
    for (int i = 0; i < 32; ++i) { const int kk = 2 * i + (lane >> 5); float v = W[(size_t)(k0 + kk) * N + n0 + (lane & 31)]; if (kscale) v *= kscale[k0 + kk]; scr[kk * 33 + (lane & 31)] = v; }
    asm volatile("s_waitcnt lgkmcnt(0)" ::: "memory");
    const int c = lane & 7;
#pragma unroll
    for (int j = 0; j < 4; ++j) { const int n = (lane >> 3) + 8 * j; const LAS float* s = scr + (8 * c) * 33 + n;
        u32x4 o; o.x = pk2(s[0 * 33], s[1 * 33]); o.y = pk2(s[2 * 33], s[3 * 33]); o.z = pk2(s[4 * 33], s[5 * 33]); o.w = pk2(s[6 * 33], s[7 * 33]);
        *(u32x4*)(WT + (size_t)rowmap(mode, n0 + n) * ldd + koff + k0 + 8 * c) = o; }
    asm volatile("s_waitcnt lgkmcnt(0)" ::: "memory");
}
__device__ __forceinline__ void rmsnorm_row_bf16(const float* xrow, const float* g, bf16_t* orow, int lane) {
    const f32x4* xr = (const f32x4*)xrow + lane; const f32x4* gr = (const f32x4*)g + lane;
    f32x4 v[4]; float s = 0.f;
#pragma unroll
    for (int j = 0; j < 4; ++j) { v[j] = xr[64 * j]; s += (v[j][0] * v[j][0] + v[j][1] * v[j][1]) + (v[j][2] * v[j][2] + v[j][3] * v[j][3]); }
    const float rstd = rsqrtf(wave_sum(s) * (1.f / DM) + NORM_EPS);
    u32x2* o = (u32x2*)orow + lane;
#pragma unroll
    for (int j = 0; j < 4; ++j) { const f32x4 gg = gr[64 * j]; o[64 * j] = pk4(v[j] * rstd * gg); }
}

__device__ __forceinline__ void phase_prologue(const Params& p, const Ctx& c) {
    LAS float* scr = (LAS float*)(c.lds + c.wave * 16384);
    unsigned char* ws = p.ws;
#define TR(Wp, K_, N_, WTp, ldd_, koff_, mode_, sc_) { const int ni_ = ((K_) / 64) * ((N_) / 32); if (r < ni_) { transpose_item(Wp, K_, N_, (bf16_t*)(WTp), ldd_, koff_, mode_, sc_, scr, r, c.lane); continue; } r -= ni_; }
    constexpr int NIT = (DM / 64) * (MIXIN / 32) + (DM / 64) * (3 * DM / 32) + (DM / 64) * (512 / 32) + (512 / 64) * (DM / 32) + 2 * (256 / 64) * (DM / 32) + (DM / 64) * (DM / 32)
                      + (DM / 64) * (2 * FF / 32) + (FF / 64) * (DM / 32) + 2 * (RD / 32) + 2 * (RD / 32) + 4 * 2;
    for (int it = c.gw; it < NIT; it += c.ngw) {
        int r = it;
        TR(p.in[I_WINMIX], DM, MIXIN, ws + WS_WG1T, DM, 0, 0, nullptr)
        TR(p.in[I_WGATE], DM, 3 * DM, ws + WS_WG1T + (size_t)MIXIN * DM * 2, DM, 0, 0, nullptr)
        TR(p.in[I_WMEMKV], DM, 512, ws + WS_WKVT, DM, 0, 0, nullptr)
        TR(p.in[I_WUPR], 512, DM, ws + WS_WUPT, DM, 0, 0, nullptr)
        TR(p.in[I_WUPP], 256, DM, ws + WS_WUPT, DM, 512, 0, nullptr)
        TR(p.in[I_WUPM], 256, DM, ws + WS_WUPT, DM, 768, 0, nullptr)
        TR(p.in[I_WO], DM, DM, ws + WS_WOT, DM, 0, 0, nullptr)
        TR(p.in[I_WFFNIN], DM, 2 * FF, ws + WS_WF1T, DM, 0, 1, p.in[I_NFFNG])
        TR(p.in[I_WFFNOUT], FF, DM, ws + WS_WF2T, FF, 0, 0, nullptr)
        TR(p.in[I_WLORAB], 64, RD, ws + WS_WLWT, 64, 0, 0, nullptr)
        TR(p.in[I_ALORAB], 64, RD, ws + WS_WLAT, 64, 0, 0, nullptr)
        TR(p.in[I_GLORAB], 128, RD, ws + WS_WLGT, 128, 0, 0, nullptr)
        TR(p.in[I_POOLW] + 0 * 4096, 64, 64, ws + WS_WPT + 0 * 8192, 64, 0, 0, nullptr)
        TR(p.in[I_POOLW] + 1 * 4096, 64, 64, ws + WS_WPT + 1 * 8192, 64, 0, 0, nullptr)
        TR(p.in[I_POOLW] + 2 * 4096, 64, 64, ws + WS_WPT + 2 * 8192, 64, 0, 0, nullptr)
        TR(p.in[I_POOLW] + 3 * 4096, 64, 64, ws + WS_WPT + 3 * 8192, 64, 0, 0, nullptr)
    }
#undef TR
    for (int m = c.gw; m < MTOK; m += c.ngw) rmsnorm_row_bf16(p.in[I_X] + (size_t)m * DM, p.in[I_NMIXG], (bf16_t*)(ws + WS_H) + (size_t)m * DM, c.lane);
    for (int m = c.gw; m < BATCH * NMEM; m += c.ngw) rmsnorm_row_bf16(p.in[I_MEM] + (size_t)m * DM, p.in[I_NMEMG], (bf16_t*)(ws + WS_MEMN) + (size_t)m * DM, c.lane);
}

__device__ __forceinline__ void wave_gemm_32x64(const bf16_t* A, int lda, const bf16_t* Bt, int ldb, int K, int m0, int n0, int fr, int fq, f32x4 (&acc)[2][4]) {
    const bf16_t* ap = A + (size_t)(m0 + fr) * lda + 8 * fq;
    const bf16_t* bp = Bt + (size_t)(n0 + fr) * ldb + 8 * fq;
    for (int k0 = 0; k0 < K; k0 += 32) {
        const bf16x8 a0 = *(const bf16x8*)(ap + k0), a1 = *(const bf16x8*)(ap + (size_t)16 * lda + k0);
        bf16x8 b[4];
#pragma unroll
        for (int j = 0; j < 4; ++j) b[j] = *(const bf16x8*)(bp + (size_t)(16 * j) * ldb + k0);
#pragma unroll
        for (int j = 0; j < 4; ++j) { acc[0][j] = __builtin_amdgcn_mfma_f32_16x16x32_bf16(b[j], a0, acc[0][j], 0, 0, 0); acc[1][j] = __builtin_amdgcn_mfma_f32_16x16x32_bf16(b[j], a1, acc[1][j], 0, 0, 0); }
    }
}
template <class Epi>
__device__ __forceinline__ void gemm_simple(const Ctx& c, const bf16_t* A, int lda, const bf16_t* Bt, int ldb, int M, int N, int K, const Epi& epi) {
    const int nMt = M / 256, nNt = N / 64, ntiles = nMt * nNt;
    for (int tile = blockIdx.x; tile < ntiles; tile += gridDim.x) {
        const int tm = tile % nMt, tn = tile / nMt, m0 = tm * 256 + c.wave * 32, n0 = tn * 64;
        f32x4 acc[2][4];
#pragma unroll
        for (int i = 0; i < 2; ++i)
#pragma unroll
            for (int j = 0; j < 4; ++j) acc[i][j] = (f32x4){0.f, 0.f, 0.f, 0.f};
        wave_gemm_32x64(A, lda, Bt, ldb, K, m0, n0, c.fr, c.fq, acc);
#pragma unroll
        for (int i = 0; i < 2; ++i)
#pragma unroll
            for (int j = 0; j < 4; ++j) epi(m0 + 16 * i + c.fr, n0 + 16 * j + 4 * c.fq, acc[i][j]);
    }
}

struct EpiBf16 { bf16_t* O; int ld; __device__ __forceinline__ void operator()(int row, int col, f32x4 v) const { *(u32x2*)(O + (size_t)row * ld + col) = pk4(v); } };
struct EpiKV { bf16_t* KB; bf16_t* VT;
    __device__ __forceinline__ void operator()(int row, int col, f32x4 v) const {
        if (col < 256) { *(u32x2*)(KB + (size_t)row * 256 + col) = pk4(v); }
        else { const int cc = col - 256, h = cc >> 6, d = cc & 63, b = row >> 8, key = row & 255;
#pragma unroll
            for (int j = 0; j < 4; ++j) VT[((size_t)((b * 4 + h) * 64 + d + j)) * 256 + key] = (bf16_t)f2bf(v[j]); }
    } };
struct EpiDecay { float* W; const float* w0;
    __device__ __forceinline__ void operator()(int row, int col, f32x4 v) const {
        const f32x4 z = v + *(const f32x4*)(w0 + col); f32x4 o;
#pragma unroll
        for (int j = 0; j < 4; ++j) o[j] = __expf(-0.60653065971f * sigmoidf_(z[j]));
        *(f32x4*)(W + (size_t)row * RD + col) = o; } };
struct EpiSigBias { bf16_t* O; int ld; const float* bias;
    __device__ __forceinline__ void operator()(int row, int col, f32x4 v) const {
        const f32x4 z = v + *(const f32x4*)(bias + col); f32x4 o;
#pragma unroll
        for (int j = 0; j < 4; ++j) o[j] = sigmoidf_(z[j]);
        *(u32x2*)(O + (size_t)row * ld + col) = pk4(o); } };
struct EpiPool { bf16_t* Y; const float* scale; int gi;
    __device__ __forceinline__ void operator()(int row, int col, f32x4 v) const {
        const f32x4 s = *(const f32x4*)(scale + 64 * gi + col); *(u32x2*)(Y + (size_t)row * DM + 512 + 64 * gi + col) = pk4(v * s); } };
struct EpiOut { const float* x; float* x1; bf16_t* x1b;
    __device__ __forceinline__ void operator()(int row, int col, f32x4 v) const {
        const size_t off = (size_t)row * DM + col; const f32x4 o = *(const f32x4*)(x + off) + v; *(f32x4*)(x1 + off) = o; *(u32x2*)(x1b + off) = pk4(o); } };
struct EpiFfnIn { bf16_t* U; const float* rstd; int row_base;
    __device__ __forceinline__ void operator()(int row, int col, f32x4 v) const {
        const float s = rstd[row_base + row]; const int j = col >> 8, cc = col & 255;
        const size_t off = (size_t)((cc >> 7) & 1) * ((WS_GV - WS_U) / 2) + (size_t)row * FF + 128 * j + (cc & 127); *(u32x2*)(U + off) = pk4(v * s); } };
struct EpiAddOut { float* x;
    __device__ __forceinline__ void operator()(int row, int col, f32x4 v) const { const size_t off = (size_t)row * DM + col; *(f32x4*)(x + off) = *(const f32x4*)(x + off) + v; } };

__device__ __forceinline__ void phase_mix(const Params& p, const Ctx& c) {
    unsigned char* ws = p.ws;
    const bf16_t* P = (const bf16_t*)(ws + WS_P); const float* mu = p.in[I_MU];
    bf16_t* R = (bf16_t*)(ws + WS_R); bf16_t* KR = (bf16_t*)(ws + WS_KRAW); bf16_t* V = (bf16_t*)(ws + WS_V);
    bf16_t* LW = (bf16_t*)(ws + WS_LW); bf16_t* LA = (bf16_t*)(ws + WS_LA); bf16_t* LG = (bf16_t*)(ws + WS_LG);
    for (int row = c.gw; row < MTOK; row += c.ngw) {
        const int t = row & (SEQ - 1); const bf16_t* cur = P + (size_t)row * MIXIN;
#pragma unroll
        for (int i = 0; i < 7; ++i) {
            const int col = 4 * c.lane + 256 * i;
            const f32x4 cv = unpk4(*(const u32x2*)(cur + col));
            f32x4 pv = (f32x4){0.f, 0.f, 0.f, 0.f}; if (t > 0) pv = unpk4(*(const u32x2*)(cur - MIXIN + col));
            const f32x4 m4 = *(const f32x4*)(mu + col);
            f32x4 pm = cv + (pv - cv) * m4;
            if (i < 2) *(u32x2*)(R + (size_t)row * RD + col) = pk4(pm);
            else if (i < 4) *(u32x2*)(KR + (size_t)row * RD + (col - 512)) = pk4(pm);
            else if (i < 6) *(u32x2*)(V + (size_t)row * RD + (col - 1024)) = pk4(pm);
            else {
                const int cc = col - 1536;
                if (cc < 64) { f32x4 o; o[0] = tanhf(pm[0]); o[1] = tanhf(pm[1]); o[2] = tanhf(pm[2]); o[3] = tanhf(pm[3]); *(u32x2*)(LW + (size_t)row * 64 + cc) = pk4(o); }
                else if (cc < 128) { *(u32x2*)(LA + (size_t)row * 64 + (cc - 64)) = pk4(pm); }
                else { f32x4 o; o[0] = sigmoidf_(pm[0]); o[1] = sigmoidf_(pm[1]); o[2] = sigmoidf_(pm[2]); o[3] = sigmoidf_(pm[3]); *(u32x2*)(LG + (size_t)row * 128 + (cc - 128)) = pk4(o); }
            }
        }
    }
}
__device__ __forceinline__ void phase_pooldiff(const Params& p, const Ctx& c) {
    unsigned char* ws = p.ws;
    const bf16_t* P = (const bf16_t*)(ws + WS_P); bf16_t* DP = (bf16_t*)(ws + WS_DPOOL);
    const int col = 4 * c.lane, gi = c.lane >> 4, win = 2 << gi;
    for (int row = c.gw; row < MTOK; row += c.ngw) {
        const int t = row & (SEQ - 1); const bf16_t* cur = P + (size_t)row * MIXIN + RWKVIN + col;
        const f32x4 x0 = unpk4(*(const u32x2*)cur); f32x4 s = x0;
        for (int j = 1; j < 16; ++j) if (j < win && j <= t) s += unpk4(*(const u32x2*)(cur - (size_t)j * MIXIN));
        const int cnt = (t + 1) < win ? (t + 1) : win;
        *(u32x2*)(DP + (size_t)row * 256 + col) = pk4(s * (1.0f / (float)cnt) - x0);
    }
}
__device__ __forceinline__ void phase_memattn(const Params& p, const Ctx& c) {
    unsigned char* ws = p.ws;
    const bf16_t* P = (const bf16_t*)(ws + WS_P); const bf16_t* KB = (const bf16_t*)(ws + WS_KB); const bf16_t* VT = (const bf16_t*)(ws + WS_VT); bf16_t* Y = (bf16_t*)(ws + WS_YCAT);
    const int fr = c.fr, fq = c.fq;
    for (int unit = blockIdx.x; unit < BATCH * 4 * 16; unit += gridDim.x) {
        const int qt = unit & 15, h = (unit >> 4) & 3, b = unit >> 6;
#pragma unroll 1
        for (int qg = 0; qg < 2; ++qg) {
            const int row = b * SEQ + qt * 256 + c.wave * 32 + 16 * qg + fr;
            const bf16x8 q0 = *(const bf16x8*)(P + (size_t)row * MIXIN + 2048 + h * 64 + 8 * fq), q1 = *(const bf16x8*)(P + (size_t)row * MIXIN + 2048 + h * 64 + 32 + 8 * fq);
            f32x4 sc[16];
#pragma unroll
            for (int kg = 0; kg < 16; ++kg) {
                const bf16_t* kp = KB + (size_t)(b * 256 + 16 * kg + fr) * 256 + h * 64 + 8 * fq;
                const bf16x8 k0 = *(const bf16x8*)kp, k1 = *(const bf16x8*)(kp + 32);
                f32x4 a = (f32x4){0.f, 0.f, 0.f, 0.f};
                a = __builtin_amdgcn_mfma_f32_16x16x32_bf16(k0, q0, a, 0, 0, 0); a = __builtin_amdgcn_mfma_f32_16x16x32_bf16(k1, q1, a, 0, 0, 0); sc[kg] = a;
                if ((kg & 3) == 3) asm volatile("" ::: "memory");
            }
            float m = -1e30f;
#pragma unroll
            for (int kg = 0; kg < 16; ++kg) m = fmaxf(m, fmaxf(fmaxf(sc[kg][0], sc[kg][1]), fmaxf(sc[kg][2], sc[kg][3])));
            m = fmaxf(m, __shfl_xor(m, 16)); m = fmaxf(m, __shfl_xor(m, 32));
            float l = 0.f;
#pragma unroll
            for (int kg = 0; kg < 16; ++kg)
#pragma unroll
                for (int j = 0; j < 4; ++j) { const float e = __expf((sc[kg][j] - m) * 0.125f); sc[kg][j] = e; l += e; }
            l += __shfl_xor(l, 16); l += __shfl_xor(l, 32);
            const float linv = 1.0f / l;
            f32x4 o[4];
#pragma unroll
            for (int dg = 0; dg < 4; ++dg) o[dg] = (f32x4){0.f, 0.f, 0.f, 0.f};
#pragma unroll
            for (int s = 0; s < 8; ++s) {
                u32x4 w; w.x = pk2(sc[2 * s][0], sc[2 * s][1]); w.y = pk2(sc[2 * s][2], sc[2 * s][3]); w.z = pk2(sc[2 * s + 1][0], sc[2 * s + 1][1]); w.w = pk2(sc[2 * s + 1][2], sc[2 * s + 1][3]);
                const bf16x8 pf = __builtin_bit_cast(bf16x8, w);
#pragma unroll
                for (int dg = 0; dg < 4; ++dg) {
                    const bf16_t* vp = VT + ((size_t)((b * 4 + h) * 64 + 16 * dg + fr)) * 256 + 32 * s + 4 * fq;
                    u32x4 v; const u32x2 lo = *(const u32x2*)vp, hi = *(const u32x2*)(vp + 16); v.x = lo.x; v.y = lo.y; v.z = hi.x; v.w = hi.y;
                    o[dg] = __builtin_amdgcn_mfma_f32_16x16x32_bf16(__builtin_bit_cast(bf16x8, v), pf, o[dg], 0, 0, 0);
                }
                if (s & 1) asm volatile("" ::: "memory");
            }
#pragma unroll
            for (int dg = 0; dg < 4; ++dg) *(u32x2*)(Y + (size_t)row * DM + 768 + h * 64 + 16 * dg + 4 * fq) = pk4(o[dg] * linv);
        }
    }
}

__device__ __forceinline__ void phase_prep2(const Params& p, const Ctx& c) {
    unsigned char* ws = p.ws;
    const bf16_t* KR = (const bf16_t*)(ws + WS_KRAW); const bf16_t* AA = (const bf16_t*)(ws + WS_AA); const bf16_t* R = (const bf16_t*)(ws + WS_R);
    bf16_t* KK = (bf16_t*)((unsigned char*)p.out + DO_KK); bf16_t* BB = (bf16_t*)((unsigned char*)p.out + DO_BB); bf16_t* KF = (bf16_t*)((unsigned char*)p.out + DO_KF);
    float* BON = (float*)(ws + WS_BONUS);
    for (int it = c.gw; it < MTOK * 8; it += c.ngw) {
        const int row = it >> 3, h = it & 7, col = h * 64 + c.lane; const size_t off = (size_t)row * RD + col;
        const float k = bf2f(KR[off]), a = bf2f(AA[off]), r = bf2f(R[off]);
        const float kkv = k * p.in[I_KK][col];
        const float nrm = wave_sum(kkv * kkv);
        const float kap = kkv * rsqrtf(nrm + 1e-12f);
        const float kf = k * (1.0f + (a - 1.0f) * p.in[I_KA][col]);
        const float bon = wave_sum(r * kf * p.in[I_RK][col]);
        KK[off] = (bf16_t)f2bf(kap); BB[off] = (bf16_t)f2bf(kap * a); KF[off] = (bf16_t)f2bf(kf);
        if (c.lane == 0) BON[it] = bon;
    }
}

constexpr int TC = 32;
__device__ __forceinline__ void phase_scan(const Params& p, const Ctx& c) {
    unsigned char* ws = p.ws;
    const bf16_t* KK = (const bf16_t*)((unsigned char*)p.out + DO_KK); const bf16_t* BB = (const bf16_t*)((unsigned char*)p.out + DO_BB); const bf16_t* KF = (const bf16_t*)((unsigned char*)p.out + DO_KF);
    const bf16_t* R = (const bf16_t*)(ws + WS_R); const bf16_t* V = (const bf16_t*)(ws + WS_V); const float* W = (const float*)(ws + WS_W);
    float* YR = (float*)(ws + WS_YRAW);
    constexpr int OPF = 5 * TC * 64, BUFF = OPF + TC * 16;
    LAS float* L = (LAS float*)c.lds; LAS float* YB = L + 2 * BUFF;
    const int tid = c.tid;
    for (int unit = blockIdx.x; unit < BATCH * 8 * 4; unit += gridDim.x) {
        const int q = unit & 3, h = (unit >> 2) & 7, b = unit >> 5;
        const size_t rowbase = (size_t)b * SEQ;
        const int ss = tid >> 4, g4 = (tid & 15) * 4;
        u32x2 rb[4]; f32x4 rw; unsigned short rv;
        const int vs = tid >> 4, vi = tid & 15;
        auto issue = [&](int ch) {
            const size_t ro = (rowbase + (size_t)ch * TC + ss) * RD + h * 64 + g4;
            rb[0] = *(const u32x2*)(KK + ro); rb[1] = *(const u32x2*)(KF + ro); rb[2] = *(const u32x2*)(BB + ro); rb[3] = *(const u32x2*)(R + ro);
            rw = *(const f32x4*)(W + ro);
            rv = V[(rowbase + (size_t)ch * TC + vs) * RD + h * 64 + 16 * q + vi];
        };
        auto commit = [&](int buf) {
            LAS float* B = L + buf * BUFF;
            *(LAS f32x4*)(B + (0 * TC + ss) * 64 + g4) = unpk4(rb[0]);
            *(LAS f32x4*)(B + (1 * TC + ss) * 64 + g4) = rw;
            *(LAS f32x4*)(B + (2 * TC + ss) * 64 + g4) = unpk4(rb[1]);
            *(LAS f32x4*)(B + (3 * TC + ss) * 64 + g4) = unpk4(rb[2]);
            *(LAS f32x4*)(B + (4 * TC + ss) * 64 + g4) = unpk4(rb[3]);
            B[OPF + vs * 16 + vi] = bf2f(rv);
        };
        __syncthreads();
        issue(0); commit(0);
        __syncthreads();
        f32x4 S = (f32x4){0.f, 0.f, 0.f, 0.f};
        const int vrow = (tid >> 4) & 15, kq = tid & 15;
        for (int ch = 0; ch < SEQ / TC; ++ch) {
            if (ch + 1 < SEQ / TC) issue(ch + 1);
            if (tid < 256) {
                const LAS float* B = L + (ch & 1) * BUFF;
#pragma unroll 4
                for (int s = 0; s < TC; ++s) {
                    const f32x4 kap = *(const LAS f32x4*)(B + (0 * TC + s) * 64 + 4 * kq);
                    const f32x4 w4 = *(const LAS f32x4*)(B + (1 * TC + s) * 64 + 4 * kq);
                    const f32x4 kf4 = *(const LAS f32x4*)(B + (2 * TC + s) * 64 + 4 * kq);
                    const f32x4 b4 = *(const LAS f32x4*)(B + (3 * TC + s) * 64 + 4 * kq);
                    const f32x4 r4 = *(const LAS f32x4*)(B + (4 * TC + s) * 64 + 4 * kq);
                    const float vv = B[OPF + s * 16 + vrow];
                    const float sk = row_sum16((S[0] * kap[0] + S[1] * kap[1]) + (S[2] * kap[2] + S[3] * kap[3]));
                    S = S * w4 + kf4 * vv - b4 * sk;
                    const float y = row_sum16((S[0] * r4[0] + S[1] * r4[1]) + (S[2] * r4[2] + S[3] * r4[3]));
                    if (kq == 0) YB[s * 16 + vrow] = y;
                }
            }
            __syncthreads();
            if (ch + 1 < SEQ / TC) commit((ch + 1) & 1);
            { const int s = tid >> 4, i = tid & 15; YR[(rowbase + (size_t)ch * TC + s) * RD + h * 64 + 16 * q + i] = YB[s * 16 + i]; }
            __syncthreads();
        }
    }
}

__device__ __forceinline__ void phase_post(const Params& p, const Ctx& c) {
    unsigned char* ws = p.ws;
    const float* YR = (const float*)(ws + WS_YRAW); const float* BON = (const float*)(ws + WS_BONUS);
    const bf16_t* V = (const bf16_t*)(ws + WS_V); const bf16_t* G = (const bf16_t*)(ws + WS_G); bf16_t* Y = (bf16_t*)(ws + WS_YCAT);
    for (int it = c.gw; it < MTOK * 8; it += c.ngw) {
        const int row = it >> 3, h = it & 7, col = h * 64 + c.lane; const size_t off = (size_t)row * RD + col;
        const float y = YR[off];
        const float mean = wave_sum(y) * (1.0f / 64.0f); const float d = y - mean;
        const float var = wave_sum(d * d) * (1.0f / 64.0f);
        const float yn = d * rsqrtf(var + GN_EPS) * p.in[I_LNW][col] + p.in[I_LNB][col];
        const float bon = BON[it];
        const float o = (yn + bon * bf2f(V[off])) * bf2f(G[off]);
        Y[(size_t)row * DM + col] = (bf16_t)f2bf(o);
    }
}

__device__ __forceinline__ void phase_up_simple(const Params& p, const Ctx& c) {
    unsigned char* ws = p.ws;
    const bf16_t* Y = (const bf16_t*)(ws + WS_YCAT); const bf16_t* WU = (const bf16_t*)(ws + WS_WUPT); const bf16_t* GT = (const bf16_t*)(ws + WS_GATES); bf16_t* MG = (bf16_t*)(ws + WS_MERGED);
    const int nMt = MTOK / 256, nNt = DM / 64, ntiles = nMt * nNt;
    for (int tile = blockIdx.x; tile < ntiles; tile += gridDim.x) {
        const int tm = tile % nMt, tn = tile / nMt, m0 = tm * 256 + c.wave * 32, n0 = tn * 64;
        f32x4 tot[2][4];
#pragma unroll
        for (int i = 0; i < 2; ++i)
#pragma unroll
            for (int j = 0; j < 4; ++j) tot[i][j] = (f32x4){0.f, 0.f, 0.f, 0.f};
#pragma unroll
        for (int seg = 0; seg < 3; ++seg) {
            const int koff = seg == 0 ? 0 : (seg == 1 ? 512 : 768), K = seg == 0 ? 512 : 256;
            f32x4 acc[2][4];
#pragma unroll
            for (int i = 0; i < 2; ++i)
#pragma unroll
                for (int j = 0; j < 4; ++j) acc[i][j] = (f32x4){0.f, 0.f, 0.f, 0.f};
            wave_gemm_32x64(Y + koff, DM, WU + koff, DM, K, m0, n0, c.fr, c.fq, acc);
#pragma unroll
            for (int i = 0; i < 2; ++i)
#pragma unroll
                for (int j = 0; j < 4; ++j) { const f32x4 g = unpk4(*(const u32x2*)(GT + (size_t)(m0 + 16 * i + c.fr) * (3 * DM) + seg * DM + n0 + 16 * j + 4 * c.fq)); tot[i][j] += g * acc[i][j]; }
        }
#pragma unroll
        for (int i = 0; i < 2; ++i)
#pragma unroll
            for (int j = 0; j < 4; ++j) *(u32x2*)(MG + (size_t)(m0 + 16 * i + c.fr) * DM + n0 + 16 * j + 4 * c.fq) = pk4(tot[i][j]);
    }
}

__device__ __forceinline__ void phase_rowstat(const Params& p, const Ctx& c) {
    float* RS = (float*)(p.ws + WS_RSTD2);
    for (int m = c.gw; m < MTOK; m += c.ngw) {
        const f32x4* xr = (const f32x4*)(p.out + (size_t)m * DM) + c.lane; float s = 0.f;
#pragma unroll
        for (int j = 0; j < 4; ++j) { const f32x4 v = xr[64 * j]; s += (v[0] * v[0] + v[1] * v[1]) + (v[2] * v[2] + v[3] * v[3]); }
        s = wave_sum(s);
        if (c.lane == 0) RS[m] = rsqrtf(s * (1.f / DM) + NORM_EPS);
    }
}
__device__ __forceinline__ void phase_ffn_act(const Params& p, const Ctx& c, int half) {
    unsigned char* ws = p.ws;
    const bf16_t* U = (const bf16_t*)(ws + WS_U); const bf16_t* GV = (const bf16_t*)(ws + WS_GV); bf16_t* ACT = (bf16_t*)(ws + WS_ACT) + (size_t)half * (MTOK / 2) * FF;
    const float* cw = p.in[I_CONVW]; const float* cb = p.in[I_CONVB];
    const int ngrp = (MTOK / 2) * (FF / 4);
    for (int idx = blockIdx.x * NTHREADS + c.tid; idx < ngrp; idx += gridDim.x * NTHREADS) {
        const int row = idx / (FF / 4), col = 4 * (idx % (FF / 4)), t = row & (SEQ - 1); const size_t off = (size_t)row * FF + col;
        const f32x4 u0 = unpk4(*(const u32x2*)(U + off));
        f32x4 u1 = (f32x4){0.f, 0.f, 0.f, 0.f}, u2 = u1;
        if (t >= 1) u1 = unpk4(*(const u32x2*)(U + off - FF));
        if (t >= 2) u2 = unpk4(*(const u32x2*)(U + off - 2 * FF));
        const f32x4 g = unpk4(*(const u32x2*)(GV + off));
        const f32x4 uc = *(const f32x4*)(cw + col) * u2 + *(const f32x4*)(cw + FF + col) * u1 + *(const f32x4*)(cw + 2 * FF + col) * u0 + *(const f32x4*)(cb + col);
        f32x4 o;
#pragma unroll
        for (int j = 0; j < 4; ++j) o[j] = 0.5f * uc[j] * (1.0f + erff(uc[j] * 0.70710678118f)) * g[j];
        *(u32x2*)(ACT + off) = pk4(o);
    }
}
__device__ __forceinline__ void phase_final_norm(const Params& p, const Ctx& c) {
    const float* g = p.in[I_NFING];
    for (int m = c.gw; m < MTOK; m += c.ngw) {
        f32x4* xr = (f32x4*)(p.out + (size_t)m * DM) + c.lane; const f32x4* gr = (const f32x4*)g + c.lane;
        f32x4 v[4]; float s = 0.f;
#pragma unroll
        for (int j = 0; j < 4; ++j) { v[j] = xr[64 * j]; s += (v[j][0] * v[j][0] + v[j][1] * v[j][1]) + (v[j][2] * v[j][2] + v[j][3] * v[j][3]); }
        const float rstd = rsqrtf(wave_sum(s) * (1.f / DM) + NORM_EPS);
#pragma unroll
        for (int j = 0; j < 4; ++j) xr[64 * j] = v[j] * rstd * gr[64 * j];
    }
}

constexpr int NPHASES = 17;
__global__ void __launch_bounds__(NTHREADS, 2) fwd_kernel(Params p) {
    extern __shared__ __attribute__((aligned(16))) unsigned char lds_raw[];
    Ctx c; c.tid = threadIdx.x; c.lane = c.tid & 63; c.wave = __builtin_amdgcn_readfirstlane(c.tid >> 6); c.fr = c.lane & 15; c.fq = c.lane >> 4;
    c.gw = blockIdx.x * NWAVES + c.wave; c.ngw = gridDim.x * NWAVES; c.lds = (LAS unsigned char*)lds_raw;
    unsigned char* ws = p.ws;
#if ONE_LAUNCH
    cg::grid_group grid = cg::this_grid();
#define SEAM() grid.sync()
#else
#define SEAM() do {} while (0)
#endif
#define IN(k) (p.ph_lo <= (k) && (k) < p.ph_hi)
#define END(k) do { if (IN((k) + 1)) SEAM(); } while (0)
    if (IN(0)) { phase_prologue(p, c); END(0); }
    if (IN(1)) {
        gemm_simple(c, (const bf16_t*)(ws + WS_H), DM, (const bf16_t*)(ws + WS_WG1T), DM, MTOK, MIXIN, DM, EpiBf16{(bf16_t*)(ws + WS_P), MIXIN});
        gemm_simple(c, (const bf16_t*)(ws + WS_MEMN), DM, (const bf16_t*)(ws + WS_WKVT), DM, BATCH * NMEM, 512, DM, EpiKV{(bf16_t*)(ws + WS_KB), (bf16_t*)(ws + WS_VT)});
        END(1); }
    if (IN(2)) { phase_mix(p, c); phase_pooldiff(p, c); phase_memattn(p, c); END(2); }
    if (IN(3)) {
        gemm_simple(c, (const bf16_t*)(ws + WS_LW), 64, (const bf16_t*)(ws + WS_WLWT), 64, MTOK, RD, 64, EpiDecay{(float*)(ws + WS_W), p.in[I_W0]});
        gemm_simple(c, (const bf16_t*)(ws + WS_LA), 64, (const bf16_t*)(ws + WS_WLAT), 64, MTOK, RD, 64, EpiSigBias{(bf16_t*)(ws + WS_AA), RD, p.in[I_A0]});
        gemm_simple(c, (const bf16_t*)(ws + WS_LG), 128, (const bf16_t*)(ws + WS_WLGT), 128, MTOK, RD, 128, EpiBf16{(bf16_t*)(ws + WS_G), RD});
#pragma unroll 1
        for (int gi = 0; gi < 4; ++gi)
            gemm_simple(c, (const bf16_t*)(ws + WS_DPOOL) + 64 * gi, 256, (const bf16_t*)(ws + WS_WPT) + 4096 * gi, 64, MTOK, 64, 64, EpiPool{(bf16_t*)(ws + WS_YCAT), p.in[I_POOLS], gi});
        END(3); }
    if (IN(4)) { phase_prep2(p, c); END(4); }
    if (IN(5)) { phase_scan(p, c); END(5); }
    if (IN(6)) { phase_post(p, c); END(6); }
    if (IN(7)) {
        gemm_simple(c, (const bf16_t*)(ws + WS_H), DM, (const bf16_t*)(ws + WS_WG1T) + (size_t)MIXIN * DM, DM, MTOK, 3 * DM, DM, EpiSigBias{(bf16_t*)(ws + WS_GATES), 3 * DM, p.in[I_BGATE]});
        END(7); }
    if (IN(8)) { phase_up_simple(p, c); END(8); }
    if (IN(9)) {
        gemm_simple(c, (const bf16_t*)(ws + WS_MERGED), DM, (const bf16_t*)(ws + WS_WOT), DM, MTOK, DM, DM, EpiOut{p.in[I_X], p.out, (bf16_t*)(ws + WS_X1B)});
        END(9); }
    if (IN(10)) { phase_rowstat(p, c); END(10); }
#pragma unroll 1
    for (int half = 0; half < 2; ++half) {
        if (IN(11 + 2 * half)) {
            gemm_simple(c, (const bf16_t*)(ws + WS_X1B) + (size_t)half * (MTOK / 2) * DM, DM, (const bf16_t*)(ws + WS_WF1T), DM, MTOK / 2, 2 * FF, DM,
                        EpiFfnIn{(bf16_t*)(ws + WS_U), (const float*)(ws + WS_RSTD2), half * (MTOK / 2)});
            END(11 + 2 * half); }
        if (IN(12 + 2 * half)) { phase_ffn_act(p, c, half); END(12 + 2 * half); }
    }
    if (IN(15)) {
        gemm_simple(c, (const bf16_t*)(ws + WS_ACT), FF, (const bf16_t*)(ws + WS_WF2T), FF, MTOK, DM, FF, EpiAddOut{p.out});
        END(15); }
    if (IN(16)) { phase_final_norm(p, c); }
#undef IN
#undef END
}

__global__ void nan_fill(float* o, int n) { const int i = blockIdx.x * blockDim.x + threadIdx.x; if (i < n) o[i] = __builtin_nanf(""); }

extern "C" void kernel_launch(void* const* d_in, const int* in_sizes, int n_in, void* d_out, int out_size, void* d_ws, size_t ws_size, hipStream_t stream) {
    static int grid = 0;
    if (grid == 0) {
        int dev = 0, cus = 0, per_cu = 0;
        if (hipGetDevice(&dev) != hipSuccess || hipDeviceGetAttribute(&cus, hipDeviceAttributeMultiprocessorCount, dev) != hipSuccess) cus = 256;
        (void)hipFuncSetAttribute((const void*)fwd_kernel, hipFuncAttributeMaxDynamicSharedMemorySize, LDS_BYTES);
        if (hipOccupancyMaxActiveBlocksPerMultiprocessor(&per_cu, (const void*)fwd_kernel, NTHREADS, LDS_BYTES) != hipSuccess || per_cu < 1) per_cu = 1;
        (void)hipGetLastError();
        grid = cus;
        if (n_in != 31 || out_size != MTOK * DM || ws_size < WS_END) grid = -1;
    }
    if (grid < 0) { nan_fill<<<(out_size + 255) / 256, 256, 0, stream>>>((float*)d_out, out_size); return; }
    Params p{};
    for (int i = 0; i < 31; ++i) p.in[i] = (const float*)d_in[i];
    p.out = (float*)d_out; p.ws = (unsigned char*)d_ws;
#if ONE_LAUNCH
    p.ph_lo = 0; p.ph_hi = NPHASES;
    void* args[] = {&p};
    hipError_t e = hipLaunchCooperativeKernel((const void*)fwd_kernel, dim3(grid), dim3(NTHREADS), args, LDS_BYTES, stream);
    if (e != hipSuccess) fprintf(stderr, "cooperative launch failed: %s (grid %d)\n", hipGetErrorString(e), grid);
#else
    for (int ph = 0; ph < NPHASES; ++ph) { p.ph_lo = ph; p.ph_hi = ph + 1; hipLaunchKernelGGL(fwd_kernel, dim3(grid), dim3(NTHREADS), LDS_BYTES, stream, p); }
#endif
}
```

```cpp
#include <hip/hip_runtime.h>
#include <hip/hip_cooperative_groups.h>
#include <cstdio>
#include <cstdint>
namespace cg = cooperative_groups;

#ifndef ONE_LAUNCH
#define ONE_LAUNCH 1
#endif
#ifndef PH_MASK
#define PH_MASK 0xFFFFFFFFu
#endif
#define PH_ON(k) ((PH_MASK >> (k)) & 1u)

#define LAS __attribute__((address_space(3)))
typedef unsigned short bf16_t;
typedef short bf16x8 __attribute__((ext_vector_type(8)));
typedef float f32x4 __attribute__((ext_vector_type(4)));
typedef float f32x2 __attribute__((ext_vector_type(2)));
typedef unsigned u32x4 __attribute__((ext_vector_type(4)));
typedef unsigned u32x2 __attribute__((ext_vector_type(2)));

constexpr int BATCH = 8, SEQ = 4096, DM = 1024, MTOK = BATCH * SEQ;
constexpr int NMEM = 256, RD = 512, MIXIN = 2304, RWKVIN = 1792, FF = 2816, NG1 = MIXIN + 3 * DM;
constexpr int NWAVES = 8, NTHREADS = 512;
constexpr float NORM_EPS = 1e-6f, GN_EPS = 64e-5f;

constexpr size_t MiB = 1u << 20;
constexpr size_t WS_WG1T = 1 * MiB;
constexpr size_t WS_WKVT = WS_WG1T + (size_t)NG1 * DM * 2;
constexpr size_t WS_WUPT = WS_WKVT + (size_t)512 * DM * 2;
constexpr size_t WS_WOT = WS_WUPT + (size_t)DM * DM * 2;
constexpr size_t WS_WF1T = WS_WOT + (size_t)DM * DM * 2;
constexpr size_t WS_WF2T = WS_WF1T + (size_t)2 * FF * DM * 2;
constexpr size_t WS_WLWT = WS_WF2T + (size_t)DM * FF * 2;
constexpr size_t WS_WLAT = WS_WLWT + (size_t)RD * 64 * 2;
constexpr size_t WS_WLGT = WS_WLAT + (size_t)RD * 64 * 2;
constexpr size_t WS_WPT = WS_WLGT + (size_t)RD * 128 * 2;
constexpr size_t WS_WEND = WS_WPT + (size_t)4 * 64 * 64 * 2;
static_assert(WS_WEND <= 34 * MiB, "weights region");
constexpr size_t WS_BONUS = 34 * MiB;
constexpr size_t WS_RSTD2 = 35 * MiB;
constexpr size_t WS_KB = 36 * MiB;
constexpr size_t WS_VT = 37 * MiB;
constexpr size_t WS_MEMN = 38 * MiB;
constexpr size_t WS_H = 42 * MiB;
constexpr size_t WS_YCAT = 106 * MiB;
constexpr size_t WS_P = 170 * MiB;
constexpr size_t WS_W = 170 * MiB;
constexpr size_t WS_G = 234 * MiB;
constexpr size_t WS_AA = 266 * MiB;
constexpr size_t WS_KRAW = 314 * MiB;
constexpr size_t WS_YRAW = 266 * MiB;
constexpr size_t WS_R = 346 * MiB;
constexpr size_t WS_V = 378 * MiB;
constexpr size_t WS_LW = 410 * MiB;
constexpr size_t WS_LA = 414 * MiB;
constexpr size_t WS_LG = 418 * MiB;
constexpr size_t WS_DPOOL = 426 * MiB;
constexpr size_t WS_GATES = 170 * MiB;
constexpr size_t WS_MERGED = 362 * MiB;
constexpr size_t WS_X1B = 426 * MiB;
constexpr size_t WS_U = 42 * MiB;
constexpr size_t WS_GV = 130 * MiB;
constexpr size_t WS_ACT = 218 * MiB;
constexpr size_t WS_END = 490 * MiB;
constexpr size_t DO_KK = 0, DO_BB = 32 * MiB, DO_KF = 64 * MiB;

constexpr int LDS_BYTES = 147456;

__device__ __forceinline__ unsigned f2bf(float f) { unsigned u = __float_as_uint(f); return (u + 0x7fffu + ((u >> 16) & 1u)) >> 16; }
__device__ __forceinline__ float bf2f(unsigned h) { return __uint_as_float(h << 16); }
__device__ __forceinline__ unsigned pk2(float lo, float hi) { return f2bf(lo) | (f2bf(hi) << 16); }
__device__ __forceinline__ u32x2 pk4(f32x4 v) { u32x2 r; r.x = pk2(v[0], v[1]); r.y = pk2(v[2], v[3]); return r; }
__device__ __forceinline__ f32x4 unpk4(u32x2 u) { f32x4 r; r[0] = bf2f(u.x & 0xffffu); r[1] = bf2f(u.x >> 16); r[2] = bf2f(u.y & 0xffffu); r[3] = bf2f(u.y >> 16); return r; }
__device__ __forceinline__ float wave_sum(float v) {
#pragma unroll
    for (int o = 1; o < 64; o <<= 1) v += __shfl_xor(v, o);
    return v;
}
__device__ __forceinline__ float sigmoidf_(float x) { return 1.0f / (1.0f + __expf(-x)); }
template <int CTRL> __device__ __forceinline__ float dpp_f(float x) { return __builtin_bit_cast(float, __builtin_amdgcn_update_dpp(0, __builtin_bit_cast(int, x), CTRL, 0xF, 0xF, false)); }
__device__ __forceinline__ float row_sum16(float x) {
    x += dpp_f<0xB1>(x);
    x += dpp_f<0x4E>(x);
    x += dpp_f<0x141>(x);
    x += dpp_f<0x140>(x);
    return x;
}

struct Params { const float* in[31]; float* out; unsigned char* ws; int ph_lo, ph_hi; };
enum { I_X = 0, I_MEM, I_NMIXG, I_WINMIX, I_MU, I_W0, I_WLORAB, I_A0, I_ALORAB, I_GLORAB, I_KK, I_KA, I_RK, I_LNW, I_LNB, I_POOLW, I_POOLS, I_NMEMG, I_WMEMKV,
       I_WUPR, I_WUPP, I_WUPM, I_WGATE, I_BGATE, I_WO, I_NFFNG, I_WFFNIN, I_CONVW, I_CONVB, I_WFFNOUT, I_NFING };

struct Ctx { int tid, lane, wave, fr, fq, gw, ngw; LAS unsigned char* lds; };

__device__ __forceinline__ int rowmap(int mode, int n) {
    if (mode == 0) return n;
    const int half = n >= FF ? 1 : 0, c = n - half * FF;
    return (c >> 7) * 256 + half * 128 + (c & 127);
}
__device__ __forceinline__ void transpose_item(const float* W, int K, int N, bf16_t* WT, int ldd, int koff, int mode, const float* kscale, LAS float* scr, int item, int lane) {
    const int nblk = N / 32, kb = item / nblk, nb = item % nblk, k0 = 64 * kb, n0 = 32 * nb;
#pragma unroll 8
    for (int i = 0; i < 32; ++i) { const int kk = 2 * i + (lane >> 5); float v = W[(size_t)(k0 + kk) * N + n0 + (lane & 31)]; if (kscale) v *= kscale[k0 + kk]; scr[kk * 33 + (lane & 31)] = v; }
    asm volatile("s_waitcnt lgkmcnt(0)" ::: "memory");
    const int c = lane & 7;
#pragma unroll
    for (int j = 0; j < 4; ++j) { const int n = (lane >> 3) + 8 * j; const LAS float* s = scr + (8 * c) * 33 + n;
        u32x4 o; o.x = pk2(s[0 * 33], s[1 * 33]); o.y = pk2(s[2 * 33], s[3 * 33]); o.z = pk2(s[4 * 33], s[5 * 33]); o.w = pk2(s[6 * 33], s[7 * 33]);
        *(u32x4*)(WT + (size_t)rowmap(mode, n0 + n) * ldd + koff + k0 + 8 * c) = o; }
    asm volatile("s_waitcnt lgkmcnt(0)" ::: "memory");
}
__device__ __forceinline__ void rmsnorm_row_bf16(const float* xrow, const float* g, bf16_t* orow, int lane) {
    const f32x4* xr = (const f32x4*)xrow + lane; const f32x4* gr = (const f32x4*)g + lane;
    f32x4 v[4]; float s = 0.f;
#pragma unroll
    for (int j = 0; j < 4; ++j) { v[j] = xr[64 * j]; s += (v[j][0] * v[j][0] + v[j][1] * v[j][1]) + (v[j][2] * v[j][2] + v[j][3] * v[j][3]); }
    const float rstd = rsqrtf(wave_sum(s) * (1.f / DM) + NORM_EPS);
    u32x2* o = (u32x2*)orow + lane;
#pragma unroll
    for (int j = 0; j < 4; ++j) { const f32x4 gg = gr[64 * j]; o[64 * j] = pk4(v[j] * rstd * gg); }
}

__device__ __forceinline__ void phase_prologue(const Params& p, const Ctx& c) {
    LAS float* scr = (LAS float*)(c.lds + c.wave * 16384);
    unsigned char* ws = p.ws;
#define TR(Wp, K_, N_, WTp, ldd_, koff_, mode_, sc_) { const int ni_ = ((K_) / 64) * ((N_) / 32); if (r < ni_) { transpose_item(Wp, K_, N_, (bf16_t*)(WTp), ldd_, koff_, mode_, sc_, scr, r, c.lane); continue; } r -= ni_; }
    constexpr int NIT = (DM / 64) * (MIXIN / 32) + (DM / 64) * (3 * DM / 32) + (DM / 64) * (512 / 32) + (512 / 64) * (DM / 32) + 2 * (256 / 64) * (DM / 32) + (DM / 64) * (DM / 32)
                      + (DM / 64) * (2 * FF / 32) + (FF / 64) * (DM / 32) + 2 * (RD / 32) + 2 * (RD / 32) + 4 * 2;
    for (int it = c.gw; it < NIT; it += c.ngw) {
        int r = it;
        TR(p.in[I_WINMIX], DM, MIXIN, ws + WS_WG1T, DM, 0, 0, nullptr)
        TR(p.in[I_WGATE], DM, 3 * DM, ws + WS_WG1T + (size_t)MIXIN * DM * 2, DM, 0, 0, nullptr)
        TR(p.in[I_WMEMKV], DM, 512, ws + WS_WKVT, DM, 0, 0, nullptr)
        TR(p.in[I_WUPR], 512, DM, ws + WS_WUPT, DM, 0, 0, nullptr)
        TR(p.in[I_WUPP], 256, DM, ws + WS_WUPT, DM, 512, 0, nullptr)
        TR(p.in[I_WUPM], 256, DM, ws + WS_WUPT, DM, 768, 0, nullptr)
        TR(p.in[I_WO], DM, DM, ws + WS_WOT, DM, 0, 0, nullptr)
        TR(p.in[I_WFFNIN], DM, 2 * FF, ws + WS_WF1T, DM, 0, 1, p.in[I_NFFNG])
        TR(p.in[I_WFFNOUT], FF, DM, ws + WS_WF2T, FF, 0, 0, nullptr)
        TR(p.in[I_WLORAB], 64, RD, ws + WS_WLWT, 64, 0, 0, nullptr)
        TR(p.in[I_ALORAB], 64, RD, ws + WS_WLAT, 64, 0, 0, nullptr)
        TR(p.in[I_GLORAB], 128, RD, ws + WS_WLGT, 128, 0, 0, nullptr)
        TR(p.in[I_POOLW] + 0 * 4096, 64, 64, ws + WS_WPT + 0 * 8192, 64, 0, 0, nullptr)
        TR(p.in[I_POOLW] + 1 * 4096, 64, 64, ws + WS_WPT + 1 * 8192, 64, 0, 0, nullptr)
        TR(p.in[I_POOLW] + 2 * 4096, 64, 64, ws + WS_WPT + 2 * 8192, 64, 0, 0, nullptr)
        TR(p.in[I_POOLW] + 3 * 4096, 64, 64, ws + WS_WPT + 3 * 8192, 64, 0, 0, nullptr)
    }
#undef TR
    for (int m = c.gw; m < MTOK; m += c.ngw) rmsnorm_row_bf16(p.in[I_X] + (size_t)m * DM, p.in[I_NMIXG], (bf16_t*)(ws + WS_H) + (size_t)m * DM, c.lane);
    for (int m = c.gw; m < BATCH * NMEM; m += c.ngw) rmsnorm_row_bf16(p.in[I_MEM] + (size_t)m * DM, p.in[I_NMEMG], (bf16_t*)(ws + WS_MEMN) + (size_t)m * DM, c.lane);
}

__device__ __forceinline__ void wave_gemm_32x64(const bf16_t* A, int lda, const bf16_t* Bt, int ldb, int K, int m0, int n0, int fr, int fq, f32x4 (&acc)[2][4]) {
    const bf16_t* ap = A + (size_t)(m0 + fr) * lda + 8 * fq;
    const bf16_t* bp = Bt + (size_t)(n0 + fr) * ldb + 8 * fq;
    for (int k0 = 0; k0 < K; k0 += 32) {
        const bf16x8 a0 = *(const bf16x8*)(ap + k0), a1 = *(const bf16x8*)(ap + (size_t)16 * lda + k0);
        bf16x8 b[4];
#pragma unroll
        for (int j = 0; j < 4; ++j) b[j] = *(const bf16x8*)(bp + (size_t)(16 * j) * ldb + k0);
#pragma unroll
        for (int j = 0; j < 4; ++j) { acc[0][j] = __builtin_amdgcn_mfma_f32_16x16x32_bf16(b[j], a0, acc[0][j], 0, 0, 0); acc[1][j] = __builtin_amdgcn_mfma_f32_16x16x32_bf16(b[j], a1, acc[1][j], 0, 0, 0); }
    }
}
template <class Epi>
__device__ __forceinline__ void gemm_simple(const Ctx& c, const bf16_t* A, int lda, const bf16_t* Bt, int ldb, int M, int N, int K, const Epi& epi) {
    const int nMt = M / 256, nNt = N / 64, ntiles = nMt * nNt;
    for (int tile = blockIdx.x; tile < ntiles; tile += gridDim.x) {
        const int tm = tile % nMt, tn = tile / nMt, m0 = tm * 256 + c.wave * 32, n0 = tn * 64;
        f32x4 acc[2][4];
#pragma unroll
        for (int i = 0; i < 2; ++i)
#pragma unroll
            for (int j = 0; j < 4; ++j) acc[i][j] = (f32x4){0.f, 0.f, 0.f, 0.f};
        wave_gemm_32x64(A, lda, Bt, ldb, K, m0, n0, c.fr, c.fq, acc);
#pragma unroll
        for (int i = 0; i < 2; ++i)
#pragma unroll
            for (int j = 0; j < 4; ++j) epi(m0 + 16 * i + c.fr, n0 + 16 * j + 4 * c.fq, acc[i][j]);
    }
}

struct EpiBf16 { bf16_t* O; int ld; __device__ __forceinline__ void operator()(int row, int col, f32x4 v) const { *(u32x2*)(O + (size_t)row * ld + col) = pk4(v); } };
struct EpiKV { bf16_t* KB; bf16_t* VT;
    __device__ __forceinline__ void operator()(int row, int col, f32x4 v) const {
        if (col < 256) { *(u32x2*)(KB + (size_t)row * 256 + col) = pk4(v); }
        else { const int cc = col - 256, h = cc >> 6, d = cc & 63, b = row >> 8, key = row & 255;
#pragma unroll
            for (int j = 0; j < 4; ++j) VT[((size_t)((b * 4 + h) * 64 + d + j)) * 256 + key] = (bf16_t)f2bf(v[j]); }
    } };
struct EpiDecay { float* W; const float* w0;
    __device__ __forceinline__ void operator()(int row, int col, f32x4 v) const {
        const f32x4 z = v + *(const f32x4*)(w0 + col); f32x4 o;
#pragma unroll
        for (int j = 0; j < 4; ++j) o[j] = __expf(-0.60653065971f * sigmoidf_(z[j]));
        *(f32x4*)(W + (size_t)row * RD + col) = o; } };
struct EpiSigBias { bf16_t* O; int ld; const float* bias;
    __device__ __forceinline__ void operator()(int row, int col, f32x4 v) const {
        const f32x4 z = v + *(const f32x4*)(bias + col); f32x4 o;
#pragma unroll
        for (int j = 0; j < 4; ++j) o[j] = sigmoidf_(z[j]);
        *(u32x2*)(O + (size_t)row * ld + col) = pk4(o); } };
struct EpiPool { bf16_t* Y; const float* scale; int gi;
    __device__ __forceinline__ void operator()(int row, int col, f32x4 v) const {
        const f32x4 s = *(const f32x4*)(scale + 64 * gi + col); *(u32x2*)(Y + (size_t)row * DM + 512 + 64 * gi + col) = pk4(v * s); } };
struct EpiOut { const float* x; float* x1; bf16_t* x1b;
    __device__ __forceinline__ void operator()(int row, int col, f32x4 v) const {
        const size_t off = (size_t)row * DM + col; const f32x4 o = *(const f32x4*)(x + off) + v; *(f32x4*)(x1 + off) = o; *(u32x2*)(x1b + off) = pk4(o); } };
struct EpiFfnIn { bf16_t* U; const float* rstd; int row_base;
    __device__ __forceinline__ void operator()(int row, int col, f32x4 v) const {
        const float s = rstd[row_base + row]; const int j = col >> 8, cc = col & 255;
        const size_t off = (size_t)((cc >> 7) & 1) * ((WS_GV - WS_U) / 2) + (size_t)row * FF + 128 * j + (cc & 127); *(u32x2*)(U + off) = pk4(v * s); } };
struct EpiAddOut { float* x;
    __device__ __forceinline__ void operator()(int row, int col, f32x4 v) const { const size_t off = (size_t)row * DM + col; *(f32x4*)(x + off) = *(const f32x4*)(x + off) + v; } };

__device__ __forceinline__ void phase_mix(const Params& p, const Ctx& c) {
    unsigned char* ws = p.ws;
    const bf16_t* P = (const bf16_t*)(ws + WS_P); const float* mu = p.in[I_MU];
    bf16_t* R = (bf16_t*)(ws + WS_R); bf16_t* KR = (bf16_t*)(ws + WS_KRAW); bf16_t* V = (bf16_t*)(ws + WS_V);
    bf16_t* LW = (bf16_t*)(ws + WS_LW); bf16_t* LA = (bf16_t*)(ws + WS_LA); bf16_t* LG = (bf16_t*)(ws + WS_LG);
    for (int row = c.gw; row < MTOK; row += c.ngw) {
        const int t = row & (SEQ - 1); const bf16_t* cur = P + (size_t)row * MIXIN;
#pragma unroll
        for (int i = 0; i < 7; ++i) {
            const int col = 4 * c.lane + 256 * i;
            const f32x4 cv = unpk4(*(const u32x2*)(cur + col));
            f32x4 pv = (f32x4){0.f, 0.f, 0.f, 0.f}; if (t > 0) pv = unpk4(*(const u32x2*)(cur - MIXIN + col));
            const f32x4 m4 = *(const f32x4*)(mu + col);
            f32x4 pm = cv + (pv - cv) * m4;
            if (i < 2) *(u32x2*)(R + (size_t)row * RD + col) = pk4(pm);
            else if (i < 4) *(u32x2*)(KR + (size_t)row * RD + (col - 512)) = pk4(pm);
            else if (i < 6) *(u32x2*)(V + (size_t)row * RD + (col - 1024)) = pk4(pm);
            else {
                const int cc = col - 1536;
                if (cc < 64) { f32x4 o; o[0] = tanhf(pm[0]); o[1] = tanhf(pm[1]); o[2] = tanhf(pm[2]); o[3] = tanhf(pm[3]); *(u32x2*)(LW + (size_t)row * 64 + cc) = pk4(o); }
                else if (cc < 128) { *(u32x2*)(LA + (size_t)row * 64 + (cc - 64)) = pk4(pm); }
                else { f32x4 o; o[0] = sigmoidf_(pm[0]); o[1] = sigmoidf_(pm[1]); o[2] = sigmoidf_(pm[2]); o[3] = sigmoidf_(pm[3]); *(u32x2*)(LG + (size_t)row * 128 + (cc - 128)) = pk4(o); }
            }
        }
    }
}
__device__ __forceinline__ void phase_pooldiff(const Params& p, const Ctx& c) {
    unsigned char* ws = p.ws;
    const bf16_t* P = (const bf16_t*)(ws + WS_P); bf16_t* DP = (bf16_t*)(ws + WS_DPOOL);
    const int col = 4 * c.lane, gi = c.lane >> 4, win = 2 << gi;
    for (int row = c.gw; row < MTOK; row += c.ngw) {
        const int t = row & (SEQ - 1); const bf16_t* cur = P + (size_t)row * MIXIN + RWKVIN + col;
        const f32x4 x0 = unpk4(*(const u32x2*)cur); f32x4 s = x0;
        for (int j = 1; j < 16; ++j) if (j < win && j <= t) s += unpk4(*(const u32x2*)(cur - (size_t)j * MIXIN));
        const int cnt = (t + 1) < win ? (t + 1) : win;
        *(u32x2*)(DP + (size_t)row * 256 + col) = pk4(s * (1.0f / (float)cnt) - x0);
    }
}
__device__ __forceinline__ void phase_memattn(const Params& p, const Ctx& c) {
    unsigned char* ws = p.ws;
    const bf16_t* P = (const bf16_t*)(ws + WS_P); const bf16_t* KB = (const bf16_t*)(ws + WS_KB); const bf16_t* VT = (const bf16_t*)(ws + WS_VT); bf16_t* Y = (bf16_t*)(ws + WS_YCAT);
    const int fr = c.fr, fq = c.fq;
    for (int unit = blockIdx.x; unit < BATCH * 4 * 16; unit += gridDim.x) {
        const int qt = unit & 15, h = (unit >> 4) & 3, b = unit >> 6;
#pragma unroll 1
        for (int qg = 0; qg < 2; ++qg) {
            const int row = b * SEQ + qt * 256 + c.wave * 32 + 16 * qg + fr;
            const bf16x8 q0 = *(const bf16x8*)(P + (size_t)row * MIXIN + 2048 + h * 64 + 8 * fq), q1 = *(const bf16x8*)(P + (size_t)row * MIXIN + 2048 + h * 64 + 32 + 8 * fq);
            f32x4 sc[16];
#pragma unroll
            for (int kg = 0; kg < 16; ++kg) {
                const bf16_t* kp = KB + (size_t)(b * 256 + 16 * kg + fr) * 256 + h * 64 + 8 * fq;
                const bf16x8 k0 = *(const bf16x8*)kp, k1 = *(const bf16x8*)(kp + 32);
                f32x4 a = (f32x4){0.f, 0.f, 0.f, 0.f};
                a = __builtin_amdgcn_mfma_f32_16x16x32_bf16(k0, q0, a, 0, 0, 0); a = __builtin_amdgcn_mfma_f32_16x16x32_bf16(k1, q1, a, 0, 0, 0); sc[kg] = a;
                if ((kg & 3) == 3) asm volatile("" ::: "memory");
            }
            float m = -1e30f;
#pragma unroll
            for (int kg = 0; kg < 16; ++kg) m = fmaxf(m, fmaxf(fmaxf(sc[kg][0], sc[kg][1]), fmaxf(sc[kg][2], sc[kg][3])));
            m = fmaxf(m, __shfl_xor(m, 16)); m = fmaxf(m, __shfl_xor(m, 32));
            float l = 0.f;
#pragma unroll
            for (int kg = 0; kg < 16; ++kg)
#pragma unroll
                for (int j = 0; j < 4; ++j) { const float e = __expf((sc[kg][j] - m) * 0.125f); sc[kg][j] = e; l += e; }
            l += __shfl_xor(l, 16); l += __shfl_xor(l, 32);
            const float linv = 1.0f / l;
            f32x4 o[4];
#pragma unroll
            for (int dg = 0; dg < 4; ++dg) o[dg] = (f32x4){0.f, 0.f, 0.f, 0.f};
#pragma unroll
            for (int s = 0; s < 8; ++s) {
                u32x4 w; w.x = pk2(sc[2 * s][0], sc[2 * s][1]); w.y = pk2(sc[2 * s][2], sc[2 * s][3]); w.z = pk2(sc[2 * s + 1][0], sc[2 * s + 1][1]); w.w = pk2(sc[2 * s + 1][2], sc[2 * s + 1][3]);
                const bf16x8 pf = __builtin_bit_cast(bf16x8, w);
#pragma unroll
                for (int dg = 0; dg < 4; ++dg) {
                    const bf16_t* vp = VT + ((size_t)((b * 4 + h) * 64 + 16 * dg + fr)) * 256 + 32 * s + 4 * fq;
                    u32x4 v; const u32x2 lo = *(const u32x2*)vp, hi = *(const u32x2*)(vp + 16); v.x = lo.x; v.y = lo.y; v.z = hi.x; v.w = hi.y;
                    o[dg] = __builtin_amdgcn_mfma_f32_16x16x32_bf16(__builtin_bit_cast(bf16x8, v), pf, o[dg], 0, 0, 0);
                }
                if (s & 1) asm volatile("" ::: "memory");
            }
#pragma unroll
            for (int dg = 0; dg < 4; ++dg) *(u32x2*)(Y + (size_t)row * DM + 768 + h * 64 + 16 * dg + 4 * fq) = pk4(o[dg] * linv);
        }
    }
}

__device__ __forceinline__ void phase_prep2(const Params& p, const Ctx& c) {
    unsigned char* ws = p.ws;
    const bf16_t* KR = (const bf16_t*)(ws + WS_KRAW); const bf16_t* AA = (const bf16_t*)(ws + WS_AA); const bf16_t* R = (const bf16_t*)(ws + WS_R);
    bf16_t* KK = (bf16_t*)((unsigned char*)p.out + DO_KK); bf16_t* BB = (bf16_t*)((unsigned char*)p.out + DO_BB); bf16_t* KF = (bf16_t*)((unsigned char*)p.out + DO_KF);
    float* BON = (float*)(ws + WS_BONUS);
    for (int it = c.gw; it < MTOK * 8; it += c.ngw) {
        const int row = it >> 3, h = it & 7, col = h * 64 + c.lane; const size_t off = (size_t)row * RD + col;
        const float k = bf2f(KR[off]), a = bf2f(AA[off]), r = bf2f(R[off]);
        const float kkv = k * p.in[I_KK][col];
        const float nrm = wave_sum(kkv * kkv);
        const float kap = kkv * rsqrtf(nrm + 1e-12f);
        const float kf = k * (1.0f + (a - 1.0f) * p.in[I_KA][col]);
        const float bon = wave_sum(r * kf * p.in[I_RK][col]);
        KK[off] = (bf16_t)f2bf(kap); BB[off] = (bf16_t)f2bf(kap * a); KF[off] = (bf16_t)f2bf(kf);
        if (c.lane == 0) BON[it] = bon;
    }
}

constexpr int TC = 32;
__device__ __forceinline__ void phase_scan(const Params& p, const Ctx& c) {
    unsigned char* ws = p.ws;
    const bf16_t* KK = (const bf16_t*)((unsigned char*)p.out + DO_KK); const bf16_t* BB = (const bf16_t*)((unsigned char*)p.out + DO_BB); const bf16_t* KF = (const bf16_t*)((unsigned char*)p.out + DO_KF);
    const bf16_t* R = (const bf16_t*)(ws + WS_R); const bf16_t* V = (const bf16_t*)(ws + WS_V); const float* W = (const float*)(ws + WS_W);
    float* YR = (float*)(ws + WS_YRAW);
    constexpr int OPF = 5 * TC * 64, BUFF = OPF + TC * 16;
    LAS float* L = (LAS float*)c.lds; LAS float* YB = L + 2 * BUFF;
    const int tid = c.tid;
    for (int unit = blockIdx.x; unit < BATCH * 8 * 4; unit += gridDim.x) {
        const int q = unit & 3, h = (unit >> 2) & 7, b = unit >> 5;
        const size_t rowbase = (size_t)b * SEQ;
        const int ss = tid >> 4, g4 = (tid & 15) * 4;
        u32x2 rb[4]; f32x4 rw; unsigned short rv;
        const int vs = tid >> 4, vi = tid & 15;
        auto issue = [&](int ch) {
            const size_t ro = (rowbase + (size_t)ch * TC + ss) * RD + h * 64 + g4;
            rb[0] = *(const u32x2*)(KK + ro); rb[1] = *(const u32x2*)(KF + ro); rb[2] = *(const u32x2*)(BB + ro); rb[3] = *(const u32x2*)(R + ro);
            rw = *(const f32x4*)(W + ro);
            rv = V[(rowbase + (size_t)ch * TC + vs) * RD + h * 64 + 16 * q + vi];
        };
        auto commit = [&](int buf) {
            LAS float* B = L + buf * BUFF;
            *(LAS f32x4*)(B + (0 * TC + ss) * 64 + g4) = unpk4(rb[0]);
            *(LAS f32x4*)(B + (1 * TC + ss) * 64 + g4) = rw;
            *(LAS f32x4*)(B + (2 * TC + ss) * 64 + g4) = unpk4(rb[1]);
            *(LAS f32x4*)(B + (3 * TC + ss) * 64 + g4) = unpk4(rb[2]);
            *(LAS f32x4*)(B + (4 * TC + ss) * 64 + g4) = unpk4(rb[3]);
            B[OPF + vs * 16 + vi] = bf2f(rv);
        };
        __syncthreads();
        issue(0); commit(0);
        __syncthreads();
        f32x4 S = (f32x4){0.f, 0.f, 0.f, 0.f};
        const int vrow = (tid >> 4) & 15, kq = tid & 15;
        for (int ch = 0; ch < SEQ / TC; ++ch) {
            if (ch + 1 < SEQ / TC) issue(ch + 1);
            if (tid < 256) {
                const LAS float* B = L + (ch & 1) * BUFF;
#pragma unroll 4
                for (int s = 0; s < TC; ++s) {
                    const f32x4 kap = *(const LAS f32x4*)(B + (0 * TC + s) * 64 + 4 * kq);
                    const f32x4 w4 = *(const LAS f32x4*)(B + (1 * TC + s) * 64 + 4 * kq);
                    const f32x4 kf4 = *(const LAS f32x4*)(B + (2 * TC + s) * 64 + 4 * kq);
                    const f32x4 b4 = *(const LAS f32x4*)(B + (3 * TC + s) * 64 + 4 * kq);
                    const f32x4 r4 = *(const LAS f32x4*)(B + (4 * TC + s) * 64 + 4 * kq);
                    const float vv = B[OPF + s * 16 + vrow];
                    const float sk = row_sum16((S[0] * kap[0] + S[1] * kap[1]) + (S[2] * kap[2] + S[3] * kap[3]));
                    S = S * w4 + kf4 * vv - b4 * sk;
                    const float y = row_sum16((S[0] * r4[0] + S[1] * r4[1]) + (S[2] * r4[2] + S[3] * r4[3]));
                    if (kq == 0) YB[s * 16 + vrow] = y;
                }
            }
            __syncthreads();
            if (ch + 1 < SEQ / TC) commit((ch + 1) & 1);
            { const int s = tid >> 4, i = tid & 15; YR[(rowbase + (size_t)ch * TC + s) * RD + h * 64 + 16 * q + i] = YB[s * 16 + i]; }
            __syncthreads();
        }
    }
}

__device__ __forceinline__ void phase_post(const Params& p, const Ctx& c) {
    unsigned char* ws = p.ws;
    const float* YR = (const float*)(ws + WS_YRAW); const float* BON = (const float*)(ws + WS_BONUS);
    const bf16_t* V = (const bf16_t*)(ws + WS_V); const bf16_t* G = (const bf16_t*)(ws + WS_G); bf16_t* Y = (bf16_t*)(ws + WS_YCAT);
    for (int it = c.gw; it < MTOK * 8; it += c.ngw) {
        const int row = it >> 3, h = it & 7, col = h * 64 + c.lane; const size_t off = (size_t)row * RD + col;
        const float y = YR[off];
        const float mean = wave_sum(y) * (1.0f / 64.0f); const float d = y - mean;
        const float var = wave_sum(d * d) * (1.0f / 64.0f);
        const float yn = d * rsqrtf(var + GN_EPS) * p.in[I_LNW][col] + p.in[I_LNB][col];
        const float bon = BON[it];
        const float o = (yn + bon * bf2f(V[off])) * bf2f(G[off]);
        Y[(size_t)row * DM + col] = (bf16_t)f2bf(o);
    }
}

__device__ __forceinline__ void phase_up_simple(const Params& p, const Ctx& c) {
    unsigned char* ws = p.ws;
    const bf16_t* Y = (const bf16_t*)(ws + WS_YCAT); const bf16_t* WU = (const bf16_t*)(ws + WS_WUPT); const bf16_t* GT = (const bf16_t*)(ws + WS_GATES); bf16_t* MG = (bf16_t*)(ws + WS_MERGED);
    const int nMt = MTOK / 256, nNt = DM / 64, ntiles = nMt * nNt;
    for (int tile = blockIdx.x; tile < ntiles; tile += gridDim.x) {
        const int tm = tile % nMt, tn = tile / nMt, m0 = tm * 256 + c.wave * 32, n0 = tn * 64;
        f32x4 tot[2][4];
#pragma unroll
        for (int i = 0; i < 2; ++i)
#pragma unroll
            for (int j = 0; j < 4; ++j) tot[i][j] = (f32x4){0.f, 0.f, 0.f, 0.f};
#pragma unroll
        for (int seg = 0; seg < 3; ++seg) {
            const int koff = seg == 0 ? 0 : (seg == 1 ? 512 : 768), K = seg == 0 ? 512 : 256;
            f32x4 acc[2][4];
#pragma unroll
            for (int i = 0; i < 2; ++i)
#pragma unroll
                for (int j = 0; j < 4; ++j) acc[i][j] = (f32x4){0.f, 0.f, 0.f, 0.f};
            wave_gemm_32x64(Y + koff, DM, WU + koff, DM, K, m0, n0, c.fr, c.fq, acc);
#pragma unroll
            for (int i = 0; i < 2; ++i)
#pragma unroll
                for (int j = 0; j < 4; ++j) { const f32x4 g = unpk4(*(const u32x2*)(GT + (size_t)(m0 + 16 * i + c.fr) * (3 * DM) + seg * DM + n0 + 16 * j + 4 * c.fq)); tot[i][j] += g * acc[i][j]; }
        }
#pragma unroll
        for (int i = 0; i < 2; ++i)
#pragma unroll
            for (int j = 0; j < 4; ++j) *(u32x2*)(MG + (size_t)(m0 + 16 * i + c.fr) * DM + n0 + 16 * j + 4 * c.fq) = pk4(tot[i][j]);
    }
}

__device__ __forceinline__ void phase_rowstat(const Params& p, const Ctx& c) {
    float* RS = (float*)(p.ws + WS_RSTD2);
    for (int m = c.gw; m < MTOK; m += c.ngw) {
        const f32x4* xr = (const f32x4*)(p.out + (size_t)m * DM) + c.lane; float s = 0.f;
#pragma unroll
        for (int j = 0; j < 4; ++j) { const f32x4 v = xr[64 * j]; s += (v[0] * v[0] + v[1] * v[1]) + (v[2] * v[2] + v[3] * v[3]); }
        s = wave_sum(s);
        if (c.lane == 0) RS[m] = rsqrtf(s * (1.f / DM) + NORM_EPS);
    }
}
__device__ __forceinline__ void phase_ffn_act(const Params& p, const Ctx& c, int half) {
    unsigned char* ws = p.ws;
    const bf16_t* U = (const bf16_t*)(ws + WS_U); const bf16_t* GV = (const bf16_t*)(ws + WS_GV); bf16_t* ACT = (bf16_t*)(ws + WS_ACT) + (size_t)half * (MTOK / 2) * FF;
    const float* cw = p.in[I_CONVW]; const float* cb = p.in[I_CONVB];
    const int ngrp = (MTOK / 2) * (FF / 4);
    for (int idx = blockIdx.x * NTHREADS + c.tid; idx < ngrp; idx += gridDim.x * NTHREADS) {
        const int row = idx / (FF / 4), col = 4 * (idx % (FF / 4)), t = row & (SEQ - 1); const size_t off = (size_t)row * FF + col;
        const f32x4 u0 = unpk4(*(const u32x2*)(U + off));
        f32x4 u1 = (f32x4){0.f, 0.f, 0.f, 0.f}, u2 = u1;
        if (t >= 1) u1 = unpk4(*(const u32x2*)(U + off - FF));
        if (t >= 2) u2 = unpk4(*(const u32x2*)(U + off - 2 * FF));
        const f32x4 g = unpk4(*(const u32x2*)(GV + off));
        const f32x4 uc = *(const f32x4*)(cw + col) * u2 + *(const f32x4*)(cw + FF + col) * u1 + *(const f32x4*)(cw + 2 * FF + col) * u0 + *(const f32x4*)(cb + col);
        f32x4 o;
#pragma unroll
        for (int j = 0; j < 4; ++j) o[j] = 0.5f * uc[j] * (1.0f + erff(uc[j] * 0.70710678118f)) * g[j];
        *(u32x2*)(ACT + off) = pk4(o);
    }
}
__device__ __forceinline__ void phase_final_norm(const Params& p, const Ctx& c) {
    const float* g = p.in[I_NFING];
    for (int m = c.gw; m < MTOK; m += c.ngw) {
        f32x4* xr = (f32x4*)(p.out + (size_t)m * DM) + c.lane; const f32x4* gr = (const f32x4*)g + c.lane;
        f32x4 v[4]; float s = 0.f;
#pragma unroll
        for (int j = 0; j < 4; ++j) { v[j] = xr[64 * j]; s += (v[j][0] * v[j][0] + v[j][1] * v[j][1]) + (v[j][2] * v[j][2] + v[j][3] * v[j][3]); }
        const float rstd = rsqrtf(wave_sum(s) * (1.f / DM) + NORM_EPS);
#pragma unroll
        for (int j = 0; j < 4; ++j) xr[64 * j] = v[j] * rstd * gr[64 * j];
    }
}

constexpr int NPHASES = 17;
__global__ void __launch_bounds__(NTHREADS, 2) fwd_kernel(Params p) {
    extern __shared__ __attribute__((aligned(16))) unsigned char lds_raw[];
    Ctx c; c.tid = threadIdx.x; c.lane = c.tid & 63; c.wave = __builtin_amdgcn_readfirstlane(c.tid >> 6); c.fr = c.lane & 15; c.fq = c.lane >> 4;
    c.gw = blockIdx.x * NWAVES + c.wave; c.ngw = gridDim.x * NWAVES; c.lds = (LAS unsigned char*)lds_raw;
    unsigned char* ws = p.ws;
#if ONE_LAUNCH
    cg::grid_group grid = cg::this_grid();
#define SEAM() grid.sync()
#else
#define SEAM() do {} while (0)
#endif
#define IN(k) (p.ph_lo <= (k) && (k) < p.ph_hi)
#define END(k) do { if (IN((k) + 1)) SEAM(); } while (0)
    if (IN(0)) { phase_prologue(p, c); END(0); }
    if (IN(1)) {
        gemm_simple(c, (const bf16_t*)(ws + WS_H), DM, (const bf16_t*)(ws + WS_WG1T), DM, MTOK, MIXIN, DM, EpiBf16{(bf16_t*)(ws + WS_P), MIXIN});
        gemm_simple(c, (const bf16_t*)(ws + WS_MEMN), DM, (const bf16_t*)(ws + WS_WKVT), DM, BATCH * NMEM, 512, DM, EpiKV{(bf16_t*)(ws + WS_KB), (bf16_t*)(ws + WS_VT)});
        END(1); }
    if (IN(2)) { phase_mix(p, c); phase_pooldiff(p, c); phase_memattn(p, c); END(2); }
    if (IN(3)) {
        gemm_simple(c, (const bf16_t*)(ws + WS_LW), 64, (const bf16_t*)(ws + WS_WLWT), 64, MTOK, RD, 64, EpiDecay{(float*)(ws + WS_W), p.in[I_W0]});
        gemm_simple(c, (const bf16_t*)(ws + WS_LA), 64, (const bf16_t*)(ws + WS_WLAT), 64, MTOK, RD, 64, EpiSigBias{(bf16_t*)(ws + WS_AA), RD, p.in[I_A0]});
        gemm_simple(c, (const bf16_t*)(ws + WS_LG), 128, (const bf16_t*)(ws + WS_WLGT), 128, MTOK, RD, 128, EpiBf16{(bf16_t*)(ws + WS_G), RD});
#pragma unroll 1
        for (int gi = 0; gi < 4; ++gi)
            gemm_simple(c, (const bf16_t*)(ws + WS_DPOOL) + 64 * gi, 256, (const bf16_t*)(ws + WS_WPT) + 4096 * gi, 64, MTOK, 64, 64, EpiPool{(bf16_t*)(ws + WS_YCAT), p.in[I_POOLS], gi});
        END(3); }
    if (IN(4)) { phase_prep2(p, c); END(4); }
    if (IN(5)) { phase_scan(p, c); END(5); }
    if (IN(6)) { phase_post(p, c); END(6); }
    if (IN(7)) {
        gemm_simple(c, (const bf16_t*)(ws + WS_H), DM, (const bf16_t*)(ws + WS_WG1T) + (size_t)MIXIN * DM, DM, MTOK, 3 * DM, DM, EpiSigBias{(bf16_t*)(ws + WS_GATES), 3 * DM, p.in[I_BGATE]});
        END(7); }
    if (IN(8)) { phase_up_simple(p, c); END(8); }
    if (IN(9)) {
        gemm_simple(c, (const bf16_t*)(ws + WS_MERGED), DM, (const bf16_t*)(ws + WS_WOT), DM, MTOK, DM, DM, EpiOut{p.in[I_X], p.out, (bf16_t*)(ws + WS_X1B)});
        END(9); }
    if (IN(10)) { phase_rowstat(p, c); END(10); }
#pragma unroll 1
    for (int half = 0; half < 2; ++half) {
        if (IN(11 + 2 * half)) {
            gemm_simple(c, (const bf16_t*)(ws + WS_X1B) + (size_t)half * (MTOK / 2) * DM, DM, (const bf16_t*)(ws + WS_WF1T), DM, MTOK / 2, 2 * FF, DM,
                        EpiFfnIn{(bf16_t*)(ws + WS_U), (const float*)(ws + WS_RSTD2), half * (MTOK / 2)});
            END(11 + 2 * half); }
        if (IN(12 + 2 * half)) { phase_ffn_act(p, c, half); END(12 + 2 * half); }
    }
    if (IN(15)) {
        gemm_simple(c, (const bf16_t*)(ws + WS_ACT), FF, (const bf16_t*)(ws + WS_WF2T), FF, MTOK, DM, FF, EpiAddOut{p.out});
        END(15); }
    if (IN(16)) { phase_final_norm(p, c); }
#undef IN
#undef END
}

__global__ void nan_fill(float* o, int n) { const int i = blockIdx.x * blockDim.x + threadIdx.x; if (i < n) o[i] = __builtin_nanf(""); }

extern "C" void kernel_launch(void* const* d_in, const int* in_sizes, int n_in, void* d_out, int out_size, void* d_ws, size_t ws_size, hipStream_t stream) {
    static int grid = 0;
    if (grid == 0) {
        int dev = 0, cus = 0, per_cu = 0;
        if (hipGetDevice(&dev) != hipSuccess || hipDeviceGetAttribute(&cus, hipDeviceAttributeMultiprocessorCount, dev) != hipSuccess) cus = 256;
        (void)hipFuncSetAttribute((const void*)fwd_kernel, hipFuncAttributeMaxDynamicSharedMemorySize, LDS_BYTES);
        if (hipOccupancyMaxActiveBlocksPerMultiprocessor(&per_cu, (const void*)fwd_kernel, NTHREADS, LDS_BYTES) != hipSuccess || per_cu < 1) per_cu = 1;
        (void)hipGetLastError();
        grid = cus;
        if (n_in != 31 || out_size != MTOK * DM || ws_size < WS_END) grid = -1;
    }
    if (grid < 0) { nan_fill<<<(out_size + 255) / 256, 256, 0, stream>>>((float*)d_out, out_size); return; }
    Params p{};
    for (int i = 0; i < 31; ++i) p.in[i] = (const float*)d_in[i];
    p.out = (float*)d_out; p.ws = (unsigned char*)d_ws;
#if ONE_LAUNCH
    p.ph_lo = 0; p.ph_hi = NPHASES;
    void* args[] = {&p};
    hipError_t e = hipLaunchCooperativeKernel((const void*)fwd_kernel, dim3(grid), dim3(NTHREADS), args, LDS_BYTES, stream);
    if (e != hipSuccess) fprintf(stderr, "cooperative launch failed: %s (grid %d)\n", hipGetErrorString(e), grid);
#else
    for (int ph = 0; ph < NPHASES; ++ph) { p.ph_lo = ph; p.ph_hi = ph + 1; hipLaunchKernelGGL(fwd_kernel, dim3(grid), dim3(NTHREADS), LDS_BYTES, stream, p); }
#endif
}
```

```cpp
#include <hip/hip_runtime.h>
#include <hip/hip_cooperative_groups.h>
#include <cstdio>
#include <cstdint>
namespace cg = cooperative_groups;

#ifndef ONE_LAUNCH
#define ONE_LAUNCH 1
#endif
#ifndef PH_MASK
#define PH_MASK 0xFFFFFFFFu
#endif
#define PH_ON(k) ((PH_MASK >> (k)) & 1u)

#define LAS __attribute__((address_space(3)))
typedef unsigned short bf16_t;
typedef short bf16x8 __attribute__((ext_vector_type(8)));
typedef float f32x4 __attribute__((ext_vector_type(4)));
typedef float f32x2 __attribute__((ext_vector_type(2)));
typedef unsigned u32x4 __attribute__((ext_vector_type(4)));
typedef unsigned u32x2 __attribute__((ext_vector_type(2)));

constexpr int BATCH = 8, SEQ = 4096, DM = 1024, MTOK = BATCH * SEQ;
constexpr int NMEM = 256, RD = 512, MIXIN = 2304, RWKVIN = 1792, FF = 2816, NG1 = MIXIN + 3 * DM;
constexpr int NWAVES = 8, NTHREADS = 512;
constexpr float NORM_EPS = 1e-6f, GN_EPS = 64e-5f;

constexpr size_t MiB = 1u << 20;
constexpr size_t WS_WG1T = 1 * MiB;
constexpr size_t WS_WKVT = WS_WG1T + (size_t)NG1 * DM * 2;
constexpr size_t WS_WUPT = WS_WKVT + (size_t)512 * DM * 2;
constexpr size_t WS_WOT = WS_WUPT + (size_t)DM * DM * 2;
constexpr size_t WS_WF1T = WS_WOT + (size_t)DM * DM * 2;
constexpr size_t WS_WF2T = WS_WF1T + (size_t)2 * FF * DM * 2;
constexpr size_t WS_WLWT = WS_WF2T + (size_t)DM * FF * 2;
constexpr size_t WS_WLAT = WS_WLWT + (size_t)RD * 64 * 2;
constexpr size_t WS_WLGT = WS_WLAT + (size_t)RD * 64 * 2;
constexpr size_t WS_WPT = WS_WLGT + (size_t)RD * 128 * 2;
constexpr size_t WS_WEND = WS_WPT + (size_t)4 * 64 * 64 * 2;
static_assert(WS_WEND <= 34 * MiB, "weights region");
constexpr size_t WS_BONUS = 34 * MiB;
constexpr size_t WS_RSTD2 = 35 * MiB;
constexpr size_t WS_KB = 36 * MiB;
constexpr size_t WS_VT = 37 * MiB;
constexpr size_t WS_MEMN = 38 * MiB;
constexpr size_t WS_H = 42 * MiB;
constexpr size_t WS_YCAT = 106 * MiB;
constexpr size_t WS_P = 170 * MiB;
constexpr size_t WS_W = 170 * MiB;
constexpr size_t WS_G = 234 * MiB;
constexpr size_t WS_AA = 266 * MiB;
constexpr size_t WS_KRAW = 314 * MiB;
constexpr size_t WS_YRAW = 266 * MiB;
constexpr size_t WS_R = 346 * MiB;
constexpr size_t WS_V = 378 * MiB;
constexpr size_t WS_LW = 410 * MiB;
constexpr size_t WS_LA = 414 * MiB;
constexpr size_t WS_LG = 418 * MiB;
constexpr size_t WS_DPOOL = 426 * MiB;
constexpr size_t WS_GATES = 170 * MiB;
constexpr size_t WS_MERGED = 362 * MiB;
constexpr size_t WS_X1B = 426 * MiB;
constexpr size_t WS_U = 42 * MiB;
constexpr size_t WS_GV = 130 * MiB;
constexpr size_t WS_ACT = 218 * MiB;
constexpr size_t WS_END = 490 * MiB;
constexpr size_t DO_KK = 0, DO_BB = 32 * MiB, DO_KF = 64 * MiB;

constexpr int LDS_BYTES = 147456;

__device__ __forceinline__ unsigned f2bf(float f) { unsigned u = __float_as_uint(f); return (u + 0x7fffu + ((u >> 16) & 1u)) >> 16; }
__device__ __forceinline__ float bf2f(unsigned h) { return __uint_as_float(h << 16); }
__device__ __forceinline__ unsigned pk2(float lo, float hi) { return f2bf(lo) | (f2bf(hi) << 16); }
__device__ __forceinline__ u32x2 pk4(f32x4 v) { u32x2 r; r.x = pk2(v[0], v[1]); r.y = pk2(v[2], v[3]); return r; }
__device__ __forceinline__ f32x4 unpk4(u32x2 u) { f32x4 r; r[0] = bf2f(u.x & 0xffffu); r[1] = bf2f(u.x >> 16); r[2] = bf2f(u.y & 0xffffu); r[3] = bf2f(u.y >> 16); return r; }
__device__ __forceinline__ float wave_sum(float v) {
#pragma unroll
    for (int o = 1; o < 64; o <<= 1) v += __shfl_xor(v, o);
    return v;
}
__device__ __forceinline__ float sigmoidf_(float x) { return 1.0f / (1.0f + __expf(-x)); }
template <int CTRL> __device__ __forceinline__ float dpp_f(float x) { return __builtin_bit_cast(float, __builtin_amdgcn_update_dpp(0, __builtin_bit_cast(int, x), CTRL, 0xF, 0xF, false)); }
__device__ __forceinline__ float row_sum16(float x) {
    x += dpp_f<0xB1>(x);
    x += dpp_f<0x4E>(x);
    x += dpp_f<0x141>(x);
    x += dpp_f<0x140>(x);
    return x;
}

struct Params { const float* in[31]; float* out; unsigned char* ws; int ph_lo, ph_hi; };
enum { I_X = 0, I_MEM, I_NMIXG, I_WINMIX, I_MU, I_W0, I_WLORAB, I_A0, I_ALORAB, I_GLORAB, I_KK, I_KA, I_RK, I_LNW, I_LNB, I_POOLW, I_POOLS, I_NMEMG, I_WMEMKV,
       I_WUPR, I_WUPP, I_WUPM, I_WGATE, I_BGATE, I_WO, I_NFFNG, I_WFFNIN, I_CONVW, I_CONVB, I_WFFNOUT, I_NFING };

struct Ctx { int tid, lane, wave, fr, fq, gw, ngw; LAS unsigned char* lds; };

__device__ __forceinline__ int rowmap(int mode, int n) {
    if (mode == 0) return n;
    const int half = n >= FF ? 1 : 0, c = n - half * FF;
    return (c >> 7) * 256 + half * 128 + (c & 127);
}
__device__ __forceinline__ void transpose_item(const float* W, int K, int N, bf16_t* WT, int ldd, int koff, int mode, const float* kscale, LAS float* scr, int item, int lane) {
    const int nblk = N / 32, kb = item / nblk, nb = item % nblk, k0 = 64 * kb, n0 = 32 * nb;
#pragma unroll 8
    for (int i = 0; i < 32; ++i) { const int kk = 2 * i + (lane >> 5); float v = W[(size_t)(k0 + kk) * N + n0 + (lane & 31)]; if (kscale) v *= kscale[k0 + kk]; scr[kk * 33 + (lane & 31)] = v; }
    asm volatile("s_waitcnt lgkmcnt(0)" ::: "memory");
    const int c = lane & 7;
#pragma unroll
    for (int j = 0; j < 4; ++j) { const int n = (lane >> 3) + 8 * j; const LAS float* s = scr + (8 * c) * 33 + n;
        u32x4 o; o.x = pk2(s[0 * 33], s[1 * 33]); o.y = pk2(s[2 * 33], s[3 * 33]); o.z = pk2(s[4 * 33], s[5 * 33]); o.w = pk2(s[6 * 33], s[7 * 33]);
        *(u32x4*)(WT + (size_t)rowmap(mode, n0 + n) * ldd + koff + k0 + 8 * c) = o; }
    asm volatile("s_waitcnt lgkmcnt(0)" ::: "memory");
}
__device__ __forceinline__ void rmsnorm_row_bf16(const float* xrow, const float* g, bf16_t* orow, int lane) {
    const f32x4* xr = (const f32x4*)xrow + lane; const f32x4* gr = (const f32x4*)g + lane;
    f32x4 v[4]; float s = 0.f;
#pragma unroll
    for (int j = 0; j < 4; ++j) { v[j] = xr[64 * j]; s += (v[j][0] * v[j][0] + v[j][1] * v[j][1]) + (v[j][2] * v[j][2] + v[j][3] * v[j][3]); }
    const float rstd = rsqrtf(wave_sum(s) * (1.f / DM) + NORM_EPS);
    u32x2* o = (u32x2*)orow + lane;
#pragma unroll
    for (int j = 0; j < 4; ++j) { const f32x4 gg = gr[64 * j]; o[64 * j] = pk4(v[j] * rstd * gg); }
}

__device__ __forceinline__ void phase_prologue(const Params& p, const Ctx& c) {
    LAS float* scr = (LAS float*)(c.lds + c.wave * 16384);
    unsigned char* ws = p.ws;
#define TR(Wp, K_, N_, WTp, ldd_, koff_, mode_, sc_) { const int ni_ = ((K_) / 64) * ((N_) / 32); if (r < ni_) { transpose_item(Wp, K_, N_, (bf16_t*)(WTp), ldd_, koff_, mode_, sc_, scr, r, c.lane); continue; } r -= ni_; }
    constexpr int NIT = (DM / 64) * (MIXIN / 32) + (DM / 64) * (3 * DM / 32) + (DM / 64) * (512 / 32) + (512 / 64) * (DM / 32) + 2 * (256 / 64) * (DM / 32) + (DM / 64) * (DM / 32)
                      + (DM / 64) * (2 * FF / 32) + (FF / 64) * (DM / 32) + 2 * (RD / 32) + 2 * (RD / 32) + 4 * 2;
    for (int it = c.gw; it < NIT; it += c.ngw) {
        int r = it;
        TR(p.in[I_WINMIX], DM, MIXIN, ws + WS_WG1T, DM, 0, 0, nullptr)
        TR(p.in[I_WGATE], DM, 3 * DM, ws + WS_WG1T + (size_t)MIXIN * DM * 2, DM, 0, 0, nullptr)
        TR(p.in[I_WMEMKV], DM, 512, ws + WS_WKVT, DM, 0, 0, nullptr)
        TR(p.in[I_WUPR], 512, DM, ws + WS_WUPT, DM, 0, 0, nullptr)
        TR(p.in[I_WUPP], 256, DM, ws + WS_WUPT, DM, 512, 0, nullptr)
        TR(p.in[I_WUPM], 256, DM, ws + WS_WUPT, DM, 768, 0, nullptr)
        TR(p.in[I_WO], DM, DM, ws + WS_WOT, DM, 0, 0, nullptr)
        TR(p.in[I_WFFNIN], DM, 2 * FF, ws + WS_WF1T, DM, 0, 1, p.in[I_NFFNG])
        TR(p.in[I_WFFNOUT], FF, DM, ws + WS_WF2T, FF, 0, 0, nullptr)
        TR(p.in[I_WLORAB], 64, RD, ws + WS_WLWT, 64, 0, 0, nullptr)
        TR(p.in[I_ALORAB], 64, RD, ws + WS_WLAT, 64, 0, 0, nullptr)
        TR(p.in[I_GLORAB], 128, RD, ws + WS_WLGT, 128, 0, 0, nullptr)
        TR(p.in[I_POOLW] + 0 * 4096, 64, 64, ws + WS_WPT + 0 * 8192, 64, 0, 0, nullptr)
        TR(p.in[I_POOLW] + 1 * 4096, 64, 64, ws + WS_WPT + 1 * 8192, 64, 0, 0, nullptr)
        TR(p.in[I_POOLW] + 2 * 4096, 64, 64, ws + WS_WPT + 2 * 8192, 64, 0, 0, nullptr)
        TR(p.in[I_POOLW] + 3 * 4096, 64, 64, ws + WS_WPT + 3 * 8192, 64, 0, 0, nullptr)
    }
#undef TR
    for (int m = c.gw; m < MTOK; m += c.ngw) rmsnorm_row_bf16(p.in[I_X] + (size_t)m * DM, p.in[I_NMIXG], (bf16_t*)(ws + WS_H) + (size_t)m * DM, c.lane);
    for (int m = c.gw; m < BATCH * NMEM; m += c.ngw) rmsnorm_row_bf16(p.in[I_MEM] + (size_t)m * DM, p.in[I_NMEMG], (bf16_t*)(ws + WS_MEMN) + (size_t)m * DM, c.lane);
}

namespace pg8 {
#define PG8_LAS __attribute__((address_space(3)))
typedef unsigned short bf16_t;
typedef short bf16x8 __attribute__((ext_vector_type(8)));
typedef float f32x4 __attribute__((ext_vector_type(4)));
typedef unsigned u32x4 __attribute__((ext_vector_type(4)));
constexpr int BM = 256, BK = 64, HALF = 128, HTB = HALF * BK * 2  , STAGE_BYTES = 8 * HTB, NXCD = 8, WGM = 8;

__host__ __device__ __forceinline__ int lds_byte(int r, int c) { const int st = (r >> 4) * 2 + (c >> 5), rr = r & 15, cc = c & 31, ob = rr * 64 + cc * 2; return st * 1024 + (ob ^ (((ob >> 9) & 1) << 5)); }
__host__ __device__ __forceinline__ void stage_rc(int b, int& R, int& C) { const int st = b / 1024, sb = b % 1024, swz = sb ^ (((sb >> 9) & 1) << 5); R = (st >> 1) * 16 + swz / 64; C = (st & 1) * 32 + (swz % 64) / 2; }
__host__ __device__ __forceinline__ int perm32(int rho) { const int n = rho >> 4, i = rho & 15; return 8 * (i >> 2) + 4 * n + (i & 3); }

struct Unit { int pm, pn; };
struct Gemm { const bf16_t* A; const bf16_t* Bt; int M, N, K, lda, ldb; };

struct StaticOrder {
    int nM, nN, nwg, G, c;
    __host__ __device__ void init(int M, int N, int G_, int c_) { nM = M / BM; nN = N / BM; nwg = nM * nN; G = G_; c = c_; }
    __host__ __device__ bool next(int i, Unit& u) const {
        const long L = (long)i * G + c; if (L >= nwg) return false;
        int wgid = (int)L; { const int q = nwg / NXCD, r = nwg % NXCD, xcd = wgid % NXCD, off = wgid / NXCD; wgid = (xcd < r ? xcd * (q + 1) : r * (q + 1) + (xcd - r) * q) + off; }
        const int nig = WGM * nN, gid = wgid / nig, fm = gid * WGM, gsz = (nM - fm) < WGM ? (nM - fm) : WGM;
        u.pm = fm + ((wgid % nig) % gsz); u.pn = (wgid % nig) / gsz; return true;
    }
    __device__ __forceinline__ void a_ready(const Unit&) const {}
    __device__ __forceinline__ void done(const Unit&) const {}
};


template <class Epi, class Sched, bool ALIGN_EPI = false, bool SP2 = false>
__device__ __forceinline__ void gemm_phase(PG8_LAS unsigned char* lds, const Gemm g, const Sched& S, const Epi& E) {
    int tid_ = threadIdx.x; asm volatile("" : "+v"(tid_));
    const int tid = tid_, wid = __builtin_amdgcn_readfirstlane(tid >> 6), lane = tid & 63, wr = wid >> 2, wc = wid & 3, fr = lane & 15, fq = lane >> 4;
    const int K = g.K, nt = K / BK;
    unsigned voffA[2], voffB[2];
#pragma unroll
    for (int i = 0; i < 2; ++i) { int R, C; stage_rc(tid * 16 + i * 8192, R, C); const int Rb = Epi::PERM ? ((R & ~31) + perm32(R & 31)) : R;
        voffA[i] = (unsigned)(R * g.lda + C) * 2u; voffB[i] = (unsigned)(Rb * g.ldb + C) * 2u; }
    const size_t kstep = (size_t)(BK * 2);
    const size_t hstepA = (size_t)HALF * g.lda * 2, hstepB = (size_t)HALF * g.ldb * 2;
    const size_t tstepA = 2 * hstepA, tstepB = 2 * hstepB;
    const unsigned ldsw = (unsigned)wid * 1024u;
    const int aoff = lds_byte(wr * 64 + fr, fq * 8), boff = lds_byte(wc * 32 + fr, fq * 8);
#define PG8_SA(b, h) (((b) * 2 + (h)) * HTB)
#define PG8_SB(b, h) ((4 + (b) * 2 + (h)) * HTB)
#define PG8_STAGE(bufoff, gbase, voff) do { _Pragma("unroll") for (int _i = 0; _i < 2; ++_i) \
        __builtin_amdgcn_global_load_lds((const unsigned*)((const char*)(gbase) + (voff)[_i]), (PG8_LAS unsigned*)(lds + (bufoff) + ldsw + _i * 8192), 16, 0, 0); } while (0)
#define PG8_LDA(dst, b, h) do { _Pragma("unroll") for (int m = 0; m < 4; ++m) _Pragma("unroll") for (int k = 0; k < 2; ++k) dst[m][k] = *(const PG8_LAS bf16x8*)(lds + PG8_SA(b, h) + aoff + m * 2048 + k * 1024); } while (0)
#define PG8_LDB(dst, b, h) do { _Pragma("unroll") for (int n = 0; n < 2; ++n) _Pragma("unroll") for (int k = 0; k < 2; ++k) dst[n][k] = *(const PG8_LAS bf16x8*)(lds + PG8_SB(b, h) + boff + n * 2048 + k * 1024); } while (0)
#define PG8_MMA(ai, bj, At, Bt) do { __builtin_amdgcn_s_setprio(1); _Pragma("unroll") for (int m = 0; m < 4; ++m) _Pragma("unroll") for (int n = 0; n < 2; ++n) _Pragma("unroll") for (int k = 0; k < 2; ++k) \
        acc[ai][bj][m][n] = __builtin_amdgcn_mfma_f32_16x16x32_bf16(Bt[n][k], At[m][k], acc[ai][bj][m][n], 0, 0, 0); __builtin_amdgcn_s_setprio(0); } while (0)
#define PG8_WAIT_V(n) asm volatile("s_waitcnt vmcnt(" #n ")" ::: "memory")
#define PG8_WAIT_L(n) asm volatile("s_waitcnt lgkmcnt(" #n ")" ::: "memory")
#define PG8_BAR __builtin_amdgcn_s_barrier()
#define PG8_SCHED __builtin_amdgcn_sched_barrier(0)
    Unit cur, nxt; int ui = 0;
    if (!S.next(0, cur)) return;
    f32x4 acc[2][2][4][2];
#pragma unroll
    for (int a = 0; a < 2; ++a)
#pragma unroll
        for (int b = 0; b < 2; ++b)
#pragma unroll
            for (int m = 0; m < 4; ++m)
#pragma unroll
                for (int n = 0; n < 2; ++n) acc[a][b][m][n] = (f32x4){0.f, 0.f, 0.f, 0.f};
    bf16x8 At[4][2], B0[2][2], B1[2][2];
    const char* cA = (const char*)g.A + (size_t)cur.pm * tstepA; const char* cB = (const char*)g.Bt + (size_t)cur.pn * tstepB;
    S.a_ready(cur);
    if constexpr (SP2) {
        PG8_STAGE(PG8_SB(0, 0), cB, voffB); PG8_STAGE(PG8_SB(0, 1), cB + hstepB, voffB); PG8_STAGE(PG8_SA(0, 0), cA, voffA); PG8_STAGE(PG8_SA(0, 1), cA + hstepA, voffA);
        if (wr == 1) PG8_BAR;
        PG8_WAIT_V(2); PG8_BAR;
        PG8_STAGE(PG8_SB(1, 0), cB + kstep, voffB); PG8_STAGE(PG8_SA(1, 0), cA + kstep, voffA); PG8_STAGE(PG8_SB(1, 1), cB + hstepB + kstep, voffB);
        PG8_WAIT_V(6); PG8_BAR;
    } else {
        PG8_STAGE(PG8_SB(0, 0), cB, voffB); PG8_STAGE(PG8_SA(0, 0), cA, voffA); PG8_STAGE(PG8_SB(0, 1), cB + hstepB, voffB); PG8_STAGE(PG8_SA(0, 1), cA + hstepA, voffA);
        if (wr == 1) PG8_BAR;
        PG8_WAIT_V(4); PG8_BAR;
        PG8_STAGE(PG8_SB(1, 0), cB + kstep, voffB); PG8_STAGE(PG8_SA(1, 0), cA + kstep, voffA); PG8_STAGE(PG8_SB(1, 1), cB + hstepB + kstep, voffB);
        PG8_WAIT_V(6); PG8_BAR;
    }
    for (;;) {
        const bool has_next = S.next(ui + 1, nxt);
        const char* nA = has_next ? (const char*)g.A + (size_t)nxt.pm * tstepA : cA; const char* nB = has_next ? (const char*)g.Bt + (size_t)nxt.pn * tstepB : cB;
        for (int t = 0; t < nt; t += 2) {
            const bool last = (t == nt - 2);
            const char* a1 = cA + (size_t)(t + 1) * kstep;
            const char* a2 = last ? nA : cA + (size_t)(t + 2) * kstep; const char* b2 = last ? nB : cB + (size_t)(t + 2) * kstep;
            const char* a3 = a2 + kstep; const char* b3 = b2 + kstep;
            if (last && has_next) S.a_ready(nxt);
            if constexpr (SP2) {
            PG8_LDB(B0, 0, 0); PG8_LDB(B1, 0, 1); PG8_SCHED; PG8_LDA(At, 0, 0); PG8_STAGE(PG8_SA(1, 1), a1 + hstepA, voffA);
            PG8_WAIT_V(8); PG8_WAIT_L(0); PG8_BAR; PG8_MMA(0, 0, At, B0); PG8_MMA(0, 1, At, B1); PG8_BAR; PG8_SCHED;
            PG8_LDA(At, 0, 1); PG8_STAGE(PG8_SB(0, 0), b2, voffB); PG8_STAGE(PG8_SB(0, 1), b2 + hstepB, voffB); PG8_STAGE(PG8_SA(0, 0), a2, voffA);
            PG8_WAIT_V(8); PG8_WAIT_L(0); PG8_BAR; PG8_MMA(1, 0, At, B0); PG8_MMA(1, 1, At, B1); PG8_BAR; PG8_SCHED;
            PG8_LDB(B0, 1, 0); PG8_LDB(B1, 1, 1); PG8_SCHED; PG8_LDA(At, 1, 0); PG8_STAGE(PG8_SA(0, 1), a2 + hstepA, voffA);
            PG8_WAIT_V(8); PG8_WAIT_L(0); PG8_BAR; PG8_MMA(0, 0, At, B0); PG8_MMA(0, 1, At, B1); PG8_BAR; PG8_SCHED;
            PG8_LDA(At, 1, 1); PG8_STAGE(PG8_SB(1, 0), b3, voffB); PG8_STAGE(PG8_SB(1, 1), b3 + hstepB, voffB); PG8_STAGE(PG8_SA(1, 0), a3, voffA);
            PG8_WAIT_V(8); PG8_WAIT_L(0); PG8_BAR; PG8_MMA(1, 0, At, B0); PG8_MMA(1, 1, At, B1); PG8_BAR; PG8_SCHED;
            } else {
            PG8_LDB(B0, 0, 0); PG8_SCHED; PG8_LDA(At, 0, 0); PG8_STAGE(PG8_SA(1, 1), a1 + hstepA, voffA);
            PG8_WAIT_L(8); PG8_BAR; PG8_WAIT_L(0); PG8_MMA(0, 0, At, B0); PG8_BAR; PG8_SCHED;
            PG8_LDB(B1, 0, 1); PG8_STAGE(PG8_SB(0, 0), b2, voffB);
            PG8_BAR; PG8_WAIT_L(0); PG8_MMA(0, 1, At, B1); PG8_BAR;
            PG8_LDA(At, 0, 1); PG8_STAGE(PG8_SA(0, 0), a2, voffA);
            PG8_BAR; PG8_WAIT_L(0); PG8_MMA(1, 0, At, B0); PG8_BAR; PG8_SCHED;
            PG8_STAGE(PG8_SB(0, 1), b2 + hstepB, voffB);
            PG8_WAIT_V(6); PG8_BAR; PG8_MMA(1, 1, At, B1); PG8_BAR;
            PG8_LDB(B0, 1, 0); PG8_SCHED; PG8_LDA(At, 1, 0); PG8_STAGE(PG8_SA(0, 1), a2 + hstepA, voffA);
            PG8_WAIT_L(8); PG8_BAR; PG8_WAIT_L(0); PG8_MMA(0, 0, At, B0); PG8_BAR; PG8_SCHED;
            PG8_LDB(B1, 1, 1); PG8_STAGE(PG8_SB(1, 0), b3, voffB);
            PG8_BAR; PG8_WAIT_L(0); PG8_MMA(0, 1, At, B1); PG8_BAR;
            PG8_LDA(At, 1, 1); PG8_STAGE(PG8_SA(1, 0), a3, voffA);
            PG8_BAR; PG8_WAIT_L(0); PG8_MMA(1, 0, At, B0); PG8_BAR; PG8_SCHED;
            PG8_STAGE(PG8_SB(1, 1), b3 + hstepB, voffB);
            PG8_WAIT_V(6); PG8_BAR; PG8_MMA(1, 1, At, B1); PG8_BAR;
            }
        }
        if constexpr (ALIGN_EPI) { if (wr == 0) PG8_BAR; }
        if constexpr (!Epi::AFTER_DRAIN) { E(acc, cur, wr, wc, fr, fq); S.done(cur); }
        if (!has_next) break;
#pragma unroll
        for (int a = 0; a < 2; ++a)
#pragma unroll
            for (int b = 0; b < 2; ++b)
#pragma unroll
                for (int m = 0; m < 4; ++m)
#pragma unroll
                    for (int n = 0; n < 2; ++n) acc[a][b][m][n] = (f32x4){0.f, 0.f, 0.f, 0.f};
        cur = nxt; cA = nA; cB = nB; ++ui;
        if constexpr (ALIGN_EPI) { if (wr == 1) PG8_BAR; }
    }
    PG8_WAIT_V(0);
    if constexpr (!ALIGN_EPI) { if (wr == 0) PG8_BAR; }
    PG8_BAR;
    if constexpr (Epi::AFTER_DRAIN) { E.fused(acc, cur, wr, wc, fr, fq, lds, wid, lane); S.done(cur); }
#undef PG8_SA
#undef PG8_SB
#undef PG8_STAGE
#undef PG8_LDA
#undef PG8_LDB
#undef PG8_MMA
#undef PG8_WAIT_V
#undef PG8_WAIT_L
#undef PG8_BAR
#undef PG8_SCHED
}
}


template <class F> struct EpiFn4 { static constexpr bool PERM = false, AFTER_DRAIN = false; F f;
    __device__ __forceinline__ void operator()(const f32x4 (&acc)[2][2][4][2], const pg8::Unit& u, int wr, int wc, int fr, int fq) const {
        const int row0 = u.pm * 256 + wr * 64 + fr, col0 = u.pn * 256 + wc * 32 + 4 * fq;
#pragma unroll
        for (int ai = 0; ai < 2; ++ai)
#pragma unroll
            for (int m = 0; m < 4; ++m)
#pragma unroll
                for (int bj = 0; bj < 2; ++bj)
#pragma unroll
                    for (int n = 0; n < 2; ++n) f(row0 + ai * 128 + m * 16, col0 + bj * 128 + n * 16, acc[ai][bj][m][n]);
    } };
template <class F> struct EpiFn8 { static constexpr bool PERM = true, AFTER_DRAIN = false; F f;
    __device__ __forceinline__ void operator()(const f32x4 (&acc)[2][2][4][2], const pg8::Unit& u, int wr, int wc, int fr, int fq) const {
        const int row0 = u.pm * 256 + wr * 64 + fr, col0 = u.pn * 256 + wc * 32 + 8 * fq;
#pragma unroll
        for (int ai = 0; ai < 2; ++ai)
#pragma unroll
            for (int m = 0; m < 4; ++m)
#pragma unroll
                for (int bj = 0; bj < 2; ++bj) f(row0 + ai * 128 + m * 16, col0 + bj * 128, acc[ai][bj][m][0], acc[ai][bj][m][1]);
    } };
template <class F> __device__ __forceinline__ void gemm_pg8_4(const Ctx& c, const bf16_t* A, int lda, const bf16_t* Bt, int ldb, int M, int N, int K, const F& f) {
    pg8::Gemm g{A, Bt, M, N, K, lda, ldb}; pg8::StaticOrder S; S.init(M, N, (int)gridDim.x, (int)blockIdx.x); EpiFn4<F> E{f};
    pg8::gemm_phase<EpiFn4<F>, pg8::StaticOrder, true, true>(c.lds, g, S, E);
}
template <class F> __device__ __forceinline__ void gemm_pg8_8(const Ctx& c, const bf16_t* A, int lda, const bf16_t* Bt, int ldb, int M, int N, int K, const F& f) {
    pg8::Gemm g{A, Bt, M, N, K, lda, ldb}; pg8::StaticOrder S; S.init(M, N, (int)gridDim.x, (int)blockIdx.x); EpiFn8<F> E{f};
    pg8::gemm_phase<EpiFn8<F>, pg8::StaticOrder, true, true>(c.lds, g, S, E);
}
__device__ __forceinline__ u32x4 pk8(f32x4 lo, f32x4 hi) { u32x4 w; w.x = pk2(lo[0], lo[1]); w.y = pk2(lo[2], lo[3]); w.z = pk2(hi[0], hi[1]); w.w = pk2(hi[2], hi[3]); return w; }
struct F8Store { bf16_t* O; int ld; __device__ __forceinline__ void operator()(int row, int col, f32x4 lo, f32x4 hi) const { *(u32x4*)(O + (size_t)row * ld + col) = pk8(lo, hi); } };
struct F8SigBias { bf16_t* O; int ld; const float* bias;
    __device__ __forceinline__ void operator()(int row, int col, f32x4 lo, f32x4 hi) const {
        lo += *(const f32x4*)(bias + col); hi += *(const f32x4*)(bias + col + 4);
#pragma unroll
        for (int j = 0; j < 4; ++j) { lo[j] = sigmoidf_(lo[j]); hi[j] = sigmoidf_(hi[j]); }
        *(u32x4*)(O + (size_t)row * ld + col) = pk8(lo, hi); } };
struct F8FfnIn { bf16_t* U; const float* rstd; int row_base;
    __device__ __forceinline__ void operator()(int row, int col, f32x4 lo, f32x4 hi) const {
        const float s = rstd[row_base + row]; const int j = col >> 8, cc = col & 255;
        const size_t off = (size_t)((cc >> 7) & 1) * ((WS_GV - WS_U) / 2) + (size_t)row * FF + 128 * j + (cc & 127); *(u32x4*)(U + off) = pk8(lo * s, hi * s); } };
template <int SEG> struct F4Up { float* MF; const bf16_t* GT; bf16_t* MG;
    __device__ __forceinline__ void operator()(int row, int col, f32x4 v) const {
        const f32x4 g = unpk4(*(const u32x2*)(GT + (size_t)row * (3 * DM) + SEG * DM + col)); const size_t off = (size_t)row * DM + col;
        if (SEG == 0) *(f32x4*)(MF + off) = g * v;
        else if (SEG == 1) *(f32x4*)(MF + off) = *(const f32x4*)(MF + off) + g * v;
        else *(u32x2*)(MG + off) = pk4(*(const f32x4*)(MF + off) + g * v); } };

__device__ __forceinline__ void wave_gemm_32x64(const bf16_t* A, int lda, const bf16_t* Bt, int ldb, int K, int m0, int n0, int fr, int fq, f32x4 (&acc)[2][4]) {
    const bf16_t* ap = A + (size_t)(m0 + fr) * lda + 8 * fq;
    const bf16_t* bp = Bt + (size_t)(n0 + fr) * ldb + 8 * fq;
    for (int k0 = 0; k0 < K; k0 += 32) {
        const bf16x8 a0 = *(const bf16x8*)(ap + k0), a1 = *(const bf16x8*)(ap + (size_t)16 * lda + k0);
        bf16x8 b[4];
#pragma unroll
        for (int j = 0; j < 4; ++j) b[j] = *(const bf16x8*)(bp + (size_t)(16 * j) * ldb + k0);
#pragma unroll
        for (int j = 0; j < 4; ++j) { acc[0][j] = __builtin_amdgcn_mfma_f32_16x16x32_bf16(b[j], a0, acc[0][j], 0, 0, 0); acc[1][j] = __builtin_amdgcn_mfma_f32_16x16x32_bf16(b[j], a1, acc[1][j], 0, 0, 0); }
    }
}
template <class Epi>
__device__ __forceinline__ void gemm_simple(const Ctx& c, const bf16_t* A, int lda, const bf16_t* Bt, int ldb, int M, int N, int K, const Epi& epi) {
    const int nMt = M / 256, nNt = N / 64, ntiles = nMt * nNt;
    for (int tile = blockIdx.x; tile < ntiles; tile += gridDim.x) {
        const int tm = tile % nMt, tn = tile / nMt, m0 = tm * 256 + c.wave * 32, n0 = tn * 64;
        f32x4 acc[2][4];
#pragma unroll
        for (int i = 0; i < 2; ++i)
#pragma unroll
            for (int j = 0; j < 4; ++j) acc[i][j] = (f32x4){0.f, 0.f, 0.f, 0.f};
        wave_gemm_32x64(A, lda, Bt, ldb, K, m0, n0, c.fr, c.fq, acc);
#pragma unroll
        for (int i = 0; i < 2; ++i)
#pragma unroll
            for (int j = 0; j < 4; ++j) epi(m0 + 16 * i + c.fr, n0 + 16 * j + 4 * c.fq, acc[i][j]);
    }
}

struct EpiBf16 { bf16_t* O; int ld; __device__ __forceinline__ void operator()(int row, int col, f32x4 v) const { *(u32x2*)(O + (size_t)row * ld + col) = pk4(v); } };
struct EpiKV { bf16_t* KB; bf16_t* VT;
    __device__ __forceinline__ void operator()(int row, int col, f32x4 v) const {
        if (col < 256) { *(u32x2*)(KB + (size_t)row * 256 + col) = pk4(v); }
        else { const int cc = col - 256, h = cc >> 6, d = cc & 63, b = row >> 8, key = row & 255;
#pragma unroll
            for (int j = 0; j < 4; ++j) VT[((size_t)((b * 4 + h) * 64 + d + j)) * 256 + key] = (bf16_t)f2bf(v[j]); }
    } };
struct EpiDecay { float* W; const float* w0;
    __device__ __forceinline__ void operator()(int row, int col, f32x4 v) const {
        const f32x4 z = v + *(const f32x4*)(w0 + col); f32x4 o;
#pragma unroll
        for (int j = 0; j < 4; ++j) o[j] = __expf(-0.60653065971f * sigmoidf_(z[j]));
        *(f32x4*)(W + (size_t)row * RD + col) = o; } };
struct EpiSigBias { bf16_t* O; int ld; const float* bias;
    __device__ __forceinline__ void operator()(int row, int col, f32x4 v) const {
        const f32x4 z = v + *(const f32x4*)(bias + col); f32x4 o;
#pragma unroll
        for (int j = 0; j < 4; ++j) o[j] = sigmoidf_(z[j]);
        *(u32x2*)(O + (size_t)row * ld + col) = pk4(o); } };
struct EpiPool { bf16_t* Y; const float* scale; int gi;
    __device__ __forceinline__ void operator()(int row, int col, f32x4 v) const {
        const f32x4 s = *(const f32x4*)(scale + 64 * gi + col); *(u32x2*)(Y + (size_t)row * DM + 512 + 64 * gi + col) = pk4(v * s); } };
struct EpiOut { const float* x; float* x1; bf16_t* x1b;
    __device__ __forceinline__ void operator()(int row, int col, f32x4 v) const {
        const size_t off = (size_t)row * DM + col; const f32x4 o = *(const f32x4*)(x + off) + v; *(f32x4*)(x1 + off) = o; *(u32x2*)(x1b + off) = pk4(o); } };
struct EpiFfnIn { bf16_t* U; const float* rstd; int row_base;
    __device__ __forceinline__ void operator()(int row, int col, f32x4 v) const {
        const float s = rstd[row_base + row]; const int j = col >> 8, cc = col & 255;
        const size_t off = (size_t)((cc >> 7) & 1) * ((WS_GV - WS_U) / 2) + (size_t)row * FF + 128 * j + (cc & 127); *(u32x2*)(U + off) = pk4(v * s); } };
struct EpiAddOut { float* x;
    __device__ __forceinline__ void operator()(int row, int col, f32x4 v) const { const size_t off = (size_t)row * DM + col; *(f32x4*)(x + off) = *(const f32x4*)(x + off) + v; } };

__device__ __forceinline__ void phase_mix(const Params& p, const Ctx& c) {
    unsigned char* ws = p.ws;
    const bf16_t* P = (const bf16_t*)(ws + WS_P); const float* mu = p.in[I_MU];
    bf16_t* R = (bf16_t*)(ws + WS_R); bf16_t* KR = (bf16_t*)(ws + WS_KRAW); bf16_t* V = (bf16_t*)(ws + WS_V);
    bf16_t* LW = (bf16_t*)(ws + WS_LW); bf16_t* LA = (bf16_t*)(ws + WS_LA); bf16_t* LG = (bf16_t*)(ws + WS_LG);
    for (int row = c.gw; row < MTOK; row += c.ngw) {
        const int t = row & (SEQ - 1); const bf16_t* cur = P + (size_t)row * MIXIN;
#pragma unroll
        for (int i = 0; i < 7; ++i) {
            const int col = 4 * c.lane + 256 * i;
            const f32x4 cv = unpk4(*(const u32x2*)(cur + col));
            f32x4 pv = (f32x4){0.f, 0.f, 0.f, 0.f}; if (t > 0) pv = unpk4(*(const u32x2*)(cur - MIXIN + col));
            const f32x4 m4 = *(const f32x4*)(mu + col);
            f32x4 pm = cv + (pv - cv) * m4;
            if (i < 2) *(u32x2*)(R + (size_t)row * RD + col) = pk4(pm);
            else if (i < 4) *(u32x2*)(KR + (size_t)row * RD + (col - 512)) = pk4(pm);
            else if (i < 6) *(u32x2*)(V + (size_t)row * RD + (col - 1024)) = pk4(pm);
            else {
                const int cc = col - 1536;
                if (cc < 64) { f32x4 o; o[0] = tanhf(pm[0]); o[1] = tanhf(pm[1]); o[2] = tanhf(pm[2]); o[3] = tanhf(pm[3]); *(u32x2*)(LW + (size_t)row * 64 + cc) = pk4(o); }
                else if (cc < 128) { *(u32x2*)(LA + (size_t)row * 64 + (cc - 64)) = pk4(pm); }
                else { f32x4 o; o[0] = sigmoidf_(pm[0]); o[1] = sigmoidf_(pm[1]); o[2] = sigmoidf_(pm[2]); o[3] = sigmoidf_(pm[3]); *(u32x2*)(LG + (size_t)row * 128 + (cc - 128)) = pk4(o); }
            }
        }
    }
}
__device__ __forceinline__ void phase_pooldiff(const Params& p, const Ctx& c) {
    unsigned char* ws = p.ws;
    const bf16_t* P = (const bf16_t*)(ws + WS_P); bf16_t* DP = (bf16_t*)(ws + WS_DPOOL);
    const int col = 4 * c.lane, gi = c.lane >> 4, win = 2 << gi;
    for (int row = c.gw; row < MTOK; row += c.ngw) {
        const int t = row & (SEQ - 1); const bf16_t* cur = P + (size_t)row * MIXIN + RWKVIN + col;
        const f32x4 x0 = unpk4(*(const u32x2*)cur); f32x4 s = x0;
        for (int j = 1; j < 16; ++j) if (j < win && j <= t) s += unpk4(*(const u32x2*)(cur - (size_t)j * MIXIN));
        const int cnt = (t + 1) < win ? (t + 1) : win;
        *(u32x2*)(DP + (size_t)row * 256 + col) = pk4(s * (1.0f / (float)cnt) - x0);
    }
}
__device__ __forceinline__ void phase_memattn(const Params& p, const Ctx& c) {
    unsigned char* ws = p.ws;
    const bf16_t* P = (const bf16_t*)(ws + WS_P); const bf16_t* KB = (const bf16_t*)(ws + WS_KB); const bf16_t* VT = (const bf16_t*)(ws + WS_VT); bf16_t* Y = (bf16_t*)(ws + WS_YCAT);
    const int fr = c.fr, fq = c.fq;
    for (int unit = blockIdx.x; unit < BATCH * 4 * 16; unit += gridDim.x) {
        const int qt = unit & 15, h = (unit >> 4) & 3, b = unit >> 6;
#pragma unroll 1
        for (int qg = 0; qg < 2; ++qg) {
            const int row = b * SEQ + qt * 256 + c.wave * 32 + 16 * qg + fr;
            const bf16x8 q0 = *(const bf16x8*)(P + (size_t)row * MIXIN + 2048 + h * 64 + 8 * fq), q1 = *(const bf16x8*)(P + (size_t)row * MIXIN + 2048 + h * 64 + 32 + 8 * fq);
            f32x4 sc[16];
#pragma unroll
            for (int kg = 0; kg < 16; ++kg) {
                const bf16_t* kp = KB + (size_t)(b * 256 + 16 * kg + fr) * 256 + h * 64 + 8 * fq;
                const bf16x8 k0 = *(const bf16x8*)kp, k1 = *(const bf16x8*)(kp + 32);
                f32x4 a = (f32x4){0.f, 0.f, 0.f, 0.f};
                a = __builtin_amdgcn_mfma_f32_16x16x32_bf16(k0, q0, a, 0, 0, 0); a = __builtin_amdgcn_mfma_f32_16x16x32_bf16(k1, q1, a, 0, 0, 0); sc[kg] = a;
                if ((kg & 3) == 3) asm volatile("" ::: "memory");
            }
            float m = -1e30f;
#pragma unroll
            for (int kg = 0; kg < 16; ++kg) m = fmaxf(m, fmaxf(fmaxf(sc[kg][0], sc[kg][1]), fmaxf(sc[kg][2], sc[kg][3])));
            m = fmaxf(m, __shfl_xor(m, 16)); m = fmaxf(m, __shfl_xor(m, 32));
            float l = 0.f;
#pragma unroll
            for (int kg = 0; kg < 16; ++kg)
#pragma unroll
                for (int j = 0; j < 4; ++j) { const float e = __expf((sc[kg][j] - m) * 0.125f); sc[kg][j] = e; l += e; }
            l += __shfl_xor(l, 16); l += __shfl_xor(l, 32);
            const float linv = 1.0f / l;
            f32x4 o[4];
#pragma unroll
            for (int dg = 0; dg < 4; ++dg) o[dg] = (f32x4){0.f, 0.f, 0.f, 0.f};
#pragma unroll
            for (int s = 0; s < 8; ++s) {
                u32x4 w; w.x = pk2(sc[2 * s][0], sc[2 * s][1]); w.y = pk2(sc[2 * s][2], sc[2 * s][3]); w.z = pk2(sc[2 * s + 1][0], sc[2 * s + 1][1]); w.w = pk2(sc[2 * s + 1][2], sc[2 * s + 1][3]);
                const bf16x8 pf = __builtin_bit_cast(bf16x8, w);
#pragma unroll
                for (int dg = 0; dg < 4; ++dg) {
                    const bf16_t* vp = VT + ((size_t)((b * 4 + h) * 64 + 16 * dg + fr)) * 256 + 32 * s + 4 * fq;
                    u32x4 v; const u32x2 lo = *(const u32x2*)vp, hi = *(const u32x2*)(vp + 16); v.x = lo.x; v.y = lo.y; v.z = hi.x; v.w = hi.y;
                    o[dg] = __builtin_amdgcn_mfma_f32_16x16x32_bf16(__builtin_bit_cast(bf16x8, v), pf, o[dg], 0, 0, 0);
                }
                if (s & 1) asm volatile("" ::: "memory");
            }
#pragma unroll
            for (int dg = 0; dg < 4; ++dg) *(u32x2*)(Y + (size_t)row * DM + 768 + h * 64 + 16 * dg + 4 * fq) = pk4(o[dg] * linv);
        }
    }
}

__device__ __forceinline__ void phase_prep2(const Params& p, const Ctx& c) {
    unsigned char* ws = p.ws;
    const bf16_t* KR = (const bf16_t*)(ws + WS_KRAW); const bf16_t* AA = (const bf16_t*)(ws + WS_AA); const bf16_t* R = (const bf16_t*)(ws + WS_R);
    bf16_t* KK = (bf16_t*)((unsigned char*)p.out + DO_KK); bf16_t* BB = (bf16_t*)((unsigned char*)p.out + DO_BB); bf16_t* KF = (bf16_t*)((unsigned char*)p.out + DO_KF);
    float* BON = (float*)(ws + WS_BONUS);
    for (int it = c.gw; it < MTOK * 8; it += c.ngw) {
        const int row = it >> 3, h = it & 7, col = h * 64 + c.lane; const size_t off = (size_t)row * RD + col;
        const float k = bf2f(KR[off]), a = bf2f(AA[off]), r = bf2f(R[off]);
        const float kkv = k * p.in[I_KK][col];
        const float nrm = wave_sum(kkv * kkv);
        const float kap = kkv * rsqrtf(nrm + 1e-12f);
        const float kf = k * (1.0f + (a - 1.0f) * p.in[I_KA][col]);
        const float bon = wave_sum(r * kf * p.in[I_RK][col]);
        KK[off] = (bf16_t)f2bf(kap); BB[off] = (bf16_t)f2bf(kap * a); KF[off] = (bf16_t)f2bf(kf);
        if (c.lane == 0) BON[it] = bon;
    }
}

constexpr int TC = 32;
__device__ __forceinline__ void phase_scan(const Params& p, const Ctx& c) {
    unsigned char* ws = p.ws;
    const bf16_t* KK = (const bf16_t*)((unsigned char*)p.out + DO_KK); const bf16_t* BB = (const bf16_t*)((unsigned char*)p.out + DO_BB); const bf16_t* KF = (const bf16_t*)((unsigned char*)p.out + DO_KF);
    const bf16_t* R = (const bf16_t*)(ws + WS_R); const bf16_t* V = (const bf16_t*)(ws + WS_V); const float* W = (const float*)(ws + WS_W);
    float* YR = (float*)(ws + WS_YRAW);
    constexpr int OPF = 5 * TC * 64, BUFF = OPF + TC * 16;
    LAS float* L = (LAS float*)c.lds; LAS float* YB = L + 2 * BUFF;
    const int tid = c.tid;
    for (int unit = blockIdx.x; unit < BATCH * 8 * 4; unit += gridDim.x) {
        const int q = unit & 3, h = (unit >> 2) & 7, b = unit >> 5;
        const size_t rowbase = (size_t)b * SEQ;
        const int ss = tid >> 4, g4 = (tid & 15) * 4;
        u32x2 rb[4]; f32x4 rw; unsigned short rv;
        const int vs = tid >> 4, vi = tid & 15;
        auto issue = [&](int ch) {
            const size_t ro = (rowbase + (size_t)ch * TC + ss) * RD + h * 64 + g4;
            rb[0] = *(const u32x2*)(KK + ro); rb[1] = *(const u32x2*)(KF + ro); rb[2] = *(const u32x2*)(BB + ro); rb[3] = *(const u32x2*)(R + ro);
            rw = *(const f32x4*)(W + ro);
            rv = V[(rowbase + (size_t)ch * TC + vs) * RD + h * 64 + 16 * q + vi];
        };
        auto commit = [&](int buf) {
            LAS float* B = L + buf * BUFF;
            *(LAS f32x4*)(B + (0 * TC + ss) * 64 + g4) = unpk4(rb[0]);
            *(LAS f32x4*)(B + (1 * TC + ss) * 64 + g4) = rw;
            *(LAS f32x4*)(B + (2 * TC + ss) * 64 + g4) = unpk4(rb[1]);
            *(LAS f32x4*)(B + (3 * TC + ss) * 64 + g4) = unpk4(rb[2]);
            *(LAS f32x4*)(B + (4 * TC + ss) * 64 + g4) = unpk4(rb[3]);
            B[OPF + vs * 16 + vi] = bf2f(rv);
        };
        __syncthreads();
        issue(0); commit(0);
        __syncthreads();
        f32x4 S = (f32x4){0.f, 0.f, 0.f, 0.f};
        const int vrow = (tid >> 4) & 15, kq = tid & 15;
        for (int ch = 0; ch < SEQ / TC; ++ch) {
            if (ch + 1 < SEQ / TC) issue(ch + 1);
            if (tid < 256) {
                const LAS float* B = L + (ch & 1) * BUFF;
#pragma unroll 4
                for (int s = 0; s < TC; ++s) {
                    const f32x4 kap = *(const LAS f32x4*)(B + (0 * TC + s) * 64 + 4 * kq);
                    const f32x4 w4 = *(const LAS f32x4*)(B + (1 * TC + s) * 64 + 4 * kq);
                    const f32x4 kf4 = *(const LAS f32x4*)(B + (2 * TC + s) * 64 + 4 * kq);
                    const f32x4 b4 = *(const LAS f32x4*)(B + (3 * TC + s) * 64 + 4 * kq);
                    const f32x4 r4 = *(const LAS f32x4*)(B + (4 * TC + s) * 64 + 4 * kq);
                    const float vv = B[OPF + s * 16 + vrow];
                    const float sk = row_sum16((S[0] * kap[0] + S[1] * kap[1]) + (S[2] * kap[2] + S[3] * kap[3]));
                    S = S * w4 + kf4 * vv - b4 * sk;
                    const float y = row_sum16((S[0] * r4[0] + S[1] * r4[1]) + (S[2] * r4[2] + S[3] * r4[3]));
                    if (kq == 0) YB[s * 16 + vrow] = y;
                }
            }
            __syncthreads();
            if (ch + 1 < SEQ / TC) commit((ch + 1) & 1);
            { const int s = tid >> 4, i = tid & 15; YR[(rowbase + (size_t)ch * TC + s) * RD + h * 64 + 16 * q + i] = YB[s * 16 + i]; }
            __syncthreads();
        }
    }
}

__device__ __forceinline__ void phase_post(const Params& p, const Ctx& c) {
    unsigned char* ws = p.ws;
    const float* YR = (const float*)(ws + WS_YRAW); const float* BON = (const float*)(ws + WS_BONUS);
    const bf16_t* V = (const bf16_t*)(ws + WS_V); const bf16_t* G = (const bf16_t*)(ws + WS_G); bf16_t* Y = (bf16_t*)(ws + WS_YCAT);
    for (int it = c.gw; it < MTOK * 8; it += c.ngw) {
        const int row = it >> 3, h = it & 7, col = h * 64 + c.lane; const size_t off = (size_t)row * RD + col;
        const float y = YR[off];
        const float mean = wave_sum(y) * (1.0f / 64.0f); const float d = y - mean;
        const float var = wave_sum(d * d) * (1.0f / 64.0f);
        const float yn = d * rsqrtf(var + GN_EPS) * p.in[I_LNW][col] + p.in[I_LNB][col];
        const float bon = BON[it];
        const float o = (yn + bon * bf2f(V[off])) * bf2f(G[off]);
        Y[(size_t)row * DM + col] = (bf16_t)f2bf(o);
    }
}

__device__ __forceinline__ void phase_up_simple(const Params& p, const Ctx& c) {
    unsigned char* ws = p.ws;
    const bf16_t* Y = (const bf16_t*)(ws + WS_YCAT); const bf16_t* WU = (const bf16_t*)(ws + WS_WUPT); const bf16_t* GT = (const bf16_t*)(ws + WS_GATES); bf16_t* MG = (bf16_t*)(ws + WS_MERGED);
    const int nMt = MTOK / 256, nNt = DM / 64, ntiles = nMt * nNt;
    for (int tile = blockIdx.x; tile < ntiles; tile += gridDim.x) {
        const int tm = tile % nMt, tn = tile / nMt, m0 = tm * 256 + c.wave * 32, n0 = tn * 64;
        f32x4 tot[2][4];
#pragma unroll
        for (int i = 0; i < 2; ++i)
#pragma unroll
            for (int j = 0; j < 4; ++j) tot[i][j] = (f32x4){0.f, 0.f, 0.f, 0.f};
#pragma unroll
        for (int seg = 0; seg < 3; ++seg) {
            const int koff = seg == 0 ? 0 : (seg == 1 ? 512 : 768), K = seg == 0 ? 512 : 256;
            f32x4 acc[2][4];
#pragma unroll
            for (int i = 0; i < 2; ++i)
#pragma unroll
                for (int j = 0; j < 4; ++j) acc[i][j] = (f32x4){0.f, 0.f, 0.f, 0.f};
            wave_gemm_32x64(Y + koff, DM, WU + koff, DM, K, m0, n0, c.fr, c.fq, acc);
#pragma unroll
            for (int i = 0; i < 2; ++i)
#pragma unroll
                for (int j = 0; j < 4; ++j) { const f32x4 g = unpk4(*(const u32x2*)(GT + (size_t)(m0 + 16 * i + c.fr) * (3 * DM) + seg * DM + n0 + 16 * j + 4 * c.fq)); tot[i][j] += g * acc[i][j]; }
        }
#pragma unroll
        for (int i = 0; i < 2; ++i)
#pragma unroll
            for (int j = 0; j < 4; ++j) *(u32x2*)(MG + (size_t)(m0 + 16 * i + c.fr) * DM + n0 + 16 * j + 4 * c.fq) = pk4(tot[i][j]);
    }
}

__device__ __forceinline__ void phase_rowstat(const Params& p, const Ctx& c) {
    float* RS = (float*)(p.ws + WS_RSTD2);
    for (int m = c.gw; m < MTOK; m += c.ngw) {
        const f32x4* xr = (const f32x4*)(p.out + (size_t)m * DM) + c.lane; float s = 0.f;
#pragma unroll
        for (int j = 0; j < 4; ++j) { const f32x4 v = xr[64 * j]; s += (v[0] * v[0] + v[1] * v[1]) + (v[2] * v[2] + v[3] * v[3]); }
        s = wave_sum(s);
        if (c.lane == 0) RS[m] = rsqrtf(s * (1.f / DM) + NORM_EPS);
    }
}
__device__ __forceinline__ void phase_ffn_act(const Params& p, const Ctx& c, int half) {
    unsigned char* ws = p.ws;
    const bf16_t* U = (const bf16_t*)(ws + WS_U); const bf16_t* GV = (const bf16_t*)(ws + WS_GV); bf16_t* ACT = (bf16_t*)(ws + WS_ACT) + (size_t)half * (MTOK / 2) * FF;
    const float* cw = p.in[I_CONVW]; const float* cb = p.in[I_CONVB];
    const int ngrp = (MTOK / 2) * (FF / 4);
    for (int idx = blockIdx.x * NTHREADS + c.tid; idx < ngrp; idx += gridDim.x * NTHREADS) {
        const int row = idx / (FF / 4), col = 4 * (idx % (FF / 4)), t = row & (SEQ - 1); const size_t off = (size_t)row * FF + col;
        const f32x4 u0 = unpk4(*(const u32x2*)(U + off));
        f32x4 u1 = (f32x4){0.f, 0.f, 0.f, 0.f}, u2 = u1;
        if (t >= 1) u1 = unpk4(*(const u32x2*)(U + off - FF));
        if (t >= 2) u2 = unpk4(*(const u32x2*)(U + off - 2 * FF));
        const f32x4 g = unpk4(*(const u32x2*)(GV + off));
        const f32x4 uc = *(const f32x4*)(cw + col) * u2 + *(const f32x4*)(cw + FF + col) * u1 + *(const f32x4*)(cw + 2 * FF + col) * u0 + *(const f32x4*)(cb + col);
        f32x4 o;
#pragma unroll
        for (int j = 0; j < 4; ++j) o[j] = 0.5f * uc[j] * (1.0f + erff(uc[j] * 0.70710678118f)) * g[j];
        *(u32x2*)(ACT + off) = pk4(o);
    }
}
__device__ __forceinline__ void phase_final_norm(const Params& p, const Ctx& c) {
    const float* g = p.in[I_NFING];
    for (int m = c.gw; m < MTOK; m += c.ngw) {
        f32x4* xr = (f32x4*)(p.out + (size_t)m * DM) + c.lane; const f32x4* gr = (const f32x4*)g + c.lane;
        f32x4 v[4]; float s = 0.f;
#pragma unroll
        for (int j = 0; j < 4; ++j) { v[j] = xr[64 * j]; s += (v[j][0] * v[j][0] + v[j][1] * v[j][1]) + (v[j][2] * v[j][2] + v[j][3] * v[j][3]); }
        const float rstd = rsqrtf(wave_sum(s) * (1.f / DM) + NORM_EPS);
#pragma unroll
        for (int j = 0; j < 4; ++j) xr[64 * j] = v[j] * rstd * gr[64 * j];
    }
}

constexpr int NPHASES = 17;
__global__ void __launch_bounds__(NTHREADS, 2) fwd_kernel(Params p) {
    extern __shared__ __attribute__((aligned(16))) unsigned char lds_raw[];
    Ctx c; c.tid = threadIdx.x; c.lane = c.tid & 63; c.wave = __builtin_amdgcn_readfirstlane(c.tid >> 6); c.fr = c.lane & 15; c.fq = c.lane >> 4;
    c.gw = blockIdx.x * NWAVES + c.wave; c.ngw = gridDim.x * NWAVES; c.lds = (LAS unsigned char*)lds_raw;
    unsigned char* ws = p.ws;
#if ONE_LAUNCH
    cg::grid_group grid = cg::this_grid();
#define SEAM() grid.sync()
#else
#define SEAM() do {} while (0)
#endif
#define IN(k) (p.ph_lo <= (k) && (k) < p.ph_hi)
#define END(k) do { if (IN((k) + 1)) SEAM(); } while (0)
    if (IN(0)) { phase_prologue(p, c); END(0); }
    if (IN(1)) {
        gemm_pg8_8(c, (const bf16_t*)(ws + WS_H), DM, (const bf16_t*)(ws + WS_WG1T), DM, MTOK, MIXIN, DM, F8Store{(bf16_t*)(ws + WS_P), MIXIN});
        gemm_simple(c, (const bf16_t*)(ws + WS_MEMN), DM, (const bf16_t*)(ws + WS_WKVT), DM, BATCH * NMEM, 512, DM, EpiKV{(bf16_t*)(ws + WS_KB), (bf16_t*)(ws + WS_VT)});
        END(1); }
    if (IN(2)) { phase_mix(p, c); phase_pooldiff(p, c); phase_memattn(p, c); END(2); }
    if (IN(3)) {
        gemm_simple(c, (const bf16_t*)(ws + WS_LW), 64, (const bf16_t*)(ws + WS_WLWT), 64, MTOK, RD, 64, EpiDecay{(float*)(ws + WS_W), p.in[I_W0]});
        gemm_simple(c, (const bf16_t*)(ws + WS_LA), 64, (const bf16_t*)(ws + WS_WLAT), 64, MTOK, RD, 64, EpiSigBias{(bf16_t*)(ws + WS_AA), RD, p.in[I_A0]});
        gemm_simple(c, (const bf16_t*)(ws + WS_LG), 128, (const bf16_t*)(ws + WS_WLGT), 128, MTOK, RD, 128, EpiBf16{(bf16_t*)(ws + WS_G), RD});
#pragma unroll 1
        for (int gi = 0; gi < 4; ++gi)
            gemm_simple(c, (const bf16_t*)(ws + WS_DPOOL) + 64 * gi, 256, (const bf16_t*)(ws + WS_WPT) + 4096 * gi, 64, MTOK, 64, 64, EpiPool{(bf16_t*)(ws + WS_YCAT), p.in[I_POOLS], gi});
        END(3); }
    if (IN(4)) { phase_prep2(p, c); END(4); }
    if (IN(5)) { phase_scan(p, c); END(5); }
    if (IN(6)) { phase_post(p, c); END(6); }
    if (IN(7)) {
        gemm_pg8_8(c, (const bf16_t*)(ws + WS_H), DM, (const bf16_t*)(ws + WS_WG1T) + (size_t)MIXIN * DM, DM, MTOK, 3 * DM, DM, F8SigBias{(bf16_t*)(ws + WS_GATES), 3 * DM, p.in[I_BGATE]});
        END(7); }
    if (IN(8)) {
        const bf16_t* Y = (const bf16_t*)(ws + WS_YCAT); const bf16_t* WU = (const bf16_t*)(ws + WS_WUPT); const bf16_t* GT = (const bf16_t*)(ws + WS_GATES); bf16_t* MG = (bf16_t*)(ws + WS_MERGED);
        gemm_pg8_4(c, Y, DM, WU, DM, MTOK, DM, 512, F4Up<0>{p.out, GT, MG});
        gemm_pg8_4(c, Y + 512, DM, WU + 512, DM, MTOK, DM, 256, F4Up<1>{p.out, GT, MG});
        gemm_pg8_4(c, Y + 768, DM, WU + 768, DM, MTOK, DM, 256, F4Up<2>{p.out, GT, MG});
        END(8); }
    if (IN(9)) {
        gemm_pg8_4(c, (const bf16_t*)(ws + WS_MERGED), DM, (const bf16_t*)(ws + WS_WOT), DM, MTOK, DM, DM, EpiOut{p.in[I_X], p.out, (bf16_t*)(ws + WS_X1B)});
        END(9); }
    if (IN(10)) { phase_rowstat(p, c); END(10); }
#pragma unroll 1
    for (int half = 0; half < 2; ++half) {
        if (IN(11 + 2 * half)) {
            gemm_pg8_8(c, (const bf16_t*)(ws + WS_X1B) + (size_t)half * (MTOK / 2) * DM, DM, (const bf16_t*)(ws + WS_WF1T), DM, MTOK / 2, 2 * FF, DM,
                       F8FfnIn{(bf16_t*)(ws + WS_U), (const float*)(ws + WS_RSTD2), half * (MTOK / 2)});
            END(11 + 2 * half); }
        if (IN(12 + 2 * half)) { phase_ffn_act(p, c, half); END(12 + 2 * half); }
    }
    if (IN(15)) {
        gemm_pg8_4(c, (const bf16_t*)(ws + WS_ACT), FF, (const bf16_t*)(ws + WS_WF2T), FF, MTOK, DM, FF, EpiAddOut{p.out});
        END(15); }
    if (IN(16)) { phase_final_norm(p, c); }
#undef IN
#undef END
}

__global__ void nan_fill(float* o, int n) { const int i = blockIdx.x * blockDim.x + threadIdx.x; if (i < n) o[i] = __builtin_nanf(""); }

extern "C" void kernel_launch(void* const* d_in, const int* in_sizes, int n_in, void* d_out, int out_size, void* d_ws, size_t ws_size, hipStream_t stream) {
    static int grid = 0;
    if (grid == 0) {
        int dev = 0, cus = 0, per_cu = 0;
        if (hipGetDevice(&dev) != hipSuccess || hipDeviceGetAttribute(&cus, hipDeviceAttributeMultiprocessorCount, dev) != hipSuccess) cus = 256;
        (void)hipFuncSetAttribute((const void*)fwd_kernel, hipFuncAttributeMaxDynamicSharedMemorySize, LDS_BYTES);
        if (hipOccupancyMaxActiveBlocksPerMultiprocessor(&per_cu, (const void*)fwd_kernel, NTHREADS, LDS_BYTES) != hipSuccess || per_cu < 1) per_cu = 1;
        (void)hipGetLastError();
        grid = cus;
        if (n_in != 31 || out_size != MTOK * DM || ws_size < WS_END) grid = -1;
    }
    if (grid < 0) { nan_fill<<<(out_size + 255) / 256, 256, 0, stream>>>((float*)d_out, out_size); return; }
    Params p{};
    for (int i = 0; i < 31; ++i) p.in[i] = (const float*)d_in[i];
    p.out = (float*)d_out; p.ws = (unsigned char*)d_ws;
#if ONE_LAUNCH
    p.ph_lo = 0; p.ph_hi = NPHASES;
    void* args[] = {&p};
    hipError_t e = hipLaunchCooperativeKernel((const void*)fwd_kernel, dim3(grid), dim3(NTHREADS), args, LDS_BYTES, stream);
    if (e != hipSuccess) fprintf(stderr, "cooperative launch failed: %s (grid %d)\n", hipGetErrorString(e), grid);
#else
    for (int ph = 0; ph < NPHASES; ++ph) { p.ph_lo = ph; p.ph_hi = ph + 1; hipLaunchKernelGGL(fwd_kernel, dim3(grid), dim3(NTHREADS), LDS_BYTES, stream, p); }
#endif
}
```

```cpp
#include <hip/hip_runtime.h>
#include <hip/hip_cooperative_groups.h>
#include <cstdio>
#include <cstdint>
namespace cg = cooperative_groups;

#ifndef ONE_LAUNCH
#define ONE_LAUNCH 1
#endif
#ifndef PH_MASK
#define PH_MASK 0xFFFFFFFFu
#endif
#define PH_ON(k) ((PH_MASK >> (k)) & 1u)
#ifndef REP_MASK
#define REP_MASK 0u
#endif

#define LAS __attribute__((address_space(3)))
typedef unsigned short bf16_t;
typedef short bf16x8 __attribute__((ext_vector_type(8)));
typedef float f32x4 __attribute__((ext_vector_type(4)));
typedef float f32x2 __attribute__((ext_vector_type(2)));
typedef unsigned u32x4 __attribute__((ext_vector_type(4)));
typedef unsigned u32x2 __attribute__((ext_vector_type(2)));

constexpr int BATCH = 8, SEQ = 4096, DM = 1024, MTOK = BATCH * SEQ;
constexpr int NMEM = 256, RD = 512, MIXIN = 2304, RWKVIN = 1792, FF = 2816, NG1 = MIXIN + 3 * DM;
constexpr int NWAVES = 8, NTHREADS = 512;
constexpr float NORM_EPS = 1e-6f, GN_EPS = 64e-5f;

constexpr size_t MiB = 1u << 20;
constexpr size_t WS_WG1T = 1 * MiB;
constexpr size_t WS_WKVT = WS_WG1T + (size_t)NG1 * DM * 2;
constexpr size_t WS_WUPT = WS_WKVT + (size_t)512 * DM * 2;
constexpr size_t WS_WOT = WS_WUPT + (size_t)DM * DM * 2;
constexpr size_t WS_WF1T = WS_WOT + (size_t)DM * DM * 2;
constexpr size_t WS_WF2T = WS_WF1T + (size_t)2 * FF * DM * 2;
constexpr size_t WS_WLWT = WS_WF2T + (size_t)DM * FF * 2;
constexpr size_t WS_WLAT = WS_WLWT + (size_t)RD * 64 * 2;
constexpr size_t WS_WLGT = WS_WLAT + (size_t)RD * 64 * 2;
constexpr size_t WS_WPT = WS_WLGT + (size_t)RD * 128 * 2;
constexpr size_t WS_WEND = WS_WPT + (size_t)4 * 64 * 64 * 2;
static_assert(WS_WEND <= 34 * MiB, "weights region");
constexpr size_t WS_BONUS = 34 * MiB;
constexpr size_t WS_RSTD2 = 35 * MiB;
constexpr size_t WS_KB = 36 * MiB;
constexpr size_t WS_VT = 37 * MiB;
constexpr size_t WS_MEMN = 38 * MiB;
constexpr size_t WS_H = 42 * MiB;
constexpr size_t WS_YCAT = 106 * MiB;
constexpr size_t WS_P = 170 * MiB;
constexpr size_t WS_W = 170 * MiB;
constexpr size_t WS_G = 234 * MiB;
constexpr size_t WS_AA = 266 * MiB;
constexpr size_t WS_KRAW = 314 * MiB;
constexpr size_t WS_YRAW = 266 * MiB;
constexpr size_t WS_R = 346 * MiB;
constexpr size_t WS_V = 378 * MiB;
constexpr size_t WS_LW = 410 * MiB;
constexpr size_t WS_LA = 414 * MiB;
constexpr size_t WS_LG = 418 * MiB;
constexpr size_t WS_DPOOL = 426 * MiB;
constexpr size_t WS_GATES = 170 * MiB;
constexpr size_t WS_MERGED = 362 * MiB;
constexpr size_t WS_X1B = 426 * MiB;
constexpr size_t WS_U = 42 * MiB;
constexpr size_t WS_GV = 130 * MiB;
constexpr size_t WS_ACT = 218 * MiB;
constexpr size_t WS_END = 490 * MiB;
constexpr size_t DO_KK = 0, DO_BB = 32 * MiB, DO_KF = 64 * MiB;

constexpr int LDS_BYTES = 147456;
constexpr int LDS_MISC_OFF = 131072 + 320;
constexpr size_t WS_BAR = 0, WS_CTL_BYTES = 65536;

__device__ __forceinline__ unsigned f2bf(float f) { unsigned u = __float_as_uint(f); return (u + 0x7fffu + ((u >> 16) & 1u)) >> 16; }
__device__ __forceinline__ float bf2f(unsigned h) { return __uint_as_float(h << 16); }
__device__ __forceinline__ unsigned pk2(float lo, float hi) { return f2bf(lo) | (f2bf(hi) << 16); }
__device__ __forceinline__ u32x2 pk4(f32x4 v) { u32x2 r; r.x = pk2(v[0], v[1]); r.y = pk2(v[2], v[3]); return r; }
__device__ __forceinline__ f32x4 unpk4(u32x2 u) { f32x4 r; r[0] = bf2f(u.x & 0xffffu); r[1] = bf2f(u.x >> 16); r[2] = bf2f(u.y & 0xffffu); r[3] = bf2f(u.y >> 16); return r; }
__device__ __forceinline__ float wave_sum(float v) {
#pragma unroll
    for (int o = 1; o < 64; o <<= 1) v += __shfl_xor(v, o);
    return v;
}
__device__ __forceinline__ float sigmoidf_(float x) { return 1.0f / (1.0f + __expf(-x)); }
template <int CTRL> __device__ __forceinline__ float dpp_f(float x) { return __builtin_bit_cast(float, __builtin_amdgcn_update_dpp(0, __builtin_bit_cast(int, x), CTRL, 0xF, 0xF, false)); }
__device__ __forceinline__ float row_sum16(float x) {
    x += dpp_f<0xB1>(x);
    x += dpp_f<0x4E>(x);
    x += dpp_f<0x141>(x);
    x += dpp_f<0x140>(x);
    return x;
}

#define XB_TMO      128
#define XB_XCNT(j)  (256  + 64 * (j))
#define XB_XSUB(j)  (1280 + 64 * (j))
#define XB_XGEN(j)  (2304 + 64 * (j))
#define XB_TOP      3328
#define XB_TOPGEN   3392
#define XCD_BAR_WORDS 3456
#define XB_SPIN_CAP (1u << 18)

__device__ __forceinline__ unsigned xb_ld(unsigned* p)              { return __hip_atomic_load(p, __ATOMIC_RELAXED, __HIP_MEMORY_SCOPE_AGENT); }
__device__ __forceinline__ unsigned xb_add(unsigned* p, unsigned v) { return __hip_atomic_fetch_add(p, v, __ATOMIC_RELAXED, __HIP_MEMORY_SCOPE_AGENT); }
__device__ __forceinline__ unsigned xb_xcc_id() { return (unsigned)__builtin_amdgcn_s_getreg((3 << 11) | 20) & 0xFu; }
#define XB_SPIN(cond, bar) do { unsigned _sp = 0; while (cond) { __builtin_amdgcn_s_sleep(1); \
    if ((++_sp & 255u) == 0u) { if (xb_ld(&(bar)[XB_TMO])) break; if (_sp > XB_SPIN_CAP) { atomicAdd(&(bar)[XB_TMO], 1u); break; } } } } while (0)

struct XcdBarrier {
    unsigned* bar; unsigned x;
    volatile LAS unsigned* st;
};

__device__ __forceinline__ XcdBarrier xcd_barrier_post(unsigned* bar, volatile LAS unsigned* st) {
    XcdBarrier b; b.bar = bar; b.x = xb_xcc_id(); b.st = st;
    if (threadIdx.x == 0) (void)xb_add(&bar[XB_XCNT(b.x)], 1u);
    return b;
}
__device__ __forceinline__ void xcd_barrier_complete(unsigned* bar, unsigned x, unsigned& nloc, unsigned& nx) {
    const unsigned G = gridDim.x * gridDim.y * gridDim.z;
    unsigned sum, cnt, mine, sp = 0u;
    for (;;) {
        sum = 0u; cnt = 0u; mine = 0u;
#pragma unroll
        for (unsigned j = 0; j < 16; ++j) { const unsigned c = xb_ld(&bar[XB_XCNT(j)]); sum += c; cnt += (c > 0u) ? 1u : 0u; mine = (j == x) ? c : mine; }
        if (sum == G) break;
        __builtin_amdgcn_s_sleep(1);
        if ((++sp & 255u) == 0u) { if (xb_ld(&bar[XB_TMO])) break; if (sp > XB_SPIN_CAP) { atomicAdd(&bar[XB_TMO], 1u); break; } }
    }
    nloc = mine > 0u ? mine : 1u; nx = cnt > 0u ? cnt : 1u;
}

__device__ __forceinline__ void xcd_barrier(const XcdBarrier& b) {
    asm volatile("s_waitcnt vmcnt(0)" ::: "memory");
    __syncthreads();
    if (threadIdx.x == 0) {
        unsigned* bar = b.bar;
        __builtin_amdgcn_s_waitcnt(0);
        unsigned nloc = b.st[0], nx = b.st[1];
        if (nloc == 0u) { xcd_barrier_complete(bar, b.x, nloc, nx); b.st[0] = nloc; b.st[1] = nx; }
        const unsigned old = xb_add(&bar[XB_XSUB(b.x)], 1u);
        const unsigned gen = old / nloc;
        if (old + 1u == (gen + 1u) * nloc) {
            __builtin_amdgcn_fence(__ATOMIC_RELEASE, "agent");
            asm volatile("s_waitcnt vmcnt(0)" ::: "memory");
            const unsigned og = xb_add(&bar[XB_TOP], 1u);
            const unsigned tg = og / nx;
            if (og + 1u == (tg + 1u) * nx) xb_add(&bar[XB_TOPGEN], 1u);
            else XB_SPIN(xb_ld(&bar[XB_TOPGEN]) == tg, bar);
            __builtin_amdgcn_fence(__ATOMIC_ACQUIRE, "agent");
            xb_add(&bar[XB_XGEN(b.x)], 1u);
            asm volatile("s_waitcnt vmcnt(0)" ::: "memory");
        } else {
            XB_SPIN(xb_ld(&bar[XB_XGEN(b.x)]) == gen, bar);
            __builtin_amdgcn_fence(__ATOMIC_ACQUIRE, "agent");
            asm volatile("s_waitcnt vmcnt(0)" ::: "memory");
        }
    }
    __syncthreads();
}


struct Params { const float* in[31]; float* out; unsigned char* ws; int ph_lo, ph_hi; };
enum { I_X = 0, I_MEM, I_NMIXG, I_WINMIX, I_MU, I_W0, I_WLORAB, I_A0, I_ALORAB, I_GLORAB, I_KK, I_KA, I_RK, I_LNW, I_LNB, I_POOLW, I_POOLS, I_NMEMG, I_WMEMKV,
       I_WUPR, I_WUPP, I_WUPM, I_WGATE, I_BGATE, I_WO, I_NFFNG, I_WFFNIN, I_CONVW, I_CONVB, I_WFFNOUT, I_NFING };

struct Ctx { int tid, lane, wave, fr, fq, gw, ngw; LAS unsigned char* lds; };

__device__ __forceinline__ int rowmap(int mode, int n) {
    if (mode == 0) return n;
    const int half = n >= FF ? 1 : 0, c = n - half * FF;
    return (c >> 7) * 256 + half * 128 + (c & 127);
}
__device__ __forceinline__ void transpose_item(const float* W, int K, int N, bf16_t* WT, int ldd, int koff, int mode, const float* kscale, LAS float* scr, int item, int lane) {
    const int nblk = N / 32, kb = item / nblk, nb = item % nblk, k0 = 64 * kb, n0 = 32 * nb;
#pragma unroll 8
    for (int i = 0; i < 32; ++i) { const int kk = 2 * i + (lane >> 5); float v = W[(size_t)(k0 + kk) * N + n0 + (lane & 31)]; if (kscale) v *= kscale[k0 + kk]; scr[kk * 33 + (lane & 31)] = v; }
    asm volatile("s_waitcnt lgkmcnt(0)" ::: "memory");
    const int c = lane & 7;
#pragma unroll
    for (int j = 0; j < 4; ++j) { const int n = (lane >> 3) + 8 * j; const LAS float* s = scr + (8 * c) * 33 + n;
        u32x4 o; o.x = pk2(s[0 * 33], s[1 * 33]); o.y = pk2(s[2 * 33], s[3 * 33]); o.z = pk2(s[4 * 33], s[5 * 33]); o.w = pk2(s[6 * 33], s[7 * 33]);
        *(u32x4*)(WT + (size_t)rowmap(mode, n0 + n) * ldd + koff + k0 + 8 * c) = o; }
    asm volatile("s_waitcnt lgkmcnt(0)" ::: "memory");
}
__device__ __forceinline__ void rmsnorm_row_bf16(const float* xrow, const float* g, bf16_t* orow, int lane) {
    const f32x4* xr = (const f32x4*)xrow + lane; const f32x4* gr = (const f32x4*)g + lane;
    f32x4 v[4]; float s = 0.f;
#pragma unroll
    for (int j = 0; j < 4; ++j) { v[j] = xr[64 * j]; s += (v[j][0] * v[j][0] + v[j][1] * v[j][1]) + (v[j][2] * v[j][2] + v[j][3] * v[j][3]); }
    const float rstd = rsqrtf(wave_sum(s) * (1.f / DM) + NORM_EPS);
    u32x2* o = (u32x2*)orow + lane;
#pragma unroll
    for (int j = 0; j < 4; ++j) { const f32x4 gg = gr[64 * j]; o[64 * j] = pk4(v[j] * rstd * gg); }
}

__device__ __forceinline__ void phase_prologue(const Params& p, const Ctx& c) {
    LAS float* scr = (LAS float*)(c.lds + c.wave * 16384);
    unsigned char* ws = p.ws;
#define TR(Wp, K_, N_, WTp, ldd_, koff_, mode_, sc_) { const int ni_ = ((K_) / 64) * ((N_) / 32); if (r < ni_) { transpose_item(Wp, K_, N_, (bf16_t*)(WTp), ldd_, koff_, mode_, sc_, scr, r, c.lane); continue; } r -= ni_; }
    constexpr int NIT = (DM / 64) * (MIXIN / 32) + (DM / 64) * (3 * DM / 32) + (DM / 64) * (512 / 32) + (512 / 64) * (DM / 32) + 2 * (256 / 64) * (DM / 32) + (DM / 64) * (DM / 32)
                      + (DM / 64) * (2 * FF / 32) + (FF / 64) * (DM / 32) + 2 * (RD / 32) + 2 * (RD / 32) + 4 * 2;
    for (int it = c.gw; it < NIT; it += c.ngw) {
        int r = it;
        TR(p.in[I_WINMIX], DM, MIXIN, ws + WS_WG1T, DM, 0, 0, nullptr)
        TR(p.in[I_WGATE], DM, 3 * DM, ws + WS_WG1T + (size_t)MIXIN * DM * 2, DM, 0, 0, nullptr)
        TR(p.in[I_WMEMKV], DM, 512, ws + WS_WKVT, DM, 0, 0, nullptr)
        TR(p.in[I_WUPR], 512, DM, ws + WS_WUPT, DM, 0, 0, nullptr)
        TR(p.in[I_WUPP], 256, DM, ws + WS_WUPT, DM, 512, 0, nullptr)
        TR(p.in[I_WUPM], 256, DM, ws + WS_WUPT, DM, 768, 0, nullptr)
        TR(p.in[I_WO], DM, DM, ws + WS_WOT, DM, 0, 0, nullptr)
        TR(p.in[I_WFFNIN], DM, 2 * FF, ws + WS_WF1T, DM, 0, 1, p.in[I_NFFNG])
        TR(p.in[I_WFFNOUT], FF, DM, ws + WS_WF2T, FF, 0, 0, nullptr)
        TR(p.in[I_WLORAB], 64, RD, ws + WS_WLWT, 64, 0, 0, nullptr)
        TR(p.in[I_ALORAB], 64, RD, ws + WS_WLAT, 64, 0, 0, nullptr)
        TR(p.in[I_GLORAB], 128, RD, ws + WS_WLGT, 128, 0, 0, nullptr)
        TR(p.in[I_POOLW] + 0 * 4096, 64, 64, ws + WS_WPT + 0 * 8192, 64, 0, 0, nullptr)
        TR(p.in[I_POOLW] + 1 * 4096, 64, 64, ws + WS_WPT + 1 * 8192, 64, 0, 0, nullptr)
        TR(p.in[I_POOLW] + 2 * 4096, 64, 64, ws + WS_WPT + 2 * 8192, 64, 0, 0, nullptr)
        TR(p.in[I_POOLW] + 3 * 4096, 64, 64, ws + WS_WPT + 3 * 8192, 64, 0, 0, nullptr)
    }
#undef TR
    for (int m = c.gw; m < MTOK; m += c.ngw) rmsnorm_row_bf16(p.in[I_X] + (size_t)m * DM, p.in[I_NMIXG], (bf16_t*)(ws + WS_H) + (size_t)m * DM, c.lane);
    for (int m = c.gw; m < BATCH * NMEM; m += c.ngw) rmsnorm_row_bf16(p.in[I_MEM] + (size_t)m * DM, p.in[I_NMEMG], (bf16_t*)(ws + WS_MEMN) + (size_t)m * DM, c.lane);
}

namespace pg8 {
#define PG8_LAS __attribute__((address_space(3)))
typedef unsigned short bf16_t;
typedef short bf16x8 __attribute__((ext_vector_type(8)));
typedef float f32x4 __attribute__((ext_vector_type(4)));
typedef unsigned u32x4 __attribute__((ext_vector_type(4)));
constexpr int BM = 256, BK = 64, HALF = 128, HTB = HALF * BK * 2  , STAGE_BYTES = 8 * HTB, NXCD = 8, WGM = 8;

__host__ __device__ __forceinline__ int lds_byte(int r, int c) { const int st = (r >> 4) * 2 + (c >> 5), rr = r & 15, cc = c & 31, ob = rr * 64 + cc * 2; return st * 1024 + (ob ^ (((ob >> 9) & 1) << 5)); }
__host__ __device__ __forceinline__ void stage_rc(int b, int& R, int& C) { const int st = b / 1024, sb = b % 1024, swz = sb ^ (((sb >> 9) & 1) << 5); R = (st >> 1) * 16 + swz / 64; C = (st & 1) * 32 + (swz % 64) / 2; }
__host__ __device__ __forceinline__ int perm32(int rho) { const int n = rho >> 4, i = rho & 15; return 8 * (i >> 2) + 4 * n + (i & 3); }

struct Unit { int pm, pn; };
struct Gemm { const bf16_t* A; const bf16_t* Bt; int M, N, K, lda, ldb; };

struct StaticOrder {
    int nM, nN, nwg, G, c;
    __host__ __device__ void init(int M, int N, int G_, int c_) { nM = M / BM; nN = N / BM; nwg = nM * nN; G = G_; c = c_; }
    __host__ __device__ bool next(int i, Unit& u) const {
        const long L = (long)i * G + c; if (L >= nwg) return false;
        int wgid = (int)L; { const int q = nwg / NXCD, r = nwg % NXCD, xcd = wgid % NXCD, off = wgid / NXCD; wgid = (xcd < r ? xcd * (q + 1) : r * (q + 1) + (xcd - r) * q) + off; }
        const int nig = WGM * nN, gid = wgid / nig, fm = gid * WGM, gsz = (nM - fm) < WGM ? (nM - fm) : WGM;
        u.pm = fm + ((wgid % nig) % gsz); u.pn = (wgid % nig) / gsz; return true;
    }
    __device__ __forceinline__ void a_ready(const Unit&) const {}
    __device__ __forceinline__ void done(const Unit&) const {}
};


template <class Epi, class Sched, bool ALIGN_EPI = false, bool SP2 = false>
__device__ __forceinline__ void gemm_phase(PG8_LAS unsigned char* lds, const Gemm g, const Sched& S, const Epi& E) {
    int tid_ = threadIdx.x; asm volatile("" : "+v"(tid_));
    const int tid = tid_, wid = __builtin_amdgcn_readfirstlane(tid >> 6), lane = tid & 63, wr = wid >> 2, wc = wid & 3, fr = lane & 15, fq = lane >> 4;
    const int K = g.K, nt = K / BK;
    unsigned voffA[2], voffB[2];
#pragma unroll
    for (int i = 0; i < 2; ++i) { int R, C; stage_rc(tid * 16 + i * 8192, R, C); const int Rb = Epi::PERM ? ((R & ~31) + perm32(R & 31)) : R;
        voffA[i] = (unsigned)(R * g.lda + C) * 2u; voffB[i] = (unsigned)(Rb * g.ldb + C) * 2u; }
    const size_t kstep = (size_t)(BK * 2);
    const size_t hstepA = (size_t)HALF * g.lda * 2, hstepB = (size_t)HALF * g.ldb * 2;
    const size_t tstepA = 2 * hstepA, tstepB = 2 * hstepB;
    const unsigned ldsw = (unsigned)wid * 1024u;
    const int aoff = lds_byte(wr * 64 + fr, fq * 8), boff = lds_byte(wc * 32 + fr, fq * 8);
#define PG8_SA(b, h) (((b) * 2 + (h)) * HTB)
#define PG8_SB(b, h) ((4 + (b) * 2 + (h)) * HTB)
#define PG8_STAGE(bufoff, gbase, voff) do { _Pragma("unroll") for (int _i = 0; _i < 2; ++_i) \
        __builtin_amdgcn_global_load_lds((const unsigned*)((const char*)(gbase) + (voff)[_i]), (PG8_LAS unsigned*)(lds + (bufoff) + ldsw + _i * 8192), 16, 0, 0); } while (0)
#define PG8_LDA(dst, b, h) do { _Pragma("unroll") for (int m = 0; m < 4; ++m) _Pragma("unroll") for (int k = 0; k < 2; ++k) dst[m][k] = *(const PG8_LAS bf16x8*)(lds + PG8_SA(b, h) + aoff + m * 2048 + k * 1024); } while (0)
#define PG8_LDB(dst, b, h) do { _Pragma("unroll") for (int n = 0; n < 2; ++n) _Pragma("unroll") for (int k = 0; k < 2; ++k) dst[n][k] = *(const PG8_LAS bf16x8*)(lds + PG8_SB(b, h) + boff + n * 2048 + k * 1024); } while (0)
#define PG8_MMA(ai, bj, At, Bt) do { __builtin_amdgcn_s_setprio(1); _Pragma("unroll") for (int m = 0; m < 4; ++m) _Pragma("unroll") for (int n = 0; n < 2; ++n) _Pragma("unroll") for (int k = 0; k < 2; ++k) \
        acc[ai][bj][m][n] = __builtin_amdgcn_mfma_f32_16x16x32_bf16(Bt[n][k], At[m][k], acc[ai][bj][m][n], 0, 0, 0); __builtin_amdgcn_s_setprio(0); } while (0)
#define PG8_WAIT_V(n) asm volatile("s_waitcnt vmcnt(" #n ")" ::: "memory")
#define PG8_WAIT_L(n) asm volatile("s_waitcnt lgkmcnt(" #n ")" ::: "memory")
#define PG8_BAR __builtin_amdgcn_s_barrier()
#define PG8_SCHED __builtin_amdgcn_sched_barrier(0)
    Unit cur, nxt; int ui = 0;
    if (!S.next(0, cur)) return;
    f32x4 acc[2][2][4][2];
#pragma unroll
    for (int a = 0; a < 2; ++a)
#pragma unroll
        for (int b = 0; b < 2; ++b)
#pragma unroll
            for (int m = 0; m < 4; ++m)
#pragma unroll
                for (int n = 0; n < 2; ++n) acc[a][b][m][n] = (f32x4){0.f, 0.f, 0.f, 0.f};
    bf16x8 At[4][2], B0[2][2], B1[2][2];
    const char* cA = (const char*)g.A + (size_t)cur.pm * tstepA; const char* cB = (const char*)g.Bt + (size_t)cur.pn * tstepB;
    S.a_ready(cur);
    if constexpr (SP2) {
        PG8_STAGE(PG8_SB(0, 0), cB, voffB); PG8_STAGE(PG8_SB(0, 1), cB + hstepB, voffB); PG8_STAGE(PG8_SA(0, 0), cA, voffA); PG8_STAGE(PG8_SA(0, 1), cA + hstepA, voffA);
        if (wr == 1) PG8_BAR;
        PG8_WAIT_V(2); PG8_BAR;
        PG8_STAGE(PG8_SB(1, 0), cB + kstep, voffB); PG8_STAGE(PG8_SA(1, 0), cA + kstep, voffA); PG8_STAGE(PG8_SB(1, 1), cB + hstepB + kstep, voffB);
        PG8_WAIT_V(6); PG8_BAR;
    } else {
        PG8_STAGE(PG8_SB(0, 0), cB, voffB); PG8_STAGE(PG8_SA(0, 0), cA, voffA); PG8_STAGE(PG8_SB(0, 1), cB + hstepB, voffB); PG8_STAGE(PG8_SA(0, 1), cA + hstepA, voffA);
        if (wr == 1) PG8_BAR;
        PG8_WAIT_V(4); PG8_BAR;
        PG8_STAGE(PG8_SB(1, 0), cB + kstep, voffB); PG8_STAGE(PG8_SA(1, 0), cA + kstep, voffA); PG8_STAGE(PG8_SB(1, 1), cB + hstepB + kstep, voffB);
        PG8_WAIT_V(6); PG8_BAR;
    }
    for (;;) {
        const bool has_next = S.next(ui + 1, nxt);
        const char* nA = has_next ? (const char*)g.A + (size_t)nxt.pm * tstepA : cA; const char* nB = has_next ? (const char*)g.Bt + (size_t)nxt.pn * tstepB : cB;
        for (int t = 0; t < nt; t += 2) {
            const bool last = (t == nt - 2);
            const char* a1 = cA + (size_t)(t + 1) * kstep;
            const char* a2 = last ? nA : cA + (size_t)(t + 2) * kstep; const char* b2 = last ? nB : cB + (size_t)(t + 2) * kstep;
            const char* a3 = a2 + kstep; const char* b3 = b2 + kstep;
            if (last && has_next) S.a_ready(nxt);
            if constexpr (SP2) {
            PG8_LDB(B0, 0, 0); PG8_LDB(B1, 0, 1); PG8_SCHED; PG8_LDA(At, 0, 0); PG8_STAGE(PG8_SA(1, 1), a1 + hstepA, voffA);
            PG8_WAIT_V(8); PG8_WAIT_L(0); PG8_BAR; PG8_MMA(0, 0, At, B0); PG8_MMA(0, 1, At, B1); PG8_BAR; PG8_SCHED;
            PG8_LDA(At, 0, 1); PG8_STAGE(PG8_SB(0, 0), b2, voffB); PG8_STAGE(PG8_SB(0, 1), b2 + hstepB, voffB); PG8_STAGE(PG8_SA(0, 0), a2, voffA);
            PG8_WAIT_V(8); PG8_WAIT_L(0); PG8_BAR; PG8_MMA(1, 0, At, B0); PG8_MMA(1, 1, At, B1); PG8_BAR; PG8_SCHED;
            PG8_LDB(B0, 1, 0); PG8_LDB(B1, 1, 1); PG8_SCHED; PG8_LDA(At, 1, 0); PG8_STAGE(PG8_SA(0, 1), a2 + hstepA, voffA);
            PG8_WAIT_V(8); PG8_WAIT_L(0); PG8_BAR; PG8_MMA(0, 0, At, B0); PG8_MMA(0, 1, At, B1); PG8_BAR; PG8_SCHED;
            PG8_LDA(At, 1, 1); PG8_STAGE(PG8_SB(1, 0), b3, voffB); PG8_STAGE(PG8_SB(1, 1), b3 + hstepB, voffB); PG8_STAGE(PG8_SA(1, 0), a3, voffA);
            PG8_WAIT_V(8); PG8_WAIT_L(0); PG8_BAR; PG8_MMA(1, 0, At, B0); PG8_MMA(1, 1, At, B1); PG8_BAR; PG8_SCHED;
            } else {
            PG8_LDB(B0, 0, 0); PG8_SCHED; PG8_LDA(At, 0, 0); PG8_STAGE(PG8_SA(1, 1), a1 + hstepA, voffA);
            PG8_WAIT_L(8); PG8_BAR; PG8_WAIT_L(0); PG8_MMA(0, 0, At, B0); PG8_BAR; PG8_SCHED;
            PG8_LDB(B1, 0, 1); PG8_STAGE(PG8_SB(0, 0), b2, voffB);
            PG8_BAR; PG8_WAIT_L(0); PG8_MMA(0, 1, At, B1); PG8_BAR;
            PG8_LDA(At, 0, 1); PG8_STAGE(PG8_SA(0, 0), a2, voffA);
            PG8_BAR; PG8_WAIT_L(0); PG8_MMA(1, 0, At, B0); PG8_BAR; PG8_SCHED;
            PG8_STAGE(PG8_SB(0, 1), b2 + hstepB, voffB);
            PG8_WAIT_V(6); PG8_BAR; PG8_MMA(1, 1, At, B1); PG8_BAR;
            PG8_LDB(B0, 1, 0); PG8_SCHED; PG8_LDA(At, 1, 0); PG8_STAGE(PG8_SA(0, 1), a2 + hstepA, voffA);
            PG8_WAIT_L(8); PG8_BAR; PG8_WAIT_L(0); PG8_MMA(0, 0, At, B0); PG8_BAR; PG8_SCHED;
            PG8_LDB(B1, 1, 1); PG8_STAGE(PG8_SB(1, 0), b3, voffB);
            PG8_BAR; PG8_WAIT_L(0); PG8_MMA(0, 1, At, B1); PG8_BAR;
            PG8_LDA(At, 1, 1); PG8_STAGE(PG8_SA(1, 0), a3, voffA);
            PG8_BAR; PG8_WAIT_L(0); PG8_MMA(1, 0, At, B0); PG8_BAR; PG8_SCHED;
            PG8_STAGE(PG8_SB(1, 1), b3 + hstepB, voffB);
            PG8_WAIT_V(6); PG8_BAR; PG8_MMA(1, 1, At, B1); PG8_BAR;
            }
        }
        if constexpr (ALIGN_EPI) { if (wr == 0) PG8_BAR; }
        if constexpr (!Epi::AFTER_DRAIN) { E(acc, cur, wr, wc, fr, fq); S.done(cur); }
        if (!has_next) break;
#pragma unroll
        for (int a = 0; a < 2; ++a)
#pragma unroll
            for (int b = 0; b < 2; ++b)
#pragma unroll
                for (int m = 0; m < 4; ++m)
#pragma unroll
                    for (int n = 0; n < 2; ++n) acc[a][b][m][n] = (f32x4){0.f, 0.f, 0.f, 0.f};
        cur = nxt; cA = nA; cB = nB; ++ui;
        if constexpr (ALIGN_EPI) { if (wr == 1) PG8_BAR; }
    }
    PG8_WAIT_V(0);
    if constexpr (!ALIGN_EPI) { if (wr == 0) PG8_BAR; }
    PG8_BAR;
    if constexpr (Epi::AFTER_DRAIN) { E.fused(acc, cur, wr, wc, fr, fq, lds, wid, lane); S.done(cur); }
#undef PG8_SA
#undef PG8_SB
#undef PG8_STAGE
#undef PG8_LDA
#undef PG8_LDB
#undef PG8_MMA
#undef PG8_WAIT_V
#undef PG8_WAIT_L
#undef PG8_BAR
#undef PG8_SCHED
}
}


template <class F> struct EpiFn4 { static constexpr bool PERM = false, AFTER_DRAIN = false; F f;
    __device__ __forceinline__ void operator()(const f32x4 (&acc)[2][2][4][2], const pg8::Unit& u, int wr, int wc, int fr, int fq) const {
        const int row0 = u.pm * 256 + wr * 64 + fr, col0 = u.pn * 256 + wc * 32 + 4 * fq;
#pragma unroll
        for (int ai = 0; ai < 2; ++ai)
#pragma unroll
            for (int m = 0; m < 4; ++m)
#pragma unroll
                for (int bj = 0; bj < 2; ++bj)
#pragma unroll
                    for (int n = 0; n < 2; ++n) f(row0 + ai * 128 + m * 16, col0 + bj * 128 + n * 16, acc[ai][bj][m][n]);
    } };
template <class F> struct EpiFn8 { static constexpr bool PERM = true, AFTER_DRAIN = false; F f;
    __device__ __forceinline__ void operator()(const f32x4 (&acc)[2][2][4][2], const pg8::Unit& u, int wr, int wc, int fr, int fq) const {
        const int row0 = u.pm * 256 + wr * 64 + fr, col0 = u.pn * 256 + wc * 32 + 8 * fq;
#pragma unroll
        for (int ai = 0; ai < 2; ++ai)
#pragma unroll
            for (int m = 0; m < 4; ++m)
#pragma unroll
                for (int bj = 0; bj < 2; ++bj) f(row0 + ai * 128 + m * 16, col0 + bj * 128, acc[ai][bj][m][0], acc[ai][bj][m][1]);
    } };
template <class F> __device__ __forceinline__ void gemm_pg8_4(const Ctx& c, const bf16_t* A, int lda, const bf16_t* Bt, int ldb, int M, int N, int K, const F& f) {
    pg8::Gemm g{A, Bt, M, N, K, lda, ldb}; pg8::StaticOrder S; S.init(M, N, (int)gridDim.x, (int)blockIdx.x); EpiFn4<F> E{f};
    pg8::gemm_phase<EpiFn4<F>, pg8::StaticOrder, true, true>(c.lds, g, S, E);
}
template <class F> __device__ __forceinline__ void gemm_pg8_8(const Ctx& c, const bf16_t* A, int lda, const bf16_t* Bt, int ldb, int M, int N, int K, const F& f) {
    pg8::Gemm g{A, Bt, M, N, K, lda, ldb}; pg8::StaticOrder S; S.init(M, N, (int)gridDim.x, (int)blockIdx.x); EpiFn8<F> E{f};
    pg8::gemm_phase<EpiFn8<F>, pg8::StaticOrder, true, true>(c.lds, g, S, E);
}
__device__ __forceinline__ u32x4 pk8(f32x4 lo, f32x4 hi) { u32x4 w; w.x = pk2(lo[0], lo[1]); w.y = pk2(lo[2], lo[3]); w.z = pk2(hi[0], hi[1]); w.w = pk2(hi[2], hi[3]); return w; }
struct F8Store { bf16_t* O; int ld; __device__ __forceinline__ void operator()(int row, int col, f32x4 lo, f32x4 hi) const { *(u32x4*)(O + (size_t)row * ld + col) = pk8(lo, hi); } };
struct F8SigBias { bf16_t* O; int ld; const float* bias;
    __device__ __forceinline__ void operator()(int row, int col, f32x4 lo, f32x4 hi) const {
        lo += *(const f32x4*)(bias + col); hi += *(const f32x4*)(bias + col + 4);
#pragma unroll
        for (int j = 0; j < 4; ++j) { lo[j] = sigmoidf_(lo[j]); hi[j] = sigmoidf_(hi[j]); }
        *(u32x4*)(O + (size_t)row * ld + col) = pk8(lo, hi); } };
struct F8FfnIn { bf16_t* U; const float* rstd; int row_base;
    __device__ __forceinline__ void operator()(int row, int col, f32x4 lo, f32x4 hi) const {
        const float s = rstd[row_base + row]; const int j = col >> 8, cc = col & 255;
        const size_t off = (size_t)((cc >> 7) & 1) * ((WS_GV - WS_U) / 2) + (size_t)row * FF + 128 * j + (cc & 127); *(u32x4*)(U + off) = pk8(lo * s, hi * s); } };
template <int SEG> struct F4Up { float* MF; const bf16_t* GT; bf16_t* MG;
    __device__ __forceinline__ void operator()(int row, int col, f32x4 v) const {
        const f32x4 g = unpk4(*(const u32x2*)(GT + (size_t)row * (3 * DM) + SEG * DM + col)); const size_t off = (size_t)row * DM + col;
        if (SEG == 0) *(f32x4*)(MF + off) = g * v;
        else if (SEG == 1) *(f32x4*)(MF + off) = *(const f32x4*)(MF + off) + g * v;
        else *(u32x2*)(MG + off) = pk4(*(const f32x4*)(MF + off) + g * v); } };

__device__ __forceinline__ void wave_gemm_32x64(const bf16_t* A, int lda, const bf16_t* Bt, int ldb, int K, int m0, int n0, int fr, int fq, f32x4 (&acc)[2][4]) {
    const bf16_t* ap = A + (size_t)(m0 + fr) * lda + 8 * fq;
    const bf16_t* bp = Bt + (size_t)(n0 + fr) * ldb + 8 * fq;
    for (int k0 = 0; k0 < K; k0 += 32) {
        const bf16x8 a0 = *(const bf16x8*)(ap + k0), a1 = *(const bf16x8*)(ap + (size_t)16 * lda + k0);
        bf16x8 b[4];
#pragma unroll
        for (int j = 0; j < 4; ++j) b[j] = *(const bf16x8*)(bp + (size_t)(16 * j) * ldb + k0);
#pragma unroll
        for (int j = 0; j < 4; ++j) { acc[0][j] = __builtin_amdgcn_mfma_f32_16x16x32_bf16(b[j], a0, acc[0][j], 0, 0, 0); acc[1][j] = __builtin_amdgcn_mfma_f32_16x16x32_bf16(b[j], a1, acc[1][j], 0, 0, 0); }
    }
}
template <class Epi>
__device__ __forceinline__ void gemm_simple(const Ctx& c, const bf16_t* A, int lda, const bf16_t* Bt, int ldb, int M, int N, int K, const Epi& epi) {
    const int nMt = M / 256, nNt = N / 64, ntiles = nMt * nNt;
    for (int tile = blockIdx.x; tile < ntiles; tile += gridDim.x) {
        const int tm = tile % nMt, tn = tile / nMt, m0 = tm * 256 + c.wave * 32, n0 = tn * 64;
        f32x4 acc[2][4];
#pragma unroll
        for (int i = 0; i < 2; ++i)
#pragma unroll
            for (int j = 0; j < 4; ++j) acc[i][j] = (f32x4){0.f, 0.f, 0.f, 0.f};
        wave_gemm_32x64(A, lda, Bt, ldb, K, m0, n0, c.fr, c.fq, acc);
#pragma unroll
        for (int i = 0; i < 2; ++i)
#pragma unroll
            for (int j = 0; j < 4; ++j) epi(m0 + 16 * i + c.fr, n0 + 16 * j + 4 * c.fq, acc[i][j]);
    }
}

struct EpiBf16 { bf16_t* O; int ld; __device__ __forceinline__ void operator()(int row, int col, f32x4 v) const { *(u32x2*)(O + (size_t)row * ld + col) = pk4(v); } };
struct EpiKV { bf16_t* KB; bf16_t* VT;
    __device__ __forceinline__ void operator()(int row, int col, f32x4 v) const {
        if (col < 256) { *(u32x2*)(KB + (size_t)row * 256 + col) = pk4(v); }
        else { const int cc = col - 256, h = cc >> 6, d = cc & 63, b = row >> 8, key = row & 255;
#pragma unroll
            for (int j = 0; j < 4; ++j) VT[((size_t)((b * 4 + h) * 64 + d + j)) * 256 + key] = (bf16_t)f2bf(v[j]); }
    } };
struct EpiDecay { float* W; const float* w0;
    __device__ __forceinline__ void operator()(int row, int col, f32x4 v) const {
        const f32x4 z = v + *(const f32x4*)(w0 + col); f32x4 o;
#pragma unroll
        for (int j = 0; j < 4; ++j) o[j] = __expf(-0.60653065971f * sigmoidf_(z[j]));
        *(f32x4*)(W + (size_t)row * RD + col) = o; } };
struct EpiSigBias { bf16_t* O; int ld; const float* bias;
    __device__ __forceinline__ void operator()(int row, int col, f32x4 v) const {
        const f32x4 z = v + *(const f32x4*)(bias + col); f32x4 o;
#pragma unroll
        for (int j = 0; j < 4; ++j) o[j] = sigmoidf_(z[j]);
        *(u32x2*)(O + (size_t)row * ld + col) = pk4(o); } };
struct EpiPool { bf16_t* Y; const float* scale; int gi;
    __device__ __forceinline__ void operator()(int row, int col, f32x4 v) const {
        const f32x4 s = *(const f32x4*)(scale + 64 * gi + col); *(u32x2*)(Y + (size_t)row * DM + 512 + 64 * gi + col) = pk4(v * s); } };
struct EpiOut { const float* x; float* x1; bf16_t* x1b;
    __device__ __forceinline__ void operator()(int row, int col, f32x4 v) const {
        const size_t off = (size_t)row * DM + col; const f32x4 o = *(const f32x4*)(x + off) + v; *(f32x4*)(x1 + off) = o; *(u32x2*)(x1b + off) = pk4(o); } };
struct EpiFfnIn { bf16_t* U; const float* rstd; int row_base;
    __device__ __forceinline__ void operator()(int row, int col, f32x4 v) const {
        const float s = rstd[row_base + row]; const int j = col >> 8, cc = col & 255;
        const size_t off = (size_t)((cc >> 7) & 1) * ((WS_GV - WS_U) / 2) + (size_t)row * FF + 128 * j + (cc & 127); *(u32x2*)(U + off) = pk4(v * s); } };
struct EpiAddOut { float* x;
    __device__ __forceinline__ void operator()(int row, int col, f32x4 v) const { const size_t off = (size_t)row * DM + col; *(f32x4*)(x + off) = *(const f32x4*)(x + off) + v; } };

__device__ __forceinline__ void phase_mix(const Params& p, const Ctx& c) {
    unsigned char* ws = p.ws;
    const bf16_t* P = (const bf16_t*)(ws + WS_P); const float* mu = p.in[I_MU];
    bf16_t* R = (bf16_t*)(ws + WS_R); bf16_t* KR = (bf16_t*)(ws + WS_KRAW); bf16_t* V = (bf16_t*)(ws + WS_V);
    bf16_t* LW = (bf16_t*)(ws + WS_LW); bf16_t* LA = (bf16_t*)(ws + WS_LA); bf16_t* LG = (bf16_t*)(ws + WS_LG);
    for (int row = c.gw; row < MTOK; row += c.ngw) {
        const int t = row & (SEQ - 1); const bf16_t* cur = P + (size_t)row * MIXIN;
#pragma unroll
        for (int i = 0; i < 7; ++i) {
            const int col = 4 * c.lane + 256 * i;
            const f32x4 cv = unpk4(*(const u32x2*)(cur + col));
            f32x4 pv = (f32x4){0.f, 0.f, 0.f, 0.f}; if (t > 0) pv = unpk4(*(const u32x2*)(cur - MIXIN + col));
            const f32x4 m4 = *(const f32x4*)(mu + col);
            f32x4 pm = cv + (pv - cv) * m4;
            if (i < 2) *(u32x2*)(R + (size_t)row * RD + col) = pk4(pm);
            else if (i < 4) *(u32x2*)(KR + (size_t)row * RD + (col - 512)) = pk4(pm);
            else if (i < 6) *(u32x2*)(V + (size_t)row * RD + (col - 1024)) = pk4(pm);
            else {
                const int cc = col - 1536;
                if (cc < 64) { f32x4 o; o[0] = tanhf(pm[0]); o[1] = tanhf(pm[1]); o[2] = tanhf(pm[2]); o[3] = tanhf(pm[3]); *(u32x2*)(LW + (size_t)row * 64 + cc) = pk4(o); }
                else if (cc < 128) { *(u32x2*)(LA + (size_t)row * 64 + (cc - 64)) = pk4(pm); }
                else { f32x4 o; o[0] = sigmoidf_(pm[0]); o[1] = sigmoidf_(pm[1]); o[2] = sigmoidf_(pm[2]); o[3] = sigmoidf_(pm[3]); *(u32x2*)(LG + (size_t)row * 128 + (cc - 128)) = pk4(o); }
            }
        }
    }
}
__device__ __forceinline__ void phase_pooldiff(const Params& p, const Ctx& c) {
    unsigned char* ws = p.ws;
    const bf16_t* P = (const bf16_t*)(ws + WS_P); bf16_t* DP = (bf16_t*)(ws + WS_DPOOL);
    const int col = 4 * c.lane, gi = c.lane >> 4, win = 2 << gi;
    for (int row = c.gw; row < MTOK; row += c.ngw) {
        const int t = row & (SEQ - 1); const bf16_t* cur = P + (size_t)row * MIXIN + RWKVIN + col;
        const f32x4 x0 = unpk4(*(const u32x2*)cur); f32x4 s = x0;
        for (int j = 1; j < 16; ++j) if (j < win && j <= t) s += unpk4(*(const u32x2*)(cur - (size_t)j * MIXIN));
        const int cnt = (t + 1) < win ? (t + 1) : win;
        *(u32x2*)(DP + (size_t)row * 256 + col) = pk4(s * (1.0f / (float)cnt) - x0);
    }
}
__device__ __forceinline__ void phase_memattn(const Params& p, const Ctx& c) {
    unsigned char* ws = p.ws;
    const bf16_t* P = (const bf16_t*)(ws + WS_P); const bf16_t* KB = (const bf16_t*)(ws + WS_KB); const bf16_t* VT = (const bf16_t*)(ws + WS_VT); bf16_t* Y = (bf16_t*)(ws + WS_YCAT);
    const int fr = c.fr, fq = c.fq;
    for (int unit = blockIdx.x; unit < BATCH * 4 * 16; unit += gridDim.x) {
        const int qt = unit & 15, h = (unit >> 4) & 3, b = unit >> 6;
#pragma unroll 1
        for (int qg = 0; qg < 2; ++qg) {
            const int row = b * SEQ + qt * 256 + c.wave * 32 + 16 * qg + fr;
            const bf16x8 q0 = *(const bf16x8*)(P + (size_t)row * MIXIN + 2048 + h * 64 + 8 * fq), q1 = *(const bf16x8*)(P + (size_t)row * MIXIN + 2048 + h * 64 + 32 + 8 * fq);
            f32x4 sc[16];
#pragma unroll
            for (int kg = 0; kg < 16; ++kg) {
                const bf16_t* kp = KB + (size_t)(b * 256 + 16 * kg + fr) * 256 + h * 64 + 8 * fq;
                const bf16x8 k0 = *(const bf16x8*)kp, k1 = *(const bf16x8*)(kp + 32);
                f32x4 a = (f32x4){0.f, 0.f, 0.f, 0.f};
                a = __builtin_amdgcn_mfma_f32_16x16x32_bf16(k0, q0, a, 0, 0, 0); a = __builtin_amdgcn_mfma_f32_16x16x32_bf16(k1, q1, a, 0, 0, 0); sc[kg] = a;
                if ((kg & 3) == 3) asm volatile("" ::: "memory");
            }
            float m = -1e30f;
#pragma unroll
            for (int kg = 0; kg < 16; ++kg) m = fmaxf(m, fmaxf(fmaxf(sc[kg][0], sc[kg][1]), fmaxf(sc[kg][2], sc[kg][3])));
            m = fmaxf(m, __shfl_xor(m, 16)); m = fmaxf(m, __shfl_xor(m, 32));
            float l = 0.f;
#pragma unroll
            for (int kg = 0; kg < 16; ++kg)
#pragma unroll
                for (int j = 0; j < 4; ++j) { const float e = __expf((sc[kg][j] - m) * 0.125f); sc[kg][j] = e; l += e; }
            l += __shfl_xor(l, 16); l += __shfl_xor(l, 32);
            const float linv = 1.0f / l;
            f32x4 o[4];
#pragma unroll
            for (int dg = 0; dg < 4; ++dg) o[dg] = (f32x4){0.f, 0.f, 0.f, 0.f};
#pragma unroll
            for (int s = 0; s < 8; ++s) {
                u32x4 w; w.x = pk2(sc[2 * s][0], sc[2 * s][1]); w.y = pk2(sc[2 * s][2], sc[2 * s][3]); w.z = pk2(sc[2 * s + 1][0], sc[2 * s + 1][1]); w.w = pk2(sc[2 * s + 1][2], sc[2 * s + 1][3]);
                const bf16x8 pf = __builtin_bit_cast(bf16x8, w);
#pragma unroll
                for (int dg = 0; dg < 4; ++dg) {
                    const bf16_t* vp = VT + ((size_t)((b * 4 + h) * 64 + 16 * dg + fr)) * 256 + 32 * s + 4 * fq;
                    u32x4 v; const u32x2 lo = *(const u32x2*)vp, hi = *(const u32x2*)(vp + 16); v.x = lo.x; v.y = lo.y; v.z = hi.x; v.w = hi.y;
                    o[dg] = __builtin_amdgcn_mfma_f32_16x16x32_bf16(__builtin_bit_cast(bf16x8, v), pf, o[dg], 0, 0, 0);
                }
                if (s & 1) asm volatile("" ::: "memory");
            }
#pragma unroll
            for (int dg = 0; dg < 4; ++dg) *(u32x2*)(Y + (size_t)row * DM + 768 + h * 64 + 16 * dg + 4 * fq) = pk4(o[dg] * linv);
        }
    }
}

__device__ __forceinline__ void phase_prep2(const Params& p, const Ctx& c) {
    unsigned char* ws = p.ws;
    const bf16_t* KR = (const bf16_t*)(ws + WS_KRAW); const bf16_t* AA = (const bf16_t*)(ws + WS_AA); const bf16_t* R = (const bf16_t*)(ws + WS_R);
    bf16_t* KK = (bf16_t*)((unsigned char*)p.out + DO_KK); bf16_t* BB = (bf16_t*)((unsigned char*)p.out + DO_BB); bf16_t* KF = (bf16_t*)((unsigned char*)p.out + DO_KF);
    float* BON = (float*)(ws + WS_BONUS);
    for (int it = c.gw; it < MTOK * 8; it += c.ngw) {
        const int row = it >> 3, h = it & 7, col = h * 64 + c.lane; const size_t off = (size_t)row * RD + col;
        const float k = bf2f(KR[off]), a = bf2f(AA[off]), r = bf2f(R[off]);
        const float kkv = k * p.in[I_KK][col];
        const float nrm = wave_sum(kkv * kkv);
        const float kap = kkv * rsqrtf(nrm + 1e-12f);
        const float kf = k * (1.0f + (a - 1.0f) * p.in[I_KA][col]);
        const float bon = wave_sum(r * kf * p.in[I_RK][col]);
        KK[off] = (bf16_t)f2bf(kap); BB[off] = (bf16_t)f2bf(kap * a); KF[off] = (bf16_t)f2bf(kf);
        if (c.lane == 0) BON[it] = bon;
    }
}

constexpr int TC = 32;
__device__ __forceinline__ void phase_scan(const Params& p, const Ctx& c) {
    unsigned char* ws = p.ws;
    const bf16_t* KK = (const bf16_t*)((unsigned char*)p.out + DO_KK); const bf16_t* BB = (const bf16_t*)((unsigned char*)p.out + DO_BB); const bf16_t* KF = (const bf16_t*)((unsigned char*)p.out + DO_KF);
    const bf16_t* R = (const bf16_t*)(ws + WS_R); const bf16_t* V = (const bf16_t*)(ws + WS_V); const float* W = (const float*)(ws + WS_W);
    float* YR = (float*)(ws + WS_YRAW);
    constexpr int OPF = 5 * TC * 64, BUFF = OPF + TC * 16;
    LAS float* L = (LAS float*)c.lds; LAS float* YB = L + 2 * BUFF;
    const int tid = c.tid;
    for (int unit = blockIdx.x; unit < BATCH * 8 * 4; unit += gridDim.x) {
        const int q = unit & 3, h = (unit >> 2) & 7, b = unit >> 5;
        const size_t rowbase = (size_t)b * SEQ;
        const int ss = tid >> 4, g4 = (tid & 15) * 4;
        u32x2 rb[4]; f32x4 rw; unsigned short rv;
        const int vs = tid >> 4, vi = tid & 15;
        auto issue = [&](int ch) {
            const size_t ro = (rowbase + (size_t)ch * TC + ss) * RD + h * 64 + g4;
            rb[0] = *(const u32x2*)(KK + ro); rb[1] = *(const u32x2*)(KF + ro); rb[2] = *(const u32x2*)(BB + ro); rb[3] = *(const u32x2*)(R + ro);
            rw = *(const f32x4*)(W + ro);
            rv = V[(rowbase + (size_t)ch * TC + vs) * RD + h * 64 + 16 * q + vi];
        };
        auto commit = [&](int buf) {
            LAS float* B = L + buf * BUFF;
            *(LAS f32x4*)(B + (0 * TC + ss) * 64 + g4) = unpk4(rb[0]);
            *(LAS f32x4*)(B + (1 * TC + ss) * 64 + g4) = rw;
            *(LAS f32x4*)(B + (2 * TC + ss) * 64 + g4) = unpk4(rb[1]);
            *(LAS f32x4*)(B + (3 * TC + ss) * 64 + g4) = unpk4(rb[2]);
            *(LAS f32x4*)(B + (4 * TC + ss) * 64 + g4) = unpk4(rb[3]);
            B[OPF + vs * 16 + vi] = bf2f(rv);
        };
        __syncthreads();
        issue(0); commit(0);
        __syncthreads();
        f32x4 S = (f32x4){0.f, 0.f, 0.f, 0.f};
        const int vrow = (tid >> 4) & 15, kq = tid & 15;
        for (int ch = 0; ch < SEQ / TC; ++ch) {
            if (ch + 1 < SEQ / TC) issue(ch + 1);
            if (tid < 256) {
                const LAS float* B = L + (ch & 1) * BUFF;
#pragma unroll 4
                for (int s = 0; s < TC; ++s) {
                    const f32x4 kap = *(const LAS f32x4*)(B + (0 * TC + s) * 64 + 4 * kq);
                    const f32x4 w4 = *(const LAS f32x4*)(B + (1 * TC + s) * 64 + 4 * kq);
                    const f32x4 kf4 = *(const LAS f32x4*)(B + (2 * TC + s) * 64 + 4 * kq);
                    const f32x4 b4 = *(const LAS f32x4*)(B + (3 * TC + s) * 64 + 4 * kq);
                    const f32x4 r4 = *(const LAS f32x4*)(B + (4 * TC + s) * 64 + 4 * kq);
                    const float vv = B[OPF + s * 16 + vrow];
                    const float sk = row_sum16((S[0] * kap[0] + S[1] * kap[1]) + (S[2] * kap[2] + S[3] * kap[3]));
                    S = S * w4 + kf4 * vv - b4 * sk;
                    const float y = row_sum16((S[0] * r4[0] + S[1] * r4[1]) + (S[2] * r4[2] + S[3] * r4[3]));
                    if (kq == 0) YB[s * 16 + vrow] = y;
                }
            }
            __syncthreads();
            if (ch + 1 < SEQ / TC) commit((ch + 1) & 1);
            { const int s = tid >> 4, i = tid & 15; YR[(rowbase + (size_t)ch * TC + s) * RD + h * 64 + 16 * q + i] = YB[s * 16 + i]; }
            __syncthreads();
        }
    }
}

__device__ __forceinline__ void phase_post(const Params& p, const Ctx& c) {
    unsigned char* ws = p.ws;
    const float* YR = (const float*)(ws + WS_YRAW); const float* BON = (const float*)(ws + WS_BONUS);
    const bf16_t* V = (const bf16_t*)(ws + WS_V); const bf16_t* G = (const bf16_t*)(ws + WS_G); bf16_t* Y = (bf16_t*)(ws + WS_YCAT);
    for (int it = c.gw; it < MTOK * 8; it += c.ngw) {
        const int row = it >> 3, h = it & 7, col = h * 64 + c.lane; const size_t off = (size_t)row * RD + col;
        const float y = YR[off];
        const float mean = wave_sum(y) * (1.0f / 64.0f); const float d = y - mean;
        const float var = wave_sum(d * d) * (1.0f / 64.0f);
        const float yn = d * rsqrtf(var + GN_EPS) * p.in[I_LNW][col] + p.in[I_LNB][col];
        const float bon = BON[it];
        const float o = (yn + bon * bf2f(V[off])) * bf2f(G[off]);
        Y[(size_t)row * DM + col] = (bf16_t)f2bf(o);
    }
}

__device__ __forceinline__ void phase_up_simple(const Params& p, const Ctx& c) {
    unsigned char* ws = p.ws;
    const bf16_t* Y = (const bf16_t*)(ws + WS_YCAT); const bf16_t* WU = (const bf16_t*)(ws + WS_WUPT); const bf16_t* GT = (const bf16_t*)(ws + WS_GATES); bf16_t* MG = (bf16_t*)(ws + WS_MERGED);
    const int nMt = MTOK / 256, nNt = DM / 64, ntiles = nMt * nNt;
    for (int tile = blockIdx.x; tile < ntiles; tile += gridDim.x) {
        const int tm = tile % nMt, tn = tile / nMt, m0 = tm * 256 + c.wave * 32, n0 = tn * 64;
        f32x4 tot[2][4];
#pragma unroll
        for (int i = 0; i < 2; ++i)
#pragma unroll
            for (int j = 0; j < 4; ++j) tot[i][j] = (f32x4){0.f, 0.f, 0.f, 0.f};
#pragma unroll
        for (int seg = 0; seg < 3; ++seg) {
            const int koff = seg == 0 ? 0 : (seg == 1 ? 512 : 768), K = seg == 0 ? 512 : 256;
            f32x4 acc[2][4];
#pragma unroll
            for (int i = 0; i < 2; ++i)
#pragma unroll
                for (int j = 0; j < 4; ++j) acc[i][j] = (f32x4){0.f, 0.f, 0.f, 0.f};
            wave_gemm_32x64(Y + koff, DM, WU + koff, DM, K, m0, n0, c.fr, c.fq, acc);
#pragma unroll
            for (int i = 0; i < 2; ++i)
#pragma unroll
                for (int j = 0; j < 4; ++j) { const f32x4 g = unpk4(*(const u32x2*)(GT + (size_t)(m0 + 16 * i + c.fr) * (3 * DM) + seg * DM + n0 + 16 * j + 4 * c.fq)); tot[i][j] += g * acc[i][j]; }
        }
#pragma unroll
        for (int i = 0; i < 2; ++i)
#pragma unroll
            for (int j = 0; j < 4; ++j) *(u32x2*)(MG + (size_t)(m0 + 16 * i + c.fr) * DM + n0 + 16 * j + 4 * c.fq) = pk4(tot[i][j]);
    }
}

__device__ __forceinline__ void phase_rowstat(const Params& p, const Ctx& c) {
    float* RS = (float*)(p.ws + WS_RSTD2);
    for (int m = c.gw; m < MTOK; m += c.ngw) {
        const f32x4* xr = (const f32x4*)(p.out + (size_t)m * DM) + c.lane; float s = 0.f;
#pragma unroll
        for (int j = 0; j < 4; ++j) { const f32x4 v = xr[64 * j]; s += (v[0] * v[0] + v[1] * v[1]) + (v[2] * v[2] + v[3] * v[3]); }
        s = wave_sum(s);
        if (c.lane == 0) RS[m] = rsqrtf(s * (1.f / DM) + NORM_EPS);
    }
}
__device__ __forceinline__ void phase_ffn_act(const Params& p, const Ctx& c, int half) {
    unsigned char* ws = p.ws;
    const bf16_t* U = (const bf16_t*)(ws + WS_U); const bf16_t* GV = (const bf16_t*)(ws + WS_GV); bf16_t* ACT = (bf16_t*)(ws + WS_ACT) + (size_t)half * (MTOK / 2) * FF;
    const float* cw = p.in[I_CONVW]; const float* cb = p.in[I_CONVB];
    const int ngrp = (MTOK / 2) * (FF / 4);
    for (int idx = blockIdx.x * NTHREADS + c.tid; idx < ngrp; idx += gridDim.x * NTHREADS) {
        const int row = idx / (FF / 4), col = 4 * (idx % (FF / 4)), t = row & (SEQ - 1); const size_t off = (size_t)row * FF + col;
        const f32x4 u0 = unpk4(*(const u32x2*)(U + off));
        f32x4 u1 = (f32x4){0.f, 0.f, 0.f, 0.f}, u2 = u1;
        if (t >= 1) u1 = unpk4(*(const u32x2*)(U + off - FF));
        if (t >= 2) u2 = unpk4(*(const u32x2*)(U + off - 2 * FF));
        const f32x4 g = unpk4(*(const u32x2*)(GV + off));
        const f32x4 uc = *(const f32x4*)(cw + col) * u2 + *(const f32x4*)(cw + FF + col) * u1 + *(const f32x4*)(cw + 2 * FF + col) * u0 + *(const f32x4*)(cb + col);
        f32x4 o;
#pragma unroll
        for (int j = 0; j < 4; ++j) o[j] = 0.5f * uc[j] * (1.0f + erff(uc[j] * 0.70710678118f)) * g[j];
        *(u32x2*)(ACT + off) = pk4(o);
    }
}
__device__ __forceinline__ void phase_final_norm(const Params& p, const Ctx& c) {
    const float* g = p.in[I_NFING];
    for (int m = c.gw; m < MTOK; m += c.ngw) {
        f32x4* xr = (f32x4*)(p.out + (size_t)m * DM) + c.lane; const f32x4* gr = (const f32x4*)g + c.lane;
        f32x4 v[4]; float s = 0.f;
#pragma unroll
        for (int j = 0; j < 4; ++j) { v[j] = xr[64 * j]; s += (v[j][0] * v[j][0] + v[j][1] * v[j][1]) + (v[j][2] * v[j][2] + v[j][3] * v[j][3]); }
        const float rstd = rsqrtf(wave_sum(s) * (1.f / DM) + NORM_EPS);
#pragma unroll
        for (int j = 0; j < 4; ++j) xr[64 * j] = v[j] * rstd * gr[64 * j];
    }
}

constexpr int NPHASES = 17;
__global__ void __launch_bounds__(NTHREADS, 2) fwd_kernel(Params p) {
    extern __shared__ __attribute__((aligned(16))) unsigned char lds_raw[];
    Ctx c; c.tid = threadIdx.x; c.lane = c.tid & 63; c.wave = __builtin_amdgcn_readfirstlane(c.tid >> 6); c.fr = c.lane & 15; c.fq = c.lane >> 4;
    c.gw = blockIdx.x * NWAVES + c.wave; c.ngw = gridDim.x * NWAVES; c.lds = (LAS unsigned char*)lds_raw;
    unsigned char* ws = p.ws;
#if ONE_LAUNCH
    cg::grid_group grid = cg::this_grid();
    volatile LAS unsigned* misc = (volatile LAS unsigned*)(c.lds + LDS_MISC_OFF);
    if (c.tid < 4) misc[c.tid] = 0u;
    __syncthreads();
    const XcdBarrier xbar = xcd_barrier_post((unsigned*)(ws + WS_BAR), misc);
    bool first_seam = true;
#define SEAM() do { if (first_seam) { grid.sync(); first_seam = false; } else xcd_barrier(xbar); } while (0)
#else
#define SEAM() do {} while (0)
#endif
#define IN(k) (p.ph_lo <= (k) && (k) < p.ph_hi)
#define END(k) do { if (IN((k) + 1)) SEAM(); } while (0)
#define REP_ON(k) ((REP_MASK >> (k)) & 1u)
#define PHASE(k, ...) if (IN(k)) { __VA_ARGS__ if (REP_ON(k)) { SEAM(); __VA_ARGS__ } END(k); }
    PHASE(0, phase_prologue(p, c);)
    PHASE(1,
        gemm_pg8_8(c, (const bf16_t*)(ws + WS_H), DM, (const bf16_t*)(ws + WS_WG1T), DM, MTOK, MIXIN, DM, F8Store{(bf16_t*)(ws + WS_P), MIXIN});
        gemm_simple(c, (const bf16_t*)(ws + WS_MEMN), DM, (const bf16_t*)(ws + WS_WKVT), DM, BATCH * NMEM, 512, DM, EpiKV{(bf16_t*)(ws + WS_KB), (bf16_t*)(ws + WS_VT)});)
    PHASE(2, phase_mix(p, c); phase_pooldiff(p, c); phase_memattn(p, c);)
    PHASE(3,
        gemm_simple(c, (const bf16_t*)(ws + WS_LW), 64, (const bf16_t*)(ws + WS_WLWT), 64, MTOK, RD, 64, EpiDecay{(float*)(ws + WS_W), p.in[I_W0]});
        gemm_simple(c, (const bf16_t*)(ws + WS_LA), 64, (const bf16_t*)(ws + WS_WLAT), 64, MTOK, RD, 64, EpiSigBias{(bf16_t*)(ws + WS_AA), RD, p.in[I_A0]});
        gemm_simple(c, (const bf16_t*)(ws + WS_LG), 128, (const bf16_t*)(ws + WS_WLGT), 128, MTOK, RD, 128, EpiBf16{(bf16_t*)(ws + WS_G), RD});
        _Pragma("unroll 1") for (int gi = 0; gi < 4; ++gi)
            gemm_simple(c, (const bf16_t*)(ws + WS_DPOOL) + 64 * gi, 256, (const bf16_t*)(ws + WS_WPT) + 4096 * gi, 64, MTOK, 64, 64, EpiPool{(bf16_t*)(ws + WS_YCAT), p.in[I_POOLS], gi});)
    PHASE(4, phase_prep2(p, c);)
    PHASE(5, phase_scan(p, c);)
    PHASE(6, phase_post(p, c);)
    PHASE(7,
        gemm_pg8_8(c, (const bf16_t*)(ws + WS_H), DM, (const bf16_t*)(ws + WS_WG1T) + (size_t)MIXIN * DM, DM, MTOK, 3 * DM, DM, F8SigBias{(bf16_t*)(ws + WS_GATES), 3 * DM, p.in[I_BGATE]});)
    PHASE(8,
        gemm_pg8_4(c, (const bf16_t*)(ws + WS_YCAT), DM, (const bf16_t*)(ws + WS_WUPT), DM, MTOK, DM, 512, F4Up<0>{p.out, (const bf16_t*)(ws + WS_GATES), (bf16_t*)(ws + WS_MERGED)});
        gemm_pg8_4(c, (const bf16_t*)(ws + WS_YCAT) + 512, DM, (const bf16_t*)(ws + WS_WUPT) + 512, DM, MTOK, DM, 256, F4Up<1>{p.out, (const bf16_t*)(ws + WS_GATES), (bf16_t*)(ws + WS_MERGED)});
        gemm_pg8_4(c, (const bf16_t*)(ws + WS_YCAT) + 768, DM, (const bf16_t*)(ws + WS_WUPT) + 768, DM, MTOK, DM, 256, F4Up<2>{p.out, (const bf16_t*)(ws + WS_GATES), (bf16_t*)(ws + WS_MERGED)});)
    PHASE(9,
        gemm_pg8_4(c, (const bf16_t*)(ws + WS_MERGED), DM, (const bf16_t*)(ws + WS_WOT), DM, MTOK, DM, DM, EpiOut{p.in[I_X], p.out, (bf16_t*)(ws + WS_X1B)});)
    PHASE(10, phase_rowstat(p, c);)
    PHASE(11, gemm_pg8_8(c, (const bf16_t*)(ws + WS_X1B), DM, (const bf16_t*)(ws + WS_WF1T), DM, MTOK / 2, 2 * FF, DM, F8FfnIn{(bf16_t*)(ws + WS_U), (const float*)(ws + WS_RSTD2), 0});)
    PHASE(12, phase_ffn_act(p, c, 0);)
    PHASE(13, gemm_pg8_8(c, (const bf16_t*)(ws + WS_X1B) + (size_t)(MTOK / 2) * DM, DM, (const bf16_t*)(ws + WS_WF1T), DM, MTOK / 2, 2 * FF, DM, F8FfnIn{(bf16_t*)(ws + WS_U), (const float*)(ws + WS_RSTD2), MTOK / 2});)
    PHASE(14, phase_ffn_act(p, c, 1);)
    PHASE(15,
        gemm_pg8_4(c, (const bf16_t*)(ws + WS_ACT), FF, (const bf16_t*)(ws + WS_WF2T), FF, MTOK, DM, FF, EpiAddOut{p.out});)
    if (IN(16)) { phase_final_norm(p, c); }
#undef IN
#undef END
}

__global__ void nan_fill(float* o, int n) { const int i = blockIdx.x * blockDim.x + threadIdx.x; if (i < n) o[i] = __builtin_nanf(""); }

extern "C" void kernel_launch(void* const* d_in, const int* in_sizes, int n_in, void* d_out, int out_size, void* d_ws, size_t ws_size, hipStream_t stream) {
    static int grid = 0;
    if (grid == 0) {
        int dev = 0, cus = 0, per_cu = 0;
        if (hipGetDevice(&dev) != hipSuccess || hipDeviceGetAttribute(&cus, hipDeviceAttributeMultiprocessorCount, dev) != hipSuccess) cus = 256;
        (void)hipFuncSetAttribute((const void*)fwd_kernel, hipFuncAttributeMaxDynamicSharedMemorySize, LDS_BYTES);
        if (hipOccupancyMaxActiveBlocksPerMultiprocessor(&per_cu, (const void*)fwd_kernel, NTHREADS, LDS_BYTES) != hipSuccess || per_cu < 1) per_cu = 1;
        (void)hipGetLastError();
        grid = cus;
        if (n_in != 31 || out_size != MTOK * DM || ws_size < WS_END) grid = -1;
    }
    if (grid < 0) { nan_fill<<<(out_size + 255) / 256, 256, 0, stream>>>((float*)d_out, out_size); return; }
    Params p{};
    for (int i = 0; i < 31; ++i) p.in[i] = (const float*)d_in[i];
    p.out = (float*)d_out; p.ws = (unsigned char*)d_ws;
#if ONE_LAUNCH
    (void)hipMemsetAsync((unsigned char*)d_ws + WS_BAR, 0, WS_CTL_BYTES, stream);
    p.ph_lo = 0; p.ph_hi = NPHASES;
    void* args[] = {&p};
    hipError_t e = hipLaunchCooperativeKernel((const void*)fwd_kernel, dim3(grid), dim3(NTHREADS), args, LDS_BYTES, stream);
    if (e != hipSuccess) fprintf(stderr, "cooperative launch failed: %s (grid %d)\n", hipGetErrorString(e), grid);
#else
    for (int ph = 0; ph < NPHASES; ++ph) { p.ph_lo = ph; p.ph_hi = ph + 1; hipLaunchKernelGGL(fwd_kernel, dim3(grid), dim3(NTHREADS), LDS_BYTES, stream, p); }
#endif
}
```

```cpp
#include <hip/hip_runtime.h>
#include <hip/hip_cooperative_groups.h>
#include <cstdio>
#include <cstdint>
namespace cg = cooperative_groups;

#ifndef ONE_LAUNCH
#define ONE_LAUNCH 1
#endif
#ifndef PH_MASK
#define PH_MASK 0xFFFFFFFFu
#endif
#define PH_ON(k) ((PH_MASK >> (k)) & 1u)
#ifndef REP_MASK
#define REP_MASK 0u
#endif

#define LAS __attribute__((address_space(3)))
typedef unsigned short bf16_t;
typedef short bf16x8 __attribute__((ext_vector_type(8)));
typedef float f32x4 __attribute__((ext_vector_type(4)));
typedef float f32x2 __attribute__((ext_vector_type(2)));
typedef unsigned u32x4 __attribute__((ext_vector_type(4)));
typedef unsigned u32x2 __attribute__((ext_vector_type(2)));

constexpr int BATCH = 8, SEQ = 4096, DM = 1024, MTOK = BATCH * SEQ;
constexpr int NMEM = 256, RD = 512, MIXIN = 2304, RWKVIN = 1792, FF = 2816, NG1 = MIXIN + 3 * DM;
constexpr int NWAVES = 8, NTHREADS = 512;
constexpr float NORM_EPS = 1e-6f, GN_EPS = 64e-5f;

constexpr size_t MiB = 1u << 20;
constexpr size_t WS_WG1T = 1 * MiB;
constexpr size_t WS_WKVT = WS_WG1T + (size_t)NG1 * DM * 2;
constexpr size_t WS_WUPT = WS_WKVT + (size_t)512 * DM * 2;
constexpr size_t WS_WOT = WS_WUPT + (size_t)DM * DM * 2;
constexpr size_t WS_WF1T = WS_WOT + (size_t)DM * DM * 2;
constexpr size_t WS_WF2T = WS_WF1T + (size_t)2 * FF * DM * 2;
constexpr size_t WS_WLWT = WS_WF2T + (size_t)DM * FF * 2;
constexpr size_t WS_WLAT = WS_WLWT + (size_t)RD * 64 * 2;
constexpr size_t WS_WLGT = WS_WLAT + (size_t)RD * 64 * 2;
constexpr size_t WS_WPT = WS_WLGT + (size_t)RD * 128 * 2;
constexpr size_t WS_WEND = WS_WPT + (size_t)4 * 64 * 64 * 2;
static_assert(WS_WEND <= 34 * MiB, "weights region");
constexpr size_t WS_BONUS = 34 * MiB;
constexpr size_t WS_RSTD2 = 35 * MiB;
constexpr size_t WS_KB = 36 * MiB;
constexpr size_t WS_VT = 37 * MiB;
constexpr size_t WS_MEMN = 38 * MiB;
constexpr size_t WS_H = 42 * MiB;
constexpr size_t WS_YCAT = 106 * MiB;
constexpr size_t WS_P = 170 * MiB;
constexpr size_t WS_W = 170 * MiB;
constexpr size_t WS_G = 234 * MiB;
constexpr size_t WS_AA = 266 * MiB;
constexpr size_t WS_KRAW = 314 * MiB;
constexpr size_t WS_YRAW = 266 * MiB;
constexpr size_t WS_R = 346 * MiB;
constexpr size_t WS_V = 378 * MiB;
constexpr size_t WS_LW = 410 * MiB;
constexpr size_t WS_LA = 414 * MiB;
constexpr size_t WS_LG = 418 * MiB;
constexpr size_t WS_DPOOL = 426 * MiB;
constexpr size_t WS_GATES = 170 * MiB;
constexpr size_t WS_MERGED = 362 * MiB;
constexpr size_t WS_X1B = 426 * MiB;
constexpr size_t WS_TAILU = 42 * MiB, WS_HEADU = 45 * MiB, WS_HEADGV = 48 * MiB;
constexpr size_t WS_ACT = 218 * MiB;
constexpr size_t WS_END = 490 * MiB;
constexpr size_t DO_KK = 0, DO_BB = 32 * MiB, DO_KF = 64 * MiB;

constexpr int LDS_BYTES = 147456;
constexpr int LDS_HALO_OFF = 131072 + 1024;
constexpr int LDS_MISC_OFF = 131072 + 320;
constexpr size_t WS_BAR = 0, WS_CTL_BYTES = 65536;

__device__ __forceinline__ unsigned f2bf(float f) { unsigned u = __float_as_uint(f); return (u + 0x7fffu + ((u >> 16) & 1u)) >> 16; }
__device__ __forceinline__ float bf2f(unsigned h) { return __uint_as_float(h << 16); }
__device__ __forceinline__ unsigned pk2(float lo, float hi) { return f2bf(lo) | (f2bf(hi) << 16); }
__device__ __forceinline__ u32x2 pk4(f32x4 v) { u32x2 r; r.x = pk2(v[0], v[1]); r.y = pk2(v[2], v[3]); return r; }
__device__ __forceinline__ f32x4 unpk4(u32x2 u) { f32x4 r; r[0] = bf2f(u.x & 0xffffu); r[1] = bf2f(u.x >> 16); r[2] = bf2f(u.y & 0xffffu); r[3] = bf2f(u.y >> 16); return r; }
__device__ __forceinline__ float wave_sum(float v) {
#pragma unroll
    for (int o = 1; o < 64; o <<= 1) v += __shfl_xor(v, o);
    return v;
}
__device__ __forceinline__ float sigmoidf_(float x) { return 1.0f / (1.0f + __expf(-x)); }
template <int CTRL> __device__ __forceinline__ float dpp_f(float x) { return __builtin_bit_cast(float, __builtin_amdgcn_update_dpp(0, __builtin_bit_cast(int, x), CTRL, 0xF, 0xF, false)); }
__device__ __forceinline__ float row_sum16(float x) {
    x += dpp_f<0xB1>(x);
    x += dpp_f<0x4E>(x);
    x += dpp_f<0x141>(x);
    x += dpp_f<0x140>(x);
    return x;
}

#define XB_TMO      128
#define XB_XCNT(j)  (256  + 64 * (j))
#define XB_XSUB(j)  (1280 + 64 * (j))
#define XB_XGEN(j)  (2304 + 64 * (j))
#define XB_TOP      3328
#define XB_TOPGEN   3392
#define XCD_BAR_WORDS 3456
#define XB_SPIN_CAP (1u << 18)

__device__ __forceinline__ unsigned xb_ld(unsigned* p)              { return __hip_atomic_load(p, __ATOMIC_RELAXED, __HIP_MEMORY_SCOPE_AGENT); }
__device__ __forceinline__ unsigned xb_add(unsigned* p, unsigned v) { return __hip_atomic_fetch_add(p, v, __ATOMIC_RELAXED, __HIP_MEMORY_SCOPE_AGENT); }
__device__ __forceinline__ unsigned xb_xcc_id() { return (unsigned)__builtin_amdgcn_s_getreg((3 << 11) | 20) & 0xFu; }
#define XB_SPIN(cond, bar) do { unsigned _sp = 0; while (cond) { __builtin_amdgcn_s_sleep(1); \
    if ((++_sp & 255u) == 0u) { if (xb_ld(&(bar)[XB_TMO])) break; if (_sp > XB_SPIN_CAP) { atomicAdd(&(bar)[XB_TMO], 1u); break; } } } } while (0)

struct XcdBarrier {
    unsigned* bar; unsigned x;
    volatile LAS unsigned* st;
};

__device__ __forceinline__ XcdBarrier xcd_barrier_post(unsigned* bar, volatile LAS unsigned* st) {
    XcdBarrier b; b.bar = bar; b.x = xb_xcc_id(); b.st = st;
    if (threadIdx.x == 0) (void)xb_add(&bar[XB_XCNT(b.x)], 1u);
    return b;
}
__device__ __forceinline__ void xcd_barrier_complete(unsigned* bar, unsigned x, unsigned& nloc, unsigned& nx) {
    const unsigned G = gridDim.x * gridDim.y * gridDim.z;
    unsigned sum, cnt, mine, sp = 0u;
    for (;;) {
        sum = 0u; cnt = 0u; mine = 0u;
#pragma unroll
        for (unsigned j = 0; j < 16; ++j) { const unsigned c = xb_ld(&bar[XB_XCNT(j)]); sum += c; cnt += (c > 0u) ? 1u : 0u; mine = (j == x) ? c : mine; }
        if (sum == G) break;
        __builtin_amdgcn_s_sleep(1);
        if ((++sp & 255u) == 0u) { if (xb_ld(&bar[XB_TMO])) break; if (sp > XB_SPIN_CAP) { atomicAdd(&bar[XB_TMO], 1u); break; } }
    }
    nloc = mine > 0u ? mine : 1u; nx = cnt > 0u ? cnt : 1u;
}

__device__ __forceinline__ void xcd_barrier(const XcdBarrier& b) {
    asm volatile("s_waitcnt vmcnt(0)" ::: "memory");
    __syncthreads();
    if (threadIdx.x == 0) {
        unsigned* bar = b.bar;
        __builtin_amdgcn_s_waitcnt(0);
        unsigned nloc = b.st[0], nx = b.st[1];
        if (nloc == 0u) { xcd_barrier_complete(bar, b.x, nloc, nx); b.st[0] = nloc; b.st[1] = nx; }
        const unsigned old = xb_add(&bar[XB_XSUB(b.x)], 1u);
        const unsigned gen = old / nloc;
        if (old + 1u == (gen + 1u) * nloc) {
            __builtin_amdgcn_fence(__ATOMIC_RELEASE, "agent");
            asm volatile("s_waitcnt vmcnt(0)" ::: "memory");
            const unsigned og = xb_add(&bar[XB_TOP], 1u);
            const unsigned tg = og / nx;
            if (og + 1u == (tg + 1u) * nx) xb_add(&bar[XB_TOPGEN], 1u);
            else XB_SPIN(xb_ld(&bar[XB_TOPGEN]) == tg, bar);
            __builtin_amdgcn_fence(__ATOMIC_ACQUIRE, "agent");
            xb_add(&bar[XB_XGEN(b.x)], 1u);
            asm volatile("s_waitcnt vmcnt(0)" ::: "memory");
        } else {
            XB_SPIN(xb_ld(&bar[XB_XGEN(b.x)]) == gen, bar);
            __builtin_amdgcn_fence(__ATOMIC_ACQUIRE, "agent");
            asm volatile("s_waitcnt vmcnt(0)" ::: "memory");
        }
    }
    __syncthreads();
}


struct Params { const float* in[31]; float* out; unsigned char* ws; int ph_lo, ph_hi; };
enum { I_X = 0, I_MEM, I_NMIXG, I_WINMIX, I_MU, I_W0, I_WLORAB, I_A0, I_ALORAB, I_GLORAB, I_KK, I_KA, I_RK, I_LNW, I_LNB, I_POOLW, I_POOLS, I_NMEMG, I_WMEMKV,
       I_WUPR, I_WUPP, I_WUPM, I_WGATE, I_BGATE, I_WO, I_NFFNG, I_WFFNIN, I_CONVW, I_CONVB, I_WFFNOUT, I_NFING };

struct Ctx { int tid, lane, wave, fr, fq, gw, ngw; LAS unsigned char* lds; };

__device__ __forceinline__ int rowmap(int mode, int n) {
    if (mode == 0) return n;
    const int half = n >= FF ? 1 : 0, c = n - half * FF;
    return (c >> 7) * 256 + half * 128 + (c & 127);
}
__device__ __forceinline__ void transpose_item(const float* W, int K, int N, bf16_t* WT, int ldd, int koff, int mode, const float* kscale, LAS float* scr, int item, int lane) {
    const int nblk = N / 32, kb = item / nblk, nb = item % nblk, k0 = 64 * kb, n0 = 32 * nb;
#pragma unroll 8
    for (int i = 0; i < 32; ++i) { const int kk = 2 * i + (lane >> 5); float v = W[(size_t)(k0 + kk) * N + n0 + (lane & 31)]; if (kscale) v *= kscale[k0 + kk]; scr[kk * 33 + (lane & 31)] = v; }
    asm volatile("s_waitcnt lgkmcnt(0)" ::: "memory");
    const int c = lane & 7;
#pragma unroll
    for (int j = 0; j < 4; ++j) { const int n = (lane >> 3) + 8 * j; const LAS float* s = scr + (8 * c) * 33 + n;
        u32x4 o; o.x = pk2(s[0 * 33], s[1 * 33]); o.y = pk2(s[2 * 33], s[3 * 33]); o.z = pk2(s[4 * 33], s[5 * 33]); o.w = pk2(s[6 * 33], s[7 * 33]);
        *(u32x4*)(WT + (size_t)rowmap(mode, n0 + n) * ldd + koff + k0 + 8 * c) = o; }
    asm volatile("s_waitcnt lgkmcnt(0)" ::: "memory");
}
__device__ __forceinline__ void rmsnorm_row_bf16(const float* xrow, const float* g, bf16_t* orow, int lane) {
    const f32x4* xr = (const f32x4*)xrow + lane; const f32x4* gr = (const f32x4*)g + lane;
    f32x4 v[4]; float s = 0.f;
#pragma unroll
    for (int j = 0; j < 4; ++j) { v[j] = xr[64 * j]; s += (v[j][0] * v[j][0] + v[j][1] * v[j][1]) + (v[j][2] * v[j][2] + v[j][3] * v[j][3]); }
    const float rstd = rsqrtf(wave_sum(s) * (1.f / DM) + NORM_EPS);
    u32x2* o = (u32x2*)orow + lane;
#pragma unroll
    for (int j = 0; j < 4; ++j) { const f32x4 gg = gr[64 * j]; o[64 * j] = pk4(v[j] * rstd * gg); }
}

__device__ __forceinline__ void phase_prologue(const Params& p, const Ctx& c) {
    LAS float* scr = (LAS float*)(c.lds + c.wave * 16384);
    unsigned char* ws = p.ws;
#define TR(Wp, K_, N_, WTp, ldd_, koff_, mode_, sc_) { const int ni_ = ((K_) / 64) * ((N_) / 32); if (r < ni_) { transpose_item(Wp, K_, N_, (bf16_t*)(WTp), ldd_, koff_, mode_, sc_, scr, r, c.lane); continue; } r -= ni_; }
    constexpr int NIT = (DM / 64) * (MIXIN / 32) + (DM / 64) * (3 * DM / 32) + (DM / 64) * (512 / 32) + (512 / 64) * (DM / 32) + 2 * (256 / 64) * (DM / 32) + (DM / 64) * (DM / 32)
                      + (DM / 64) * (2 * FF / 32) + (FF / 64) * (DM / 32) + 2 * (RD / 32) + 2 * (RD / 32) + 4 * 2;
    for (int it = c.gw; it < NIT; it += c.ngw) {
        int r = it;
        TR(p.in[I_WINMIX], DM, MIXIN, ws + WS_WG1T, DM, 0, 0, nullptr)
        TR(p.in[I_WGATE], DM, 3 * DM, ws + WS_WG1T + (size_t)MIXIN * DM * 2, DM, 0, 0, nullptr)
        TR(p.in[I_WMEMKV], DM, 512, ws + WS_WKVT, DM, 0, 0, nullptr)
        TR(p.in[I_WUPR], 512, DM, ws + WS_WUPT, DM, 0, 0, nullptr)
        TR(p.in[I_WUPP], 256, DM, ws + WS_WUPT, DM, 512, 0, nullptr)
        TR(p.in[I_WUPM], 256, DM, ws + WS_WUPT, DM, 768, 0, nullptr)
        TR(p.in[I_WO], DM, DM, ws + WS_WOT, DM, 0, 0, nullptr)
        TR(p.in[I_WFFNIN], DM, 2 * FF, ws + WS_WF1T, DM, 0, 1, p.in[I_NFFNG])
        TR(p.in[I_WFFNOUT], FF, DM, ws + WS_WF2T, FF, 0, 0, nullptr)
        TR(p.in[I_WLORAB], 64, RD, ws + WS_WLWT, 64, 0, 0, nullptr)
        TR(p.in[I_ALORAB], 64, RD, ws + WS_WLAT, 64, 0, 0, nullptr)
        TR(p.in[I_GLORAB], 128, RD, ws + WS_WLGT, 128, 0, 0, nullptr)
        TR(p.in[I_POOLW] + 0 * 4096, 64, 64, ws + WS_WPT + 0 * 8192, 64, 0, 0, nullptr)
        TR(p.in[I_POOLW] + 1 * 4096, 64, 64, ws + WS_WPT + 1 * 8192, 64, 0, 0, nullptr)
        TR(p.in[I_POOLW] + 2 * 4096, 64, 64, ws + WS_WPT + 2 * 8192, 64, 0, 0, nullptr)
        TR(p.in[I_POOLW] + 3 * 4096, 64, 64, ws + WS_WPT + 3 * 8192, 64, 0, 0, nullptr)
    }
#undef TR
    for (int m = c.gw; m < MTOK; m += c.ngw) rmsnorm_row_bf16(p.in[I_X] + (size_t)m * DM, p.in[I_NMIXG], (bf16_t*)(ws + WS_H) + (size_t)m * DM, c.lane);
    for (int m = c.gw; m < BATCH * NMEM; m += c.ngw) rmsnorm_row_bf16(p.in[I_MEM] + (size_t)m * DM, p.in[I_NMEMG], (bf16_t*)(ws + WS_MEMN) + (size_t)m * DM, c.lane);
}

namespace pg8 {
#define PG8_LAS __attribute__((address_space(3)))
typedef unsigned short bf16_t;
typedef short bf16x8 __attribute__((ext_vector_type(8)));
typedef float f32x4 __attribute__((ext_vector_type(4)));
typedef unsigned u32x4 __attribute__((ext_vector_type(4)));
constexpr int BM = 256, BK = 64, HALF = 128, HTB = HALF * BK * 2  , STAGE_BYTES = 8 * HTB, NXCD = 8, WGM = 8;

__host__ __device__ __forceinline__ int lds_byte(int r, int c) { const int st = (r >> 4) * 2 + (c >> 5), rr = r & 15, cc = c & 31, ob = rr * 64 + cc * 2; return st * 1024 + (ob ^ (((ob >> 9) & 1) << 5)); }
__host__ __device__ __forceinline__ void stage_rc(int b, int& R, int& C) { const int st = b / 1024, sb = b % 1024, swz = sb ^ (((sb >> 9) & 1) << 5); R = (st >> 1) * 16 + swz / 64; C = (st & 1) * 32 + (swz % 64) / 2; }
__host__ __device__ __forceinline__ int perm32(int rho) { const int n = rho >> 4, i = rho & 15; return 8 * (i >> 2) + 4 * n + (i & 3); }

struct Unit { int pm, pn; };
struct Gemm { const bf16_t* A; const bf16_t* Bt; int M, N, K, lda, ldb; };

struct StaticOrder {
    int nM, nN, nwg, G, c;
    __host__ __device__ void init(int M, int N, int G_, int c_) { nM = M / BM; nN = N / BM; nwg = nM * nN; G = G_; c = c_; }
    __host__ __device__ bool next(int i, Unit& u) const {
        const long L = (long)i * G + c; if (L >= nwg) return false;
        int wgid = (int)L; { const int q = nwg / NXCD, r = nwg % NXCD, xcd = wgid % NXCD, off = wgid / NXCD; wgid = (xcd < r ? xcd * (q + 1) : r * (q + 1) + (xcd - r) * q) + off; }
        const int nig = WGM * nN, gid = wgid / nig, fm = gid * WGM, gsz = (nM - fm) < WGM ? (nM - fm) : WGM;
        u.pm = fm + ((wgid % nig) % gsz); u.pn = (wgid % nig) / gsz; return true;
    }
    __device__ __forceinline__ void a_ready(const Unit&) const {}
    __device__ __forceinline__ void done(const Unit&) const {}
};


template <class Epi, class Sched, bool ALIGN_EPI = false, bool SP2 = false>
__device__ __forceinline__ void gemm_phase(PG8_LAS unsigned char* lds, const Gemm g, const Sched& S, const Epi& E) {
    int tid_ = threadIdx.x; asm volatile("" : "+v"(tid_));
    const int tid = tid_, wid = __builtin_amdgcn_readfirstlane(tid >> 6), lane = tid & 63, wr = wid >> 2, wc = wid & 3, fr = lane & 15, fq = lane >> 4;
    const int K = g.K, nt = K / BK;
    unsigned voffA[2], voffB[2];
#pragma unroll
    for (int i = 0; i < 2; ++i) { int R, C; stage_rc(tid * 16 + i * 8192, R, C); const int Rb = Epi::PERM ? ((R & ~31) + perm32(R & 31)) : R;
        voffA[i] = (unsigned)(R * g.lda + C) * 2u; voffB[i] = (unsigned)(Rb * g.ldb + C) * 2u; }
    const size_t kstep = (size_t)(BK * 2);
    const size_t hstepA = (size_t)HALF * g.lda * 2, hstepB = (size_t)HALF * g.ldb * 2;
    const size_t tstepA = 2 * hstepA, tstepB = 2 * hstepB;
    const unsigned ldsw = (unsigned)wid * 1024u;
    const int aoff = lds_byte(wr * 64 + fr, fq * 8), boff = lds_byte(wc * 32 + fr, fq * 8);
#define PG8_SA(b, h) (((b) * 2 + (h)) * HTB)
#define PG8_SB(b, h) ((4 + (b) * 2 + (h)) * HTB)
#define PG8_STAGE(bufoff, gbase, voff) do { _Pragma("unroll") for (int _i = 0; _i < 2; ++_i) \
        __builtin_amdgcn_global_load_lds((const unsigned*)((const char*)(gbase) + (voff)[_i]), (PG8_LAS unsigned*)(lds + (bufoff) + ldsw + _i * 8192), 16, 0, 0); } while (0)
#define PG8_LDA(dst, b, h) do { _Pragma("unroll") for (int m = 0; m < 4; ++m) _Pragma("unroll") for (int k = 0; k < 2; ++k) dst[m][k] = *(const PG8_LAS bf16x8*)(lds + PG8_SA(b, h) + aoff + m * 2048 + k * 1024); } while (0)
#define PG8_LDB(dst, b, h) do { _Pragma("unroll") for (int n = 0; n < 2; ++n) _Pragma("unroll") for (int k = 0; k < 2; ++k) dst[n][k] = *(const PG8_LAS bf16x8*)(lds + PG8_SB(b, h) + boff + n * 2048 + k * 1024); } while (0)
#define PG8_MMA(ai, bj, At, Bt) do { __builtin_amdgcn_s_setprio(1); _Pragma("unroll") for (int m = 0; m < 4; ++m) _Pragma("unroll") for (int n = 0; n < 2; ++n) _Pragma("unroll") for (int k = 0; k < 2; ++k) \
        acc[ai][bj][m][n] = __builtin_amdgcn_mfma_f32_16x16x32_bf16(Bt[n][k], At[m][k], acc[ai][bj][m][n], 0, 0, 0); __builtin_amdgcn_s_setprio(0); } while (0)
#define PG8_WAIT_V(n) asm volatile("s_waitcnt vmcnt(" #n ")" ::: "memory")
#define PG8_WAIT_L(n) asm volatile("s_waitcnt lgkmcnt(" #n ")" ::: "memory")
#define PG8_BAR __builtin_amdgcn_s_barrier()
#define PG8_SCHED __builtin_amdgcn_sched_barrier(0)
    Unit cur, nxt; int ui = 0;
    if (!S.next(0, cur)) return;
    f32x4 acc[2][2][4][2];
#pragma unroll
    for (int a = 0; a < 2; ++a)
#pragma unroll
        for (int b = 0; b < 2; ++b)
#pragma unroll
            for (int m = 0; m < 4; ++m)
#pragma unroll
                for (int n = 0; n < 2; ++n) acc[a][b][m][n] = (f32x4){0.f, 0.f, 0.f, 0.f};
    bf16x8 At[4][2], B0[2][2], B1[2][2];
    const char* cA = (const char*)g.A + (size_t)cur.pm * tstepA; const char* cB = (const char*)g.Bt + (size_t)cur.pn * tstepB;
    S.a_ready(cur);
    if constexpr (SP2) {
        PG8_STAGE(PG8_SB(0, 0), cB, voffB); PG8_STAGE(PG8_SB(0, 1), cB + hstepB, voffB); PG8_STAGE(PG8_SA(0, 0), cA, voffA); PG8_STAGE(PG8_SA(0, 1), cA + hstepA, voffA);
        if (wr == 1) PG8_BAR;
        PG8_WAIT_V(2); PG8_BAR;
        PG8_STAGE(PG8_SB(1, 0), cB + kstep, voffB); PG8_STAGE(PG8_SA(1, 0), cA + kstep, voffA); PG8_STAGE(PG8_SB(1, 1), cB + hstepB + kstep, voffB);
        PG8_WAIT_V(6); PG8_BAR;
    } else {
        PG8_STAGE(PG8_SB(0, 0), cB, voffB); PG8_STAGE(PG8_SA(0, 0), cA, voffA); PG8_STAGE(PG8_SB(0, 1), cB + hstepB, voffB); PG8_STAGE(PG8_SA(0, 1), cA + hstepA, voffA);
        if (wr == 1) PG8_BAR;
        PG8_WAIT_V(4); PG8_BAR;
        PG8_STAGE(PG8_SB(1, 0), cB + kstep, voffB); PG8_STAGE(PG8_SA(1, 0), cA + kstep, voffA); PG8_STAGE(PG8_SB(1, 1), cB + hstepB + kstep, voffB);
        PG8_WAIT_V(6); PG8_BAR;
    }
    for (;;) {
        const bool has_next = S.next(ui + 1, nxt);
        const char* nA = has_next ? (const char*)g.A + (size_t)nxt.pm * tstepA : cA; const char* nB = has_next ? (const char*)g.Bt + (size_t)nxt.pn * tstepB : cB;
        for (int t = 0; t < nt; t += 2) {
            const bool last = (t == nt - 2);
            const char* a1 = cA + (size_t)(t + 1) * kstep;
            const char* a2 = last ? nA : cA + (size_t)(t + 2) * kstep; const char* b2 = last ? nB : cB + (size_t)(t + 2) * kstep;
            const char* a3 = a2 + kstep; const char* b3 = b2 + kstep;
            if (last && has_next) S.a_ready(nxt);
            if constexpr (SP2) {
            PG8_LDB(B0, 0, 0); PG8_LDB(B1, 0, 1); PG8_SCHED; PG8_LDA(At, 0, 0); PG8_STAGE(PG8_SA(1, 1), a1 + hstepA, voffA);
            PG8_WAIT_V(8); PG8_WAIT_L(0); PG8_BAR; PG8_MMA(0, 0, At, B0); PG8_MMA(0, 1, At, B1); PG8_BAR; PG8_SCHED;
            PG8_LDA(At, 0, 1); PG8_STAGE(PG8_SB(0, 0), b2, voffB); PG8_STAGE(PG8_SB(0, 1), b2 + hstepB, voffB); PG8_STAGE(PG8_SA(0, 0), a2, voffA);
            PG8_WAIT_V(8); PG8_WAIT_L(0); PG8_BAR; PG8_MMA(1, 0, At, B0); PG8_MMA(1, 1, At, B1); PG8_BAR; PG8_SCHED;
            PG8_LDB(B0, 1, 0); PG8_LDB(B1, 1, 1); PG8_SCHED; PG8_LDA(At, 1, 0); PG8_STAGE(PG8_SA(0, 1), a2 + hstepA, voffA);
            PG8_WAIT_V(8); PG8_WAIT_L(0); PG8_BAR; PG8_MMA(0, 0, At, B0); PG8_MMA(0, 1, At, B1); PG8_BAR; PG8_SCHED;
            PG8_LDA(At, 1, 1); PG8_STAGE(PG8_SB(1, 0), b3, voffB); PG8_STAGE(PG8_SB(1, 1), b3 + hstepB, voffB); PG8_STAGE(PG8_SA(1, 0), a3, voffA);
            PG8_WAIT_V(8); PG8_WAIT_L(0); PG8_BAR; PG8_MMA(1, 0, At, B0); PG8_MMA(1, 1, At, B1); PG8_BAR; PG8_SCHED;
            } else {
            PG8_LDB(B0, 0, 0); PG8_SCHED; PG8_LDA(At, 0, 0); PG8_STAGE(PG8_SA(1, 1), a1 + hstepA, voffA);
            PG8_WAIT_L(8); PG8_BAR; PG8_WAIT_L(0); PG8_MMA(0, 0, At, B0); PG8_BAR; PG8_SCHED;
            PG8_LDB(B1, 0, 1); PG8_STAGE(PG8_SB(0, 0), b2, voffB);
            PG8_BAR; PG8_WAIT_L(0); PG8_MMA(0, 1, At, B1); PG8_BAR;
            PG8_LDA(At, 0, 1); PG8_STAGE(PG8_SA(0, 0), a2, voffA);
            PG8_BAR; PG8_WAIT_L(0); PG8_MMA(1, 0, At, B0); PG8_BAR; PG8_SCHED;
            PG8_STAGE(PG8_SB(0, 1), b2 + hstepB, voffB);
            PG8_WAIT_V(6); PG8_BAR; PG8_MMA(1, 1, At, B1); PG8_BAR;
            PG8_LDB(B0, 1, 0); PG8_SCHED; PG8_LDA(At, 1, 0); PG8_STAGE(PG8_SA(0, 1), a2 + hstepA, voffA);
            PG8_WAIT_L(8); PG8_BAR; PG8_WAIT_L(0); PG8_MMA(0, 0, At, B0); PG8_BAR; PG8_SCHED;
            PG8_LDB(B1, 1, 1); PG8_STAGE(PG8_SB(1, 0), b3, voffB);
            PG8_BAR; PG8_WAIT_L(0); PG8_MMA(0, 1, At, B1); PG8_BAR;
            PG8_LDA(At, 1, 1); PG8_STAGE(PG8_SA(1, 0), a3, voffA);
            PG8_BAR; PG8_WAIT_L(0); PG8_MMA(1, 0, At, B0); PG8_BAR; PG8_SCHED;
            PG8_STAGE(PG8_SB(1, 1), b3 + hstepB, voffB);
            PG8_WAIT_V(6); PG8_BAR; PG8_MMA(1, 1, At, B1); PG8_BAR;
            }
        }
        if constexpr (ALIGN_EPI) { if (wr == 0) PG8_BAR; }
        if constexpr (!Epi::AFTER_DRAIN) { E(acc, cur, wr, wc, fr, fq); S.done(cur); }
        if (!has_next) break;
#pragma unroll
        for (int a = 0; a < 2; ++a)
#pragma unroll
            for (int b = 0; b < 2; ++b)
#pragma unroll
                for (int m = 0; m < 4; ++m)
#pragma unroll
                    for (int n = 0; n < 2; ++n) acc[a][b][m][n] = (f32x4){0.f, 0.f, 0.f, 0.f};
        cur = nxt; cA = nA; cB = nB; ++ui;
        if constexpr (ALIGN_EPI) { if (wr == 1) PG8_BAR; }
    }
    PG8_WAIT_V(0);
    if constexpr (!ALIGN_EPI) { if (wr == 0) PG8_BAR; }
    PG8_BAR;
    if constexpr (Epi::AFTER_DRAIN) { E.fused(acc, cur, wr, wc, fr, fq, lds, wid, lane); S.done(cur); }
#undef PG8_SA
#undef PG8_SB
#undef PG8_STAGE
#undef PG8_LDA
#undef PG8_LDB
#undef PG8_MMA
#undef PG8_WAIT_V
#undef PG8_WAIT_L
#undef PG8_BAR
#undef PG8_SCHED
}
}


template <class F> struct EpiFn4 { static constexpr bool PERM = false, AFTER_DRAIN = false; F f;
    __device__ __forceinline__ void operator()(const f32x4 (&acc)[2][2][4][2], const pg8::Unit& u, int wr, int wc, int fr, int fq) const {
        const int row0 = u.pm * 256 + wr * 64 + fr, col0 = u.pn * 256 + wc * 32 + 4 * fq;
#pragma unroll
        for (int ai = 0; ai < 2; ++ai)
#pragma unroll
            for (int m = 0; m < 4; ++m)
#pragma unroll
                for (int bj = 0; bj < 2; ++bj)
#pragma unroll
                    for (int n = 0; n < 2; ++n) f(row0 + ai * 128 + m * 16, col0 + bj * 128 + n * 16, acc[ai][bj][m][n]);
    } };
template <class F> struct EpiFn8 { static constexpr bool PERM = true, AFTER_DRAIN = false; F f;
    __device__ __forceinline__ void operator()(const f32x4 (&acc)[2][2][4][2], const pg8::Unit& u, int wr, int wc, int fr, int fq) const {
        const int row0 = u.pm * 256 + wr * 64 + fr, col0 = u.pn * 256 + wc * 32 + 8 * fq;
#pragma unroll
        for (int ai = 0; ai < 2; ++ai)
#pragma unroll
            for (int m = 0; m < 4; ++m)
#pragma unroll
                for (int bj = 0; bj < 2; ++bj) f(row0 + ai * 128 + m * 16, col0 + bj * 128, acc[ai][bj][m][0], acc[ai][bj][m][1]);
    } };
template <class F> __device__ __forceinline__ void gemm_pg8_4(const Ctx& c, const bf16_t* A, int lda, const bf16_t* Bt, int ldb, int M, int N, int K, const F& f) {
    pg8::Gemm g{A, Bt, M, N, K, lda, ldb}; pg8::StaticOrder S; S.init(M, N, (int)gridDim.x, (int)blockIdx.x); EpiFn4<F> E{f};
    pg8::gemm_phase<EpiFn4<F>, pg8::StaticOrder, true, true>(c.lds, g, S, E);
}
template <class F> __device__ __forceinline__ void gemm_pg8_8(const Ctx& c, const bf16_t* A, int lda, const bf16_t* Bt, int ldb, int M, int N, int K, const F& f) {
    pg8::Gemm g{A, Bt, M, N, K, lda, ldb}; pg8::StaticOrder S; S.init(M, N, (int)gridDim.x, (int)blockIdx.x); EpiFn8<F> E{f};
    pg8::gemm_phase<EpiFn8<F>, pg8::StaticOrder, true, true>(c.lds, g, S, E);
}
__device__ __forceinline__ u32x4 pk8(f32x4 lo, f32x4 hi) { u32x4 w; w.x = pk2(lo[0], lo[1]); w.y = pk2(lo[2], lo[3]); w.z = pk2(hi[0], hi[1]); w.w = pk2(hi[2], hi[3]); return w; }
struct F8Store { bf16_t* O; int ld; __device__ __forceinline__ void operator()(int row, int col, f32x4 lo, f32x4 hi) const { *(u32x4*)(O + (size_t)row * ld + col) = pk8(lo, hi); } };
struct F8SigBias { bf16_t* O; int ld; const float* bias;
    __device__ __forceinline__ void operator()(int row, int col, f32x4 lo, f32x4 hi) const {
        lo += *(const f32x4*)(bias + col); hi += *(const f32x4*)(bias + col + 4);
#pragma unroll
        for (int j = 0; j < 4; ++j) { lo[j] = sigmoidf_(lo[j]); hi[j] = sigmoidf_(hi[j]); }
        *(u32x4*)(O + (size_t)row * ld + col) = pk8(lo, hi); } };
template <int SEG> struct F4Up { float* MF; const bf16_t* GT; bf16_t* MG;
    __device__ __forceinline__ void operator()(int row, int col, f32x4 v) const {
        const f32x4 g = unpk4(*(const u32x2*)(GT + (size_t)row * (3 * DM) + SEG * DM + col)); const size_t off = (size_t)row * DM + col;
        if (SEG == 0) *(f32x4*)(MF + off) = g * v;
        else if (SEG == 1) *(f32x4*)(MF + off) = *(const f32x4*)(MF + off) + g * v;
        else *(u32x2*)(MG + off) = pk4(*(const f32x4*)(MF + off) + g * v); } };


__device__ __forceinline__ f32x2 gelu_pk(f32x2 v) {
    const f32x2 av = __builtin_elementwise_abs(v), d = av * 0.2316418882f + 1.0f;
    f32x2 t; t.x = __builtin_amdgcn_rcpf(d.x); t.y = __builtin_amdgcn_rcpf(d.y);
    f32x2 q = t * 0.5307027145f + (-0.7265760135f); q = q * t + 0.7107068705f; q = q * t + (-0.142248368f); q = q * t + 0.127414796f; q = q * t;
    const f32x2 s = (v * v) * (-0.72134752044f);
    f32x2 e; e.x = __builtin_amdgcn_exp2f(s.x); e.y = __builtin_amdgcn_exp2f(s.y);
    const f32x2 m = v * (q * e), r = v - m;
    f32x2 o; o.x = v.x < 0.f ? m.x : r.x; o.y = v.y < 0.f ? m.y : r.y; return o;
}
struct EpiFfnAct { static constexpr bool PERM = true, AFTER_DRAIN = false;
    bf16_t* ACT; const float* rstd; const float* cw; const float* cb; float* TAILU; float* HEADU; float* HEADGV; LAS float* halo;
    __device__ __forceinline__ void operator()(const f32x4 (&acc)[2][2][4][2], const pg8::Unit& u, int wr, int wc, int fr, int fq) const {
        const int ch0 = u.pn * 128 + wc * 32 + 8 * fq, rowt = wr * 64 + fr, grow0 = u.pm * 256 + rowt;
        f32x4 c0[2], c1[2], c2[2], cbv[2];
#pragma unroll
        for (int n = 0; n < 2; ++n) { c0[n] = *(const f32x4*)(cw + ch0 + 4 * n); c1[n] = *(const f32x4*)(cw + FF + ch0 + 4 * n); c2[n] = *(const f32x4*)(cw + 2 * FF + ch0 + 4 * n); cbv[n] = *(const f32x4*)(cb + ch0 + 4 * n); }
#pragma unroll
        for (int ai = 0; ai < 2; ++ai) { const float rs3 = rstd[grow0 + ai * 128 + 48];
            if (fr >= 14) {
#pragma unroll
                for (int n = 0; n < 2; ++n) *(LAS f32x4*)(halo + (((((ai * 2 + wr) * 2 + (fr - 14)) * 4 + wc) * 4 + fq) * 8 + 4 * n)) = acc[ai][0][3][n] * rs3; } }
        asm volatile("s_waitcnt lgkmcnt(0)" ::: "memory"); __builtin_amdgcn_s_barrier(); asm volatile("" ::: "memory");
#pragma unroll
        for (int ai = 0; ai < 2; ++ai) {
            f32x4 r1p[2], r2p[2];
            if (wr == 1 || ai == 1) { const int src = (wr == 1) ? (ai * 2) : ((ai - 1) * 2 + 1);
#pragma unroll
                for (int n = 0; n < 2; ++n) { const f32x4 hv0 = *(const LAS f32x4*)(halo + ((((src * 2 + 0) * 4 + wc) * 4 + fq) * 8 + 4 * n)), hv1 = *(const LAS f32x4*)(halo + ((((src * 2 + 1) * 4 + wc) * 4 + fq) * 8 + 4 * n));
                    r1p[n] = hv1; r2p[n] = (fr == 0) ? hv0 : hv1; } }
            else { r1p[0] = r1p[1] = r2p[0] = r2p[1] = (f32x4){0.f, 0.f, 0.f, 0.f}; }
#pragma unroll
            for (int m = 0; m < 4; ++m) {
                const int grow = grow0 + ai * 128 + 16 * m; const float rs = rstd[grow];
                u32x4 w;
#pragma unroll
                for (int n = 0; n < 2; ++n) {
                    const f32x4 uu = acc[ai][0][m][n] * rs, gg = acc[ai][1][m][n] * rs;
                    f32x4 R1, R2;
#pragma unroll
                    for (int j = 0; j < 4; ++j) { R1[j] = dpp_f<0x121>(uu[j]); R2[j] = dpp_f<0x122>(uu[j]); }
                    const f32x4 p1 = (fr >= 1) ? R1 : r1p[n], p2 = (fr >= 2) ? R2 : r2p[n];
                    r1p[n] = R1; r2p[n] = R2;
                    const f32x4 uc = c0[n] * p2 + c1[n] * p1 + c2[n] * uu + cbv[n];
                    const f32x2 ga = gelu_pk((f32x2){uc[0], uc[1]}), gb = gelu_pk((f32x2){uc[2], uc[3]});
                    const unsigned lo = pk2(ga.x * gg[0], ga.y * gg[1]), hi = pk2(gb.x * gg[2], gb.y * gg[3]);
                    if (n == 0) { w.x = lo; w.y = hi; } else { w.z = lo; w.w = hi; }
                    if (ai == 0 && m == 0) { if (wr == 0 && fr < 2) { const size_t so = (size_t)(u.pm * 2 + fr) * FF + ch0 + 4 * n; *(f32x4*)(HEADU + so) = uu; *(f32x4*)(HEADGV + so) = gg; } }
                    if (ai == 1 && m == 3) { if (wr == 1 && fr >= 14) { const size_t so = (size_t)(u.pm * 2 + (fr - 14)) * FF + ch0 + 4 * n; *(f32x4*)(TAILU + so) = uu; } }
                }
                *(u32x4*)(ACT + (size_t)grow * FF + ch0) = w;
            }
        }
    } };
__device__ __forceinline__ void phase_ffn_fix(const Params& p, const Ctx& c) {
    unsigned char* ws = p.ws;
    const float* TAILU = (const float*)(ws + WS_TAILU); const float* HEADU = (const float*)(ws + WS_HEADU); const float* HEADGV = (const float*)(ws + WS_HEADGV); bf16_t* ACT = (bf16_t*)(ws + WS_ACT);
    const float* cw = p.in[I_CONVW]; const float* cb = p.in[I_CONVB];
    const int nit = (MTOK / 256) * 2 * (FF / 4);
    for (int idx = blockIdx.x * NTHREADS + c.tid; idx < nit; idx += gridDim.x * NTHREADS) {
        const int col = 4 * (idx % (FF / 4)), pr = idx / (FF / 4), pm = pr >> 1, rr = pr & 1;
        if ((pm & 15) == 0) continue;
        const f32x4 u0 = *(const f32x4*)(HEADU + (size_t)(pm * 2 + rr) * FF + col), gg = *(const f32x4*)(HEADGV + (size_t)(pm * 2 + rr) * FF + col);
        const f32x4 t1 = *(const f32x4*)(TAILU + (size_t)((pm - 1) * 2 + 1) * FF + col), t0 = *(const f32x4*)(TAILU + (size_t)((pm - 1) * 2 + 0) * FF + col);
        f32x4 u1, u2; if (rr == 0) { u1 = t1; u2 = t0; } else { u1 = *(const f32x4*)(HEADU + (size_t)(pm * 2) * FF + col); u2 = t1; }
        const f32x4 uc = *(const f32x4*)(cw + col) * u2 + *(const f32x4*)(cw + FF + col) * u1 + *(const f32x4*)(cw + 2 * FF + col) * u0 + *(const f32x4*)(cb + col);
        const f32x2 ga = gelu_pk((f32x2){uc[0], uc[1]}), gb = gelu_pk((f32x2){uc[2], uc[3]});
        u32x2 w; w.x = pk2(ga.x * gg[0], ga.y * gg[1]); w.y = pk2(gb.x * gg[2], gb.y * gg[3]);
        *(u32x2*)(ACT + (size_t)(pm * 256 + rr) * FF + col) = w;
    }
}

__device__ __forceinline__ void wave_gemm_32x64(const bf16_t* A, int lda, const bf16_t* Bt, int ldb, int K, int m0, int n0, int fr, int fq, f32x4 (&acc)[2][4]) {
    const bf16_t* ap = A + (size_t)(m0 + fr) * lda + 8 * fq;
    const bf16_t* bp = Bt + (size_t)(n0 + fr) * ldb + 8 * fq;
    for (int k0 = 0; k0 < K; k0 += 32) {
        const bf16x8 a0 = *(const bf16x8*)(ap + k0), a1 = *(const bf16x8*)(ap + (size_t)16 * lda + k0);
        bf16x8 b[4];
#pragma unroll
        for (int j = 0; j < 4; ++j) b[j] = *(const bf16x8*)(bp + (size_t)(16 * j) * ldb + k0);
#pragma unroll
        for (int j = 0; j < 4; ++j) { acc[0][j] = __builtin_amdgcn_mfma_f32_16x16x32_bf16(b[j], a0, acc[0][j], 0, 0, 0); acc[1][j] = __builtin_amdgcn_mfma_f32_16x16x32_bf16(b[j], a1, acc[1][j], 0, 0, 0); }
    }
}
template <class Epi>
__device__ __forceinline__ void gemm_simple(const Ctx& c, const bf16_t* A, int lda, const bf16_t* Bt, int ldb, int M, int N, int K, const Epi& epi) {
    const int nMt = M / 256, nNt = N / 64, ntiles = nMt * nNt;
    for (int tile = blockIdx.x; tile < ntiles; tile += gridDim.x) {
        const int tm = tile % nMt, tn = tile / nMt, m0 = tm * 256 + c.wave * 32, n0 = tn * 64;
        f32x4 acc[2][4];
#pragma unroll
        for (int i = 0; i < 2; ++i)
#pragma unroll
            for (int j = 0; j < 4; ++j) acc[i][j] = (f32x4){0.f, 0.f, 0.f, 0.f};
        wave_gemm_32x64(A, lda, Bt, ldb, K, m0, n0, c.fr, c.fq, acc);
#pragma unroll
        for (int i = 0; i < 2; ++i)
#pragma unroll
            for (int j = 0; j < 4; ++j) epi(m0 + 16 * i + c.fr, n0 + 16 * j + 4 * c.fq, acc[i][j]);
    }
}

struct EpiBf16 { bf16_t* O; int ld; __device__ __forceinline__ void operator()(int row, int col, f32x4 v) const { *(u32x2*)(O + (size_t)row * ld + col) = pk4(v); } };
struct EpiKV { bf16_t* KB; bf16_t* VT;
    __device__ __forceinline__ void operator()(int row, int col, f32x4 v) const {
        if (col < 256) { *(u32x2*)(KB + (size_t)row * 256 + col) = pk4(v); }
        else { const int cc = col - 256, h = cc >> 6, d = cc & 63, b = row >> 8, key = row & 255;
#pragma unroll
            for (int j = 0; j < 4; ++j) VT[((size_t)((b * 4 + h) * 64 + d + j)) * 256 + key] = (bf16_t)f2bf(v[j]); }
    } };
struct EpiDecay { float* W; const float* w0;
    __device__ __forceinline__ void operator()(int row, int col, f32x4 v) const {
        const f32x4 z = v + *(const f32x4*)(w0 + col); f32x4 o;
#pragma unroll
        for (int j = 0; j < 4; ++j) o[j] = __expf(-0.60653065971f * sigmoidf_(z[j]));
        *(f32x4*)(W + (size_t)row * RD + col) = o; } };
struct EpiSigBias { bf16_t* O; int ld; const float* bias;
    __device__ __forceinline__ void operator()(int row, int col, f32x4 v) const {
        const f32x4 z = v + *(const f32x4*)(bias + col); f32x4 o;
#pragma unroll
        for (int j = 0; j < 4; ++j) o[j] = sigmoidf_(z[j]);
        *(u32x2*)(O + (size_t)row * ld + col) = pk4(o); } };
struct EpiPool { bf16_t* Y; const float* scale; int gi;
    __device__ __forceinline__ void operator()(int row, int col, f32x4 v) const {
        const f32x4 s = *(const f32x4*)(scale + 64 * gi + col); *(u32x2*)(Y + (size_t)row * DM + 512 + 64 * gi + col) = pk4(v * s); } };
struct EpiOut { const float* x; float* x1; bf16_t* x1b;
    __device__ __forceinline__ void operator()(int row, int col, f32x4 v) const {
        const size_t off = (size_t)row * DM + col; const f32x4 o = *(const f32x4*)(x + off) + v; *(f32x4*)(x1 + off) = o; *(u32x2*)(x1b + off) = pk4(o); } };
struct EpiAddOut { float* x;
    __device__ __forceinline__ void operator()(int row, int col, f32x4 v) const { const size_t off = (size_t)row * DM + col; *(f32x4*)(x + off) = *(const f32x4*)(x + off) + v; } };

__device__ __forceinline__ void phase_mix(const Params& p, const Ctx& c) {
    unsigned char* ws = p.ws;
    const bf16_t* P = (const bf16_t*)(ws + WS_P); const float* mu = p.in[I_MU];
    bf16_t* R = (bf16_t*)(ws + WS_R); bf16_t* KR = (bf16_t*)(ws + WS_KRAW); bf16_t* V = (bf16_t*)(ws + WS_V);
    bf16_t* LW = (bf16_t*)(ws + WS_LW); bf16_t* LA = (bf16_t*)(ws + WS_LA); bf16_t* LG = (bf16_t*)(ws + WS_LG);
    for (int row = c.gw; row < MTOK; row += c.ngw) {
        const int t = row & (SEQ - 1); const bf16_t* cur = P + (size_t)row * MIXIN;
#pragma unroll
        for (int i = 0; i < 7; ++i) {
            const int col = 4 * c.lane + 256 * i;
            const f32x4 cv = unpk4(*(const u32x2*)(cur + col));
            f32x4 pv = (f32x4){0.f, 0.f, 0.f, 0.f}; if (t > 0) pv = unpk4(*(const u32x2*)(cur - MIXIN + col));
            const f32x4 m4 = *(const f32x4*)(mu + col);
            f32x4 pm = cv + (pv - cv) * m4;
            if (i < 2) *(u32x2*)(R + (size_t)row * RD + col) = pk4(pm);
            else if (i < 4) *(u32x2*)(KR + (size_t)row * RD + (col - 512)) = pk4(pm);
            else if (i < 6) *(u32x2*)(V + (size_t)row * RD + (col - 1024)) = pk4(pm);
            else {
                const int cc = col - 1536;
                if (cc < 64) { f32x4 o; o[0] = tanhf(pm[0]); o[1] = tanhf(pm[1]); o[2] = tanhf(pm[2]); o[3] = tanhf(pm[3]); *(u32x2*)(LW + (size_t)row * 64 + cc) = pk4(o); }
                else if (cc < 128) { *(u32x2*)(LA + (size_t)row * 64 + (cc - 64)) = pk4(pm); }
                else { f32x4 o; o[0] = sigmoidf_(pm[0]); o[1] = sigmoidf_(pm[1]); o[2] = sigmoidf_(pm[2]); o[3] = sigmoidf_(pm[3]); *(u32x2*)(LG + (size_t)row * 128 + (cc - 128)) = pk4(o); }
            }
        }
    }
}
__device__ __forceinline__ void phase_pooldiff(const Params& p, const Ctx& c) {
    unsigned char* ws = p.ws;
    const bf16_t* P = (const bf16_t*)(ws + WS_P); bf16_t* DP = (bf16_t*)(ws + WS_DPOOL);
    const int col = 4 * c.lane, gi = c.lane >> 4, win = 2 << gi;
    for (int row = c.gw; row < MTOK; row += c.ngw) {
        const int t = row & (SEQ - 1); const bf16_t* cur = P + (size_t)row * MIXIN + RWKVIN + col;
        const f32x4 x0 = unpk4(*(const u32x2*)cur); f32x4 s = x0;
        for (int j = 1; j < 16; ++j) if (j < win && j <= t) s += unpk4(*(const u32x2*)(cur - (size_t)j * MIXIN));
        const int cnt = (t + 1) < win ? (t + 1) : win;
        *(u32x2*)(DP + (size_t)row * 256 + col) = pk4(s * (1.0f / (float)cnt) - x0);
    }
}
__device__ __forceinline__ void phase_memattn(const Params& p, const Ctx& c) {
    unsigned char* ws = p.ws;
    const bf16_t* P = (const bf16_t*)(ws + WS_P); const bf16_t* KB = (const bf16_t*)(ws + WS_KB); const bf16_t* VT = (const bf16_t*)(ws + WS_VT); bf16_t* Y = (bf16_t*)(ws + WS_YCAT);
    const int fr = c.fr, fq = c.fq;
    for (int unit = blockIdx.x; unit < BATCH * 4 * 16; unit += gridDim.x) {
        const int qt = unit & 15, h = (unit >> 4) & 3, b = unit >> 6;
#pragma unroll 1
        for (int qg = 0; qg < 2; ++qg) {
            const int row = b * SEQ + qt * 256 + c.wave * 32 + 16 * qg + fr;
            const bf16x8 q0 = *(const bf16x8*)(P + (size_t)row * MIXIN + 2048 + h * 64 + 8 * fq), q1 = *(const bf16x8*)(P + (size_t)row * MIXIN + 2048 + h * 64 + 32 + 8 * fq);
            f32x4 sc[16];
#pragma unroll
            for (int kg = 0; kg < 16; ++kg) {
                const bf16_t* kp = KB + (size_t)(b * 256 + 16 * kg + fr) * 256 + h * 64 + 8 * fq;
                const bf16x8 k0 = *(const bf16x8*)kp, k1 = *(const bf16x8*)(kp + 32);
                f32x4 a = (f32x4){0.f, 0.f, 0.f, 0.f};
                a = __builtin_amdgcn_mfma_f32_16x16x32_bf16(k0, q0, a, 0, 0, 0); a = __builtin_amdgcn_mfma_f32_16x16x32_bf16(k1, q1, a, 0, 0, 0); sc[kg] = a;
                if ((kg & 3) == 3) asm volatile("" ::: "memory");
            }
            float m = -1e30f;
#pragma unroll
            for (int kg = 0; kg < 16; ++kg) m = fmaxf(m, fmaxf(fmaxf(sc[kg][0], sc[kg][1]), fmaxf(sc[kg][2], sc[kg][3])));
            m = fmaxf(m, __shfl_xor(m, 16)); m = fmaxf(m, __shfl_xor(m, 32));
            float l = 0.f;
#pragma unroll
            for (int kg = 0; kg < 16; ++kg)
#pragma unroll
                for (int j = 0; j < 4; ++j) { const float e = __expf((sc[kg][j] - m) * 0.125f); sc[kg][j] = e; l += e; }
            l += __shfl_xor(l, 16); l += __shfl_xor(l, 32);
            const float linv = 1.0f / l;
            f32x4 o[4];
#pragma unroll
            for (int dg = 0; dg < 4; ++dg) o[dg] = (f32x4){0.f, 0.f, 0.f, 0.f};
#pragma unroll
            for (int s = 0; s < 8; ++s) {
                u32x4 w; w.x = pk2(sc[2 * s][0], sc[2 * s][1]); w.y = pk2(sc[2 * s][2], sc[2 * s][3]); w.z = pk2(sc[2 * s + 1][0], sc[2 * s + 1][1]); w.w = pk2(sc[2 * s + 1][2], sc[2 * s + 1][3]);
                const bf16x8 pf = __builtin_bit_cast(bf16x8, w);
#pragma unroll
                for (int dg = 0; dg < 4; ++dg) {
                    const bf16_t* vp = VT + ((size_t)((b * 4 + h) * 64 + 16 * dg + fr)) * 256 + 32 * s + 4 * fq;
                    u32x4 v; const u32x2 lo = *(const u32x2*)vp, hi = *(const u32x2*)(vp + 16); v.x = lo.x; v.y = lo.y; v.z = hi.x; v.w = hi.y;
                    o[dg] = __builtin_amdgcn_mfma_f32_16x16x32_bf16(__builtin_bit_cast(bf16x8, v), pf, o[dg], 0, 0, 0);
                }
                if (s & 1) asm volatile("" ::: "memory");
            }
#pragma unroll
            for (int dg = 0; dg < 4; ++dg) *(u32x2*)(Y + (size_t)row * DM + 768 + h * 64 + 16 * dg + 4 * fq) = pk4(o[dg] * linv);
        }
    }
}

__device__ __forceinline__ void phase_prep2(const Params& p, const Ctx& c) {
    unsigned char* ws = p.ws;
    const bf16_t* KR = (const bf16_t*)(ws + WS_KRAW); const bf16_t* AA = (const bf16_t*)(ws + WS_AA); const bf16_t* R = (const bf16_t*)(ws + WS_R);
    bf16_t* KK = (bf16_t*)((unsigned char*)p.out + DO_KK); bf16_t* BB = (bf16_t*)((unsigned char*)p.out + DO_BB); bf16_t* KF = (bf16_t*)((unsigned char*)p.out + DO_KF);
    float* BON = (float*)(ws + WS_BONUS);
    for (int it = c.gw; it < MTOK * 8; it += c.ngw) {
        const int row = it >> 3, h = it & 7, col = h * 64 + c.lane; const size_t off = (size_t)row * RD + col;
        const float k = bf2f(KR[off]), a = bf2f(AA[off]), r = bf2f(R[off]);
        const float kkv = k * p.in[I_KK][col];
        const float nrm = wave_sum(kkv * kkv);
        const float kap = kkv * rsqrtf(nrm + 1e-12f);
        const float kf = k * (1.0f + (a - 1.0f) * p.in[I_KA][col]);
        const float bon = wave_sum(r * kf * p.in[I_RK][col]);
        KK[off] = (bf16_t)f2bf(kap); BB[off] = (bf16_t)f2bf(kap * a); KF[off] = (bf16_t)f2bf(kf);
        if (c.lane == 0) BON[it] = bon;
    }
}

constexpr int TC = 32;
__device__ __forceinline__ void phase_scan(const Params& p, const Ctx& c) {
    unsigned char* ws = p.ws;
    const bf16_t* KK = (const bf16_t*)((unsigned char*)p.out + DO_KK); const bf16_t* BB = (const bf16_t*)((unsigned char*)p.out + DO_BB); const bf16_t* KF = (const bf16_t*)((unsigned char*)p.out + DO_KF);
    const bf16_t* R = (const bf16_t*)(ws + WS_R); const bf16_t* V = (const bf16_t*)(ws + WS_V); const float* W = (const float*)(ws + WS_W);
    float* YR = (float*)(ws + WS_YRAW);
    constexpr int OPF = 5 * TC * 64, BUFF = OPF + TC * 16;
    LAS float* L = (LAS float*)c.lds; LAS float* YB = L + 2 * BUFF;
    const int tid = c.tid;
    for (int unit = blockIdx.x; unit < BATCH * 8 * 4; unit += gridDim.x) {
        const int q = unit & 3, h = (unit >> 2) & 7, b = unit >> 5;
        const size_t rowbase = (size_t)b * SEQ;
        const int ss = tid >> 4, g4 = (tid & 15) * 4;
        u32x2 rb[4]; f32x4 rw; unsigned short rv;
        const int vs = tid >> 4, vi = tid & 15;
        auto issue = [&](int ch) {
            const size_t ro = (rowbase + (size_t)ch * TC + ss) * RD + h * 64 + g4;
            rb[0] = *(const u32x2*)(KK + ro); rb[1] = *(const u32x2*)(KF + ro); rb[2] = *(const u32x2*)(BB + ro); rb[3] = *(const u32x2*)(R + ro);
            rw = *(const f32x4*)(W + ro);
            rv = V[(rowbase + (size_t)ch * TC + vs) * RD + h * 64 + 16 * q + vi];
        };
        auto commit = [&](int buf) {
            LAS float* B = L + buf * BUFF;
            *(LAS f32x4*)(B + (0 * TC + ss) * 64 + g4) = unpk4(rb[0]);
            *(LAS f32x4*)(B + (1 * TC + ss) * 64 + g4) = rw;
            *(LAS f32x4*)(B + (2 * TC + ss) * 64 + g4) = unpk4(rb[1]);
            *(LAS f32x4*)(B + (3 * TC + ss) * 64 + g4) = unpk4(rb[2]);
            *(LAS f32x4*)(B + (4 * TC + ss) * 64 + g4) = unpk4(rb[3]);
            B[OPF + vs * 16 + vi] = bf2f(rv);
        };
        __syncthreads();
        issue(0); commit(0);
        __syncthreads();
        f32x4 S = (f32x4){0.f, 0.f, 0.f, 0.f};
        const int vrow = (tid >> 4) & 15, kq = tid & 15;
        for (int ch = 0; ch < SEQ / TC; ++ch) {
            if (ch + 1 < SEQ / TC) issue(ch + 1);
            if (tid < 256) {
                const LAS float* B = L + (ch & 1) * BUFF;
#pragma unroll 4
                for (int s = 0; s < TC; ++s) {
                    const f32x4 kap = *(const LAS f32x4*)(B + (0 * TC + s) * 64 + 4 * kq);
                    const f32x4 w4 = *(const LAS f32x4*)(B + (1 * TC + s) * 64 + 4 * kq);
                    const f32x4 kf4 = *(const LAS f32x4*)(B + (2 * TC + s) * 64 + 4 * kq);
                    const f32x4 b4 = *(const LAS f32x4*)(B + (3 * TC + s) * 64 + 4 * kq);
                    const f32x4 r4 = *(const LAS f32x4*)(B + (4 * TC + s) * 64 + 4 * kq);
                    const float vv = B[OPF + s * 16 + vrow];
                    const float sk = row_sum16((S[0] * kap[0] + S[1] * kap[1]) + (S[2] * kap[2] + S[3] * kap[3]));
                    S = S * w4 + kf4 * vv - b4 * sk;
                    const float y = row_sum16((S[0] * r4[0] + S[1] * r4[1]) + (S[2] * r4[2] + S[3] * r4[3]));
                    if (kq == 0) YB[s * 16 + vrow] = y;
                }
            }
            __syncthreads();
            if (ch + 1 < SEQ / TC) commit((ch + 1) & 1);
            { const int s = tid >> 4, i = tid & 15; YR[(rowbase + (size_t)ch * TC + s) * RD + h * 64 + 16 * q + i] = YB[s * 16 + i]; }
            __syncthreads();
        }
    }
}

__device__ __forceinline__ void phase_post(const Params& p, const Ctx& c) {
    unsigned char* ws = p.ws;
    const float* YR = (const float*)(ws + WS_YRAW); const float* BON = (const float*)(ws + WS_BONUS);
    const bf16_t* V = (const bf16_t*)(ws + WS_V); const bf16_t* G = (const bf16_t*)(ws + WS_G); bf16_t* Y = (bf16_t*)(ws + WS_YCAT);
    for (int it = c.gw; it < MTOK * 8; it += c.ngw) {
        const int row = it >> 3, h = it & 7, col = h * 64 + c.lane; const size_t off = (size_t)row * RD + col;
        const float y = YR[off];
        const float mean = wave_sum(y) * (1.0f / 64.0f); const float d = y - mean;
        const float var = wave_sum(d * d) * (1.0f / 64.0f);
        const float yn = d * rsqrtf(var + GN_EPS) * p.in[I_LNW][col] + p.in[I_LNB][col];
        const float bon = BON[it];
        const float o = (yn + bon * bf2f(V[off])) * bf2f(G[off]);
        Y[(size_t)row * DM + col] = (bf16_t)f2bf(o);
    }
}

__device__ __forceinline__ void phase_up_simple(const Params& p, const Ctx& c) {
    unsigned char* ws = p.ws;
    const bf16_t* Y = (const bf16_t*)(ws + WS_YCAT); const bf16_t* WU = (const bf16_t*)(ws + WS_WUPT); const bf16_t* GT = (const bf16_t*)(ws + WS_GATES); bf16_t* MG = (bf16_t*)(ws + WS_MERGED);
    const int nMt = MTOK / 256, nNt = DM / 64, ntiles = nMt * nNt;
    for (int tile = blockIdx.x; tile < ntiles; tile += gridDim.x) {
        const int tm = tile % nMt, tn = tile / nMt, m0 = tm * 256 + c.wave * 32, n0 = tn * 64;
        f32x4 tot[2][4];
#pragma unroll
        for (int i = 0; i < 2; ++i)
#pragma unroll
            for (int j = 0; j < 4; ++j) tot[i][j] = (f32x4){0.f, 0.f, 0.f, 0.f};
#pragma unroll
        for (int seg = 0; seg < 3; ++seg) {
            const int koff = seg == 0 ? 0 : (seg == 1 ? 512 : 768), K = seg == 0 ? 512 : 256;
            f32x4 acc[2][4];
#pragma unroll
            for (int i = 0; i < 2; ++i)
#pragma unroll
                for (int j = 0; j < 4; ++j) acc[i][j] = (f32x4){0.f, 0.f, 0.f, 0.f};
            wave_gemm_32x64(Y + koff, DM, WU + koff, DM, K, m0, n0, c.fr, c.fq, acc);
#pragma unroll
            for (int i = 0; i < 2; ++i)
#pragma unroll
                for (int j = 0; j < 4; ++j) { const f32x4 g = unpk4(*(const u32x2*)(GT + (size_t)(m0 + 16 * i + c.fr) * (3 * DM) + seg * DM + n0 + 16 * j + 4 * c.fq)); tot[i][j] += g * acc[i][j]; }
        }
#pragma unroll
        for (int i = 0; i < 2; ++i)
#pragma unroll
            for (int j = 0; j < 4; ++j) *(u32x2*)(MG + (size_t)(m0 + 16 * i + c.fr) * DM + n0 + 16 * j + 4 * c.fq) = pk4(tot[i][j]);
    }
}

__device__ __forceinline__ void phase_rowstat(const Params& p, const Ctx& c) {
    float* RS = (float*)(p.ws + WS_RSTD2);
    for (int m = c.gw; m < MTOK; m += c.ngw) {
        const f32x4* xr = (const f32x4*)(p.out + (size_t)m * DM) + c.lane; float s = 0.f;
#pragma unroll
        for (int j = 0; j < 4; ++j) { const f32x4 v = xr[64 * j]; s += (v[0] * v[0] + v[1] * v[1]) + (v[2] * v[2] + v[3] * v[3]); }
        s = wave_sum(s);
        if (c.lane == 0) RS[m] = rsqrtf(s * (1.f / DM) + NORM_EPS);
    }
}
__device__ __forceinline__ void phase_final_norm(const Params& p, const Ctx& c) {
    const float* g = p.in[I_NFING];
    for (int m = c.gw; m < MTOK; m += c.ngw) {
        f32x4* xr = (f32x4*)(p.out + (size_t)m * DM) + c.lane; const f32x4* gr = (const f32x4*)g + c.lane;
        f32x4 v[4]; float s = 0.f;
#pragma unroll
        for (int j = 0; j < 4; ++j) { v[j] = xr[64 * j]; s += (v[j][0] * v[j][0] + v[j][1] * v[j][1]) + (v[j][2] * v[j][2] + v[j][3] * v[j][3]); }
        const float rstd = rsqrtf(wave_sum(s) * (1.f / DM) + NORM_EPS);
#pragma unroll
        for (int j = 0; j < 4; ++j) xr[64 * j] = v[j] * rstd * gr[64 * j];
    }
}

constexpr int NPHASES = 15;
__global__ void __launch_bounds__(NTHREADS, 2) fwd_kernel(Params p) {
    extern __shared__ __attribute__((aligned(16))) unsigned char lds_raw[];
    Ctx c; c.tid = threadIdx.x; c.lane = c.tid & 63; c.wave = __builtin_amdgcn_readfirstlane(c.tid >> 6); c.fr = c.lane & 15; c.fq = c.lane >> 4;
    c.gw = blockIdx.x * NWAVES + c.wave; c.ngw = gridDim.x * NWAVES; c.lds = (LAS unsigned char*)lds_raw;
    unsigned char* ws = p.ws;
#if ONE_LAUNCH
    cg::grid_group grid = cg::this_grid();
    volatile LAS unsigned* misc = (volatile LAS unsigned*)(c.lds + LDS_MISC_OFF);
    if (c.tid < 4) misc[c.tid] = 0u;
    __syncthreads();
    const XcdBarrier xbar = xcd_barrier_post((unsigned*)(ws + WS_BAR), misc);
    bool first_seam = true;
#define SEAM() do { if (first_seam) { grid.sync(); first_seam = false; } else xcd_barrier(xbar); } while (0)
#else
#define SEAM() do {} while (0)
#endif
#define IN(k) (p.ph_lo <= (k) && (k) < p.ph_hi)
#define END(k) do { if (IN((k) + 1)) SEAM(); } while (0)
#define REP_ON(k) ((REP_MASK >> (k)) & 1u)
#define PHASE(k, ...) if (IN(k)) { __VA_ARGS__ if (REP_ON(k)) { SEAM(); __VA_ARGS__ } END(k); }
    PHASE(0, phase_prologue(p, c);)
    PHASE(1,
        gemm_pg8_8(c, (const bf16_t*)(ws + WS_H), DM, (const bf16_t*)(ws + WS_WG1T), DM, MTOK, MIXIN, DM, F8Store{(bf16_t*)(ws + WS_P), MIXIN});
        gemm_simple(c, (const bf16_t*)(ws + WS_MEMN), DM, (const bf16_t*)(ws + WS_WKVT), DM, BATCH * NMEM, 512, DM, EpiKV{(bf16_t*)(ws + WS_KB), (bf16_t*)(ws + WS_VT)});)
    PHASE(2, phase_mix(p, c); phase_pooldiff(p, c); phase_memattn(p, c);)
    PHASE(3,
        gemm_simple(c, (const bf16_t*)(ws + WS_LW), 64, (const bf16_t*)(ws + WS_WLWT), 64, MTOK, RD, 64, EpiDecay{(float*)(ws + WS_W), p.in[I_W0]});
        gemm_simple(c, (const bf16_t*)(ws + WS_LA), 64, (const bf16_t*)(ws + WS_WLAT), 64, MTOK, RD, 64, EpiSigBias{(bf16_t*)(ws + WS_AA), RD, p.in[I_A0]});
        gemm_simple(c, (const bf16_t*)(ws + WS_LG), 128, (const bf16_t*)(ws + WS_WLGT), 128, MTOK, RD, 128, EpiBf16{(bf16_t*)(ws + WS_G), RD});
        _Pragma("unroll 1") for (int gi = 0; gi < 4; ++gi)
            gemm_simple(c, (const bf16_t*)(ws + WS_DPOOL) + 64 * gi, 256, (const bf16_t*)(ws + WS_WPT) + 4096 * gi, 64, MTOK, 64, 64, EpiPool{(bf16_t*)(ws + WS_YCAT), p.in[I_POOLS], gi});)
    PHASE(4, phase_prep2(p, c);)
    PHASE(5, phase_scan(p, c);)
    PHASE(6, phase_post(p, c);)
    PHASE(7,
        gemm_pg8_8(c, (const bf16_t*)(ws + WS_H), DM, (const bf16_t*)(ws + WS_WG1T) + (size_t)MIXIN * DM, DM, MTOK, 3 * DM, DM, F8SigBias{(bf16_t*)(ws + WS_GATES), 3 * DM, p.in[I_BGATE]});)
    PHASE(8,
        gemm_pg8_4(c, (const bf16_t*)(ws + WS_YCAT), DM, (const bf16_t*)(ws + WS_WUPT), DM, MTOK, DM, 512, F4Up<0>{p.out, (const bf16_t*)(ws + WS_GATES), (bf16_t*)(ws + WS_MERGED)});
        gemm_pg8_4(c, (const bf16_t*)(ws + WS_YCAT) + 512, DM, (const bf16_t*)(ws + WS_WUPT) + 512, DM, MTOK, DM, 256, F4Up<1>{p.out, (const bf16_t*)(ws + WS_GATES), (bf16_t*)(ws + WS_MERGED)});
        gemm_pg8_4(c, (const bf16_t*)(ws + WS_YCAT) + 768, DM, (const bf16_t*)(ws + WS_WUPT) + 768, DM, MTOK, DM, 256, F4Up<2>{p.out, (const bf16_t*)(ws + WS_GATES), (bf16_t*)(ws + WS_MERGED)});)
    PHASE(9,
        gemm_pg8_4(c, (const bf16_t*)(ws + WS_MERGED), DM, (const bf16_t*)(ws + WS_WOT), DM, MTOK, DM, DM, EpiOut{p.in[I_X], p.out, (bf16_t*)(ws + WS_X1B)});)
    PHASE(10, phase_rowstat(p, c);)
    PHASE(11, {
        pg8::Gemm g{(const bf16_t*)(ws + WS_X1B), (const bf16_t*)(ws + WS_WF1T), MTOK, 2 * FF, DM, DM, DM}; pg8::StaticOrder S; S.init(MTOK, 2 * FF, (int)gridDim.x, (int)blockIdx.x);
        EpiFfnAct E{(bf16_t*)(ws + WS_ACT), (const float*)(ws + WS_RSTD2), p.in[I_CONVW], p.in[I_CONVB], (float*)(ws + WS_TAILU), (float*)(ws + WS_HEADU), (float*)(ws + WS_HEADGV), (LAS float*)(c.lds + LDS_HALO_OFF)};
        pg8::gemm_phase<EpiFfnAct, pg8::StaticOrder, true, true>(c.lds, g, S, E); })
    PHASE(12, phase_ffn_fix(p, c);)
    PHASE(13,
        gemm_pg8_4(c, (const bf16_t*)(ws + WS_ACT), FF, (const bf16_t*)(ws + WS_WF2T), FF, MTOK, DM, FF, EpiAddOut{p.out});)
    if (IN(14)) { phase_final_norm(p, c); }
#undef IN
#undef END
}

__global__ void nan_fill(float* o, int n) { const int i = blockIdx.x * blockDim.x + threadIdx.x; if (i < n) o[i] = __builtin_nanf(""); }

extern "C" void kernel_launch(void* const* d_in, const int* in_sizes, int n_in, void* d_out, int out_size, void* d_ws, size_t ws_size, hipStream_t stream) {
    static int grid = 0;
    if (grid == 0) {
        int dev = 0, cus = 0, per_cu = 0;
        if (hipGetDevice(&dev) != hipSuccess || hipDeviceGetAttribute(&cus, hipDeviceAttributeMultiprocessorCount, dev) != hipSuccess) cus = 256;
        (void)hipFuncSetAttribute((const void*)fwd_kernel, hipFuncAttributeMaxDynamicSharedMemorySize, LDS_BYTES);
        if (hipOccupancyMaxActiveBlocksPerMultiprocessor(&per_cu, (const void*)fwd_kernel, NTHREADS, LDS_BYTES) != hipSuccess || per_cu < 1) per_cu = 1;
        (void)hipGetLastError();
        grid = cus;
        if (n_in != 31 || out_size != MTOK * DM || ws_size < WS_END) grid = -1;
    }
    if (grid < 0) { nan_fill<<<(out_size + 255) / 256, 256, 0, stream>>>((float*)d_out, out_size); return; }
    Params p{};
    for (int i = 0; i < 31; ++i) p.in[i] = (const float*)d_in[i];
    p.out = (float*)d_out; p.ws = (unsigned char*)d_ws;
#if ONE_LAUNCH
    (void)hipMemsetAsync((unsigned char*)d_ws + WS_BAR, 0, WS_CTL_BYTES, stream);
    p.ph_lo = 0; p.ph_hi = NPHASES;
    void* args[] = {&p};
    hipError_t e = hipLaunchCooperativeKernel((const void*)fwd_kernel, dim3(grid), dim3(NTHREADS), args, LDS_BYTES, stream);
    if (e != hipSuccess) fprintf(stderr, "cooperative launch failed: %s (grid %d)\n", hipGetErrorString(e), grid);
#else
    for (int ph = 0; ph < NPHASES; ++ph) { p.ph_lo = ph; p.ph_hi = ph + 1; hipLaunchKernelGGL(fwd_kernel, dim3(grid), dim3(NTHREADS), LDS_BYTES, stream, p); }
#endif
}
```

```cpp
#include <hip/hip_runtime.h>
#include <hip/hip_cooperative_groups.h>
#include <cstdio>
#include <cstdint>
namespace cg = cooperative_groups;

#ifndef ONE_LAUNCH
#define ONE_LAUNCH 1
#endif
#ifndef PH_MASK
#define PH_MASK 0xFFFFFFFFu
#endif
#define PH_ON(k) ((PH_MASK >> (k)) & 1u)
#ifndef REP_MASK
#define REP_MASK 0u
#endif

#define LAS __attribute__((address_space(3)))
typedef unsigned short bf16_t;
typedef short bf16x8 __attribute__((ext_vector_type(8)));
typedef float f32x4 __attribute__((ext_vector_type(4)));
typedef float f32x2 __attribute__((ext_vector_type(2)));
typedef unsigned u32x4 __attribute__((ext_vector_type(4)));
typedef unsigned u32x2 __attribute__((ext_vector_type(2)));

constexpr int BATCH = 8, SEQ = 4096, DM = 1024, MTOK = BATCH * SEQ;
constexpr int NMEM = 256, RD = 512, MIXIN = 2304, RWKVIN = 1792, FF = 2816, NG1 = MIXIN + 3 * DM;
constexpr int NWAVES = 8, NTHREADS = 512;
constexpr float NORM_EPS = 1e-6f, GN_EPS = 64e-5f;

constexpr size_t MiB = 1u << 20;
constexpr size_t WS_WG1T = 1 * MiB;
constexpr size_t WS_WKVT = WS_WG1T + (size_t)NG1 * DM * 2;
constexpr size_t WS_WUPT = WS_WKVT + (size_t)512 * DM * 2;
constexpr size_t WS_WOT = WS_WUPT + (size_t)DM * DM * 2;
constexpr size_t WS_WF1T = WS_WOT + (size_t)DM * DM * 2;
constexpr size_t WS_WF2T = WS_WF1T + (size_t)2 * FF * DM * 2;
constexpr size_t WS_WLWT = WS_WF2T + (size_t)DM * FF * 2;
constexpr size_t WS_WLAT = WS_WLWT + (size_t)RD * 64 * 2;
constexpr size_t WS_WLGT = WS_WLAT + (size_t)RD * 64 * 2;
constexpr size_t WS_WPT = WS_WLGT + (size_t)RD * 128 * 2;
constexpr size_t WS_WEND = WS_WPT + (size_t)4 * 64 * 64 * 2;
static_assert(WS_WEND <= 34 * MiB, "weights region");
constexpr size_t WS_BONUS = 34 * MiB;
constexpr size_t WS_RSTD2 = 35 * MiB;
constexpr size_t WS_KB = 36 * MiB;
constexpr size_t WS_VT = 37 * MiB;
constexpr size_t WS_MEMN = 38 * MiB;
constexpr size_t WS_H = 42 * MiB;
constexpr size_t WS_YCAT = 106 * MiB;
constexpr size_t WS_P = 170 * MiB;
constexpr size_t WS_W = 170 * MiB;
constexpr size_t WS_G = 234 * MiB;
constexpr size_t WS_AA = 266 * MiB;
constexpr size_t WS_KRAW = 314 * MiB;
constexpr size_t WS_YRAW = 266 * MiB;
constexpr size_t WS_R = 346 * MiB;
constexpr size_t WS_V = 378 * MiB;
constexpr size_t WS_LW = 410 * MiB;
constexpr size_t WS_LA = 414 * MiB;
constexpr size_t WS_LG = 418 * MiB;
constexpr size_t WS_DPOOL = 426 * MiB;
constexpr size_t WS_GATES = 170 * MiB;
constexpr size_t WS_MERGED = 362 * MiB;
constexpr size_t WS_X1B = 426 * MiB;
constexpr size_t WS_TAILU = 42 * MiB, WS_HEADU = 45 * MiB, WS_HEADGV = 48 * MiB;
constexpr size_t WS_ACT = 218 * MiB;
constexpr size_t WS_END = 490 * MiB;
constexpr size_t DO_KK = 0, DO_BB = 32 * MiB, DO_KF = 64 * MiB;

constexpr int LDS_BYTES = 147456;
constexpr int LDS_HALO_OFF = 131072 + 1024;
constexpr int LDS_MISC_OFF = 131072 + 320;
constexpr size_t WS_BAR = 0, WS_CTL_BYTES = 65536;

__device__ __forceinline__ unsigned f2bf(float f) { unsigned u = __float_as_uint(f); return (u + 0x7fffu + ((u >> 16) & 1u)) >> 16; }
__device__ __forceinline__ float bf2f(unsigned h) { return __uint_as_float(h << 16); }
__device__ __forceinline__ unsigned pk2(float lo, float hi) { return f2bf(lo) | (f2bf(hi) << 16); }
__device__ __forceinline__ u32x2 pk4(f32x4 v) { u32x2 r; r.x = pk2(v[0], v[1]); r.y = pk2(v[2], v[3]); return r; }
__device__ __forceinline__ f32x4 unpk4(u32x2 u) { f32x4 r; r[0] = bf2f(u.x & 0xffffu); r[1] = bf2f(u.x >> 16); r[2] = bf2f(u.y & 0xffffu); r[3] = bf2f(u.y >> 16); return r; }
__device__ __forceinline__ float wave_sum(float v) {
#pragma unroll
    for (int o = 1; o < 64; o <<= 1) v += __shfl_xor(v, o);
    return v;
}
__device__ __forceinline__ float sigmoidf_(float x) { return 1.0f / (1.0f + __expf(-x)); }
template <int CTRL> __device__ __forceinline__ float dpp_f(float x) { return __builtin_bit_cast(float, __builtin_amdgcn_update_dpp(0, __builtin_bit_cast(int, x), CTRL, 0xF, 0xF, false)); }
__device__ __forceinline__ float row_sum16(float x) {
    x += dpp_f<0xB1>(x);
    x += dpp_f<0x4E>(x);
    x += dpp_f<0x141>(x);
    x += dpp_f<0x140>(x);
    return x;
}

#define XB_TMO      128
#define XB_XCNT(j)  (256  + 64 * (j))
#define XB_XSUB(j)  (1280 + 64 * (j))
#define XB_XGEN(j)  (2304 + 64 * (j))
#define XB_TOP      3328
#define XB_TOPGEN   3392
#define XCD_BAR_WORDS 3456
#define XB_SPIN_CAP (1u << 18)

__device__ __forceinline__ unsigned xb_ld(unsigned* p)              { return __hip_atomic_load(p, __ATOMIC_RELAXED, __HIP_MEMORY_SCOPE_AGENT); }
__device__ __forceinline__ unsigned xb_add(unsigned* p, unsigned v) { return __hip_atomic_fetch_add(p, v, __ATOMIC_RELAXED, __HIP_MEMORY_SCOPE_AGENT); }
__device__ __forceinline__ unsigned xb_xcc_id() { return (unsigned)__builtin_amdgcn_s_getreg((3 << 11) | 20) & 0xFu; }
#define XB_SPIN(cond, bar) do { unsigned _sp = 0; while (cond) { __builtin_amdgcn_s_sleep(1); \
    if ((++_sp & 255u) == 0u) { if (xb_ld(&(bar)[XB_TMO])) break; if (_sp > XB_SPIN_CAP) { atomicAdd(&(bar)[XB_TMO], 1u); break; } } } } while (0)

struct XcdBarrier {
    unsigned* bar; unsigned x;
    volatile LAS unsigned* st;
};

__device__ __forceinline__ XcdBarrier xcd_barrier_post(unsigned* bar, volatile LAS unsigned* st) {
    XcdBarrier b; b.bar = bar; b.x = xb_xcc_id(); b.st = st;
    if (threadIdx.x == 0) (void)xb_add(&bar[XB_XCNT(b.x)], 1u);
    return b;
}
__device__ __forceinline__ void xcd_barrier_complete(unsigned* bar, unsigned x, unsigned& nloc, unsigned& nx) {
    const unsigned G = gridDim.x * gridDim.y * gridDim.z;
    unsigned sum, cnt, mine, sp = 0u;
    for (;;) {
        sum = 0u; cnt = 0u; mine = 0u;
#pragma unroll
        for (unsigned j = 0; j < 16; ++j) { const unsigned c = xb_ld(&bar[XB_XCNT(j)]); sum += c; cnt += (c > 0u) ? 1u : 0u; mine = (j == x) ? c : mine; }
        if (sum == G) break;
        __builtin_amdgcn_s_sleep(1);
        if ((++sp & 255u) == 0u) { if (xb_ld(&bar[XB_TMO])) break; if (sp > XB_SPIN_CAP) { atomicAdd(&bar[XB_TMO], 1u); break; } }
    }
    nloc = mine > 0u ? mine : 1u; nx = cnt > 0u ? cnt : 1u;
}

__device__ __forceinline__ void xcd_barrier(const XcdBarrier& b) {
    asm volatile("s_waitcnt vmcnt(0)" ::: "memory");
    __syncthreads();
    if (threadIdx.x == 0) {
        unsigned* bar = b.bar;
        __builtin_amdgcn_s_waitcnt(0);
        unsigned nloc = b.st[0], nx = b.st[1];
        if (nloc == 0u) { xcd_barrier_complete(bar, b.x, nloc, nx); b.st[0] = nloc; b.st[1] = nx; }
        const unsigned old = xb_add(&bar[XB_XSUB(b.x)], 1u);
        const unsigned gen = old / nloc;
        if (old + 1u == (gen + 1u) * nloc) {
            __builtin_amdgcn_fence(__ATOMIC_RELEASE, "agent");
            asm volatile("s_waitcnt vmcnt(0)" ::: "memory");
            const unsigned og = xb_add(&bar[XB_TOP], 1u);
            const unsigned tg = og / nx;
            if (og + 1u == (tg + 1u) * nx) xb_add(&bar[XB_TOPGEN], 1u);
            else XB_SPIN(xb_ld(&bar[XB_TOPGEN]) == tg, bar);
            __builtin_amdgcn_fence(__ATOMIC_ACQUIRE, "agent");
            xb_add(&bar[XB_XGEN(b.x)], 1u);
            asm volatile("s_waitcnt vmcnt(0)" ::: "memory");
        } else {
            XB_SPIN(xb_ld(&bar[XB_XGEN(b.x)]) == gen, bar);
            __builtin_amdgcn_fence(__ATOMIC_ACQUIRE, "agent");
            asm volatile("s_waitcnt vmcnt(0)" ::: "memory");
        }
    }
    __syncthreads();
}


struct Params { const float* in[31]; float* out; unsigned char* ws; int ph_lo, ph_hi; };
enum { I_X = 0, I_MEM, I_NMIXG, I_WINMIX, I_MU, I_W0, I_WLORAB, I_A0, I_ALORAB, I_GLORAB, I_KK, I_KA, I_RK, I_LNW, I_LNB, I_POOLW, I_POOLS, I_NMEMG, I_WMEMKV,
       I_WUPR, I_WUPP, I_WUPM, I_WGATE, I_BGATE, I_WO, I_NFFNG, I_WFFNIN, I_CONVW, I_CONVB, I_WFFNOUT, I_NFING };

struct Ctx { int tid, lane, wave, fr, fq, gw, ngw; LAS unsigned char* lds; };

__device__ __forceinline__ int rowmap(int mode, int n) {
    if (mode == 0) return n;
    const int half = n >= FF ? 1 : 0, c = n - half * FF;
    return (c >> 7) * 256 + half * 128 + (c & 127);
}
__device__ __forceinline__ void transpose_item(const float* W, int K, int N, bf16_t* WT, int ldd, int koff, int mode, const float* kscale, LAS float* scr, int item, int lane) {
    const int nblk = N / 32, kb = item / nblk, nb = item % nblk, k0 = 64 * kb, n0 = 32 * nb;
#pragma unroll 8
    for (int i = 0; i < 32; ++i) { const int kk = 2 * i + (lane >> 5); float v = W[(size_t)(k0 + kk) * N + n0 + (lane & 31)]; if (kscale) v *= kscale[k0 + kk]; scr[kk * 33 + (lane & 31)] = v; }
    asm volatile("s_waitcnt lgkmcnt(0)" ::: "memory");
    const int c = lane & 7;
#pragma unroll
    for (int j = 0; j < 4; ++j) { const int n = (lane >> 3) + 8 * j; const LAS float* s = scr + (8 * c) * 33 + n;
        u32x4 o; o.x = pk2(s[0 * 33], s[1 * 33]); o.y = pk2(s[2 * 33], s[3 * 33]); o.z = pk2(s[4 * 33], s[5 * 33]); o.w = pk2(s[6 * 33], s[7 * 33]);
        *(u32x4*)(WT + (size_t)rowmap(mode, n0 + n) * ldd + koff + k0 + 8 * c) = o; }
    asm volatile("s_waitcnt lgkmcnt(0)" ::: "memory");
}
__device__ __forceinline__ void rmsnorm_row_bf16(const float* xrow, const float* g, bf16_t* orow, int lane) {
    const f32x4* xr = (const f32x4*)xrow + lane; const f32x4* gr = (const f32x4*)g + lane;
    f32x4 v[4]; float s = 0.f;
#pragma unroll
    for (int j = 0; j < 4; ++j) { v[j] = xr[64 * j]; s += (v[j][0] * v[j][0] + v[j][1] * v[j][1]) + (v[j][2] * v[j][2] + v[j][3] * v[j][3]); }
    const float rstd = rsqrtf(wave_sum(s) * (1.f / DM) + NORM_EPS);
    u32x2* o = (u32x2*)orow + lane;
#pragma unroll
    for (int j = 0; j < 4; ++j) { const f32x4 gg = gr[64 * j]; o[64 * j] = pk4(v[j] * rstd * gg); }
}

__device__ __forceinline__ void phase_prologue(const Params& p, const Ctx& c) {
    LAS float* scr = (LAS float*)(c.lds + c.wave * 16384);
    unsigned char* ws = p.ws;
#define TR(Wp, K_, N_, WTp, ldd_, koff_, mode_, sc_) { const int ni_ = ((K_) / 64) * ((N_) / 32); if (r < ni_) { transpose_item(Wp, K_, N_, (bf16_t*)(WTp), ldd_, koff_, mode_, sc_, scr, r, c.lane); continue; } r -= ni_; }
    constexpr int NIT = (DM / 64) * (MIXIN / 32) + (DM / 64) * (3 * DM / 32) + (DM / 64) * (512 / 32) + (512 / 64) * (DM / 32) + 2 * (256 / 64) * (DM / 32) + (DM / 64) * (DM / 32)
                      + (DM / 64) * (2 * FF / 32) + (FF / 64) * (DM / 32) + 2 * (RD / 32) + 2 * (RD / 32) + 4 * 2;
    for (int it = c.gw; it < NIT; it += c.ngw) {
        int r = it;
        TR(p.in[I_WINMIX], DM, MIXIN, ws + WS_WG1T, DM, 0, 0, nullptr)
        TR(p.in[I_WGATE], DM, 3 * DM, ws + WS_WG1T + (size_t)MIXIN * DM * 2, DM, 0, 0, nullptr)
        TR(p.in[I_WMEMKV], DM, 512, ws + WS_WKVT, DM, 0, 0, nullptr)
        TR(p.in[I_WUPR], 512, DM, ws + WS_WUPT, DM, 0, 0, nullptr)
        TR(p.in[I_WUPP], 256, DM, ws + WS_WUPT, DM, 512, 0, nullptr)
        TR(p.in[I_WUPM], 256, DM, ws + WS_WUPT, DM, 768, 0, nullptr)
        TR(p.in[I_WO], DM, DM, ws + WS_WOT, DM, 0, 0, nullptr)
        TR(p.in[I_WFFNIN], DM, 2 * FF, ws + WS_WF1T, DM, 0, 1, p.in[I_NFFNG])
        TR(p.in[I_WFFNOUT], FF, DM, ws + WS_WF2T, FF, 0, 0, nullptr)
        TR(p.in[I_WLORAB], 64, RD, ws + WS_WLWT, 64, 0, 0, nullptr)
        TR(p.in[I_ALORAB], 64, RD, ws + WS_WLAT, 64, 0, 0, nullptr)
        TR(p.in[I_GLORAB], 128, RD, ws + WS_WLGT, 128, 0, 0, nullptr)
        TR(p.in[I_POOLW] + 0 * 4096, 64, 64, ws + WS_WPT + 0 * 8192, 64, 0, 0, nullptr)
        TR(p.in[I_POOLW] + 1 * 4096, 64, 64, ws + WS_WPT + 1 * 8192, 64, 0, 0, nullptr)
        TR(p.in[I_POOLW] + 2 * 4096, 64, 64, ws + WS_WPT + 2 * 8192, 64, 0, 0, nullptr)
        TR(p.in[I_POOLW] + 3 * 4096, 64, 64, ws + WS_WPT + 3 * 8192, 64, 0, 0, nullptr)
    }
#undef TR
    for (int m = c.gw; m < MTOK; m += c.ngw) rmsnorm_row_bf16(p.in[I_X] + (size_t)m * DM, p.in[I_NMIXG], (bf16_t*)(ws + WS_H) + (size_t)m * DM, c.lane);
    for (int m = c.gw; m < BATCH * NMEM; m += c.ngw) rmsnorm_row_bf16(p.in[I_MEM] + (size_t)m * DM, p.in[I_NMEMG], (bf16_t*)(ws + WS_MEMN) + (size_t)m * DM, c.lane);
}

namespace pg8 {
#define PG8_LAS __attribute__((address_space(3)))
typedef unsigned short bf16_t;
typedef short bf16x8 __attribute__((ext_vector_type(8)));
typedef float f32x4 __attribute__((ext_vector_type(4)));
typedef unsigned u32x4 __attribute__((ext_vector_type(4)));
constexpr int BM = 256, BK = 64, HALF = 128, HTB = HALF * BK * 2  , STAGE_BYTES = 8 * HTB, NXCD = 8, WGM = 8;

__host__ __device__ __forceinline__ int lds_byte(int r, int c) { const int st = (r >> 4) * 2 + (c >> 5), rr = r & 15, cc = c & 31, ob = rr * 64 + cc * 2; return st * 1024 + (ob ^ (((ob >> 9) & 1) << 5)); }
__host__ __device__ __forceinline__ void stage_rc(int b, int& R, int& C) { const int st = b / 1024, sb = b % 1024, swz = sb ^ (((sb >> 9) & 1) << 5); R = (st >> 1) * 16 + swz / 64; C = (st & 1) * 32 + (swz % 64) / 2; }
__host__ __device__ __forceinline__ int perm32(int rho) { const int n = rho >> 4, i = rho & 15; return 8 * (i >> 2) + 4 * n + (i & 3); }

struct Unit { int pm, pn; };
struct Gemm { const bf16_t* A; const bf16_t* Bt; int M, N, K, lda, ldb; };

struct StaticOrder {
    int nM, nN, nwg, G, c;
    __host__ __device__ void init(int M, int N, int G_, int c_) { nM = M / BM; nN = N / BM; nwg = nM * nN; G = G_; c = c_; }
    __host__ __device__ bool next(int i, Unit& u) const {
        const long L = (long)i * G + c; if (L >= nwg) return false;
        int wgid = (int)L; { const int q = nwg / NXCD, r = nwg % NXCD, xcd = wgid % NXCD, off = wgid / NXCD; wgid = (xcd < r ? xcd * (q + 1) : r * (q + 1) + (xcd - r) * q) + off; }
        const int nig = WGM * nN, gid = wgid / nig, fm = gid * WGM, gsz = (nM - fm) < WGM ? (nM - fm) : WGM;
        u.pm = fm + ((wgid % nig) % gsz); u.pn = (wgid % nig) / gsz; return true;
    }
    __device__ __forceinline__ void a_ready(const Unit&) const {}
    __device__ __forceinline__ void done(const Unit&) const {}
};


template <class Epi, class Sched, bool ALIGN_EPI = false, bool SP2 = false>
__device__ __forceinline__ void gemm_phase(PG8_LAS unsigned char* lds, const Gemm g, const Sched& S, const Epi& E) {
    int tid_ = threadIdx.x; asm volatile("" : "+v"(tid_));
    const int tid = tid_, wid = __builtin_amdgcn_readfirstlane(tid >> 6), lane = tid & 63, wr = wid >> 2, wc = wid & 3, fr = lane & 15, fq = lane >> 4;
    const int K = g.K, nt = K / BK;
    unsigned voffA[2], voffB[2];
#pragma unroll
    for (int i = 0; i < 2; ++i) { int R, C; stage_rc(tid * 16 + i * 8192, R, C); const int Rb = Epi::PERM ? ((R & ~31) + perm32(R & 31)) : R;
        voffA[i] = (unsigned)(R * g.lda + C) * 2u; voffB[i] = (unsigned)(Rb * g.ldb + C) * 2u; }
    const size_t kstep = (size_t)(BK * 2);
    const size_t hstepA = (size_t)HALF * g.lda * 2, hstepB = (size_t)HALF * g.ldb * 2;
    const size_t tstepA = 2 * hstepA, tstepB = 2 * hstepB;
    const unsigned ldsw = (unsigned)wid * 1024u;
    const int aoff = lds_byte(wr * 64 + fr, fq * 8), boff = lds_byte(wc * 32 + fr, fq * 8);
#define PG8_SA(b, h) (((b) * 2 + (h)) * HTB)
#define PG8_SB(b, h) ((4 + (b) * 2 + (h)) * HTB)
#define PG8_STAGE(bufoff, gbase, voff) do { _Pragma("unroll") for (int _i = 0; _i < 2; ++_i) \
        __builtin_amdgcn_global_load_lds((const unsigned*)((const char*)(gbase) + (voff)[_i]), (PG8_LAS unsigned*)(lds + (bufoff) + ldsw + _i * 8192), 16, 0, 0); } while (0)
#define PG8_LDA(dst, b, h) do { _Pragma("unroll") for (int m = 0; m < 4; ++m) _Pragma("unroll") for (int k = 0; k < 2; ++k) dst[m][k] = *(const PG8_LAS bf16x8*)(lds + PG8_SA(b, h) + aoff + m * 2048 + k * 1024); } while (0)
#define PG8_LDB(dst, b, h) do { _Pragma("unroll") for (int n = 0; n < 2; ++n) _Pragma("unroll") for (int k = 0; k < 2; ++k) dst[n][k] = *(const PG8_LAS bf16x8*)(lds + PG8_SB(b, h) + boff + n * 2048 + k * 1024); } while (0)
#define PG8_MMA(ai, bj, At, Bt) do { __builtin_amdgcn_s_setprio(1); _Pragma("unroll") for (int m = 0; m < 4; ++m) _Pragma("unroll") for (int n = 0; n < 2; ++n) _Pragma("unroll") for (int k = 0; k < 2; ++k) \
        acc[ai][bj][m][n] = __builtin_amdgcn_mfma_f32_16x16x32_bf16(Bt[n][k], At[m][k], acc[ai][bj][m][n], 0, 0, 0); __builtin_amdgcn_s_setprio(0); } while (0)
#define PG8_WAIT_V(n) asm volatile("s_waitcnt vmcnt(" #n ")" ::: "memory")
#define PG8_WAIT_L(n) asm volatile("s_waitcnt lgkmcnt(" #n ")" ::: "memory")
#define PG8_BAR __builtin_amdgcn_s_barrier()
#define PG8_SCHED __builtin_amdgcn_sched_barrier(0)
    Unit cur, nxt; int ui = 0;
    if (!S.next(0, cur)) return;
    f32x4 acc[2][2][4][2];
#pragma unroll
    for (int a = 0; a < 2; ++a)
#pragma unroll
        for (int b = 0; b < 2; ++b)
#pragma unroll
            for (int m = 0; m < 4; ++m)
#pragma unroll
                for (int n = 0; n < 2; ++n) acc[a][b][m][n] = (f32x4){0.f, 0.f, 0.f, 0.f};
    bf16x8 At[4][2], B0[2][2], B1[2][2];
    const char* cA = (const char*)g.A + (size_t)cur.pm * tstepA; const char* cB = (const char*)g.Bt + (size_t)cur.pn * tstepB;
    S.a_ready(cur);
    if constexpr (SP2) {
        PG8_STAGE(PG8_SB(0, 0), cB, voffB); PG8_STAGE(PG8_SB(0, 1), cB + hstepB, voffB); PG8_STAGE(PG8_SA(0, 0), cA, voffA); PG8_STAGE(PG8_SA(0, 1), cA + hstepA, voffA);
        if (wr == 1) PG8_BAR;
        PG8_WAIT_V(2); PG8_BAR;
        PG8_STAGE(PG8_SB(1, 0), cB + kstep, voffB); PG8_STAGE(PG8_SA(1, 0), cA + kstep, voffA); PG8_STAGE(PG8_SB(1, 1), cB + hstepB + kstep, voffB);
        PG8_WAIT_V(6); PG8_BAR;
    } else {
        PG8_STAGE(PG8_SB(0, 0), cB, voffB); PG8_STAGE(PG8_SA(0, 0), cA, voffA); PG8_STAGE(PG8_SB(0, 1), cB + hstepB, voffB); PG8_STAGE(PG8_SA(0, 1), cA + hstepA, voffA);
        if (wr == 1) PG8_BAR;
        PG8_WAIT_V(4); PG8_BAR;
        PG8_STAGE(PG8_SB(1, 0), cB + kstep, voffB); PG8_STAGE(PG8_SA(1, 0), cA + kstep, voffA); PG8_STAGE(PG8_SB(1, 1), cB + hstepB + kstep, voffB);
        PG8_WAIT_V(6); PG8_BAR;
    }
    for (;;) {
        const bool has_next = S.next(ui + 1, nxt);
        const char* nA = has_next ? (const char*)g.A + (size_t)nxt.pm * tstepA : cA; const char* nB = has_next ? (const char*)g.Bt + (size_t)nxt.pn * tstepB : cB;
        for (int t = 0; t < nt; t += 2) {
            const bool last = (t == nt - 2);
            const char* a1 = cA + (size_t)(t + 1) * kstep;
            const char* a2 = last ? nA : cA + (size_t)(t + 2) * kstep; const char* b2 = last ? nB : cB + (size_t)(t + 2) * kstep;
            const char* a3 = a2 + kstep; const char* b3 = b2 + kstep;
            if (last && has_next) S.a_ready(nxt);
            if constexpr (SP2) {
            PG8_LDB(B0, 0, 0); PG8_LDB(B1, 0, 1); PG8_SCHED; PG8_LDA(At, 0, 0); PG8_STAGE(PG8_SA(1, 1), a1 + hstepA, voffA);
            PG8_WAIT_V(8); PG8_WAIT_L(0); PG8_BAR; PG8_MMA(0, 0, At, B0); PG8_MMA(0, 1, At, B1); PG8_BAR; PG8_SCHED;
            PG8_LDA(At, 0, 1); PG8_STAGE(PG8_SB(0, 0), b2, voffB); PG8_STAGE(PG8_SB(0, 1), b2 + hstepB, voffB); PG8_STAGE(PG8_SA(0, 0), a2, voffA);
            PG8_WAIT_V(8); PG8_WAIT_L(0); PG8_BAR; PG8_MMA(1, 0, At, B0); PG8_MMA(1, 1, At, B1); PG8_BAR; PG8_SCHED;
            PG8_LDB(B0, 1, 0); PG8_LDB(B1, 1, 1); PG8_SCHED; PG8_LDA(At, 1, 0); PG8_STAGE(PG8_SA(0, 1), a2 + hstepA, voffA);
            PG8_WAIT_V(8); PG8_WAIT_L(0); PG8_BAR; PG8_MMA(0, 0, At, B0); PG8_MMA(0, 1, At, B1); PG8_BAR; PG8_SCHED;
            PG8_LDA(At, 1, 1); PG8_STAGE(PG8_SB(1, 0), b3, voffB); PG8_STAGE(PG8_SB(1, 1), b3 + hstepB, voffB); PG8_STAGE(PG8_SA(1, 0), a3, voffA);
            PG8_WAIT_V(8); PG8_WAIT_L(0); PG8_BAR; PG8_MMA(1, 0, At, B0); PG8_MMA(1, 1, At, B1); PG8_BAR; PG8_SCHED;
            } else {
            PG8_LDB(B0, 0, 0); PG8_SCHED; PG8_LDA(At, 0, 0); PG8_STAGE(PG8_SA(1, 1), a1 + hstepA, voffA);
            PG8_WAIT_L(8); PG8_BAR; PG8_WAIT_L(0); PG8_MMA(0, 0, At, B0); PG8_BAR; PG8_SCHED;
            PG8_LDB(B1, 0, 1); PG8_STAGE(PG8_SB(0, 0), b2, voffB);
            PG8_BAR; PG8_WAIT_L(0); PG8_MMA(0, 1, At, B1); PG8_BAR;
            PG8_LDA(At, 0, 1); PG8_STAGE(PG8_SA(0, 0), a2, voffA);
            PG8_BAR; PG8_WAIT_L(0); PG8_MMA(1, 0, At, B0); PG8_BAR; PG8_SCHED;
            PG8_STAGE(PG8_SB(0, 1), b2 + hstepB, voffB);
            PG8_WAIT_V(6); PG8_BAR; PG8_MMA(1, 1, At, B1); PG8_BAR;
            PG8_LDB(B0, 1, 0); PG8_SCHED; PG8_LDA(At, 1, 0); PG8_STAGE(PG8_SA(0, 1), a2 + hstepA, voffA);
            PG8_WAIT_L(8); PG8_BAR; PG8_WAIT_L(0); PG8_MMA(0, 0, At, B0); PG8_BAR; PG8_SCHED;
            PG8_LDB(B1, 1, 1); PG8_STAGE(PG8_SB(1, 0), b3, voffB);
            PG8_BAR; PG8_WAIT_L(0); PG8_MMA(0, 1, At, B1); PG8_BAR;
            PG8_LDA(At, 1, 1); PG8_STAGE(PG8_SA(1, 0), a3, voffA);
            PG8_BAR; PG8_WAIT_L(0); PG8_MMA(1, 0, At, B0); PG8_BAR; PG8_SCHED;
            PG8_STAGE(PG8_SB(1, 1), b3 + hstepB, voffB);
            PG8_WAIT_V(6); PG8_BAR; PG8_MMA(1, 1, At, B1); PG8_BAR;
            }
        }
        if constexpr (ALIGN_EPI) { if (wr == 0) PG8_BAR; }
        if constexpr (!Epi::AFTER_DRAIN) { E(acc, cur, wr, wc, fr, fq); S.done(cur); }
        if (!has_next) break;
#pragma unroll
        for (int a = 0; a < 2; ++a)
#pragma unroll
            for (int b = 0; b < 2; ++b)
#pragma unroll
                for (int m = 0; m < 4; ++m)
#pragma unroll
                    for (int n = 0; n < 2; ++n) acc[a][b][m][n] = (f32x4){0.f, 0.f, 0.f, 0.f};
        cur = nxt; cA = nA; cB = nB; ++ui;
        if constexpr (ALIGN_EPI) { if (wr == 1) PG8_BAR; }
    }
    PG8_WAIT_V(0);
    if constexpr (!ALIGN_EPI) { if (wr == 0) PG8_BAR; }
    PG8_BAR;
    if constexpr (Epi::AFTER_DRAIN) { E.fused(acc, cur, wr, wc, fr, fq, lds, wid, lane); S.done(cur); }
#undef PG8_SA
#undef PG8_SB
#undef PG8_STAGE
#undef PG8_LDA
#undef PG8_LDB
#undef PG8_MMA
#undef PG8_WAIT_V
#undef PG8_WAIT_L
#undef PG8_BAR
#undef PG8_SCHED
}
}


template <class F> struct EpiFn4 { static constexpr bool PERM = false, AFTER_DRAIN = false; F f;
    __device__ __forceinline__ void operator()(const f32x4 (&acc)[2][2][4][2], const pg8::Unit& u, int wr, int wc, int fr, int fq) const {
        const int row0 = u.pm * 256 + wr * 64 + fr, col0 = u.pn * 256 + wc * 32 + 4 * fq;
#pragma unroll
        for (int ai = 0; ai < 2; ++ai)
#pragma unroll
            for (int m = 0; m < 4; ++m)
#pragma unroll
                for (int bj = 0; bj < 2; ++bj)
#pragma unroll
                    for (int n = 0; n < 2; ++n) f(row0 + ai * 128 + m * 16, col0 + bj * 128 + n * 16, acc[ai][bj][m][n]);
    } };
template <class F> struct EpiFn8 { static constexpr bool PERM = true, AFTER_DRAIN = false; F f;
    __device__ __forceinline__ void operator()(const f32x4 (&acc)[2][2][4][2], const pg8::Unit& u, int wr, int wc, int fr, int fq) const {
        const int row0 = u.pm * 256 + wr * 64 + fr, col0 = u.pn * 256 + wc * 32 + 8 * fq;
#pragma unroll
        for (int ai = 0; ai < 2; ++ai)
#pragma unroll
            for (int m = 0; m < 4; ++m)
#pragma unroll
                for (int bj = 0; bj < 2; ++bj) f(row0 + ai * 128 + m * 16, col0 + bj * 128, acc[ai][bj][m][0], acc[ai][bj][m][1]);
    } };
template <class F> __device__ __forceinline__ void gemm_pg8_4(const Ctx& c, const bf16_t* A, int lda, const bf16_t* Bt, int ldb, int M, int N, int K, const F& f) {
    pg8::Gemm g{A, Bt, M, N, K, lda, ldb}; pg8::StaticOrder S; S.init(M, N, (int)gridDim.x, (int)blockIdx.x); EpiFn4<F> E{f};
    pg8::gemm_phase<EpiFn4<F>, pg8::StaticOrder, true, true>(c.lds, g, S, E);
}
template <class F> __device__ __forceinline__ void gemm_pg8_8(const Ctx& c, const bf16_t* A, int lda, const bf16_t* Bt, int ldb, int M, int N, int K, const F& f) {
    pg8::Gemm g{A, Bt, M, N, K, lda, ldb}; pg8::StaticOrder S; S.init(M, N, (int)gridDim.x, (int)blockIdx.x); EpiFn8<F> E{f};
    pg8::gemm_phase<EpiFn8<F>, pg8::StaticOrder, true, true>(c.lds, g, S, E);
}
__device__ __forceinline__ u32x4 pk8(f32x4 lo, f32x4 hi) { u32x4 w; w.x = pk2(lo[0], lo[1]); w.y = pk2(lo[2], lo[3]); w.z = pk2(hi[0], hi[1]); w.w = pk2(hi[2], hi[3]); return w; }
struct F8Store { bf16_t* O; int ld; __device__ __forceinline__ void operator()(int row, int col, f32x4 lo, f32x4 hi) const { *(u32x4*)(O + (size_t)row * ld + col) = pk8(lo, hi); } };
struct F8SigBias { bf16_t* O; int ld; const float* bias;
    __device__ __forceinline__ void operator()(int row, int col, f32x4 lo, f32x4 hi) const {
        lo += *(const f32x4*)(bias + col); hi += *(const f32x4*)(bias + col + 4);
#pragma unroll
        for (int j = 0; j < 4; ++j) { lo[j] = sigmoidf_(lo[j]); hi[j] = sigmoidf_(hi[j]); }
        *(u32x4*)(O + (size_t)row * ld + col) = pk8(lo, hi); } };
template <int SEG> struct F4Up { float* MF; const bf16_t* GT; bf16_t* MG;
    __device__ __forceinline__ void operator()(int row, int col, f32x4 v) const {
        const f32x4 g = unpk4(*(const u32x2*)(GT + (size_t)row * (3 * DM) + SEG * DM + col)); const size_t off = (size_t)row * DM + col;
        if (SEG == 0) *(f32x4*)(MF + off) = g * v;
        else if (SEG == 1) *(f32x4*)(MF + off) = *(const f32x4*)(MF + off) + g * v;
        else *(u32x2*)(MG + off) = pk4(*(const f32x4*)(MF + off) + g * v); } };


__device__ __forceinline__ f32x2 gelu_pk(f32x2 v) {
    const f32x2 av = __builtin_elementwise_abs(v), d = av * 0.2316418882f + 1.0f;
    f32x2 t; t.x = __builtin_amdgcn_rcpf(d.x); t.y = __builtin_amdgcn_rcpf(d.y);
    f32x2 q = t * 0.5307027145f + (-0.7265760135f); q = q * t + 0.7107068705f; q = q * t + (-0.142248368f); q = q * t + 0.127414796f; q = q * t;
    const f32x2 s = (v * v) * (-0.72134752044f);
    f32x2 e; e.x = __builtin_amdgcn_exp2f(s.x); e.y = __builtin_amdgcn_exp2f(s.y);
    const f32x2 m = v * (q * e), r = v - m;
    f32x2 o; o.x = v.x < 0.f ? m.x : r.x; o.y = v.y < 0.f ? m.y : r.y; return o;
}
struct EpiFfnAct { static constexpr bool PERM = true, AFTER_DRAIN = false;
    bf16_t* ACT; const float* rstd; const float* cw; const float* cb; float* TAILU; float* HEADU; float* HEADGV; LAS float* halo;
    __device__ __forceinline__ void operator()(const f32x4 (&acc)[2][2][4][2], const pg8::Unit& u, int wr, int wc, int fr, int fq) const {
        const int ch0 = u.pn * 128 + wc * 32 + 8 * fq, rowt = wr * 64 + fr, grow0 = u.pm * 256 + rowt;
        f32x4 c0[2], c1[2], c2[2], cbv[2];
#pragma unroll
        for (int n = 0; n < 2; ++n) { c0[n] = *(const f32x4*)(cw + ch0 + 4 * n); c1[n] = *(const f32x4*)(cw + FF + ch0 + 4 * n); c2[n] = *(const f32x4*)(cw + 2 * FF + ch0 + 4 * n); cbv[n] = *(const f32x4*)(cb + ch0 + 4 * n); }
#pragma unroll
        for (int ai = 0; ai < 2; ++ai) { const float rs3 = rstd[grow0 + ai * 128 + 48];
            if (fr >= 14) {
#pragma unroll
                for (int n = 0; n < 2; ++n) *(LAS f32x4*)(halo + (((((ai * 2 + wr) * 2 + (fr - 14)) * 4 + wc) * 4 + fq) * 8 + 4 * n)) = acc[ai][0][3][n] * rs3; } }
        asm volatile("s_waitcnt lgkmcnt(0)" ::: "memory"); __builtin_amdgcn_s_barrier(); asm volatile("" ::: "memory");
#pragma unroll
        for (int ai = 0; ai < 2; ++ai) {
            f32x4 r1p[2], r2p[2];
            if (wr == 1 || ai == 1) { const int src = (wr == 1) ? (ai * 2) : ((ai - 1) * 2 + 1);
#pragma unroll
                for (int n = 0; n < 2; ++n) { const f32x4 hv0 = *(const LAS f32x4*)(halo + ((((src * 2 + 0) * 4 + wc) * 4 + fq) * 8 + 4 * n)), hv1 = *(const LAS f32x4*)(halo + ((((src * 2 + 1) * 4 + wc) * 4 + fq) * 8 + 4 * n));
                    r1p[n] = hv1; r2p[n] = (fr == 0) ? hv0 : hv1; } }
            else { r1p[0] = r1p[1] = r2p[0] = r2p[1] = (f32x4){0.f, 0.f, 0.f, 0.f}; }
#pragma unroll
            for (int m = 0; m < 4; ++m) {
                const int grow = grow0 + ai * 128 + 16 * m; const float rs = rstd[grow];
                u32x4 w;
#pragma unroll
                for (int n = 0; n < 2; ++n) {
                    const f32x4 uu = acc[ai][0][m][n] * rs, gg = acc[ai][1][m][n] * rs;
                    f32x4 R1, R2;
#pragma unroll
                    for (int j = 0; j < 4; ++j) { R1[j] = dpp_f<0x121>(uu[j]); R2[j] = dpp_f<0x122>(uu[j]); }
                    const f32x4 p1 = (fr >= 1) ? R1 : r1p[n], p2 = (fr >= 2) ? R2 : r2p[n];
                    r1p[n] = R1; r2p[n] = R2;
                    const f32x4 uc = c0[n] * p2 + c1[n] * p1 + c2[n] * uu + cbv[n];
                    const f32x2 ga = gelu_pk((f32x2){uc[0], uc[1]}), gb = gelu_pk((f32x2){uc[2], uc[3]});
                    const unsigned lo = pk2(ga.x * gg[0], ga.y * gg[1]), hi = pk2(gb.x * gg[2], gb.y * gg[3]);
                    if (n == 0) { w.x = lo; w.y = hi; } else { w.z = lo; w.w = hi; }
                    if (ai == 0 && m == 0) { if (wr == 0 && fr < 2) { const size_t so = (size_t)(u.pm * 2 + fr) * FF + ch0 + 4 * n; *(f32x4*)(HEADU + so) = uu; *(f32x4*)(HEADGV + so) = gg; } }
                    if (ai == 1 && m == 3) { if (wr == 1 && fr >= 14) { const size_t so = (size_t)(u.pm * 2 + (fr - 14)) * FF + ch0 + 4 * n; *(f32x4*)(TAILU + so) = uu; } }
                }
                *(u32x4*)(ACT + (size_t)grow * FF + ch0) = w;
            }
        }
    } };
__device__ __forceinline__ void phase_ffn_fix(const Params& p, const Ctx& c) {
    unsigned char* ws = p.ws;
    const float* TAILU = (const float*)(ws + WS_TAILU); const float* HEADU = (const float*)(ws + WS_HEADU); const float* HEADGV = (const float*)(ws + WS_HEADGV); bf16_t* ACT = (bf16_t*)(ws + WS_ACT);
    const float* cw = p.in[I_CONVW]; const float* cb = p.in[I_CONVB];
    const int nit = (MTOK / 256) * 2 * (FF / 4);
    for (int idx = blockIdx.x * NTHREADS + c.tid; idx < nit; idx += gridDim.x * NTHREADS) {
        const int col = 4 * (idx % (FF / 4)), pr = idx / (FF / 4), pm = pr >> 1, rr = pr & 1;
        if ((pm & 15) == 0) continue;
        const f32x4 u0 = *(const f32x4*)(HEADU + (size_t)(pm * 2 + rr) * FF + col), gg = *(const f32x4*)(HEADGV + (size_t)(pm * 2 + rr) * FF + col);
        const f32x4 t1 = *(const f32x4*)(TAILU + (size_t)((pm - 1) * 2 + 1) * FF + col), t0 = *(const f32x4*)(TAILU + (size_t)((pm - 1) * 2 + 0) * FF + col);
        f32x4 u1, u2; if (rr == 0) { u1 = t1; u2 = t0; } else { u1 = *(const f32x4*)(HEADU + (size_t)(pm * 2) * FF + col); u2 = t1; }
        const f32x4 uc = *(const f32x4*)(cw + col) * u2 + *(const f32x4*)(cw + FF + col) * u1 + *(const f32x4*)(cw + 2 * FF + col) * u0 + *(const f32x4*)(cb + col);
        const f32x2 ga = gelu_pk((f32x2){uc[0], uc[1]}), gb = gelu_pk((f32x2){uc[2], uc[3]});
        u32x2 w; w.x = pk2(ga.x * gg[0], ga.y * gg[1]); w.y = pk2(gb.x * gg[2], gb.y * gg[3]);
        *(u32x2*)(ACT + (size_t)(pm * 256 + rr) * FF + col) = w;
    }
}

__device__ __forceinline__ void wave_gemm_32x64(const bf16_t* A, int lda, const bf16_t* Bt, int ldb, int K, int m0, int n0, int fr, int fq, f32x4 (&acc)[2][4]) {
    const bf16_t* ap = A + (size_t)(m0 + fr) * lda + 8 * fq;
    const bf16_t* bp = Bt + (size_t)(n0 + fr) * ldb + 8 * fq;
    for (int k0 = 0; k0 < K; k0 += 32) {
        const bf16x8 a0 = *(const bf16x8*)(ap + k0), a1 = *(const bf16x8*)(ap + (size_t)16 * lda + k0);
        bf16x8 b[4];
#pragma unroll
        for (int j = 0; j < 4; ++j) b[j] = *(const bf16x8*)(bp + (size_t)(16 * j) * ldb + k0);
#pragma unroll
        for (int j = 0; j < 4; ++j) { acc[0][j] = __builtin_amdgcn_mfma_f32_16x16x32_bf16(b[j], a0, acc[0][j], 0, 0, 0); acc[1][j] = __builtin_amdgcn_mfma_f32_16x16x32_bf16(b[j], a1, acc[1][j], 0, 0, 0); }
    }
}
template <class Epi>
__device__ __forceinline__ void gemm_simple(const Ctx& c, const bf16_t* A, int lda, const bf16_t* Bt, int ldb, int M, int N, int K, const Epi& epi) {
    const int nMt = M / 256, nNt = N / 64, ntiles = nMt * nNt;
    for (int tile = blockIdx.x; tile < ntiles; tile += gridDim.x) {
        const int tm = tile % nMt, tn = tile / nMt, m0 = tm * 256 + c.wave * 32, n0 = tn * 64;
        f32x4 acc[2][4];
#pragma unroll
        for (int i = 0; i < 2; ++i)
#pragma unroll
            for (int j = 0; j < 4; ++j) acc[i][j] = (f32x4){0.f, 0.f, 0.f, 0.f};
        wave_gemm_32x64(A, lda, Bt, ldb, K, m0, n0, c.fr, c.fq, acc);
#pragma unroll
        for (int i = 0; i < 2; ++i)
#pragma unroll
            for (int j = 0; j < 4; ++j) epi(m0 + 16 * i + c.fr, n0 + 16 * j + 4 * c.fq, acc[i][j]);
    }
}

struct EpiBf16 { bf16_t* O; int ld; __device__ __forceinline__ void operator()(int row, int col, f32x4 v) const { *(u32x2*)(O + (size_t)row * ld + col) = pk4(v); } };
struct EpiKV { bf16_t* KB; bf16_t* VT;
    __device__ __forceinline__ void operator()(int row, int col, f32x4 v) const {
        if (col < 256) { *(u32x2*)(KB + (size_t)row * 256 + col) = pk4(v); }
        else { const int cc = col - 256, h = cc >> 6, d = cc & 63, b = row >> 8, key = row & 255;
#pragma unroll
            for (int j = 0; j < 4; ++j) VT[((size_t)((b * 4 + h) * 64 + d + j)) * 256 + key] = (bf16_t)f2bf(v[j]); }
    } };
struct EpiDecay { float* W; const float* w0;
    __device__ __forceinline__ void operator()(int row, int col, f32x4 v) const {
        const f32x4 z = v + *(const f32x4*)(w0 + col); f32x4 o;
#pragma unroll
        for (int j = 0; j < 4; ++j) o[j] = __expf(-0.60653065971f * sigmoidf_(z[j]));
        *(f32x4*)(W + (size_t)row * RD + col) = o; } };
struct EpiSigBias { bf16_t* O; int ld; const float* bias;
    __device__ __forceinline__ void operator()(int row, int col, f32x4 v) const {
        const f32x4 z = v + *(const f32x4*)(bias + col); f32x4 o;
#pragma unroll
        for (int j = 0; j < 4; ++j) o[j] = sigmoidf_(z[j]);
        *(u32x2*)(O + (size_t)row * ld + col) = pk4(o); } };
struct EpiPool { bf16_t* Y; const float* scale; int gi;
    __device__ __forceinline__ void operator()(int row, int col, f32x4 v) const {
        const f32x4 s = *(const f32x4*)(scale + 64 * gi + col); *(u32x2*)(Y + (size_t)row * DM + 512 + 64 * gi + col) = pk4(v * s); } };
struct EpiOut { const float* x; float* x1; bf16_t* x1b;
    __device__ __forceinline__ void operator()(int row, int col, f32x4 v) const {
        const size_t off = (size_t)row * DM + col; const f32x4 o = *(const f32x4*)(x + off) + v; *(f32x4*)(x1 + off) = o; *(u32x2*)(x1b + off) = pk4(o); } };
struct EpiAddOut { float* x;
    __device__ __forceinline__ void operator()(int row, int col, f32x4 v) const { const size_t off = (size_t)row * DM + col; *(f32x4*)(x + off) = *(const f32x4*)(x + off) + v; } };

__device__ __forceinline__ void phase_mix(const Params& p, const Ctx& c) {
    unsigned char* ws = p.ws;
    const bf16_t* P = (const bf16_t*)(ws + WS_P); const float* mu = p.in[I_MU];
    bf16_t* R = (bf16_t*)(ws + WS_R); bf16_t* KR = (bf16_t*)(ws + WS_KRAW); bf16_t* V = (bf16_t*)(ws + WS_V);
    bf16_t* LW = (bf16_t*)(ws + WS_LW); bf16_t* LA = (bf16_t*)(ws + WS_LA); bf16_t* LG = (bf16_t*)(ws + WS_LG);
    for (int row = c.gw; row < MTOK; row += c.ngw) {
        const int t = row & (SEQ - 1); const bf16_t* cur = P + (size_t)row * MIXIN;
#pragma unroll
        for (int i = 0; i < 7; ++i) {
            const int col = 4 * c.lane + 256 * i;
            const f32x4 cv = unpk4(*(const u32x2*)(cur + col));
            f32x4 pv = (f32x4){0.f, 0.f, 0.f, 0.f}; if (t > 0) pv = unpk4(*(const u32x2*)(cur - MIXIN + col));
            const f32x4 m4 = *(const f32x4*)(mu + col);
            f32x4 pm = cv + (pv - cv) * m4;
            if (i < 2) *(u32x2*)(R + (size_t)row * RD + col) = pk4(pm);
            else if (i < 4) *(u32x2*)(KR + (size_t)row * RD + (col - 512)) = pk4(pm);
            else if (i < 6) *(u32x2*)(V + (size_t)row * RD + (col - 1024)) = pk4(pm);
            else {
                const int cc = col - 1536;
                if (cc < 64) { f32x4 o; o[0] = tanhf(pm[0]); o[1] = tanhf(pm[1]); o[2] = tanhf(pm[2]); o[3] = tanhf(pm[3]); *(u32x2*)(LW + (size_t)row * 64 + cc) = pk4(o); }
                else if (cc < 128) { *(u32x2*)(LA + (size_t)row * 64 + (cc - 64)) = pk4(pm); }
                else { f32x4 o; o[0] = sigmoidf_(pm[0]); o[1] = sigmoidf_(pm[1]); o[2] = sigmoidf_(pm[2]); o[3] = sigmoidf_(pm[3]); *(u32x2*)(LG + (size_t)row * 128 + (cc - 128)) = pk4(o); }
            }
        }
    }
}
__device__ __forceinline__ void phase_pooldiff(const Params& p, const Ctx& c) {
    unsigned char* ws = p.ws;
    const bf16_t* P = (const bf16_t*)(ws + WS_P); bf16_t* DP = (bf16_t*)(ws + WS_DPOOL);
    const int col = 4 * c.lane, gi = c.lane >> 4, win = 2 << gi;
    for (int row = c.gw; row < MTOK; row += c.ngw) {
        const int t = row & (SEQ - 1); const bf16_t* cur = P + (size_t)row * MIXIN + RWKVIN + col;
        const f32x4 x0 = unpk4(*(const u32x2*)cur); f32x4 s = x0;
        for (int j = 1; j < 16; ++j) if (j < win && j <= t) s += unpk4(*(const u32x2*)(cur - (size_t)j * MIXIN));
        const int cnt = (t + 1) < win ? (t + 1) : win;
        *(u32x2*)(DP + (size_t)row * 256 + col) = pk4(s * (1.0f / (float)cnt) - x0);
    }
}
__device__ __forceinline__ void phase_memattn(const Params& p, const Ctx& c) {
    unsigned char* ws = p.ws;
    const bf16_t* P = (const bf16_t*)(ws + WS_P); const bf16_t* KB = (const bf16_t*)(ws + WS_KB); const bf16_t* VT = (const bf16_t*)(ws + WS_VT); bf16_t* Y = (bf16_t*)(ws + WS_YCAT);
    const int fr = c.fr, fq = c.fq;
    for (int unit = blockIdx.x; unit < BATCH * 4 * 16; unit += gridDim.x) {
        const int qt = unit & 15, h = (unit >> 4) & 3, b = unit >> 6;
#pragma unroll 1
        for (int qg = 0; qg < 2; ++qg) {
            const int row = b * SEQ + qt * 256 + c.wave * 32 + 16 * qg + fr;
            const bf16x8 q0 = *(const bf16x8*)(P + (size_t)row * MIXIN + 2048 + h * 64 + 8 * fq), q1 = *(const bf16x8*)(P + (size_t)row * MIXIN + 2048 + h * 64 + 32 + 8 * fq);
            f32x4 sc[16];
#pragma unroll
            for (int kg = 0; kg < 16; ++kg) {
                const bf16_t* kp = KB + (size_t)(b * 256 + 16 * kg + fr) * 256 + h * 64 + 8 * fq;
                const bf16x8 k0 = *(const bf16x8*)kp, k1 = *(const bf16x8*)(kp + 32);
                f32x4 a = (f32x4){0.f, 0.f, 0.f, 0.f};
                a = __builtin_amdgcn_mfma_f32_16x16x32_bf16(k0, q0, a, 0, 0, 0); a = __builtin_amdgcn_mfma_f32_16x16x32_bf16(k1, q1, a, 0, 0, 0); sc[kg] = a;
                if ((kg & 3) == 3) asm volatile("" ::: "memory");
            }
            float m = -1e30f;
#pragma unroll
            for (int kg = 0; kg < 16; ++kg) m = fmaxf(m, fmaxf(fmaxf(sc[kg][0], sc[kg][1]), fmaxf(sc[kg][2], sc[kg][3])));
            m = fmaxf(m, __shfl_xor(m, 16)); m = fmaxf(m, __shfl_xor(m, 32));
            float l = 0.f;
#pragma unroll
            for (int kg = 0; kg < 16; ++kg)
#pragma unroll
                for (int j = 0; j < 4; ++j) { const float e = __expf((sc[kg][j] - m) * 0.125f); sc[kg][j] = e; l += e; }
            l += __shfl_xor(l, 16); l += __shfl_xor(l, 32);
            const float linv = 1.0f / l;
            f32x4 o[4];
#pragma unroll
            for (int dg = 0; dg < 4; ++dg) o[dg] = (f32x4){0.f, 0.f, 0.f, 0.f};
#pragma unroll
            for (int s = 0; s < 8; ++s) {
                u32x4 w; w.x = pk2(sc[2 * s][0], sc[2 * s][1]); w.y = pk2(sc[2 * s][2], sc[2 * s][3]); w.z = pk2(sc[2 * s + 1][0], sc[2 * s + 1][1]); w.w = pk2(sc[2 * s + 1][2], sc[2 * s + 1][3]);
                const bf16x8 pf = __builtin_bit_cast(bf16x8, w);
#pragma unroll
                for (int dg = 0; dg < 4; ++dg) {
                    const bf16_t* vp = VT + ((size_t)((b * 4 + h) * 64 + 16 * dg + fr)) * 256 + 32 * s + 4 * fq;
                    u32x4 v; const u32x2 lo = *(const u32x2*)vp, hi = *(const u32x2*)(vp + 16); v.x = lo.x; v.y = lo.y; v.z = hi.x; v.w = hi.y;
                    o[dg] = __builtin_amdgcn_mfma_f32_16x16x32_bf16(__builtin_bit_cast(bf16x8, v), pf, o[dg], 0, 0, 0);
                }
                if (s & 1) asm volatile("" ::: "memory");
            }
#pragma unroll
            for (int dg = 0; dg < 4; ++dg) *(u32x2*)(Y + (size_t)row * DM + 768 + h * 64 + 16 * dg + 4 * fq) = pk4(o[dg] * linv);
        }
    }
}

__device__ __forceinline__ void phase_prep2(const Params& p, const Ctx& c) {
    unsigned char* ws = p.ws;
    const bf16_t* KR = (const bf16_t*)(ws + WS_KRAW); const bf16_t* AA = (const bf16_t*)(ws + WS_AA); const bf16_t* R = (const bf16_t*)(ws + WS_R);
    bf16_t* KK = (bf16_t*)((unsigned char*)p.out + DO_KK); bf16_t* BB = (bf16_t*)((unsigned char*)p.out + DO_BB); bf16_t* KF = (bf16_t*)((unsigned char*)p.out + DO_KF);
    float* BON = (float*)(ws + WS_BONUS);
    for (int it = c.gw; it < MTOK * 8; it += c.ngw) {
        const int row = it >> 3, h = it & 7, col = h * 64 + c.lane; const size_t off = (size_t)row * RD + col;
        const float k = bf2f(KR[off]), a = bf2f(AA[off]), r = bf2f(R[off]);
        const float kkv = k * p.in[I_KK][col];
        const float nrm = wave_sum(kkv * kkv);
        const float kap = kkv * rsqrtf(nrm + 1e-12f);
        const float kf = k * (1.0f + (a - 1.0f) * p.in[I_KA][col]);
        const float bon = wave_sum(r * kf * p.in[I_RK][col]);
        KK[off] = (bf16_t)f2bf(kap); BB[off] = (bf16_t)f2bf(kap * a); KF[off] = (bf16_t)f2bf(kf);
        if (c.lane == 0) BON[it] = bon;
    }
}

constexpr int TC = 32;
__device__ __forceinline__ void phase_scan(const Params& p, const Ctx& c) {
    unsigned char* ws = p.ws;
    const bf16_t* KK = (const bf16_t*)((unsigned char*)p.out + DO_KK); const bf16_t* BB = (const bf16_t*)((unsigned char*)p.out + DO_BB); const bf16_t* KF = (const bf16_t*)((unsigned char*)p.out + DO_KF);
    const bf16_t* R = (const bf16_t*)(ws + WS_R); const bf16_t* V = (const bf16_t*)(ws + WS_V); const float* W = (const float*)(ws + WS_W);
    float* YR = (float*)(ws + WS_YRAW);
    constexpr int OPF = 5 * TC * 64, BUFF = OPF + TC * 16;
    LAS float* L = (LAS float*)c.lds; LAS float* YB = L + 2 * BUFF;
    const int tid = c.tid, lt = tid & 255;
    const bool loader = tid >= 256;
    for (int unit = blockIdx.x; unit < BATCH * 8 * 4; unit += gridDim.x) {
        const int q = unit & 3, h = (unit >> 2) & 7, b = unit >> 5;
        const size_t rowbase = (size_t)b * SEQ;
        auto stage = [&](int ch, int buf) {
            LAS float* B = L + buf * BUFF;
#pragma unroll
            for (int hh = 0; hh < 2; ++hh) {
                const int ss = (lt >> 4) + 16 * hh, g4 = (lt & 15) * 4;
                const size_t ro = (rowbase + (size_t)ch * TC + ss) * RD + h * 64 + g4;
                const u32x2 r0 = *(const u32x2*)(KK + ro), r1 = *(const u32x2*)(KF + ro), r2 = *(const u32x2*)(BB + ro), r3 = *(const u32x2*)(R + ro);
                const f32x4 rw = *(const f32x4*)(W + ro);
                const unsigned short rv = V[(rowbase + (size_t)ch * TC + ss) * RD + h * 64 + 16 * q + (lt & 15)];
                *(LAS f32x4*)(B + (0 * TC + ss) * 64 + g4) = unpk4(r0);
                *(LAS f32x4*)(B + (1 * TC + ss) * 64 + g4) = rw;
                *(LAS f32x4*)(B + (2 * TC + ss) * 64 + g4) = unpk4(r1);
                *(LAS f32x4*)(B + (3 * TC + ss) * 64 + g4) = unpk4(r2);
                *(LAS f32x4*)(B + (4 * TC + ss) * 64 + g4) = unpk4(r3);
                B[OPF + ss * 16 + (lt & 15)] = bf2f(rv);
            }
        };
        auto flush = [&](int ch) {
#pragma unroll
            for (int hh = 0; hh < 2; ++hh) { const int ss = (lt >> 4) + 16 * hh, i = lt & 15;
                YR[(rowbase + (size_t)ch * TC + ss) * RD + h * 64 + 16 * q + i] = YB[(ch & 1) * TC * 16 + ss * 16 + i]; }
        };
        __syncthreads();
        if (loader) stage(0, 0);
        f32x4 S = (f32x4){0.f, 0.f, 0.f, 0.f};
        const int vrow = (tid >> 4) & 15, kq = tid & 15;
        for (int ch = 0; ch < SEQ / TC; ++ch) {
            __syncthreads();
            if (loader) {
                if (ch > 0) flush(ch - 1);
                if (ch + 1 < SEQ / TC) stage(ch + 1, (ch + 1) & 1);
            } else {
                const LAS float* B = L + (ch & 1) * BUFF; LAS float* YO = YB + (ch & 1) * TC * 16;
                f32x4 kap = *(const LAS f32x4*)(B + (0 * TC) * 64 + 4 * kq), w4 = *(const LAS f32x4*)(B + (1 * TC) * 64 + 4 * kq), kf4 = *(const LAS f32x4*)(B + (2 * TC) * 64 + 4 * kq);
                f32x4 b4 = *(const LAS f32x4*)(B + (3 * TC) * 64 + 4 * kq), r4 = *(const LAS f32x4*)(B + (4 * TC) * 64 + 4 * kq); float vv = B[OPF + vrow];
#pragma unroll
                for (int s0 = 0; s0 < TC; s0 += 16) {
                    float ykeep = 0.f;
#pragma unroll
                    for (int s1 = 0; s1 < 16; ++s1) { const int s = s0 + s1, sn = (s + 1 < TC) ? s + 1 : s;
                        const f32x4 nkap = *(const LAS f32x4*)(B + (0 * TC + sn) * 64 + 4 * kq), nw4 = *(const LAS f32x4*)(B + (1 * TC + sn) * 64 + 4 * kq), nkf4 = *(const LAS f32x4*)(B + (2 * TC + sn) * 64 + 4 * kq);
                        const f32x4 nb4 = *(const LAS f32x4*)(B + (3 * TC + sn) * 64 + 4 * kq), nr4 = *(const LAS f32x4*)(B + (4 * TC + sn) * 64 + 4 * kq); const float nvv = B[OPF + sn * 16 + vrow];
                        __builtin_amdgcn_sched_barrier(0);
                        const float sk = row_sum16((S[0] * kap[0] + S[1] * kap[1]) + (S[2] * kap[2] + S[3] * kap[3]));
                        S = (S * w4 + kf4 * vv) - b4 * sk;
                        const float y = row_sum16((S[0] * r4[0] + S[1] * r4[1]) + (S[2] * r4[2] + S[3] * r4[3]));
                        ykeep = (kq == s1) ? y : ykeep;
                        kap = nkap; w4 = nw4; kf4 = nkf4; b4 = nb4; r4 = nr4; vv = nvv;
                    }
                    YO[(s0 + kq) * 16 + vrow] = ykeep;
                }
            }
        }
        __syncthreads();
        if (loader) flush(SEQ / TC - 1);
    }
}

__device__ __forceinline__ void phase_post(const Params& p, const Ctx& c) {
    unsigned char* ws = p.ws;
    const float* YR = (const float*)(ws + WS_YRAW); const float* BON = (const float*)(ws + WS_BONUS);
    const bf16_t* V = (const bf16_t*)(ws + WS_V); const bf16_t* G = (const bf16_t*)(ws + WS_G); bf16_t* Y = (bf16_t*)(ws + WS_YCAT);
    for (int it = c.gw; it < MTOK * 8; it += c.ngw) {
        const int row = it >> 3, h = it & 7, col = h * 64 + c.lane; const size_t off = (size_t)row * RD + col;
        const float y = YR[off];
        const float mean = wave_sum(y) * (1.0f / 64.0f); const float d = y - mean;
        const float var = wave_sum(d * d) * (1.0f / 64.0f);
        const float yn = d * rsqrtf(var + GN_EPS) * p.in[I_LNW][col] + p.in[I_LNB][col];
        const float bon = BON[it];
        const float o = (yn + bon * bf2f(V[off])) * bf2f(G[off]);
        Y[(size_t)row * DM + col] = (bf16_t)f2bf(o);
    }
}

__device__ __forceinline__ void phase_up_simple(const Params& p, const Ctx& c) {
    unsigned char* ws = p.ws;
    const bf16_t* Y = (const bf16_t*)(ws + WS_YCAT); const bf16_t* WU = (const bf16_t*)(ws + WS_WUPT); const bf16_t* GT = (const bf16_t*)(ws + WS_GATES); bf16_t* MG = (bf16_t*)(ws + WS_MERGED);
    const int nMt = MTOK / 256, nNt = DM / 64, ntiles = nMt * nNt;
    for (int tile = blockIdx.x; tile < ntiles; tile += gridDim.x) {
        const int tm = tile % nMt, tn = tile / nMt, m0 = tm * 256 + c.wave * 32, n0 = tn * 64;
        f32x4 tot[2][4];
#pragma unroll
        for (int i = 0; i < 2; ++i)
#pragma unroll
            for (int j = 0; j < 4; ++j) tot[i][j] = (f32x4){0.f, 0.f, 0.f, 0.f};
#pragma unroll
        for (int seg = 0; seg < 3; ++seg) {
            const int koff = seg == 0 ? 0 : (seg == 1 ? 512 : 768), K = seg == 0 ? 512 : 256;
            f32x4 acc[2][4];
#pragma unroll
            for (int i = 0; i < 2; ++i)
#pragma unroll
                for (int j = 0; j < 4; ++j) acc[i][j] = (f32x4){0.f, 0.f, 0.f, 0.f};
            wave_gemm_32x64(Y + koff, DM, WU + koff, DM, K, m0, n0, c.fr, c.fq, acc);
#pragma unroll
            for (int i = 0; i < 2; ++i)
#pragma unroll
                for (int j = 0; j < 4; ++j) { const f32x4 g = unpk4(*(const u32x2*)(GT + (size_t)(m0 + 16 * i + c.fr) * (3 * DM) + seg * DM + n0 + 16 * j + 4 * c.fq)); tot[i][j] += g * acc[i][j]; }
        }
#pragma unroll
        for (int i = 0; i < 2; ++i)
#pragma unroll
            for (int j = 0; j < 4; ++j) *(u32x2*)(MG + (size_t)(m0 + 16 * i + c.fr) * DM + n0 + 16 * j + 4 * c.fq) = pk4(tot[i][j]);
    }
}

__device__ __forceinline__ void phase_rowstat(const Params& p, const Ctx& c) {
    float* RS = (float*)(p.ws + WS_RSTD2);
    for (int m = c.gw; m < MTOK; m += c.ngw) {
        const f32x4* xr = (const f32x4*)(p.out + (size_t)m * DM) + c.lane; float s = 0.f;
#pragma unroll
        for (int j = 0; j < 4; ++j) { const f32x4 v = xr[64 * j]; s += (v[0] * v[0] + v[1] * v[1]) + (v[2] * v[2] + v[3] * v[3]); }
        s = wave_sum(s);
        if (c.lane == 0) RS[m] = rsqrtf(s * (1.f / DM) + NORM_EPS);
    }
}
__device__ __forceinline__ void phase_final_norm(const Params& p, const Ctx& c) {
    const float* g = p.in[I_NFING];
    for (int m = c.gw; m < MTOK; m += c.ngw) {
        f32x4* xr = (f32x4*)(p.out + (size_t)m * DM) + c.lane; const f32x4* gr = (const f32x4*)g + c.lane;
        f32x4 v[4]; float s = 0.f;
#pragma unroll
        for (int j = 0; j < 4; ++j) { v[j] = xr[64 * j]; s += (v[j][0] * v[j][0] + v[j][1] * v[j][1]) + (v[j][2] * v[j][2] + v[j][3] * v[j][3]); }
        const float rstd = rsqrtf(wave_sum(s) * (1.f / DM) + NORM_EPS);
#pragma unroll
        for (int j = 0; j < 4; ++j) xr[64 * j] = v[j] * rstd * gr[64 * j];
    }
}

constexpr int NPHASES = 15;
__global__ void __launch_bounds__(NTHREADS, 2) fwd_kernel(Params p) {
    extern __shared__ __attribute__((aligned(16))) unsigned char lds_raw[];
    Ctx c; c.tid = threadIdx.x; c.lane = c.tid & 63; c.wave = __builtin_amdgcn_readfirstlane(c.tid >> 6); c.fr = c.lane & 15; c.fq = c.lane >> 4;
    c.gw = blockIdx.x * NWAVES + c.wave; c.ngw = gridDim.x * NWAVES; c.lds = (LAS unsigned char*)lds_raw;
    unsigned char* ws = p.ws;
#if ONE_LAUNCH
    cg::grid_group grid = cg::this_grid();
    volatile LAS unsigned* misc = (volatile LAS unsigned*)(c.lds + LDS_MISC_OFF);
    if (c.tid < 4) misc[c.tid] = 0u;
    __syncthreads();
    const XcdBarrier xbar = xcd_barrier_post((unsigned*)(ws + WS_BAR), misc);
    bool first_seam = true;
#define SEAM() do { if (first_seam) { grid.sync(); first_seam = false; } else xcd_barrier(xbar); } while (0)
#else
#define SEAM() do {} while (0)
#endif
#define IN(k) (p.ph_lo <= (k) && (k) < p.ph_hi)
#define END(k) do { if (IN((k) + 1)) SEAM(); } while (0)
#define REP_ON(k) ((REP_MASK >> (k)) & 1u)
#define PHASE(k, ...) if (IN(k)) { __VA_ARGS__ if (REP_ON(k)) { SEAM(); __VA_ARGS__ } END(k); }
    PHASE(0, phase_prologue(p, c);)
    PHASE(1,
        gemm_pg8_8(c, (const bf16_t*)(ws + WS_H), DM, (const bf16_t*)(ws + WS_WG1T), DM, MTOK, MIXIN, DM, F8Store{(bf16_t*)(ws + WS_P), MIXIN});
        gemm_simple(c, (const bf16_t*)(ws + WS_MEMN), DM, (const bf16_t*)(ws + WS_WKVT), DM, BATCH * NMEM, 512, DM, EpiKV{(bf16_t*)(ws + WS_KB), (bf16_t*)(ws + WS_VT)});)
    PHASE(2, phase_mix(p, c); phase_pooldiff(p, c); phase_memattn(p, c);)
    PHASE(3,
        gemm_simple(c, (const bf16_t*)(ws + WS_LW), 64, (const bf16_t*)(ws + WS_WLWT), 64, MTOK, RD, 64, EpiDecay{(float*)(ws + WS_W), p.in[I_W0]});
        gemm_simple(c, (const bf16_t*)(ws + WS_LA), 64, (const bf16_t*)(ws + WS_WLAT), 64, MTOK, RD, 64, EpiSigBias{(bf16_t*)(ws + WS_AA), RD, p.in[I_A0]});
        gemm_simple(c, (const bf16_t*)(ws + WS_LG), 128, (const bf16_t*)(ws + WS_WLGT), 128, MTOK, RD, 128, EpiBf16{(bf16_t*)(ws + WS_G), RD});
        _Pragma("unroll 1") for (int gi = 0; gi < 4; ++gi)
            gemm_simple(c, (const bf16_t*)(ws + WS_DPOOL) + 64 * gi, 256, (const bf16_t*)(ws + WS_WPT) + 4096 * gi, 64, MTOK, 64, 64, EpiPool{(bf16_t*)(ws + WS_YCAT), p.in[I_POOLS], gi});)
    PHASE(4, phase_prep2(p, c);)
    PHASE(5, phase_scan(p, c);)
    PHASE(6, phase_post(p, c);)
    PHASE(7,
        gemm_pg8_8(c, (const bf16_t*)(ws + WS_H), DM, (const bf16_t*)(ws + WS_WG1T) + (size_t)MIXIN * DM, DM, MTOK, 3 * DM, DM, F8SigBias{(bf16_t*)(ws + WS_GATES), 3 * DM, p.in[I_BGATE]});)
    PHASE(8,
        gemm_pg8_4(c, (const bf16_t*)(ws + WS_YCAT), DM, (const bf16_t*)(ws + WS_WUPT), DM, MTOK, DM, 512, F4Up<0>{p.out, (const bf16_t*)(ws + WS_GATES), (bf16_t*)(ws + WS_MERGED)});
        gemm_pg8_4(c, (const bf16_t*)(ws + WS_YCAT) + 512, DM, (const bf16_t*)(ws + WS_WUPT) + 512, DM, MTOK, DM, 256, F4Up<1>{p.out, (const bf16_t*)(ws + WS_GATES), (bf16_t*)(ws + WS_MERGED)});
        gemm_pg8_4(c, (const bf16_t*)(ws + WS_YCAT) + 768, DM, (const bf16_t*)(ws + WS_WUPT) + 768, DM, MTOK, DM, 256, F4Up<2>{p.out, (const bf16_t*)(ws + WS_GATES), (bf16_t*)(ws + WS_MERGED)});)
    PHASE(9,
        gemm_pg8_4(c, (const bf16_t*)(ws + WS_MERGED), DM, (const bf16_t*)(ws + WS_WOT), DM, MTOK, DM, DM, EpiOut{p.in[I_X], p.out, (bf16_t*)(ws + WS_X1B)});)
    PHASE(10, phase_rowstat(p, c);)
    PHASE(11, {
        pg8::Gemm g{(const bf16_t*)(ws + WS_X1B), (const bf16_t*)(ws + WS_WF1T), MTOK, 2 * FF, DM, DM, DM}; pg8::StaticOrder S; S.init(MTOK, 2 * FF, (int)gridDim.x, (int)blockIdx.x);
        EpiFfnAct E{(bf16_t*)(ws + WS_ACT), (const float*)(ws + WS_RSTD2), p.in[I_CONVW], p.in[I_CONVB], (float*)(ws + WS_TAILU), (float*)(ws + WS_HEADU), (float*)(ws + WS_HEADGV), (LAS float*)(c.lds + LDS_HALO_OFF)};
        pg8::gemm_phase<EpiFfnAct, pg8::StaticOrder, true, true>(c.lds, g, S, E); })
    PHASE(12, phase_ffn_fix(p, c);)
    PHASE(13,
        gemm_pg8_4(c, (const bf16_t*)(ws + WS_ACT), FF, (const bf16_t*)(ws + WS_WF2T), FF, MTOK, DM, FF, EpiAddOut{p.out});)
    if (IN(14)) { phase_final_norm(p, c); }
#undef IN
#undef END
}

__global__ void nan_fill(float* o, int n) { const int i = blockIdx.x * blockDim.x + threadIdx.x; if (i < n) o[i] = __builtin_nanf(""); }

extern "C" void kernel_launch(void* const* d_in, const int* in_sizes, int n_in, void* d_out, int out_size, void* d_ws, size_t ws_size, hipStream_t stream) {
    static int grid = 0;
    if (grid == 0) {
        int dev = 0, cus = 0, per_cu = 0;
        if (hipGetDevice(&dev) != hipSuccess || hipDeviceGetAttribute(&cus, hipDeviceAttributeMultiprocessorCount, dev) != hipSuccess) cus = 256;
        (void)hipFuncSetAttribute((const void*)fwd_kernel, hipFuncAttributeMaxDynamicSharedMemorySize, LDS_BYTES);
        if (hipOccupancyMaxActiveBlocksPerMultiprocessor(&per_cu, (const void*)fwd_kernel, NTHREADS, LDS_BYTES) != hipSuccess || per_cu < 1) per_cu = 1;
        (void)hipGetLastError();
        grid = cus;
        if (n_in != 31 || out_size != MTOK * DM || ws_size < WS_END) grid = -1;
    }
    if (grid < 0) { nan_fill<<<(out_size + 255) / 256, 256, 0, stream>>>((float*)d_out, out_size); return; }
    Params p{};
    for (int i = 0; i < 31; ++i) p.in[i] = (const float*)d_in[i];
    p.out = (float*)d_out; p.ws = (unsigned char*)d_ws;
#if ONE_LAUNCH
    (void)hipMemsetAsync((unsigned char*)d_ws + WS_BAR, 0, WS_CTL_BYTES, stream);
    p.ph_lo = 0; p.ph_hi = NPHASES;
    void* args[] = {&p};
    hipError_t e = hipLaunchCooperativeKernel((const void*)fwd_kernel, dim3(grid), dim3(NTHREADS), args, LDS_BYTES, stream);
    if (e != hipSuccess) fprintf(stderr, "cooperative launch failed: %s (grid %d)\n", hipGetErrorString(e), grid);
#else
    for (int ph = 0; ph < NPHASES; ++ph) { p.ph_lo = ph; p.ph_hi = ph + 1; hipLaunchKernelGGL(fwd_kernel, dim3(grid), dim3(NTHREADS), LDS_BYTES, stream, p); }
#endif
}
```

```cpp
#include <hip/hip_runtime.h>
#include <hip/hip_cooperative_groups.h>
#include <cstdio>
#include <cstdint>
namespace cg = cooperative_groups;

#ifndef ONE_LAUNCH
#define ONE_LAUNCH 1
#endif
#ifndef PH_MASK
#define PH_MASK 0xFFFFFFFFu
#endif
#define PH_ON(k) ((PH_MASK >> (k)) & 1u)
#ifndef REP_MASK
#define REP_MASK 0u
#endif

#define LAS __attribute__((address_space(3)))
typedef unsigned short bf16_t;
typedef short bf16x8 __attribute__((ext_vector_type(8)));
typedef float f32x4 __attribute__((ext_vector_type(4)));
typedef float f32x2 __attribute__((ext_vector_type(2)));
typedef unsigned u32x4 __attribute__((ext_vector_type(4)));
typedef unsigned u32x2 __attribute__((ext_vector_type(2)));

constexpr int BATCH = 8, SEQ = 4096, DM = 1024, MTOK = BATCH * SEQ;
constexpr int NMEM = 256, RD = 512, MIXIN = 2304, RWKVIN = 1792, FF = 2816, NG1 = MIXIN + 3 * DM;
constexpr int NWAVES = 8, NTHREADS = 512;
constexpr float NORM_EPS = 1e-6f, GN_EPS = 64e-5f;

constexpr size_t MiB = 1u << 20;
constexpr size_t WS_WG1T = 1 * MiB;
constexpr size_t WS_WKVT = WS_WG1T + (size_t)NG1 * DM * 2;
constexpr size_t WS_WUPT = WS_WKVT + (size_t)512 * DM * 2;
constexpr size_t WS_WOT = WS_WUPT + (size_t)DM * DM * 2;
constexpr size_t WS_WF1T = WS_WOT + (size_t)DM * DM * 2;
constexpr size_t WS_WF2T = WS_WF1T + (size_t)2 * FF * DM * 2;
constexpr size_t WS_WLWT = WS_WF2T + (size_t)DM * FF * 2;
constexpr size_t WS_WLAT = WS_WLWT + (size_t)RD * 64 * 2;
constexpr size_t WS_WLGT = WS_WLAT + (size_t)RD * 64 * 2;
constexpr size_t WS_WPT = WS_WLGT + (size_t)RD * 128 * 2;
constexpr size_t WS_WEND = WS_WPT + (size_t)4 * 64 * 64 * 2;
static_assert(WS_WEND <= 34 * MiB, "weights region");
constexpr size_t WS_BONUS = 34 * MiB;
constexpr size_t WS_RSTD2 = 35 * MiB;
constexpr size_t WS_KB = 36 * MiB;
constexpr size_t WS_VT = 37 * MiB;
constexpr size_t WS_MEMN = 38 * MiB;
constexpr size_t WS_H = 42 * MiB;
constexpr size_t WS_YCAT = 106 * MiB;
constexpr size_t WS_P = 170 * MiB;
constexpr size_t WS_W = 170 * MiB;
constexpr size_t WS_G = 234 * MiB;
constexpr size_t WS_AA = 266 * MiB;
constexpr size_t WS_KRAW = 314 * MiB;
constexpr size_t WS_YRAW = 266 * MiB;
constexpr size_t WS_R = 346 * MiB;
constexpr size_t WS_V = 378 * MiB;
constexpr size_t WS_LW = 410 * MiB;
constexpr size_t WS_LA = 414 * MiB;
constexpr size_t WS_LG = 418 * MiB;
constexpr size_t WS_DPOOL = 426 * MiB;
constexpr size_t WS_GATES = 170 * MiB;
constexpr size_t WS_MERGED = 362 * MiB;
constexpr size_t WS_X1B = 426 * MiB;
constexpr size_t WS_TAILU = 42 * MiB, WS_HEADU = 45 * MiB, WS_HEADGV = 48 * MiB;
constexpr size_t WS_ACT = 218 * MiB;
constexpr size_t WS_END = 490 * MiB;
constexpr size_t DO_KK = 0, DO_BB = 32 * MiB, DO_KF = 64 * MiB;

constexpr int LDS_BYTES = 147456;
constexpr int LDS_HALO_OFF = 131072 + 1024;
constexpr int LDS_MISC_OFF = 131072 + 320;
constexpr size_t WS_BAR = 0, WS_CTL_BYTES = 65536;

__device__ __forceinline__ unsigned f2bf(float f) { unsigned u = __float_as_uint(f); return (u + 0x7fffu + ((u >> 16) & 1u)) >> 16; }
__device__ __forceinline__ float bf2f(unsigned h) { return __uint_as_float(h << 16); }
__device__ __forceinline__ unsigned pk2(float lo, float hi) { return f2bf(lo) | (f2bf(hi) << 16); }
__device__ __forceinline__ u32x2 pk4(f32x4 v) { u32x2 r; r.x = pk2(v[0], v[1]); r.y = pk2(v[2], v[3]); return r; }
__device__ __forceinline__ f32x4 unpk4(u32x2 u) { f32x4 r; r[0] = bf2f(u.x & 0xffffu); r[1] = bf2f(u.x >> 16); r[2] = bf2f(u.y & 0xffffu); r[3] = bf2f(u.y >> 16); return r; }
__device__ __forceinline__ float wave_sum(float v) {
#pragma unroll
    for (int o = 1; o < 64; o <<= 1) v += __shfl_xor(v, o);
    return v;
}
__device__ __forceinline__ float sigmoidf_(float x) { return 1.0f / (1.0f + __expf(-x)); }
template <int CTRL> __device__ __forceinline__ float dpp_f(float x) { return __builtin_bit_cast(float, __builtin_amdgcn_update_dpp(0, __builtin_bit_cast(int, x), CTRL, 0xF, 0xF, false)); }
__device__ __forceinline__ float row_sum16(float x) {
    x += dpp_f<0xB1>(x);
    x += dpp_f<0x4E>(x);
    x += dpp_f<0x141>(x);
    x += dpp_f<0x140>(x);
    return x;
}

#define XB_TMO      128
#define XB_XCNT(j)  (256  + 64 * (j))
#define XB_XSUB(j)  (1280 + 64 * (j))
#define XB_XGEN(j)  (2304 + 64 * (j))
#define XB_TOP      3328
#define XB_TOPGEN   3392
#define XCD_BAR_WORDS 3456
#define XB_SPIN_CAP (1u << 18)

__device__ __forceinline__ unsigned xb_ld(unsigned* p)              { return __hip_atomic_load(p, __ATOMIC_RELAXED, __HIP_MEMORY_SCOPE_AGENT); }
__device__ __forceinline__ unsigned xb_add(unsigned* p, unsigned v) { return __hip_atomic_fetch_add(p, v, __ATOMIC_RELAXED, __HIP_MEMORY_SCOPE_AGENT); }
__device__ __forceinline__ unsigned xb_xcc_id() { return (unsigned)__builtin_amdgcn_s_getreg((3 << 11) | 20) & 0xFu; }
#define XB_SPIN(cond, bar) do { unsigned _sp = 0; while (cond) { __builtin_amdgcn_s_sleep(1); \
    if ((++_sp & 255u) == 0u) { if (xb_ld(&(bar)[XB_TMO])) break; if (_sp > XB_SPIN_CAP) { atomicAdd(&(bar)[XB_TMO], 1u); break; } } } } while (0)

struct XcdBarrier {
    unsigned* bar; unsigned x;
    volatile LAS unsigned* st;
};

__device__ __forceinline__ XcdBarrier xcd_barrier_post(unsigned* bar, volatile LAS unsigned* st) {
    XcdBarrier b; b.bar = bar; b.x = xb_xcc_id(); b.st = st;
    if (threadIdx.x == 0) (void)xb_add(&bar[XB_XCNT(b.x)], 1u);
    return b;
}
__device__ __forceinline__ void xcd_barrier_complete(unsigned* bar, unsigned x, unsigned& nloc, unsigned& nx) {
    const unsigned G = gridDim.x * gridDim.y * gridDim.z;
    unsigned sum, cnt, mine, sp = 0u;
    for (;;) {
        sum = 0u; cnt = 0u; mine = 0u;
#pragma unroll
        for (unsigned j = 0; j < 16; ++j) { const unsigned c = xb_ld(&bar[XB_XCNT(j)]); sum += c; cnt += (c > 0u) ? 1u : 0u; mine = (j == x) ? c : mine; }
        if (sum == G) break;
        __builtin_amdgcn_s_sleep(1);
        if ((++sp & 255u) == 0u) { if (xb_ld(&bar[XB_TMO])) break; if (sp > XB_SPIN_CAP) { atomicAdd(&bar[XB_TMO], 1u); break; } }
    }
    nloc = mine > 0u ? mine : 1u; nx = cnt > 0u ? cnt : 1u;
}

__device__ __forceinline__ void xcd_barrier(const XcdBarrier& b) {
    asm volatile("s_waitcnt vmcnt(0)" ::: "memory");
    __syncthreads();
    if (threadIdx.x == 0) {
        unsigned* bar = b.bar;
        __builtin_amdgcn_s_waitcnt(0);
        unsigned nloc = b.st[0], nx = b.st[1];
        if (nloc == 0u) { xcd_barrier_complete(bar, b.x, nloc, nx); b.st[0] = nloc; b.st[1] = nx; }
        const unsigned old = xb_add(&bar[XB_XSUB(b.x)], 1u);
        const unsigned gen = old / nloc;
        if (old + 1u == (gen + 1u) * nloc) {
            __builtin_amdgcn_fence(__ATOMIC_RELEASE, "agent");
            asm volatile("s_waitcnt vmcnt(0)" ::: "memory");
            const unsigned og = xb_add(&bar[XB_TOP], 1u);
            const unsigned tg = og / nx;
            if (og + 1u == (tg + 1u) * nx) xb_add(&bar[XB_TOPGEN], 1u);
            else XB_SPIN(xb_ld(&bar[XB_TOPGEN]) == tg, bar);
            __builtin_amdgcn_fence(__ATOMIC_ACQUIRE, "agent");
            xb_add(&bar[XB_XGEN(b.x)], 1u);
            asm volatile("s_waitcnt vmcnt(0)" ::: "memory");
        } else {
            XB_SPIN(xb_ld(&bar[XB_XGEN(b.x)]) == gen, bar);
            __builtin_amdgcn_fence(__ATOMIC_ACQUIRE, "agent");
            asm volatile("s_waitcnt vmcnt(0)" ::: "memory");
        }
    }
    __syncthreads();
}


struct Params { const float* in[31]; float* out; unsigned char* ws; int ph_lo, ph_hi; };
enum { I_X = 0, I_MEM, I_NMIXG, I_WINMIX, I_MU, I_W0, I_WLORAB, I_A0, I_ALORAB, I_GLORAB, I_KK, I_KA, I_RK, I_LNW, I_LNB, I_POOLW, I_POOLS, I_NMEMG, I_WMEMKV,
       I_WUPR, I_WUPP, I_WUPM, I_WGATE, I_BGATE, I_WO, I_NFFNG, I_WFFNIN, I_CONVW, I_CONVB, I_WFFNOUT, I_NFING };

struct Ctx { int tid, lane, wave, fr, fq, gw, ngw; LAS unsigned char* lds; };

__device__ __forceinline__ int rowmap(int mode, int n) {
    if (mode == 0) return n;
    const int half = n >= FF ? 1 : 0, c = n - half * FF;
    return (c >> 7) * 256 + half * 128 + (c & 127);
}
__device__ __forceinline__ void transpose_item(const float* W, int K, int N, bf16_t* WT, int ldd, int koff, int mode, const float* kscale, LAS float* scr, int item, int lane) {
    const int nblk = N / 32, kb = item / nblk, nb = item % nblk, k0 = 64 * kb, n0 = 32 * nb;
#pragma unroll 8
    for (int i = 0; i < 32; ++i) { const int kk = 2 * i + (lane >> 5); float v = W[(size_t)(k0 + kk) * N + n0 + (lane & 31)]; if (kscale) v *= kscale[k0 + kk]; scr[kk * 33 + (lane & 31)] = v; }
    asm volatile("s_waitcnt lgkmcnt(0)" ::: "memory");
    const int c = lane & 7;
#pragma unroll
    for (int j = 0; j < 4; ++j) { const int n = (lane >> 3) + 8 * j; const LAS float* s = scr + (8 * c) * 33 + n;
        u32x4 o; o.x = pk2(s[0 * 33], s[1 * 33]); o.y = pk2(s[2 * 33], s[3 * 33]); o.z = pk2(s[4 * 33], s[5 * 33]); o.w = pk2(s[6 * 33], s[7 * 33]);
        *(u32x4*)(WT + (size_t)rowmap(mode, n0 + n) * ldd + koff + k0 + 8 * c) = o; }
    asm volatile("s_waitcnt lgkmcnt(0)" ::: "memory");
}
__device__ __forceinline__ void rmsnorm_row_bf16(const float* xrow, const float* g, bf16_t* orow, int lane) {
    const f32x4* xr = (const f32x4*)xrow + lane; const f32x4* gr = (const f32x4*)g + lane;
    f32x4 v[4]; float s = 0.f;
#pragma unroll
    for (int j = 0; j < 4; ++j) { v[j] = xr[64 * j]; s += (v[j][0] * v[j][0] + v[j][1] * v[j][1]) + (v[j][2] * v[j][2] + v[j][3] * v[j][3]); }
    const float rstd = rsqrtf(wave_sum(s) * (1.f / DM) + NORM_EPS);
    u32x2* o = (u32x2*)orow + lane;
#pragma unroll
    for (int j = 0; j < 4; ++j) { const f32x4 gg = gr[64 * j]; o[64 * j] = pk4(v[j] * rstd * gg); }
}

__device__ __forceinline__ void phase_prologue(const Params& p, const Ctx& c) {
    LAS float* scr = (LAS float*)(c.lds + c.wave * 16384);
    unsigned char* ws = p.ws;
#define TR(Wp, K_, N_, WTp, ldd_, koff_, mode_, sc_) { const int ni_ = ((K_) / 64) * ((N_) / 32); if (r < ni_) { transpose_item(Wp, K_, N_, (bf16_t*)(WTp), ldd_, koff_, mode_, sc_, scr, r, c.lane); continue; } r -= ni_; }
    constexpr int NIT = (DM / 64) * (MIXIN / 32) + (DM / 64) * (3 * DM / 32) + (DM / 64) * (512 / 32) + (512 / 64) * (DM / 32) + 2 * (256 / 64) * (DM / 32) + (DM / 64) * (DM / 32)
                      + (DM / 64) * (2 * FF / 32) + (FF / 64) * (DM / 32) + 2 * (RD / 32) + 2 * (RD / 32) + 4 * 2;
    for (int it = c.gw; it < NIT; it += c.ngw) {
        int r = it;
        TR(p.in[I_WINMIX], DM, MIXIN, ws + WS_WG1T, DM, 0, 0, nullptr)
        TR(p.in[I_WGATE], DM, 3 * DM, ws + WS_WG1T + (size_t)MIXIN * DM * 2, DM, 0, 0, nullptr)
        TR(p.in[I_WMEMKV], DM, 512, ws + WS_WKVT, DM, 0, 0, nullptr)
        TR(p.in[I_WUPR], 512, DM, ws + WS_WUPT, DM, 0, 0, nullptr)
        TR(p.in[I_WUPP], 256, DM, ws + WS_WUPT, DM, 512, 0, nullptr)
        TR(p.in[I_WUPM], 256, DM, ws + WS_WUPT, DM, 768, 0, nullptr)
        TR(p.in[I_WO], DM, DM, ws + WS_WOT, DM, 0, 0, nullptr)
        TR(p.in[I_WFFNIN], DM, 2 * FF, ws + WS_WF1T, DM, 0, 1, p.in[I_NFFNG])
        TR(p.in[I_WFFNOUT], FF, DM, ws + WS_WF2T, FF, 0, 0, nullptr)
        TR(p.in[I_WLORAB], 64, RD, ws + WS_WLWT, 64, 0, 0, nullptr)
        TR(p.in[I_ALORAB], 64, RD, ws + WS_WLAT, 64, 0, 0, nullptr)
        TR(p.in[I_GLORAB], 128, RD, ws + WS_WLGT, 128, 0, 0, nullptr)
        TR(p.in[I_POOLW] + 0 * 4096, 64, 64, ws + WS_WPT + 0 * 8192, 64, 0, 0, nullptr)
        TR(p.in[I_POOLW] + 1 * 4096, 64, 64, ws + WS_WPT + 1 * 8192, 64, 0, 0, nullptr)
        TR(p.in[I_POOLW] + 2 * 4096, 64, 64, ws + WS_WPT + 2 * 8192, 64, 0, 0, nullptr)
        TR(p.in[I_POOLW] + 3 * 4096, 64, 64, ws + WS_WPT + 3 * 8192, 64, 0, 0, nullptr)
    }
#undef TR
    for (int m = c.gw; m < MTOK; m += c.ngw) rmsnorm_row_bf16(p.in[I_X] + (size_t)m * DM, p.in[I_NMIXG], (bf16_t*)(ws + WS_H) + (size_t)m * DM, c.lane);
    for (int m = c.gw; m < BATCH * NMEM; m += c.ngw) rmsnorm_row_bf16(p.in[I_MEM] + (size_t)m * DM, p.in[I_NMEMG], (bf16_t*)(ws + WS_MEMN) + (size_t)m * DM, c.lane);
}

namespace pg8 {
#define PG8_LAS __attribute__((address_space(3)))
typedef unsigned short bf16_t;
typedef short bf16x8 __attribute__((ext_vector_type(8)));
typedef float f32x4 __attribute__((ext_vector_type(4)));
typedef unsigned u32x4 __attribute__((ext_vector_type(4)));
constexpr int BM = 256, BK = 64, HALF = 128, HTB = HALF * BK * 2  , STAGE_BYTES = 8 * HTB, NXCD = 8, WGM = 8;

__host__ __device__ __forceinline__ int lds_byte(int r, int c) { const int st = (r >> 4) * 2 + (c >> 5), rr = r & 15, cc = c & 31, ob = rr * 64 + cc * 2; return st * 1024 + (ob ^ (((ob >> 9) & 1) << 5)); }
__host__ __device__ __forceinline__ void stage_rc(int b, int& R, int& C) { const int st = b / 1024, sb = b % 1024, swz = sb ^ (((sb >> 9) & 1) << 5); R = (st >> 1) * 16 + swz / 64; C = (st & 1) * 32 + (swz % 64) / 2; }
__host__ __device__ __forceinline__ int perm32(int rho) { const int n = rho >> 4, i = rho & 15; return 8 * (i >> 2) + 4 * n + (i & 3); }

struct Unit { int pm, pn; };
struct Gemm { const bf16_t* A; const bf16_t* Bt; int M, N, K, lda, ldb; };

struct StaticOrder {
    int nM, nN, nwg, G, c;
    __host__ __device__ void init(int M, int N, int G_, int c_) { nM = M / BM; nN = N / BM; nwg = nM * nN; G = G_; c = c_; }
    __host__ __device__ bool next(int i, Unit& u) const {
        const long L = (long)i * G + c; if (L >= nwg) return false;
        int wgid = (int)L; { const int q = nwg / NXCD, r = nwg % NXCD, xcd = wgid % NXCD, off = wgid / NXCD; wgid = (xcd < r ? xcd * (q + 1) : r * (q + 1) + (xcd - r) * q) + off; }
        const int nig = WGM * nN, gid = wgid / nig, fm = gid * WGM, gsz = (nM - fm) < WGM ? (nM - fm) : WGM;
        u.pm = fm + ((wgid % nig) % gsz); u.pn = (wgid % nig) / gsz; return true;
    }
    __device__ __forceinline__ void a_ready(const Unit&) const {}
    __device__ __forceinline__ void done(const Unit&) const {}
};


struct NoHook { __device__ __forceinline__ void operator()(f32x4 (&)[2][2][4][2], const Unit&, int, int, int, int, int) const {} };
template <class Epi, class Sched, bool ALIGN_EPI, bool SP2, class Hook>
__device__ __forceinline__ void gemm_phase_h(PG8_LAS unsigned char* lds, const Gemm g, const Sched& S, const Epi& E, const Hook& H) {
    int tid_ = threadIdx.x; asm volatile("" : "+v"(tid_));
    const int tid = tid_, wid = __builtin_amdgcn_readfirstlane(tid >> 6), lane = tid & 63, wr = wid >> 2, wc = wid & 3, fr = lane & 15, fq = lane >> 4;
    const int K = g.K, nt = K / BK;
    unsigned voffA[2], voffB[2];
#pragma unroll
    for (int i = 0; i < 2; ++i) { int R, C; stage_rc(tid * 16 + i * 8192, R, C); const int Rb = Epi::PERM ? ((R & ~31) + perm32(R & 31)) : R;
        voffA[i] = (unsigned)(R * g.lda + C) * 2u; voffB[i] = (unsigned)(Rb * g.ldb + C) * 2u; }
    const size_t kstep = (size_t)(BK * 2);
    const size_t hstepA = (size_t)HALF * g.lda * 2, hstepB = (size_t)HALF * g.ldb * 2;
    const size_t tstepA = 2 * hstepA, tstepB = 2 * hstepB;
    const unsigned ldsw = (unsigned)wid * 1024u;
    const int aoff = lds_byte(wr * 64 + fr, fq * 8), boff = lds_byte(wc * 32 + fr, fq * 8);
#define PG8_SA(b, h) (((b) * 2 + (h)) * HTB)
#define PG8_SB(b, h) ((4 + (b) * 2 + (h)) * HTB)
#define PG8_STAGE(bufoff, gbase, voff) do { _Pragma("unroll") for (int _i = 0; _i < 2; ++_i) \
        __builtin_amdgcn_global_load_lds((const unsigned*)((const char*)(gbase) + (voff)[_i]), (PG8_LAS unsigned*)(lds + (bufoff) + ldsw + _i * 8192), 16, 0, 0); } while (0)
#define PG8_LDA(dst, b, h) do { _Pragma("unroll") for (int m = 0; m < 4; ++m) _Pragma("unroll") for (int k = 0; k < 2; ++k) dst[m][k] = *(const PG8_LAS bf16x8*)(lds + PG8_SA(b, h) + aoff + m * 2048 + k * 1024); } while (0)
#define PG8_LDB(dst, b, h) do { _Pragma("unroll") for (int n = 0; n < 2; ++n) _Pragma("unroll") for (int k = 0; k < 2; ++k) dst[n][k] = *(const PG8_LAS bf16x8*)(lds + PG8_SB(b, h) + boff + n * 2048 + k * 1024); } while (0)
#define PG8_MMA(ai, bj, At, Bt) do { __builtin_amdgcn_s_setprio(1); _Pragma("unroll") for (int m = 0; m < 4; ++m) _Pragma("unroll") for (int n = 0; n < 2; ++n) _Pragma("unroll") for (int k = 0; k < 2; ++k) \
        acc[ai][bj][m][n] = __builtin_amdgcn_mfma_f32_16x16x32_bf16(Bt[n][k], At[m][k], acc[ai][bj][m][n], 0, 0, 0); __builtin_amdgcn_s_setprio(0); } while (0)
#define PG8_WAIT_V(n) asm volatile("s_waitcnt vmcnt(" #n ")" ::: "memory")
#define PG8_WAIT_L(n) asm volatile("s_waitcnt lgkmcnt(" #n ")" ::: "memory")
#define PG8_BAR __builtin_amdgcn_s_barrier()
#define PG8_SCHED __builtin_amdgcn_sched_barrier(0)
    Unit cur, nxt; int ui = 0;
    if (!S.next(0, cur)) return;
    f32x4 acc[2][2][4][2];
#pragma unroll
    for (int a = 0; a < 2; ++a)
#pragma unroll
        for (int b = 0; b < 2; ++b)
#pragma unroll
            for (int m = 0; m < 4; ++m)
#pragma unroll
                for (int n = 0; n < 2; ++n) acc[a][b][m][n] = (f32x4){0.f, 0.f, 0.f, 0.f};
    bf16x8 At[4][2], B0[2][2], B1[2][2];
    const char* cA = (const char*)g.A + (size_t)cur.pm * tstepA; const char* cB = (const char*)g.Bt + (size_t)cur.pn * tstepB;
    S.a_ready(cur);
    if constexpr (SP2) {
        PG8_STAGE(PG8_SB(0, 0), cB, voffB); PG8_STAGE(PG8_SB(0, 1), cB + hstepB, voffB); PG8_STAGE(PG8_SA(0, 0), cA, voffA); PG8_STAGE(PG8_SA(0, 1), cA + hstepA, voffA);
        if (wr == 1) PG8_BAR;
        PG8_WAIT_V(2); PG8_BAR;
        PG8_STAGE(PG8_SB(1, 0), cB + kstep, voffB); PG8_STAGE(PG8_SA(1, 0), cA + kstep, voffA); PG8_STAGE(PG8_SB(1, 1), cB + hstepB + kstep, voffB);
        PG8_WAIT_V(6); PG8_BAR;
    } else {
        PG8_STAGE(PG8_SB(0, 0), cB, voffB); PG8_STAGE(PG8_SA(0, 0), cA, voffA); PG8_STAGE(PG8_SB(0, 1), cB + hstepB, voffB); PG8_STAGE(PG8_SA(0, 1), cA + hstepA, voffA);
        if (wr == 1) PG8_BAR;
        PG8_WAIT_V(4); PG8_BAR;
        PG8_STAGE(PG8_SB(1, 0), cB + kstep, voffB); PG8_STAGE(PG8_SA(1, 0), cA + kstep, voffA); PG8_STAGE(PG8_SB(1, 1), cB + hstepB + kstep, voffB);
        PG8_WAIT_V(6); PG8_BAR;
    }
    for (;;) {
        const bool has_next = S.next(ui + 1, nxt);
        const char* nA = has_next ? (const char*)g.A + (size_t)nxt.pm * tstepA : cA; const char* nB = has_next ? (const char*)g.Bt + (size_t)nxt.pn * tstepB : cB;
        for (int t = 0; t < nt; t += 2) {
            H(acc, cur, t, wr, wc, fr, fq);
            const bool last = (t == nt - 2);
            const char* a1 = cA + (size_t)(t + 1) * kstep;
            const char* a2 = last ? nA : cA + (size_t)(t + 2) * kstep; const char* b2 = last ? nB : cB + (size_t)(t + 2) * kstep;
            const char* a3 = a2 + kstep; const char* b3 = b2 + kstep;
            if (last && has_next) S.a_ready(nxt);
            if constexpr (SP2) {
            PG8_LDB(B0, 0, 0); PG8_LDB(B1, 0, 1); PG8_SCHED; PG8_LDA(At, 0, 0); PG8_STAGE(PG8_SA(1, 1), a1 + hstepA, voffA);
            PG8_WAIT_V(8); PG8_WAIT_L(0); PG8_BAR; PG8_MMA(0, 0, At, B0); PG8_MMA(0, 1, At, B1); PG8_BAR; PG8_SCHED;
            PG8_LDA(At, 0, 1); PG8_STAGE(PG8_SB(0, 0), b2, voffB); PG8_STAGE(PG8_SB(0, 1), b2 + hstepB, voffB); PG8_STAGE(PG8_SA(0, 0), a2, voffA);
            PG8_WAIT_V(8); PG8_WAIT_L(0); PG8_BAR; PG8_MMA(1, 0, At, B0); PG8_MMA(1, 1, At, B1); PG8_BAR; PG8_SCHED;
            PG8_LDB(B0, 1, 0); PG8_LDB(B1, 1, 1); PG8_SCHED; PG8_LDA(At, 1, 0); PG8_STAGE(PG8_SA(0, 1), a2 + hstepA, voffA);
            PG8_WAIT_V(8); PG8_WAIT_L(0); PG8_BAR; PG8_MMA(0, 0, At, B0); PG8_MMA(0, 1, At, B1); PG8_BAR; PG8_SCHED;
            PG8_LDA(At, 1, 1); PG8_STAGE(PG8_SB(1, 0), b3, voffB); PG8_STAGE(PG8_SB(1, 1), b3 + hstepB, voffB); PG8_STAGE(PG8_SA(1, 0), a3, voffA);
            PG8_WAIT_V(8); PG8_WAIT_L(0); PG8_BAR; PG8_MMA(1, 0, At, B0); PG8_MMA(1, 1, At, B1); PG8_BAR; PG8_SCHED;
            } else {
            PG8_LDB(B0, 0, 0); PG8_SCHED; PG8_LDA(At, 0, 0); PG8_STAGE(PG8_SA(1, 1), a1 + hstepA, voffA);
            PG8_WAIT_L(8); PG8_BAR; PG8_WAIT_L(0); PG8_MMA(0, 0, At, B0); PG8_BAR; PG8_SCHED;
            PG8_LDB(B1, 0, 1); PG8_STAGE(PG8_SB(0, 0), b2, voffB);
            PG8_BAR; PG8_WAIT_L(0); PG8_MMA(0, 1, At, B1); PG8_BAR;
            PG8_LDA(At, 0, 1); PG8_STAGE(PG8_SA(0, 0), a2, voffA);
            PG8_BAR; PG8_WAIT_L(0); PG8_MMA(1, 0, At, B0); PG8_BAR; PG8_SCHED;
            PG8_STAGE(PG8_SB(0, 1), b2 + hstepB, voffB);
            PG8_WAIT_V(6); PG8_BAR; PG8_MMA(1, 1, At, B1); PG8_BAR;
            PG8_LDB(B0, 1, 0); PG8_SCHED; PG8_LDA(At, 1, 0); PG8_STAGE(PG8_SA(0, 1), a2 + hstepA, voffA);
            PG8_WAIT_L(8); PG8_BAR; PG8_WAIT_L(0); PG8_MMA(0, 0, At, B0); PG8_BAR; PG8_SCHED;
            PG8_LDB(B1, 1, 1); PG8_STAGE(PG8_SB(1, 0), b3, voffB);
            PG8_BAR; PG8_WAIT_L(0); PG8_MMA(0, 1, At, B1); PG8_BAR;
            PG8_LDA(At, 1, 1); PG8_STAGE(PG8_SA(1, 0), a3, voffA);
            PG8_BAR; PG8_WAIT_L(0); PG8_MMA(1, 0, At, B0); PG8_BAR; PG8_SCHED;
            PG8_STAGE(PG8_SB(1, 1), b3 + hstepB, voffB);
            PG8_WAIT_V(6); PG8_BAR; PG8_MMA(1, 1, At, B1); PG8_BAR;
            }
        }
        if constexpr (ALIGN_EPI) { if (wr == 0) PG8_BAR; }
        if constexpr (!Epi::AFTER_DRAIN) { E(acc, cur, wr, wc, fr, fq); S.done(cur); }
        if (!has_next) break;
#pragma unroll
        for (int a = 0; a < 2; ++a)
#pragma unroll
            for (int b = 0; b < 2; ++b)
#pragma unroll
                for (int m = 0; m < 4; ++m)
#pragma unroll
                    for (int n = 0; n < 2; ++n) acc[a][b][m][n] = (f32x4){0.f, 0.f, 0.f, 0.f};
        cur = nxt; cA = nA; cB = nB; ++ui;
        if constexpr (ALIGN_EPI) { if (wr == 1) PG8_BAR; }
    }
    PG8_WAIT_V(0);
    if constexpr (!ALIGN_EPI) { if (wr == 0) PG8_BAR; }
    PG8_BAR;
    if constexpr (Epi::AFTER_DRAIN) { E.fused(acc, cur, wr, wc, fr, fq, lds, wid, lane); S.done(cur); }
#undef PG8_SA
#undef PG8_SB
#undef PG8_STAGE
#undef PG8_LDA
#undef PG8_LDB
#undef PG8_MMA
#undef PG8_WAIT_V
#undef PG8_WAIT_L
#undef PG8_BAR
#undef PG8_SCHED
}
template <class Epi, class Sched, bool ALIGN_EPI = false, bool SP2 = false>
__device__ __forceinline__ void gemm_phase(PG8_LAS unsigned char* lds, const Gemm g, const Sched& S, const Epi& E) { gemm_phase_h<Epi, Sched, ALIGN_EPI, SP2, NoHook>(lds, g, S, E, NoHook{}); }
}


template <class F> struct EpiFn4 { static constexpr bool PERM = false, AFTER_DRAIN = false; F f;
    __device__ __forceinline__ void operator()(const f32x4 (&acc)[2][2][4][2], const pg8::Unit& u, int wr, int wc, int fr, int fq) const {
        const int row0 = u.pm * 256 + wr * 64 + fr, col0 = u.pn * 256 + wc * 32 + 4 * fq;
#pragma unroll
        for (int ai = 0; ai < 2; ++ai)
#pragma unroll
            for (int m = 0; m < 4; ++m)
#pragma unroll
                for (int bj = 0; bj < 2; ++bj)
#pragma unroll
                    for (int n = 0; n < 2; ++n) f(row0 + ai * 128 + m * 16, col0 + bj * 128 + n * 16, acc[ai][bj][m][n]);
    } };
template <class F> struct EpiFn8 { static constexpr bool PERM = true, AFTER_DRAIN = false; F f;
    __device__ __forceinline__ void operator()(const f32x4 (&acc)[2][2][4][2], const pg8::Unit& u, int wr, int wc, int fr, int fq) const {
        const int row0 = u.pm * 256 + wr * 64 + fr, col0 = u.pn * 256 + wc * 32 + 8 * fq;
#pragma unroll
        for (int ai = 0; ai < 2; ++ai)
#pragma unroll
            for (int m = 0; m < 4; ++m)
#pragma unroll
                for (int bj = 0; bj < 2; ++bj) f(row0 + ai * 128 + m * 16, col0 + bj * 128, acc[ai][bj][m][0], acc[ai][bj][m][1]);
    } };
template <class F> __device__ __forceinline__ void gemm_pg8_4(const Ctx& c, const bf16_t* A, int lda, const bf16_t* Bt, int ldb, int M, int N, int K, const F& f) {
    pg8::Gemm g{A, Bt, M, N, K, lda, ldb}; pg8::StaticOrder S; S.init(M, N, (int)gridDim.x, (int)blockIdx.x); EpiFn4<F> E{f};
    pg8::gemm_phase<EpiFn4<F>, pg8::StaticOrder, true, true>(c.lds, g, S, E);
}
template <class F> __device__ __forceinline__ void gemm_pg8_8(const Ctx& c, const bf16_t* A, int lda, const bf16_t* Bt, int ldb, int M, int N, int K, const F& f) {
    pg8::Gemm g{A, Bt, M, N, K, lda, ldb}; pg8::StaticOrder S; S.init(M, N, (int)gridDim.x, (int)blockIdx.x); EpiFn8<F> E{f};
    pg8::gemm_phase<EpiFn8<F>, pg8::StaticOrder, true, true>(c.lds, g, S, E);
}
__device__ __forceinline__ u32x4 pk8(f32x4 lo, f32x4 hi) { u32x4 w; w.x = pk2(lo[0], lo[1]); w.y = pk2(lo[2], lo[3]); w.z = pk2(hi[0], hi[1]); w.w = pk2(hi[2], hi[3]); return w; }
struct F8Store { bf16_t* O; int ld; __device__ __forceinline__ void operator()(int row, int col, f32x4 lo, f32x4 hi) const { *(u32x4*)(O + (size_t)row * ld + col) = pk8(lo, hi); } };
struct F8SigBias { bf16_t* O; int ld; const float* bias;
    __device__ __forceinline__ void operator()(int row, int col, f32x4 lo, f32x4 hi) const {
        lo += *(const f32x4*)(bias + col); hi += *(const f32x4*)(bias + col + 4);
#pragma unroll
        for (int j = 0; j < 4; ++j) { lo[j] = sigmoidf_(lo[j]); hi[j] = sigmoidf_(hi[j]); }
        *(u32x4*)(O + (size_t)row * ld + col) = pk8(lo, hi); } };
struct UpHook { const bf16_t* GT;
    __device__ __forceinline__ void operator()(f32x4 (&acc)[2][2][4][2], const pg8::Unit& u, int t, int wr, int wc, int fr, int fq) const {
        if (t != 8 && t != 12) return;
        const int sa = (t == 8) ? 0 : 1;
        const bf16_t* gp0 = GT + (size_t)(u.pm * 256 + wr * 64 + fr) * (3 * DM) + sa * DM + u.pn * 256 + wc * 32 + 8 * fq;
#pragma unroll
        for (int ai = 0; ai < 2; ++ai)
#pragma unroll
            for (int m = 0; m < 4; ++m) { const bf16_t* gp = gp0 + (size_t)(ai * 128 + m * 16) * (3 * DM);
#pragma unroll
                for (int bj = 0; bj < 2; ++bj) { const u32x4 ga = *(const u32x4*)(gp + bj * 128), gb = *(const u32x4*)(gp + DM + bj * 128);
                    const f32x4 a0 = unpk4((u32x2){ga.x, ga.y}), a1 = unpk4((u32x2){ga.z, ga.w}), b0 = unpk4((u32x2){gb.x, gb.y}), b1 = unpk4((u32x2){gb.z, gb.w});
#pragma unroll
                    for (int j = 0; j < 4; ++j) { acc[ai][bj][m][0][j] *= a0[j] * __builtin_amdgcn_rcpf(b0[j]); acc[ai][bj][m][1][j] *= a1[j] * __builtin_amdgcn_rcpf(b1[j]); } }
                asm volatile("" ::: "memory"); }
    } };
struct F8UpFinal { bf16_t* MG; const bf16_t* GT;
    __device__ __forceinline__ void operator()(int row, int col, f32x4 lo, f32x4 hi) const {
        const u32x4 g = *(const u32x4*)(GT + (size_t)row * (3 * DM) + 2 * DM + col);
        *(u32x4*)(MG + (size_t)row * DM + col) = pk8(lo * unpk4((u32x2){g.x, g.y}), hi * unpk4((u32x2){g.z, g.w})); } };

__device__ __forceinline__ f32x2 gelu_pk(f32x2 v) {
    const f32x2 av = __builtin_elementwise_abs(v), d = av * 0.2316418882f + 1.0f;
    f32x2 t; t.x = __builtin_amdgcn_rcpf(d.x); t.y = __builtin_amdgcn_rcpf(d.y);
    f32x2 q = t * 0.5307027145f + (-0.7265760135f); q = q * t + 0.7107068705f; q = q * t + (-0.142248368f); q = q * t + 0.127414796f; q = q * t;
    const f32x2 s = (v * v) * (-0.72134752044f);
    f32x2 e; e.x = __builtin_amdgcn_exp2f(s.x); e.y = __builtin_amdgcn_exp2f(s.y);
    const f32x2 m = v * (q * e), r = v - m;
    f32x2 o; o.x = v.x < 0.f ? m.x : r.x; o.y = v.y < 0.f ? m.y : r.y; return o;
}
struct EpiFfnAct { static constexpr bool PERM = true, AFTER_DRAIN = false;
    bf16_t* ACT; const float* rstd; const float* cw; const float* cb; float* TAILU; float* HEADU; float* HEADGV; LAS float* halo;
    __device__ __forceinline__ void operator()(const f32x4 (&acc)[2][2][4][2], const pg8::Unit& u, int wr, int wc, int fr, int fq) const {
        const int ch0 = u.pn * 128 + wc * 32 + 8 * fq, rowt = wr * 64 + fr, grow0 = u.pm * 256 + rowt;
        f32x4 c0[2], c1[2], c2[2], cbv[2];
#pragma unroll
        for (int n = 0; n < 2; ++n) { c0[n] = *(const f32x4*)(cw + ch0 + 4 * n); c1[n] = *(const f32x4*)(cw + FF + ch0 + 4 * n); c2[n] = *(const f32x4*)(cw + 2 * FF + ch0 + 4 * n); cbv[n] = *(const f32x4*)(cb + ch0 + 4 * n); }
#pragma unroll
        for (int ai = 0; ai < 2; ++ai) { const float rs3 = rstd[grow0 + ai * 128 + 48];
            if (fr >= 14) {
#pragma unroll
                for (int n = 0; n < 2; ++n) *(LAS f32x4*)(halo + (((((ai * 2 + wr) * 2 + (fr - 14)) * 4 + wc) * 4 + fq) * 8 + 4 * n)) = acc[ai][0][3][n] * rs3; } }
        asm volatile("s_waitcnt lgkmcnt(0)" ::: "memory"); __builtin_amdgcn_s_barrier(); asm volatile("" ::: "memory");
#pragma unroll
        for (int ai = 0; ai < 2; ++ai) {
            f32x4 r1p[2], r2p[2];
            if (wr == 1 || ai == 1) { const int src = (wr == 1) ? (ai * 2) : ((ai - 1) * 2 + 1);
#pragma unroll
                for (int n = 0; n < 2; ++n) { const f32x4 hv0 = *(const LAS f32x4*)(halo + ((((src * 2 + 0) * 4 + wc) * 4 + fq) * 8 + 4 * n)), hv1 = *(const LAS f32x4*)(halo + ((((src * 2 + 1) * 4 + wc) * 4 + fq) * 8 + 4 * n));
                    r1p[n] = hv1; r2p[n] = (fr == 0) ? hv0 : hv1; } }
            else { r1p[0] = r1p[1] = r2p[0] = r2p[1] = (f32x4){0.f, 0.f, 0.f, 0.f}; }
#pragma unroll
            for (int m = 0; m < 4; ++m) {
                const int grow = grow0 + ai * 128 + 16 * m; const float rs = rstd[grow];
                u32x4 w;
#pragma unroll
                for (int n = 0; n < 2; ++n) {
                    const f32x4 uu = acc[ai][0][m][n] * rs, gg = acc[ai][1][m][n] * rs;
                    f32x4 R1, R2;
#pragma unroll
                    for (int j = 0; j < 4; ++j) { R1[j] = dpp_f<0x121>(uu[j]); R2[j] = dpp_f<0x122>(uu[j]); }
                    const f32x4 p1 = (fr >= 1) ? R1 : r1p[n], p2 = (fr >= 2) ? R2 : r2p[n];
                    r1p[n] = R1; r2p[n] = R2;
                    const f32x4 uc = c0[n] * p2 + c1[n] * p1 + c2[n] * uu + cbv[n];
                    const f32x2 ga = gelu_pk((f32x2){uc[0], uc[1]}), gb = gelu_pk((f32x2){uc[2], uc[3]});
                    const unsigned lo = pk2(ga.x * gg[0], ga.y * gg[1]), hi = pk2(gb.x * gg[2], gb.y * gg[3]);
                    if (n == 0) { w.x = lo; w.y = hi; } else { w.z = lo; w.w = hi; }
                    if (ai == 0 && m == 0) { if (wr == 0 && fr < 2) { const size_t so = (size_t)(u.pm * 2 + fr) * FF + ch0 + 4 * n; *(f32x4*)(HEADU + so) = uu; *(f32x4*)(HEADGV + so) = gg; } }
                    if (ai == 1 && m == 3) { if (wr == 1 && fr >= 14) { const size_t so = (size_t)(u.pm * 2 + (fr - 14)) * FF + ch0 + 4 * n; *(f32x4*)(TAILU + so) = uu; } }
                }
                *(u32x4*)(ACT + (size_t)grow * FF + ch0) = w;
            }
        }
    } };
__device__ __forceinline__ void phase_ffn_fix(const Params& p, const Ctx& c) {
    unsigned char* ws = p.ws;
    const float* TAILU = (const float*)(ws + WS_TAILU); const float* HEADU = (const float*)(ws + WS_HEADU); const float* HEADGV = (const float*)(ws + WS_HEADGV); bf16_t* ACT = (bf16_t*)(ws + WS_ACT);
    const float* cw = p.in[I_CONVW]; const float* cb = p.in[I_CONVB];
    const int nit = (MTOK / 256) * 2 * (FF / 4);
    for (int idx = blockIdx.x * NTHREADS + c.tid; idx < nit; idx += gridDim.x * NTHREADS) {
        const int col = 4 * (idx % (FF / 4)), pr = idx / (FF / 4), pm = pr >> 1, rr = pr & 1;
        if ((pm & 15) == 0) continue;
        const f32x4 u0 = *(const f32x4*)(HEADU + (size_t)(pm * 2 + rr) * FF + col), gg = *(const f32x4*)(HEADGV + (size_t)(pm * 2 + rr) * FF + col);
        const f32x4 t1 = *(const f32x4*)(TAILU + (size_t)((pm - 1) * 2 + 1) * FF + col), t0 = *(const f32x4*)(TAILU + (size_t)((pm - 1) * 2 + 0) * FF + col);
        f32x4 u1, u2; if (rr == 0) { u1 = t1; u2 = t0; } else { u1 = *(const f32x4*)(HEADU + (size_t)(pm * 2) * FF + col); u2 = t1; }
        const f32x4 uc = *(const f32x4*)(cw + col) * u2 + *(const f32x4*)(cw + FF + col) * u1 + *(const f32x4*)(cw + 2 * FF + col) * u0 + *(const f32x4*)(cb + col);
        const f32x2 ga = gelu_pk((f32x2){uc[0], uc[1]}), gb = gelu_pk((f32x2){uc[2], uc[3]});
        u32x2 w; w.x = pk2(ga.x * gg[0], ga.y * gg[1]); w.y = pk2(gb.x * gg[2], gb.y * gg[3]);
        *(u32x2*)(ACT + (size_t)(pm * 256 + rr) * FF + col) = w;
    }
}

__device__ __forceinline__ void wave_gemm_32x64(const bf16_t* A, int lda, const bf16_t* Bt, int ldb, int K, int m0, int n0, int fr, int fq, f32x4 (&acc)[2][4]) {
    const bf16_t* ap = A + (size_t)(m0 + fr) * lda + 8 * fq;
    const bf16_t* bp = Bt + (size_t)(n0 + fr) * ldb + 8 * fq;
    for (int k0 = 0; k0 < K; k0 += 32) {
        const bf16x8 a0 = *(const bf16x8*)(ap + k0), a1 = *(const bf16x8*)(ap + (size_t)16 * lda + k0);
        bf16x8 b[4];
#pragma unroll
        for (int j = 0; j < 4; ++j) b[j] = *(const bf16x8*)(bp + (size_t)(16 * j) * ldb + k0);
#pragma unroll
        for (int j = 0; j < 4; ++j) { acc[0][j] = __builtin_amdgcn_mfma_f32_16x16x32_bf16(b[j], a0, acc[0][j], 0, 0, 0); acc[1][j] = __builtin_amdgcn_mfma_f32_16x16x32_bf16(b[j], a1, acc[1][j], 0, 0, 0); }
    }
}
template <class Epi>
__device__ __forceinline__ void gemm_simple(const Ctx& c, const bf16_t* A, int lda, const bf16_t* Bt, int ldb, int M, int N, int K, const Epi& epi) {
    const int nMt = M / 256, nNt = N / 64, ntiles = nMt * nNt;
    for (int tile = blockIdx.x; tile < ntiles; tile += gridDim.x) {
        const int tm = tile % nMt, tn = tile / nMt, m0 = tm * 256 + c.wave * 32, n0 = tn * 64;
        f32x4 acc[2][4];
#pragma unroll
        for (int i = 0; i < 2; ++i)
#pragma unroll
            for (int j = 0; j < 4; ++j) acc[i][j] = (f32x4){0.f, 0.f, 0.f, 0.f};
        wave_gemm_32x64(A, lda, Bt, ldb, K, m0, n0, c.fr, c.fq, acc);
#pragma unroll
        for (int i = 0; i < 2; ++i)
#pragma unroll
            for (int j = 0; j < 4; ++j) epi(m0 + 16 * i + c.fr, n0 + 16 * j + 4 * c.fq, acc[i][j]);
    }
}

struct EpiBf16 { bf16_t* O; int ld; __device__ __forceinline__ void operator()(int row, int col, f32x4 v) const { *(u32x2*)(O + (size_t)row * ld + col) = pk4(v); } };
struct EpiKV { bf16_t* KB; bf16_t* VT;
    __device__ __forceinline__ void operator()(int row, int col, f32x4 v) const {
        if (col < 256) { *(u32x2*)(KB + (size_t)row * 256 + col) = pk4(v); }
        else { const int cc = col - 256, h = cc >> 6, d = cc & 63, b = row >> 8, key = row & 255;
#pragma unroll
            for (int j = 0; j < 4; ++j) VT[((size_t)((b * 4 + h) * 64 + d + j)) * 256 + key] = (bf16_t)f2bf(v[j]); }
    } };
struct EpiDecay { float* W; const float* w0;
    __device__ __forceinline__ void operator()(int row, int col, f32x4 v) const {
        const f32x4 z = v + *(const f32x4*)(w0 + col); f32x4 o;
#pragma unroll
        for (int j = 0; j < 4; ++j) o[j] = __expf(-0.60653065971f * sigmoidf_(z[j]));
        *(f32x4*)(W + (size_t)row * RD + col) = o; } };
struct EpiSigBias { bf16_t* O; int ld; const float* bias;
    __device__ __forceinline__ void operator()(int row, int col, f32x4 v) const {
        const f32x4 z = v + *(const f32x4*)(bias + col); f32x4 o;
#pragma unroll
        for (int j = 0; j < 4; ++j) o[j] = sigmoidf_(z[j]);
        *(u32x2*)(O + (size_t)row * ld + col) = pk4(o); } };
struct EpiPool { bf16_t* Y; const float* scale; int gi;
    __device__ __forceinline__ void operator()(int row, int col, f32x4 v) const {
        const f32x4 s = *(const f32x4*)(scale + 64 * gi + col); *(u32x2*)(Y + (size_t)row * DM + 512 + 64 * gi + col) = pk4(v * s); } };
struct EpiOut { const float* x; float* x1; bf16_t* x1b;
    __device__ __forceinline__ void operator()(int row, int col, f32x4 v) const {
        const size_t off = (size_t)row * DM + col; const f32x4 o = *(const f32x4*)(x + off) + v; *(f32x4*)(x1 + off) = o; *(u32x2*)(x1b + off) = pk4(o); } };
struct EpiAddOut { float* x;
    __device__ __forceinline__ void operator()(int row, int col, f32x4 v) const { const size_t off = (size_t)row * DM + col; *(f32x4*)(x + off) = *(const f32x4*)(x + off) + v; } };

__device__ __forceinline__ void phase_mix(const Params& p, const Ctx& c) {
    unsigned char* ws = p.ws;
    const bf16_t* P = (const bf16_t*)(ws + WS_P); const float* mu = p.in[I_MU];
    bf16_t* R = (bf16_t*)(ws + WS_R); bf16_t* KR = (bf16_t*)(ws + WS_KRAW); bf16_t* V = (bf16_t*)(ws + WS_V);
    bf16_t* LW = (bf16_t*)(ws + WS_LW); bf16_t* LA = (bf16_t*)(ws + WS_LA); bf16_t* LG = (bf16_t*)(ws + WS_LG);
    for (int row = c.gw; row < MTOK; row += c.ngw) {
        const int t = row & (SEQ - 1); const bf16_t* cur = P + (size_t)row * MIXIN;
#pragma unroll
        for (int i = 0; i < 7; ++i) {
            const int col = 4 * c.lane + 256 * i;
            const f32x4 cv = unpk4(*(const u32x2*)(cur + col));
            f32x4 pv = (f32x4){0.f, 0.f, 0.f, 0.f}; if (t > 0) pv = unpk4(*(const u32x2*)(cur - MIXIN + col));
            const f32x4 m4 = *(const f32x4*)(mu + col);
            f32x4 pm = cv + (pv - cv) * m4;
            if (i < 2) *(u32x2*)(R + (size_t)row * RD + col) = pk4(pm);
            else if (i < 4) *(u32x2*)(KR + (size_t)row * RD + (col - 512)) = pk4(pm);
            else if (i < 6) *(u32x2*)(V + (size_t)row * RD + (col - 1024)) = pk4(pm);
            else {
                const int cc = col - 1536;
                if (cc < 64) { f32x4 o; o[0] = tanhf(pm[0]); o[1] = tanhf(pm[1]); o[2] = tanhf(pm[2]); o[3] = tanhf(pm[3]); *(u32x2*)(LW + (size_t)row * 64 + cc) = pk4(o); }
                else if (cc < 128) { *(u32x2*)(LA + (size_t)row * 64 + (cc - 64)) = pk4(pm); }
                else { f32x4 o; o[0] = sigmoidf_(pm[0]); o[1] = sigmoidf_(pm[1]); o[2] = sigmoidf_(pm[2]); o[3] = sigmoidf_(pm[3]); *(u32x2*)(LG + (size_t)row * 128 + (cc - 128)) = pk4(o); }
            }
        }
    }
}
__device__ __forceinline__ void phase_pooldiff(const Params& p, const Ctx& c) {
    unsigned char* ws = p.ws;
    const bf16_t* P = (const bf16_t*)(ws + WS_P); bf16_t* DP = (bf16_t*)(ws + WS_DPOOL);
    const int col = 4 * c.lane, gi = c.lane >> 4, win = 2 << gi;
    for (int row = c.gw; row < MTOK; row += c.ngw) {
        const int t = row & (SEQ - 1); const bf16_t* cur = P + (size_t)row * MIXIN + RWKVIN + col;
        const f32x4 x0 = unpk4(*(const u32x2*)cur); f32x4 s = x0;
        for (int j = 1; j < 16; ++j) if (j < win && j <= t) s += unpk4(*(const u32x2*)(cur - (size_t)j * MIXIN));
        const int cnt = (t + 1) < win ? (t + 1) : win;
        *(u32x2*)(DP + (size_t)row * 256 + col) = pk4(s * (1.0f / (float)cnt) - x0);
    }
}
__device__ __forceinline__ void phase_memattn(const Params& p, const Ctx& c) {
    unsigned char* ws = p.ws;
    const bf16_t* P = (const bf16_t*)(ws + WS_P); const bf16_t* KB = (const bf16_t*)(ws + WS_KB); const bf16_t* VT = (const bf16_t*)(ws + WS_VT); bf16_t* Y = (bf16_t*)(ws + WS_YCAT);
    const int fr = c.fr, fq = c.fq;
    for (int unit = blockIdx.x; unit < BATCH * 4 * 16; unit += gridDim.x) {
        const int qt = unit & 15, h = (unit >> 4) & 3, b = unit >> 6;
#pragma unroll 1
        for (int qg = 0; qg < 2; ++qg) {
            const int row = b * SEQ + qt * 256 + c.wave * 32 + 16 * qg + fr;
            const bf16x8 q0 = *(const bf16x8*)(P + (size_t)row * MIXIN + 2048 + h * 64 + 8 * fq), q1 = *(const bf16x8*)(P + (size_t)row * MIXIN + 2048 + h * 64 + 32 + 8 * fq);
            f32x4 sc[16];
#pragma unroll
            for (int kg = 0; kg < 16; ++kg) {
                const bf16_t* kp = KB + (size_t)(b * 256 + 16 * kg + fr) * 256 + h * 64 + 8 * fq;
                const bf16x8 k0 = *(const bf16x8*)kp, k1 = *(const bf16x8*)(kp + 32);
                f32x4 a = (f32x4){0.f, 0.f, 0.f, 0.f};
                a = __builtin_amdgcn_mfma_f32_16x16x32_bf16(k0, q0, a, 0, 0, 0); a = __builtin_amdgcn_mfma_f32_16x16x32_bf16(k1, q1, a, 0, 0, 0); sc[kg] = a;
                if ((kg & 3) == 3) asm volatile("" ::: "memory");
            }
            float m = -1e30f;
#pragma unroll
            for (int kg = 0; kg < 16; ++kg) m = fmaxf(m, fmaxf(fmaxf(sc[kg][0], sc[kg][1]), fmaxf(sc[kg][2], sc[kg][3])));
            m = fmaxf(m, __shfl_xor(m, 16)); m = fmaxf(m, __shfl_xor(m, 32));
            float l = 0.f;
#pragma unroll
            for (int kg = 0; kg < 16; ++kg)
#pragma unroll
                for (int j = 0; j < 4; ++j) { const float e = __expf((sc[kg][j] - m) * 0.125f); sc[kg][j] = e; l += e; }
            l += __shfl_xor(l, 16); l += __shfl_xor(l, 32);
            const float linv = 1.0f / l;
            f32x4 o[4];
#pragma unroll
            for (int dg = 0; dg < 4; ++dg) o[dg] = (f32x4){0.f, 0.f, 0.f, 0.f};
#pragma unroll
            for (int s = 0; s < 8; ++s) {
                u32x4 w; w.x = pk2(sc[2 * s][0], sc[2 * s][1]); w.y = pk2(sc[2 * s][2], sc[2 * s][3]); w.z = pk2(sc[2 * s + 1][0], sc[2 * s + 1][1]); w.w = pk2(sc[2 * s + 1][2], sc[2 * s + 1][3]);
                const bf16x8 pf = __builtin_bit_cast(bf16x8, w);
#pragma unroll
                for (int dg = 0; dg < 4; ++dg) {
                    const bf16_t* vp = VT + ((size_t)((b * 4 + h) * 64 + 16 * dg + fr)) * 256 + 32 * s + 4 * fq;
                    u32x4 v; const u32x2 lo = *(const u32x2*)vp, hi = *(const u32x2*)(vp + 16); v.x = lo.x; v.y = lo.y; v.z = hi.x; v.w = hi.y;
                    o[dg] = __builtin_amdgcn_mfma_f32_16x16x32_bf16(__builtin_bit_cast(bf16x8, v), pf, o[dg], 0, 0, 0);
                }
                if (s & 1) asm volatile("" ::: "memory");
            }
#pragma unroll
            for (int dg = 0; dg < 4; ++dg) *(u32x2*)(Y + (size_t)row * DM + 768 + h * 64 + 16 * dg + 4 * fq) = pk4(o[dg] * linv);
        }
    }
}

__device__ __forceinline__ void phase_prep2(const Params& p, const Ctx& c) {
    unsigned char* ws = p.ws;
    const bf16_t* KR = (const bf16_t*)(ws + WS_KRAW); const bf16_t* AA = (const bf16_t*)(ws + WS_AA); const bf16_t* R = (const bf16_t*)(ws + WS_R);
    bf16_t* KK = (bf16_t*)((unsigned char*)p.out + DO_KK); bf16_t* BB = (bf16_t*)((unsigned char*)p.out + DO_BB); bf16_t* KF = (bf16_t*)((unsigned char*)p.out + DO_KF);
    float* BON = (float*)(ws + WS_BONUS);
    for (int it = c.gw; it < MTOK * 8; it += c.ngw) {
        const int row = it >> 3, h = it & 7, col = h * 64 + c.lane; const size_t off = (size_t)row * RD + col;
        const float k = bf2f(KR[off]), a = bf2f(AA[off]), r = bf2f(R[off]);
        const float kkv = k * p.in[I_KK][col];
        const float nrm = wave_sum(kkv * kkv);
        const float kap = kkv * rsqrtf(nrm + 1e-12f);
        const float kf = k * (1.0f + (a - 1.0f) * p.in[I_KA][col]);
        const float bon = wave_sum(r * kf * p.in[I_RK][col]);
        KK[off] = (bf16_t)f2bf(kap); BB[off] = (bf16_t)f2bf(kap * a); KF[off] = (bf16_t)f2bf(kf);
        if (c.lane == 0) BON[it] = bon;
    }
}

constexpr int TC = 32;
__device__ __forceinline__ void phase_scan(const Params& p, const Ctx& c) {
    unsigned char* ws = p.ws;
    const bf16_t* KK = (const bf16_t*)((unsigned char*)p.out + DO_KK); const bf16_t* BB = (const bf16_t*)((unsigned char*)p.out + DO_BB); const bf16_t* KF = (const bf16_t*)((unsigned char*)p.out + DO_KF);
    const bf16_t* R = (const bf16_t*)(ws + WS_R); const bf16_t* V = (const bf16_t*)(ws + WS_V); const float* W = (const float*)(ws + WS_W);
    float* YR = (float*)(ws + WS_YRAW);
    constexpr int OPF = 5 * TC * 64, BUFF = OPF + TC * 16;
    LAS float* L = (LAS float*)c.lds; LAS float* YB = L + 2 * BUFF;
    const int tid = c.tid, lt = tid & 255;
    const bool loader = tid >= 256;
    for (int unit = blockIdx.x; unit < BATCH * 8 * 4; unit += gridDim.x) {
        const int q = unit & 3, h = (unit >> 2) & 7, b = unit >> 5;
        const size_t rowbase = (size_t)b * SEQ;
        auto stage = [&](int ch, int buf) {
            LAS float* B = L + buf * BUFF;
#pragma unroll
            for (int hh = 0; hh < 2; ++hh) {
                const int ss = (lt >> 4) + 16 * hh, g4 = (lt & 15) * 4;
                const size_t ro = (rowbase + (size_t)ch * TC + ss) * RD + h * 64 + g4;
                const u32x2 r0 = *(const u32x2*)(KK + ro), r1 = *(const u32x2*)(KF + ro), r2 = *(const u32x2*)(BB + ro), r3 = *(const u32x2*)(R + ro);
                const f32x4 rw = *(const f32x4*)(W + ro);
                const unsigned short rv = V[(rowbase + (size_t)ch * TC + ss) * RD + h * 64 + 16 * q + (lt & 15)];
                *(LAS f32x4*)(B + (0 * TC + ss) * 64 + g4) = unpk4(r0);
                *(LAS f32x4*)(B + (1 * TC + ss) * 64 + g4) = rw;
                *(LAS f32x4*)(B + (2 * TC + ss) * 64 + g4) = unpk4(r1);
                *(LAS f32x4*)(B + (3 * TC + ss) * 64 + g4) = unpk4(r2);
                *(LAS f32x4*)(B + (4 * TC + ss) * 64 + g4) = unpk4(r3);
                B[OPF + ss * 16 + (lt & 15)] = bf2f(rv);
            }
        };
        auto flush = [&](int ch) {
#pragma unroll
            for (int hh = 0; hh < 2; ++hh) { const int ss = (lt >> 4) + 16 * hh, i = lt & 15;
                YR[(rowbase + (size_t)ch * TC + ss) * RD + h * 64 + 16 * q + i] = YB[(ch & 1) * TC * 16 + ss * 16 + i]; }
        };
        __syncthreads();
        if (loader) stage(0, 0);
        f32x4 S = (f32x4){0.f, 0.f, 0.f, 0.f};
        const int vrow = (tid >> 4) & 15, kq = tid & 15;
        for (int ch = 0; ch < SEQ / TC; ++ch) {
            __syncthreads();
            if (loader) {
                if (ch > 0) flush(ch - 1);
                if (ch + 1 < SEQ / TC) stage(ch + 1, (ch + 1) & 1);
            } else {
                const LAS float* B = L + (ch & 1) * BUFF; LAS float* YO = YB + (ch & 1) * TC * 16;
                f32x4 kap = *(const LAS f32x4*)(B + (0 * TC) * 64 + 4 * kq), w4 = *(const LAS f32x4*)(B + (1 * TC) * 64 + 4 * kq), kf4 = *(const LAS f32x4*)(B + (2 * TC) * 64 + 4 * kq);
                f32x4 b4 = *(const LAS f32x4*)(B + (3 * TC) * 64 + 4 * kq), r4 = *(const LAS f32x4*)(B + (4 * TC) * 64 + 4 * kq); float vv = B[OPF + vrow];
#pragma unroll
                for (int s0 = 0; s0 < TC; s0 += 16) {
                    float ykeep = 0.f;
#pragma unroll
                    for (int s1 = 0; s1 < 16; ++s1) { const int s = s0 + s1, sn = (s + 1 < TC) ? s + 1 : s;
                        const f32x4 nkap = *(const LAS f32x4*)(B + (0 * TC + sn) * 64 + 4 * kq), nw4 = *(const LAS f32x4*)(B + (1 * TC + sn) * 64 + 4 * kq), nkf4 = *(const LAS f32x4*)(B + (2 * TC + sn) * 64 + 4 * kq);
                        const f32x4 nb4 = *(const LAS f32x4*)(B + (3 * TC + sn) * 64 + 4 * kq), nr4 = *(const LAS f32x4*)(B + (4 * TC + sn) * 64 + 4 * kq); const float nvv = B[OPF + sn * 16 + vrow];
                        __builtin_amdgcn_sched_barrier(0);
                        const float sk = row_sum16((S[0] * kap[0] + S[1] * kap[1]) + (S[2] * kap[2] + S[3] * kap[3]));
                        S = (S * w4 + kf4 * vv) - b4 * sk;
                        const float y = row_sum16((S[0] * r4[0] + S[1] * r4[1]) + (S[2] * r4[2] + S[3] * r4[3]));
                        ykeep = (kq == s1) ? y : ykeep;
                        kap = nkap; w4 = nw4; kf4 = nkf4; b4 = nb4; r4 = nr4; vv = nvv;
                    }
                    YO[(s0 + kq) * 16 + vrow] = ykeep;
                }
            }
        }
        __syncthreads();
        if (loader) flush(SEQ / TC - 1);
    }
}

__device__ __forceinline__ void phase_post(const Params& p, const Ctx& c) {
    unsigned char* ws = p.ws;
    const float* YR = (const float*)(ws + WS_YRAW); const float* BON = (const float*)(ws + WS_BONUS);
    const bf16_t* V = (const bf16_t*)(ws + WS_V); const bf16_t* G = (const bf16_t*)(ws + WS_G); bf16_t* Y = (bf16_t*)(ws + WS_YCAT);
    for (int it = c.gw; it < MTOK * 8; it += c.ngw) {
        const int row = it >> 3, h = it & 7, col = h * 64 + c.lane; const size_t off = (size_t)row * RD + col;
        const float y = YR[off];
        const float mean = wave_sum(y) * (1.0f / 64.0f); const float d = y - mean;
        const float var = wave_sum(d * d) * (1.0f / 64.0f);
        const float yn = d * rsqrtf(var + GN_EPS) * p.in[I_LNW][col] + p.in[I_LNB][col];
        const float bon = BON[it];
        const float o = (yn + bon * bf2f(V[off])) * bf2f(G[off]);
        Y[(size_t)row * DM + col] = (bf16_t)f2bf(o);
    }
}

__device__ __forceinline__ void phase_up_simple(const Params& p, const Ctx& c) {
    unsigned char* ws = p.ws;
    const bf16_t* Y = (const bf16_t*)(ws + WS_YCAT); const bf16_t* WU = (const bf16_t*)(ws + WS_WUPT); const bf16_t* GT = (const bf16_t*)(ws + WS_GATES); bf16_t* MG = (bf16_t*)(ws + WS_MERGED);
    const int nMt = MTOK / 256, nNt = DM / 64, ntiles = nMt * nNt;
    for (int tile = blockIdx.x; tile < ntiles; tile += gridDim.x) {
        const int tm = tile % nMt, tn = tile / nMt, m0 = tm * 256 + c.wave * 32, n0 = tn * 64;
        f32x4 tot[2][4];
#pragma unroll
        for (int i = 0; i < 2; ++i)
#pragma unroll
            for (int j = 0; j < 4; ++j) tot[i][j] = (f32x4){0.f, 0.f, 0.f, 0.f};
#pragma unroll
        for (int seg = 0; seg < 3; ++seg) {
            const int koff = seg == 0 ? 0 : (seg == 1 ? 512 : 768), K = seg == 0 ? 512 : 256;
            f32x4 acc[2][4];
#pragma unroll
            for (int i = 0; i < 2; ++i)
#pragma unroll
                for (int j = 0; j < 4; ++j) acc[i][j] = (f32x4){0.f, 0.f, 0.f, 0.f};
            wave_gemm_32x64(Y + koff, DM, WU + koff, DM, K, m0, n0, c.fr, c.fq, acc);
#pragma unroll
            for (int i = 0; i < 2; ++i)
#pragma unroll
                for (int j = 0; j < 4; ++j) { const f32x4 g = unpk4(*(const u32x2*)(GT + (size_t)(m0 + 16 * i + c.fr) * (3 * DM) + seg * DM + n0 + 16 * j + 4 * c.fq)); tot[i][j] += g * acc[i][j]; }
        }
#pragma unroll
        for (int i = 0; i < 2; ++i)
#pragma unroll
            for (int j = 0; j < 4; ++j) *(u32x2*)(MG + (size_t)(m0 + 16 * i + c.fr) * DM + n0 + 16 * j + 4 * c.fq) = pk4(tot[i][j]);
    }
}

__device__ __forceinline__ void phase_rowstat(const Params& p, const Ctx& c) {
    float* RS = (float*)(p.ws + WS_RSTD2);
    for (int m = c.gw; m < MTOK; m += c.ngw) {
        const f32x4* xr = (const f32x4*)(p.out + (size_t)m * DM) + c.lane; float s = 0.f;
#pragma unroll
        for (int j = 0; j < 4; ++j) { const f32x4 v = xr[64 * j]; s += (v[0] * v[0] + v[1] * v[1]) + (v[2] * v[2] + v[3] * v[3]); }
        s = wave_sum(s);
        if (c.lane == 0) RS[m] = rsqrtf(s * (1.f / DM) + NORM_EPS);
    }
}
__device__ __forceinline__ void phase_final_norm(const Params& p, const Ctx& c) {
    const float* g = p.in[I_NFING];
    for (int m = c.gw; m < MTOK; m += c.ngw) {
        f32x4* xr = (f32x4*)(p.out + (size_t)m * DM) + c.lane; const f32x4* gr = (const f32x4*)g + c.lane;
        f32x4 v[4]; float s = 0.f;
#pragma unroll
        for (int j = 0; j < 4; ++j) { v[j] = xr[64 * j]; s += (v[j][0] * v[j][0] + v[j][1] * v[j][1]) + (v[j][2] * v[j][2] + v[j][3] * v[j][3]); }
        const float rstd = rsqrtf(wave_sum(s) * (1.f / DM) + NORM_EPS);
#pragma unroll
        for (int j = 0; j < 4; ++j) xr[64 * j] = v[j] * rstd * gr[64 * j];
    }
}

constexpr int NPHASES = 15;
__global__ void __launch_bounds__(NTHREADS, 2) fwd_kernel(Params p) {
    extern __shared__ __attribute__((aligned(16))) unsigned char lds_raw[];
    Ctx c; c.tid = threadIdx.x; c.lane = c.tid & 63; c.wave = __builtin_amdgcn_readfirstlane(c.tid >> 6); c.fr = c.lane & 15; c.fq = c.lane >> 4;
    c.gw = blockIdx.x * NWAVES + c.wave; c.ngw = gridDim.x * NWAVES; c.lds = (LAS unsigned char*)lds_raw;
    unsigned char* ws = p.ws;
#if ONE_LAUNCH
    cg::grid_group grid = cg::this_grid();
    volatile LAS unsigned* misc = (volatile LAS unsigned*)(c.lds + LDS_MISC_OFF);
    if (c.tid < 4) misc[c.tid] = 0u;
    __syncthreads();
    const XcdBarrier xbar = xcd_barrier_post((unsigned*)(ws + WS_BAR), misc);
    bool first_seam = true;
#define SEAM() do { if (first_seam) { grid.sync(); first_seam = false; } else xcd_barrier(xbar); } while (0)
#else
#define SEAM() do {} while (0)
#endif
#define IN(k) (p.ph_lo <= (k) && (k) < p.ph_hi)
#define END(k) do { if (IN((k) + 1)) SEAM(); } while (0)
#define REP_ON(k) ((REP_MASK >> (k)) & 1u)
#define PHASE(k, ...) if (IN(k)) { __VA_ARGS__ if (REP_ON(k)) { SEAM(); __VA_ARGS__ } END(k); }
    PHASE(0, phase_prologue(p, c);)
    PHASE(1,
        gemm_pg8_8(c, (const bf16_t*)(ws + WS_H), DM, (const bf16_t*)(ws + WS_WG1T), DM, MTOK, MIXIN, DM, F8Store{(bf16_t*)(ws + WS_P), MIXIN});
        gemm_simple(c, (const bf16_t*)(ws + WS_MEMN), DM, (const bf16_t*)(ws + WS_WKVT), DM, BATCH * NMEM, 512, DM, EpiKV{(bf16_t*)(ws + WS_KB), (bf16_t*)(ws + WS_VT)});)
    PHASE(2, phase_mix(p, c); phase_pooldiff(p, c); phase_memattn(p, c);)
    PHASE(3,
        gemm_simple(c, (const bf16_t*)(ws + WS_LW), 64, (const bf16_t*)(ws + WS_WLWT), 64, MTOK, RD, 64, EpiDecay{(float*)(ws + WS_W), p.in[I_W0]});
        gemm_simple(c, (const bf16_t*)(ws + WS_LA), 64, (const bf16_t*)(ws + WS_WLAT), 64, MTOK, RD, 64, EpiSigBias{(bf16_t*)(ws + WS_AA), RD, p.in[I_A0]});
        gemm_simple(c, (const bf16_t*)(ws + WS_LG), 128, (const bf16_t*)(ws + WS_WLGT), 128, MTOK, RD, 128, EpiBf16{(bf16_t*)(ws + WS_G), RD});
        _Pragma("unroll 1") for (int gi = 0; gi < 4; ++gi)
            gemm_simple(c, (const bf16_t*)(ws + WS_DPOOL) + 64 * gi, 256, (const bf16_t*)(ws + WS_WPT) + 4096 * gi, 64, MTOK, 64, 64, EpiPool{(bf16_t*)(ws + WS_YCAT), p.in[I_POOLS], gi});)
    PHASE(4, phase_prep2(p, c);)
    PHASE(5, phase_scan(p, c);)
    PHASE(6, phase_post(p, c);)
    PHASE(7,
        gemm_pg8_8(c, (const bf16_t*)(ws + WS_H), DM, (const bf16_t*)(ws + WS_WG1T) + (size_t)MIXIN * DM, DM, MTOK, 3 * DM, DM, F8SigBias{(bf16_t*)(ws + WS_GATES), 3 * DM, p.in[I_BGATE]});)
    PHASE(8, {
        pg8::Gemm g{(const bf16_t*)(ws + WS_YCAT), (const bf16_t*)(ws + WS_WUPT), MTOK, DM, DM, DM, DM}; pg8::StaticOrder S; S.init(MTOK, DM, (int)gridDim.x, (int)blockIdx.x);
        EpiFn8<F8UpFinal> E{F8UpFinal{(bf16_t*)(ws + WS_MERGED), (const bf16_t*)(ws + WS_GATES)}};
        pg8::gemm_phase_h<EpiFn8<F8UpFinal>, pg8::StaticOrder, true, true, UpHook>(c.lds, g, S, E, UpHook{(const bf16_t*)(ws + WS_GATES)}); })
    PHASE(9,
        gemm_pg8_4(c, (const bf16_t*)(ws + WS_MERGED), DM, (const bf16_t*)(ws + WS_WOT), DM, MTOK, DM, DM, EpiOut{p.in[I_X], p.out, (bf16_t*)(ws + WS_X1B)});)
    PHASE(10, phase_rowstat(p, c);)
    PHASE(11, {
        pg8::Gemm g{(const bf16_t*)(ws + WS_X1B), (const bf16_t*)(ws + WS_WF1T), MTOK, 2 * FF, DM, DM, DM}; pg8::StaticOrder S; S.init(MTOK, 2 * FF, (int)gridDim.x, (int)blockIdx.x);
        EpiFfnAct E{(bf16_t*)(ws + WS_ACT), (const float*)(ws + WS_RSTD2), p.in[I_CONVW], p.in[I_CONVB], (float*)(ws + WS_TAILU), (float*)(ws + WS_HEADU), (float*)(ws + WS_HEADGV), (LAS float*)(c.lds + LDS_HALO_OFF)};
        pg8::gemm_phase<EpiFfnAct, pg8::StaticOrder, true, true>(c.lds, g, S, E); })
    PHASE(12, phase_ffn_fix(p, c);)
    PHASE(13,
        gemm_pg8_4(c, (const bf16_t*)(ws + WS_ACT), FF, (const bf16_t*)(ws + WS_WF2T), FF, MTOK, DM, FF, EpiAddOut{p.out});)
    if (IN(14)) { phase_final_norm(p, c); }
#undef IN
#undef END
}

__global__ void nan_fill(float* o, int n) { const int i = blockIdx.x * blockDim.x + threadIdx.x; if (i < n) o[i] = __builtin_nanf(""); }

extern "C" void kernel_launch(void* const* d_in, const int* in_sizes, int n_in, void* d_out, int out_size, void* d_ws, size_t ws_size, hipStream_t stream) {
    static int grid = 0;
    if (grid == 0) {
        int dev = 0, cus = 0, per_cu = 0;
        if (hipGetDevice(&dev) != hipSuccess || hipDeviceGetAttribute(&cus, hipDeviceAttributeMultiprocessorCount, dev) != hipSuccess) cus = 256;
        (void)hipFuncSetAttribute((const void*)fwd_kernel, hipFuncAttributeMaxDynamicSharedMemorySize, LDS_BYTES);
        if (hipOccupancyMaxActiveBlocksPerMultiprocessor(&per_cu, (const void*)fwd_kernel, NTHREADS, LDS_BYTES) != hipSuccess || per_cu < 1) per_cu = 1;
        (void)hipGetLastError();
        grid = cus;
        if (n_in != 31 || out_size != MTOK * DM || ws_size < WS_END) grid = -1;
    }
    if (grid < 0) { nan_fill<<<(out_size + 255) / 256, 256, 0, stream>>>((float*)d_out, out_size); return; }
    Params p{};
    for (int i = 0; i < 31; ++i) p.in[i] = (const float*)d_in[i];
    p.out = (float*)d_out; p.ws = (unsigned char*)d_ws;
#if ONE_LAUNCH
    (void)hipMemsetAsync((unsigned char*)d_ws + WS_BAR, 0, WS_CTL_BYTES, stream);
    p.ph_lo = 0; p.ph_hi = NPHASES;
    void* args[] = {&p};
    hipError_t e = hipLaunchCooperativeKernel((const void*)fwd_kernel, dim3(grid), dim3(NTHREADS), args, LDS_BYTES, stream);
    if (e != hipSuccess) fprintf(stderr, "cooperative launch failed: %s (grid %d)\n", hipGetErrorString(e), grid);
#else
    for (int ph = 0; ph < NPHASES; ++ph) { p.ph_lo = ph; p.ph_hi = ph + 1; hipLaunchKernelGGL(fwd_kernel, dim3(grid), dim3(NTHREADS), LDS_BYTES, stream, p); }
#endif
}
```

```cpp
#include <hip/hip_runtime.h>
#include <hip/hip_cooperative_groups.h>
#include <cstdio>
#include <cstdint>
namespace cg = cooperative_groups;

#ifndef ONE_LAUNCH
#define ONE_LAUNCH 1
#endif
#ifndef PH_MASK
#define PH_MASK 0xFFFFFFFFu
#endif
#define PH_ON(k) ((PH_MASK >> (k)) & 1u)
#ifndef REP_MASK
#define REP_MASK 0u
#endif

#define LAS __attribute__((address_space(3)))
typedef unsigned short bf16_t;
typedef short bf16x8 __attribute__((ext_vector_type(8)));
typedef float f32x4 __attribute__((ext_vector_type(4)));
typedef float f32x2 __attribute__((ext_vector_type(2)));
typedef unsigned u32x4 __attribute__((ext_vector_type(4)));
typedef unsigned u32x2 __attribute__((ext_vector_type(2)));

constexpr int BATCH = 8, SEQ = 4096, DM = 1024, MTOK = BATCH * SEQ;
constexpr int NMEM = 256, RD = 512, MIXIN = 2304, RWKVIN = 1792, FF = 2816, NG1 = MIXIN + 3 * DM;
constexpr int NWAVES = 8, NTHREADS = 512;
constexpr float NORM_EPS = 1e-6f, GN_EPS = 64e-5f;

constexpr size_t MiB = 1u << 20;
constexpr size_t WS_WG1T = 1 * MiB;
constexpr size_t WS_WKVT = WS_WG1T + (size_t)NG1 * DM * 2;
constexpr size_t WS_WUPT = WS_WKVT + (size_t)512 * DM * 2;
constexpr size_t WS_WOT = WS_WUPT + (size_t)DM * DM * 2;
constexpr size_t WS_WF1T = WS_WOT + (size_t)DM * DM * 2;
constexpr size_t WS_WF2T = WS_WF1T + (size_t)2 * FF * DM * 2;
constexpr size_t WS_WLWT = WS_WF2T + (size_t)DM * FF * 2;
constexpr size_t WS_WLAT = WS_WLWT + (size_t)RD * 64 * 2;
constexpr size_t WS_WLGT = WS_WLAT + (size_t)RD * 64 * 2;
constexpr size_t WS_WPT = WS_WLGT + (size_t)RD * 128 * 2;
constexpr size_t WS_WEND = WS_WPT + (size_t)4 * 64 * 64 * 2;
static_assert(WS_WEND <= 34 * MiB, "weights region");
constexpr size_t WS_BONUS = 34 * MiB;
constexpr size_t WS_RSTD2 = 35 * MiB;
constexpr size_t WS_KB = 36 * MiB;
constexpr size_t WS_VT = 37 * MiB;
constexpr size_t WS_MEMN = 38 * MiB;
constexpr size_t WS_H = 42 * MiB;
constexpr size_t WS_YCAT = 106 * MiB;
constexpr size_t WS_P = 170 * MiB;
constexpr size_t WS_W = 170 * MiB;
constexpr size_t WS_G = 234 * MiB;
constexpr size_t WS_AA = 266 * MiB;
constexpr size_t WS_KRAW = 314 * MiB;
constexpr size_t WS_YRAW = 266 * MiB;
constexpr size_t WS_R = 346 * MiB;
constexpr size_t WS_V = 378 * MiB;
constexpr size_t WS_LW = 410 * MiB;
constexpr size_t WS_LA = 414 * MiB;
constexpr size_t WS_LG = 418 * MiB;
constexpr size_t WS_DPOOL = 426 * MiB;
constexpr size_t WS_SP = 442 * MiB;
constexpr size_t WS_GATES = 170 * MiB;
constexpr size_t WS_MERGED = 362 * MiB;
constexpr size_t WS_X1B = 426 * MiB;
constexpr size_t WS_TAILU = 42 * MiB, WS_HEADU = 45 * MiB, WS_HEADGV = 48 * MiB;
constexpr size_t WS_ACT = 218 * MiB;
constexpr size_t WS_END = 490 * MiB;
constexpr size_t DO_RTT = 0, DO_MTT = 32 * MiB, DO_Y0D = 64 * MiB, DO_ND = 96 * MiB;

constexpr int LDS_BYTES = 147456;
constexpr int LDS_HALO_OFF = 131072 + 1024;
constexpr int LDS_MISC_OFF = 131072 + 320;
constexpr size_t WS_BAR = 0, WS_CTL_BYTES = 65536;

__device__ __forceinline__ unsigned f2bf(float f) { unsigned u = __float_as_uint(f); return (u + 0x7fffu + ((u >> 16) & 1u)) >> 16; }
__device__ __forceinline__ float bf2f(unsigned h) { return __uint_as_float(h << 16); }
__device__ __forceinline__ unsigned pk2(float lo, float hi) { return f2bf(lo) | (f2bf(hi) << 16); }
__device__ __forceinline__ u32x2 pk4(f32x4 v) { u32x2 r; r.x = pk2(v[0], v[1]); r.y = pk2(v[2], v[3]); return r; }
__device__ __forceinline__ f32x4 unpk4(u32x2 u) { f32x4 r; r[0] = bf2f(u.x & 0xffffu); r[1] = bf2f(u.x >> 16); r[2] = bf2f(u.y & 0xffffu); r[3] = bf2f(u.y >> 16); return r; }
__device__ __forceinline__ float wave_sum(float v) {
#pragma unroll
    for (int o = 1; o < 64; o <<= 1) v += __shfl_xor(v, o);
    return v;
}
__device__ __forceinline__ float sigmoidf_(float x) { return 1.0f / (1.0f + __expf(-x)); }
template <int CTRL> __device__ __forceinline__ float dpp_f(float x) { return __builtin_bit_cast(float, __builtin_amdgcn_update_dpp(0, __builtin_bit_cast(int, x), CTRL, 0xF, 0xF, false)); }
__device__ __forceinline__ float row_sum16(float x) {
    x += dpp_f<0xB1>(x);
    x += dpp_f<0x4E>(x);
    x += dpp_f<0x141>(x);
    x += dpp_f<0x140>(x);
    return x;
}

#define XB_TMO      128
#define XB_XCNT(j)  (256  + 64 * (j))
#define XB_XSUB(j)  (1280 + 64 * (j))
#define XB_XGEN(j)  (2304 + 64 * (j))
#define XB_TOP      3328
#define XB_TOPGEN   3392
#define XCD_BAR_WORDS 3456
#define XB_SPIN_CAP (1u << 18)

__device__ __forceinline__ unsigned xb_ld(unsigned* p)              { return __hip_atomic_load(p, __ATOMIC_RELAXED, __HIP_MEMORY_SCOPE_AGENT); }
__device__ __forceinline__ unsigned xb_add(unsigned* p, unsigned v) { return __hip_atomic_fetch_add(p, v, __ATOMIC_RELAXED, __HIP_MEMORY_SCOPE_AGENT); }
__device__ __forceinline__ unsigned xb_xcc_id() { return (unsigned)__builtin_amdgcn_s_getreg((3 << 11) | 20) & 0xFu; }
#define XB_SPIN(cond, bar) do { unsigned _sp = 0; while (cond) { __builtin_amdgcn_s_sleep(1); \
    if ((++_sp & 255u) == 0u) { if (xb_ld(&(bar)[XB_TMO])) break; if (_sp > XB_SPIN_CAP) { atomicAdd(&(bar)[XB_TMO], 1u); break; } } } } while (0)

struct XcdBarrier {
    unsigned* bar; unsigned x;
    volatile LAS unsigned* st;
};

__device__ __forceinline__ XcdBarrier xcd_barrier_post(unsigned* bar, volatile LAS unsigned* st) {
    XcdBarrier b; b.bar = bar; b.x = xb_xcc_id(); b.st = st;
    if (threadIdx.x == 0) (void)xb_add(&bar[XB_XCNT(b.x)], 1u);
    return b;
}
__device__ __forceinline__ void xcd_barrier_complete(unsigned* bar, unsigned x, unsigned& nloc, unsigned& nx) {
    const unsigned G = gridDim.x * gridDim.y * gridDim.z;
    unsigned sum, cnt, mine, sp = 0u;
    for (;;) {
        sum = 0u; cnt = 0u; mine = 0u;
#pragma unroll
        for (unsigned j = 0; j < 16; ++j) { const unsigned c = xb_ld(&bar[XB_XCNT(j)]); sum += c; cnt += (c > 0u) ? 1u : 0u; mine = (j == x) ? c : mine; }
        if (sum == G) break;
        __builtin_amdgcn_s_sleep(1);
        if ((++sp & 255u) == 0u) { if (xb_ld(&bar[XB_TMO])) break; if (sp > XB_SPIN_CAP) { atomicAdd(&bar[XB_TMO], 1u); break; } }
    }
    nloc = mine > 0u ? mine : 1u; nx = cnt > 0u ? cnt : 1u;
}

__device__ __forceinline__ void xcd_barrier(const XcdBarrier& b) {
    asm volatile("s_waitcnt vmcnt(0)" ::: "memory");
    __syncthreads();
    if (threadIdx.x == 0) {
        unsigned* bar = b.bar;
        __builtin_amdgcn_s_waitcnt(0);
        unsigned nloc = b.st[0], nx = b.st[1];
        if (nloc == 0u) { xcd_barrier_complete(bar, b.x, nloc, nx); b.st[0] = nloc; b.st[1] = nx; }
        const unsigned old = xb_add(&bar[XB_XSUB(b.x)], 1u);
        const unsigned gen = old / nloc;
        if (old + 1u == (gen + 1u) * nloc) {
            __builtin_amdgcn_fence(__ATOMIC_RELEASE, "agent");
            asm volatile("s_waitcnt vmcnt(0)" ::: "memory");
            const unsigned og = xb_add(&bar[XB_TOP], 1u);
            const unsigned tg = og / nx;
            if (og + 1u == (tg + 1u) * nx) xb_add(&bar[XB_TOPGEN], 1u);
            else XB_SPIN(xb_ld(&bar[XB_TOPGEN]) == tg, bar);
            __builtin_amdgcn_fence(__ATOMIC_ACQUIRE, "agent");
            xb_add(&bar[XB_XGEN(b.x)], 1u);
            asm volatile("s_waitcnt vmcnt(0)" ::: "memory");
        } else {
            XB_SPIN(xb_ld(&bar[XB_XGEN(b.x)]) == gen, bar);
            __builtin_amdgcn_fence(__ATOMIC_ACQUIRE, "agent");
            asm volatile("s_waitcnt vmcnt(0)" ::: "memory");
        }
    }
    __syncthreads();
}


struct Params { const float* in[31]; float* out; unsigned char* ws; int ph_lo, ph_hi; };
enum { I_X = 0, I_MEM, I_NMIXG, I_WINMIX, I_MU, I_W0, I_WLORAB, I_A0, I_ALORAB, I_GLORAB, I_KK, I_KA, I_RK, I_LNW, I_LNB, I_POOLW, I_POOLS, I_NMEMG, I_WMEMKV,
       I_WUPR, I_WUPP, I_WUPM, I_WGATE, I_BGATE, I_WO, I_NFFNG, I_WFFNIN, I_CONVW, I_CONVB, I_WFFNOUT, I_NFING };

struct Ctx { int tid, lane, wave, fr, fq, gw, ngw; LAS unsigned char* lds; };

__device__ __forceinline__ int rowmap(int mode, int n) {
    if (mode == 0) return n;
    const int half = n >= FF ? 1 : 0, c = n - half * FF;
    return (c >> 7) * 256 + half * 128 + (c & 127);
}
__device__ __forceinline__ void transpose_item(const float* W, int K, int N, bf16_t* WT, int ldd, int koff, int mode, const float* kscale, LAS float* scr, int item, int lane) {
    const int nblk = N / 32, kb = item / nblk, nb = item % nblk, k0 = 64 * kb, n0 = 32 * nb;
#pragma unroll 8
    for (int i = 0; i < 32; ++i) { const int kk = 2 * i + (lane >> 5); float v = W[(size_t)(k0 + kk) * N + n0 + (lane & 31)]; if (kscale) v *= kscale[k0 + kk]; scr[kk * 33 + (lane & 31)] = v; }
    asm volatile("s_waitcnt lgkmcnt(0)" ::: "memory");
    const int c = lane & 7;
#pragma unroll
    for (int j = 0; j < 4; ++j) { const int n = (lane >> 3) + 8 * j; const LAS float* s = scr + (8 * c) * 33 + n;
        u32x4 o; o.x = pk2(s[0 * 33], s[1 * 33]); o.y = pk2(s[2 * 33], s[3 * 33]); o.z = pk2(s[4 * 33], s[5 * 33]); o.w = pk2(s[6 * 33], s[7 * 33]);
        *(u32x4*)(WT + (size_t)rowmap(mode, n0 + n) * ldd + koff + k0 + 8 * c) = o; }
    asm volatile("s_waitcnt lgkmcnt(0)" ::: "memory");
}
__device__ __forceinline__ void rmsnorm_row_bf16(const float* xrow, const float* g, bf16_t* orow, int lane) {
    const f32x4* xr = (const f32x4*)xrow + lane; const f32x4* gr = (const f32x4*)g + lane;
    f32x4 v[4]; float s = 0.f;
#pragma unroll
    for (int j = 0; j < 4; ++j) { v[j] = xr[64 * j]; s += (v[j][0] * v[j][0] + v[j][1] * v[j][1]) + (v[j][2] * v[j][2] + v[j][3] * v[j][3]); }
    const float rstd = rsqrtf(wave_sum(s) * (1.f / DM) + NORM_EPS);
    u32x2* o = (u32x2*)orow + lane;
#pragma unroll
    for (int j = 0; j < 4; ++j) { const f32x4 gg = gr[64 * j]; o[64 * j] = pk4(v[j] * rstd * gg); }
}

__device__ __forceinline__ void phase_prologue(const Params& p, const Ctx& c) {
    LAS float* scr = (LAS float*)(c.lds + c.wave * 16384);
    unsigned char* ws = p.ws;
#define TR(Wp, K_, N_, WTp, ldd_, koff_, mode_, sc_) { const int ni_ = ((K_) / 64) * ((N_) / 32); if (r < ni_) { transpose_item(Wp, K_, N_, (bf16_t*)(WTp), ldd_, koff_, mode_, sc_, scr, r, c.lane); continue; } r -= ni_; }
    constexpr int NIT = (DM / 64) * (MIXIN / 32) + (DM / 64) * (3 * DM / 32) + (DM / 64) * (512 / 32) + (512 / 64) * (DM / 32) + 2 * (256 / 64) * (DM / 32) + (DM / 64) * (DM / 32)
                      + (DM / 64) * (2 * FF / 32) + (FF / 64) * (DM / 32) + 2 * (RD / 32) + 2 * (RD / 32) + 4 * 2;
    for (int it = c.gw; it < NIT; it += c.ngw) {
        int r = it;
        TR(p.in[I_WINMIX], DM, MIXIN, ws + WS_WG1T, DM, 0, 0, nullptr)
        TR(p.in[I_WGATE], DM, 3 * DM, ws + WS_WG1T + (size_t)MIXIN * DM * 2, DM, 0, 0, nullptr)
        TR(p.in[I_WMEMKV], DM, 512, ws + WS_WKVT, DM, 0, 0, nullptr)
        TR(p.in[I_WUPR], 512, DM, ws + WS_WUPT, DM, 0, 0, nullptr)
        TR(p.in[I_WUPP], 256, DM, ws + WS_WUPT, DM, 512, 0, nullptr)
        TR(p.in[I_WUPM], 256, DM, ws + WS_WUPT, DM, 768, 0, nullptr)
        TR(p.in[I_WO], DM, DM, ws + WS_WOT, DM, 0, 0, nullptr)
        TR(p.in[I_WFFNIN], DM, 2 * FF, ws + WS_WF1T, DM, 0, 1, p.in[I_NFFNG])
        TR(p.in[I_WFFNOUT], FF, DM, ws + WS_WF2T, FF, 0, 0, nullptr)
        TR(p.in[I_WLORAB], 64, RD, ws + WS_WLWT, 64, 0, 0, nullptr)
        TR(p.in[I_ALORAB], 64, RD, ws + WS_WLAT, 64, 0, 0, nullptr)
        TR(p.in[I_GLORAB], 128, RD, ws + WS_WLGT, 128, 0, 0, nullptr)
        TR(p.in[I_POOLW] + 0 * 4096, 64, 64, ws + WS_WPT + 0 * 8192, 64, 0, 0, nullptr)
        TR(p.in[I_POOLW] + 1 * 4096, 64, 64, ws + WS_WPT + 1 * 8192, 64, 0, 0, nullptr)
        TR(p.in[I_POOLW] + 2 * 4096, 64, 64, ws + WS_WPT + 2 * 8192, 64, 0, 0, nullptr)
        TR(p.in[I_POOLW] + 3 * 4096, 64, 64, ws + WS_WPT + 3 * 8192, 64, 0, 0, nullptr)
    }
#undef TR
    for (int m = c.gw; m < MTOK; m += c.ngw) rmsnorm_row_bf16(p.in[I_X] + (size_t)m * DM, p.in[I_NMIXG], (bf16_t*)(ws + WS_H) + (size_t)m * DM, c.lane);
    for (int m = c.gw; m < BATCH * NMEM; m += c.ngw) rmsnorm_row_bf16(p.in[I_MEM] + (size_t)m * DM, p.in[I_NMEMG], (bf16_t*)(ws + WS_MEMN) + (size_t)m * DM, c.lane);
}

namespace pg8 {
#define PG8_LAS __attribute__((address_space(3)))
typedef unsigned short bf16_t;
typedef short bf16x8 __attribute__((ext_vector_type(8)));
typedef float f32x4 __attribute__((ext_vector_type(4)));
typedef unsigned u32x4 __attribute__((ext_vector_type(4)));
constexpr int BM = 256, BK = 64, HALF = 128, HTB = HALF * BK * 2  , STAGE_BYTES = 8 * HTB, NXCD = 8, WGM = 8;

__host__ __device__ __forceinline__ int lds_byte(int r, int c) { const int st = (r >> 4) * 2 + (c >> 5), rr = r & 15, cc = c & 31, ob = rr * 64 + cc * 2; return st * 1024 + (ob ^ (((ob >> 9) & 1) << 5)); }
__host__ __device__ __forceinline__ void stage_rc(int b, int& R, int& C) { const int st = b / 1024, sb = b % 1024, swz = sb ^ (((sb >> 9) & 1) << 5); R = (st >> 1) * 16 + swz / 64; C = (st & 1) * 32 + (swz % 64) / 2; }
__host__ __device__ __forceinline__ int perm32(int rho) { const int n = rho >> 4, i = rho & 15; return 8 * (i >> 2) + 4 * n + (i & 3); }

struct Unit { int pm, pn; };
struct Gemm { const bf16_t* A; const bf16_t* Bt; int M, N, K, lda, ldb; };

struct StaticOrder {
    int nM, nN, nwg, G, c;
    __host__ __device__ void init(int M, int N, int G_, int c_) { nM = M / BM; nN = N / BM; nwg = nM * nN; G = G_; c = c_; }
    __host__ __device__ bool next(int i, Unit& u) const {
        const long L = (long)i * G + c; if (L >= nwg) return false;
        int wgid = (int)L; { const int q = nwg / NXCD, r = nwg % NXCD, xcd = wgid % NXCD, off = wgid / NXCD; wgid = (xcd < r ? xcd * (q + 1) : r * (q + 1) + (xcd - r) * q) + off; }
        const int nig = WGM * nN, gid = wgid / nig, fm = gid * WGM, gsz = (nM - fm) < WGM ? (nM - fm) : WGM;
        u.pm = fm + ((wgid % nig) % gsz); u.pn = (wgid % nig) / gsz; return true;
    }
    __device__ __forceinline__ void a_ready(const Unit&) const {}
    __device__ __forceinline__ void done(const Unit&) const {}
};


struct NoHook { __device__ __forceinline__ void operator()(f32x4 (&)[2][2][4][2], const Unit&, int, int, int, int, int) const {} };
template <class Epi, class Sched, bool ALIGN_EPI, bool SP2, class Hook>
__device__ __forceinline__ void gemm_phase_h(PG8_LAS unsigned char* lds, const Gemm g, const Sched& S, const Epi& E, const Hook& H) {
    int tid_ = threadIdx.x; asm volatile("" : "+v"(tid_));
    const int tid = tid_, wid = __builtin_amdgcn_readfirstlane(tid >> 6), lane = tid & 63, wr = wid >> 2, wc = wid & 3, fr = lane & 15, fq = lane >> 4;
    const int K = g.K, nt = K / BK;
    unsigned voffA[2], voffB[2];
#pragma unroll
    for (int i = 0; i < 2; ++i) { int R, C; stage_rc(tid * 16 + i * 8192, R, C); const int Rb = Epi::PERM ? ((R & ~31) + perm32(R & 31)) : R;
        voffA[i] = (unsigned)(R * g.lda + C) * 2u; voffB[i] = (unsigned)(Rb * g.ldb + C) * 2u; }
    const size_t kstep = (size_t)(BK * 2);
    const size_t hstepA = (size_t)HALF * g.lda * 2, hstepB = (size_t)HALF * g.ldb * 2;
    const size_t tstepA = 2 * hstepA, tstepB = 2 * hstepB;
    const unsigned ldsw = (unsigned)wid * 1024u;
    const int aoff = lds_byte(wr * 64 + fr, fq * 8), boff = lds_byte(wc * 32 + fr, fq * 8);
#define PG8_SA(b, h) (((b) * 2 + (h)) * HTB)
#define PG8_SB(b, h) ((4 + (b) * 2 + (h)) * HTB)
#define PG8_STAGE(bufoff, gbase, voff) do { _Pragma("unroll") for (int _i = 0; _i < 2; ++_i) \
        __builtin_amdgcn_global_load_lds((const unsigned*)((const char*)(gbase) + (voff)[_i]), (PG8_LAS unsigned*)(lds + (bufoff) + ldsw + _i * 8192), 16, 0, 0); } while (0)
#define PG8_LDA(dst, b, h) do { _Pragma("unroll") for (int m = 0; m < 4; ++m) _Pragma("unroll") for (int k = 0; k < 2; ++k) dst[m][k] = *(const PG8_LAS bf16x8*)(lds + PG8_SA(b, h) + aoff + m * 2048 + k * 1024); } while (0)
#define PG8_LDB(dst, b, h) do { _Pragma("unroll") for (int n = 0; n < 2; ++n) _Pragma("unroll") for (int k = 0; k < 2; ++k) dst[n][k] = *(const PG8_LAS bf16x8*)(lds + PG8_SB(b, h) + boff + n * 2048 + k * 1024); } while (0)
#define PG8_MMA(ai, bj, At, Bt) do { __builtin_amdgcn_s_setprio(1); _Pragma("unroll") for (int m = 0; m < 4; ++m) _Pragma("unroll") for (int n = 0; n < 2; ++n) _Pragma("unroll") for (int k = 0; k < 2; ++k) \
        acc[ai][bj][m][n] = __builtin_amdgcn_mfma_f32_16x16x32_bf16(Bt[n][k], At[m][k], acc[ai][bj][m][n], 0, 0, 0); __builtin_amdgcn_s_setprio(0); } while (0)
#define PG8_WAIT_V(n) asm volatile("s_waitcnt vmcnt(" #n ")" ::: "memory")
#define PG8_WAIT_L(n) asm volatile("s_waitcnt lgkmcnt(" #n ")" ::: "memory")
#define PG8_BAR __builtin_amdgcn_s_barrier()
#define PG8_SCHED __builtin_amdgcn_sched_barrier(0)
    Unit cur, nxt; int ui = 0;
    if (!S.next(0, cur)) return;
    f32x4 acc[2][2][4][2];
#pragma unroll
    for (int a = 0; a < 2; ++a)
#pragma unroll
        for (int b = 0; b < 2; ++b)
#pragma unroll
            for (int m = 0; m < 4; ++m)
#pragma unroll
                for (int n = 0; n < 2; ++n) acc[a][b][m][n] = (f32x4){0.f, 0.f, 0.f, 0.f};
    bf16x8 At[4][2], B0[2][2], B1[2][2];
    const char* cA = (const char*)g.A + (size_t)cur.pm * tstepA; const char* cB = (const char*)g.Bt + (size_t)cur.pn * tstepB;
    S.a_ready(cur);
    if constexpr (SP2) {
        PG8_STAGE(PG8_SB(0, 0), cB, voffB); PG8_STAGE(PG8_SB(0, 1), cB + hstepB, voffB); PG8_STAGE(PG8_SA(0, 0), cA, voffA); PG8_STAGE(PG8_SA(0, 1), cA + hstepA, voffA);
        if (wr == 1) PG8_BAR;
        PG8_WAIT_V(2); PG8_BAR;
        PG8_STAGE(PG8_SB(1, 0), cB + kstep, voffB); PG8_STAGE(PG8_SA(1, 0), cA + kstep, voffA); PG8_STAGE(PG8_SB(1, 1), cB + hstepB + kstep, voffB);
        PG8_WAIT_V(6); PG8_BAR;
    } else {
        PG8_STAGE(PG8_SB(0, 0), cB, voffB); PG8_STAGE(PG8_SA(0, 0), cA, voffA); PG8_STAGE(PG8_SB(0, 1), cB + hstepB, voffB); PG8_STAGE(PG8_SA(0, 1), cA + hstepA, voffA);
        if (wr == 1) PG8_BAR;
        PG8_WAIT_V(4); PG8_BAR;
        PG8_STAGE(PG8_SB(1, 0), cB + kstep, voffB); PG8_STAGE(PG8_SA(1, 0), cA + kstep, voffA); PG8_STAGE(PG8_SB(1, 1), cB + hstepB + kstep, voffB);
        PG8_WAIT_V(6); PG8_BAR;
    }
    for (;;) {
        const bool has_next = S.next(ui + 1, nxt);
        const char* nA = has_next ? (const char*)g.A + (size_t)nxt.pm * tstepA : cA; const char* nB = has_next ? (const char*)g.Bt + (size_t)nxt.pn * tstepB : cB;
        for (int t = 0; t < nt; t += 2) {
            H(acc, cur, t, wr, wc, fr, fq);
            const bool last = (t == nt - 2);
            const char* a1 = cA + (size_t)(t + 1) * kstep;
            const char* a2 = last ? nA : cA + (size_t)(t + 2) * kstep; const char* b2 = last ? nB : cB + (size_t)(t + 2) * kstep;
            const char* a3 = a2 + kstep; const char* b3 = b2 + kstep;
            if (last && has_next) S.a_ready(nxt);
            if constexpr (SP2) {
            PG8_LDB(B0, 0, 0); PG8_LDB(B1, 0, 1); PG8_SCHED; PG8_LDA(At, 0, 0); PG8_STAGE(PG8_SA(1, 1), a1 + hstepA, voffA);
            PG8_WAIT_V(8); PG8_WAIT_L(0); PG8_BAR; PG8_MMA(0, 0, At, B0); PG8_MMA(0, 1, At, B1); PG8_BAR; PG8_SCHED;
            PG8_LDA(At, 0, 1); PG8_STAGE(PG8_SB(0, 0), b2, voffB); PG8_STAGE(PG8_SB(0, 1), b2 + hstepB, voffB); PG8_STAGE(PG8_SA(0, 0), a2, voffA);
            PG8_WAIT_V(8); PG8_WAIT_L(0); PG8_BAR; PG8_MMA(1, 0, At, B0); PG8_MMA(1, 1, At, B1); PG8_BAR; PG8_SCHED;
            PG8_LDB(B0, 1, 0); PG8_LDB(B1, 1, 1); PG8_SCHED; PG8_LDA(At, 1, 0); PG8_STAGE(PG8_SA(0, 1), a2 + hstepA, voffA);
            PG8_WAIT_V(8); PG8_WAIT_L(0); PG8_BAR; PG8_MMA(0, 0, At, B0); PG8_MMA(0, 1, At, B1); PG8_BAR; PG8_SCHED;
            PG8_LDA(At, 1, 1); PG8_STAGE(PG8_SB(1, 0), b3, voffB); PG8_STAGE(PG8_SB(1, 1), b3 + hstepB, voffB); PG8_STAGE(PG8_SA(1, 0), a3, voffA);
            PG8_WAIT_V(8); PG8_WAIT_L(0); PG8_BAR; PG8_MMA(1, 0, At, B0); PG8_MMA(1, 1, At, B1); PG8_BAR; PG8_SCHED;
            } else {
            PG8_LDB(B0, 0, 0); PG8_SCHED; PG8_LDA(At, 0, 0); PG8_STAGE(PG8_SA(1, 1), a1 + hstepA, voffA);
            PG8_WAIT_L(8); PG8_BAR; PG8_WAIT_L(0); PG8_MMA(0, 0, At, B0); PG8_BAR; PG8_SCHED;
            PG8_LDB(B1, 0, 1); PG8_STAGE(PG8_SB(0, 0), b2, voffB);
            PG8_BAR; PG8_WAIT_L(0); PG8_MMA(0, 1, At, B1); PG8_BAR;
            PG8_LDA(At, 0, 1); PG8_STAGE(PG8_SA(0, 0), a2, voffA);
            PG8_BAR; PG8_WAIT_L(0); PG8_MMA(1, 0, At, B0); PG8_BAR; PG8_SCHED;
            PG8_STAGE(PG8_SB(0, 1), b2 + hstepB, voffB);
            PG8_WAIT_V(6); PG8_BAR; PG8_MMA(1, 1, At, B1); PG8_BAR;
            PG8_LDB(B0, 1, 0); PG8_SCHED; PG8_LDA(At, 1, 0); PG8_STAGE(PG8_SA(0, 1), a2 + hstepA, voffA);
            PG8_WAIT_L(8); PG8_BAR; PG8_WAIT_L(0); PG8_MMA(0, 0, At, B0); PG8_BAR; PG8_SCHED;
            PG8_LDB(B1, 1, 1); PG8_STAGE(PG8_SB(1, 0), b3, voffB);
            PG8_BAR; PG8_WAIT_L(0); PG8_MMA(0, 1, At, B1); PG8_BAR;
            PG8_LDA(At, 1, 1); PG8_STAGE(PG8_SA(1, 0), a3, voffA);
            PG8_BAR; PG8_WAIT_L(0); PG8_MMA(1, 0, At, B0); PG8_BAR; PG8_SCHED;
            PG8_STAGE(PG8_SB(1, 1), b3 + hstepB, voffB);
            PG8_WAIT_V(6); PG8_BAR; PG8_MMA(1, 1, At, B1); PG8_BAR;
            }
        }
        if constexpr (ALIGN_EPI) { if (wr == 0) PG8_BAR; }
        if constexpr (!Epi::AFTER_DRAIN) { E(acc, cur, wr, wc, fr, fq); S.done(cur); }
        if (!has_next) break;
#pragma unroll
        for (int a = 0; a < 2; ++a)
#pragma unroll
            for (int b = 0; b < 2; ++b)
#pragma unroll
                for (int m = 0; m < 4; ++m)
#pragma unroll
                    for (int n = 0; n < 2; ++n) acc[a][b][m][n] = (f32x4){0.f, 0.f, 0.f, 0.f};
        cur = nxt; cA = nA; cB = nB; ++ui;
        if constexpr (ALIGN_EPI) { if (wr == 1) PG8_BAR; }
    }
    PG8_WAIT_V(0);
    if constexpr (!ALIGN_EPI) { if (wr == 0) PG8_BAR; }
    PG8_BAR;
    if constexpr (Epi::AFTER_DRAIN) { E.fused(acc, cur, wr, wc, fr, fq, lds, wid, lane); S.done(cur); }
#undef PG8_SA
#undef PG8_SB
#undef PG8_STAGE
#undef PG8_LDA
#undef PG8_LDB
#undef PG8_MMA
#undef PG8_WAIT_V
#undef PG8_WAIT_L
#undef PG8_BAR
#undef PG8_SCHED
}
template <class Epi, class Sched, bool ALIGN_EPI = false, bool SP2 = false>
__device__ __forceinline__ void gemm_phase(PG8_LAS unsigned char* lds, const Gemm g, const Sched& S, const Epi& E) { gemm_phase_h<Epi, Sched, ALIGN_EPI, SP2, NoHook>(lds, g, S, E, NoHook{}); }
}


template <class F> struct EpiFn4 { static constexpr bool PERM = false, AFTER_DRAIN = false; F f;
    __device__ __forceinline__ void operator()(const f32x4 (&acc)[2][2][4][2], const pg8::Unit& u, int wr, int wc, int fr, int fq) const {
        const int row0 = u.pm * 256 + wr * 64 + fr, col0 = u.pn * 256 + wc * 32 + 4 * fq;
#pragma unroll
        for (int ai = 0; ai < 2; ++ai)
#pragma unroll
            for (int m = 0; m < 4; ++m)
#pragma unroll
                for (int bj = 0; bj < 2; ++bj)
#pragma unroll
                    for (int n = 0; n < 2; ++n) f(row0 + ai * 128 + m * 16, col0 + bj * 128 + n * 16, acc[ai][bj][m][n]);
    } };
template <class F> struct EpiFn8 { static constexpr bool PERM = true, AFTER_DRAIN = false; F f;
    __device__ __forceinline__ void operator()(const f32x4 (&acc)[2][2][4][2], const pg8::Unit& u, int wr, int wc, int fr, int fq) const {
        const int row0 = u.pm * 256 + wr * 64 + fr, col0 = u.pn * 256 + wc * 32 + 8 * fq;
#pragma unroll
        for (int ai = 0; ai < 2; ++ai)
#pragma unroll
            for (int m = 0; m < 4; ++m)
#pragma unroll
                for (int bj = 0; bj < 2; ++bj) f(row0 + ai * 128 + m * 16, col0 + bj * 128, acc[ai][bj][m][0], acc[ai][bj][m][1]);
    } };
template <class F> __device__ __forceinline__ void gemm_pg8_4(const Ctx& c, const bf16_t* A, int lda, const bf16_t* Bt, int ldb, int M, int N, int K, const F& f) {
    pg8::Gemm g{A, Bt, M, N, K, lda, ldb}; pg8::StaticOrder S; S.init(M, N, (int)gridDim.x, (int)blockIdx.x); EpiFn4<F> E{f};
    pg8::gemm_phase<EpiFn4<F>, pg8::StaticOrder, true, true>(c.lds, g, S, E);
}
template <class F> __device__ __forceinline__ void gemm_pg8_8(const Ctx& c, const bf16_t* A, int lda, const bf16_t* Bt, int ldb, int M, int N, int K, const F& f) {
    pg8::Gemm g{A, Bt, M, N, K, lda, ldb}; pg8::StaticOrder S; S.init(M, N, (int)gridDim.x, (int)blockIdx.x); EpiFn8<F> E{f};
    pg8::gemm_phase<EpiFn8<F>, pg8::StaticOrder, true, true>(c.lds, g, S, E);
}
__device__ __forceinline__ u32x4 pk8(f32x4 lo, f32x4 hi) { u32x4 w; w.x = pk2(lo[0], lo[1]); w.y = pk2(lo[2], lo[3]); w.z = pk2(hi[0], hi[1]); w.w = pk2(hi[2], hi[3]); return w; }
struct F8Store { bf16_t* O; int ld; __device__ __forceinline__ void operator()(int row, int col, f32x4 lo, f32x4 hi) const { *(u32x4*)(O + (size_t)row * ld + col) = pk8(lo, hi); } };
struct F8SigBias { bf16_t* O; int ld; const float* bias;
    __device__ __forceinline__ void operator()(int row, int col, f32x4 lo, f32x4 hi) const {
        lo += *(const f32x4*)(bias + col); hi += *(const f32x4*)(bias + col + 4);
#pragma unroll
        for (int j = 0; j < 4; ++j) { lo[j] = sigmoidf_(lo[j]); hi[j] = sigmoidf_(hi[j]); }
        *(u32x4*)(O + (size_t)row * ld + col) = pk8(lo, hi); } };
struct UpHook { const bf16_t* GT;
    __device__ __forceinline__ void operator()(f32x4 (&acc)[2][2][4][2], const pg8::Unit& u, int t, int wr, int wc, int fr, int fq) const {
        if (t != 8 && t != 12) return;
        const int sa = (t == 8) ? 0 : 1;
        const bf16_t* gp0 = GT + (size_t)(u.pm * 256 + wr * 64 + fr) * (3 * DM) + sa * DM + u.pn * 256 + wc * 32 + 8 * fq;
#pragma unroll
        for (int ai = 0; ai < 2; ++ai)
#pragma unroll
            for (int m = 0; m < 4; ++m) { const bf16_t* gp = gp0 + (size_t)(ai * 128 + m * 16) * (3 * DM);
#pragma unroll
                for (int bj = 0; bj < 2; ++bj) { const u32x4 ga = *(const u32x4*)(gp + bj * 128), gb = *(const u32x4*)(gp + DM + bj * 128);
                    const f32x4 a0 = unpk4((u32x2){ga.x, ga.y}), a1 = unpk4((u32x2){ga.z, ga.w}), b0 = unpk4((u32x2){gb.x, gb.y}), b1 = unpk4((u32x2){gb.z, gb.w});
#pragma unroll
                    for (int j = 0; j < 4; ++j) { acc[ai][bj][m][0][j] *= a0[j] * __builtin_amdgcn_rcpf(b0[j]); acc[ai][bj][m][1][j] *= a1[j] * __builtin_amdgcn_rcpf(b1[j]); } }
                asm volatile("" ::: "memory"); }
    } };
struct F8UpFinal { bf16_t* MG; const bf16_t* GT;
    __device__ __forceinline__ void operator()(int row, int col, f32x4 lo, f32x4 hi) const {
        const u32x4 g = *(const u32x4*)(GT + (size_t)row * (3 * DM) + 2 * DM + col);
        *(u32x4*)(MG + (size_t)row * DM + col) = pk8(lo * unpk4((u32x2){g.x, g.y}), hi * unpk4((u32x2){g.z, g.w})); } };

__device__ __forceinline__ f32x2 gelu_pk(f32x2 v) {
    const f32x2 av = __builtin_elementwise_abs(v), d = av * 0.2316418882f + 1.0f;
    f32x2 t; t.x = __builtin_amdgcn_rcpf(d.x); t.y = __builtin_amdgcn_rcpf(d.y);
    f32x2 q = t * 0.5307027145f + (-0.7265760135f); q = q * t + 0.7107068705f; q = q * t + (-0.142248368f); q = q * t + 0.127414796f; q = q * t;
    const f32x2 s = (v * v) * (-0.72134752044f);
    f32x2 e; e.x = __builtin_amdgcn_exp2f(s.x); e.y = __builtin_amdgcn_exp2f(s.y);
    const f32x2 m = v * (q * e), r = v - m;
    f32x2 o; o.x = v.x < 0.f ? m.x : r.x; o.y = v.y < 0.f ? m.y : r.y; return o;
}
struct EpiFfnAct { static constexpr bool PERM = true, AFTER_DRAIN = false;
    bf16_t* ACT; const float* rstd; const float* cw; const float* cb; float* TAILU; float* HEADU; float* HEADGV; LAS float* halo;
    __device__ __forceinline__ void operator()(const f32x4 (&acc)[2][2][4][2], const pg8::Unit& u, int wr, int wc, int fr, int fq) const {
        const int ch0 = u.pn * 128 + wc * 32 + 8 * fq, rowt = wr * 64 + fr, grow0 = u.pm * 256 + rowt;
        f32x4 c0[2], c1[2], c2[2], cbv[2];
#pragma unroll
        for (int n = 0; n < 2; ++n) { c0[n] = *(const f32x4*)(cw + ch0 + 4 * n); c1[n] = *(const f32x4*)(cw + FF + ch0 + 4 * n); c2[n] = *(const f32x4*)(cw + 2 * FF + ch0 + 4 * n); cbv[n] = *(const f32x4*)(cb + ch0 + 4 * n); }
#pragma unroll
        for (int ai = 0; ai < 2; ++ai) { const float rs3 = rstd[grow0 + ai * 128 + 48];
            if (fr >= 14) {
#pragma unroll
                for (int n = 0; n < 2; ++n) *(LAS f32x4*)(halo + (((((ai * 2 + wr) * 2 + (fr - 14)) * 4 + wc) * 4 + fq) * 8 + 4 * n)) = acc[ai][0][3][n] * rs3; } }
        asm volatile("s_waitcnt lgkmcnt(0)" ::: "memory"); __builtin_amdgcn_s_barrier(); asm volatile("" ::: "memory");
#pragma unroll
        for (int ai = 0; ai < 2; ++ai) {
            f32x4 r1p[2], r2p[2];
            if (wr == 1 || ai == 1) { const int src = (wr == 1) ? (ai * 2) : ((ai - 1) * 2 + 1);
#pragma unroll
                for (int n = 0; n < 2; ++n) { const f32x4 hv0 = *(const LAS f32x4*)(halo + ((((src * 2 + 0) * 4 + wc) * 4 + fq) * 8 + 4 * n)), hv1 = *(const LAS f32x4*)(halo + ((((src * 2 + 1) * 4 + wc) * 4 + fq) * 8 + 4 * n));
                    r1p[n] = hv1; r2p[n] = (fr == 0) ? hv0 : hv1; } }
            else { r1p[0] = r1p[1] = r2p[0] = r2p[1] = (f32x4){0.f, 0.f, 0.f, 0.f}; }
#pragma unroll
            for (int m = 0; m < 4; ++m) {
                const int grow = grow0 + ai * 128 + 16 * m; const float rs = rstd[grow];
                u32x4 w;
#pragma unroll
                for (int n = 0; n < 2; ++n) {
                    const f32x4 uu = acc[ai][0][m][n] * rs, gg = acc[ai][1][m][n] * rs;
                    f32x4 R1, R2;
#pragma unroll
                    for (int j = 0; j < 4; ++j) { R1[j] = dpp_f<0x121>(uu[j]); R2[j] = dpp_f<0x122>(uu[j]); }
                    const f32x4 p1 = (fr >= 1) ? R1 : r1p[n], p2 = (fr >= 2) ? R2 : r2p[n];
                    r1p[n] = R1; r2p[n] = R2;
                    const f32x4 uc = c0[n] * p2 + c1[n] * p1 + c2[n] * uu + cbv[n];
                    const f32x2 ga = gelu_pk((f32x2){uc[0], uc[1]}), gb = gelu_pk((f32x2){uc[2], uc[3]});
                    const unsigned lo = pk2(ga.x * gg[0], ga.y * gg[1]), hi = pk2(gb.x * gg[2], gb.y * gg[3]);
                    if (n == 0) { w.x = lo; w.y = hi; } else { w.z = lo; w.w = hi; }
                    if (ai == 0 && m == 0) { if (wr == 0 && fr < 2) { const size_t so = (size_t)(u.pm * 2 + fr) * FF + ch0 + 4 * n; *(f32x4*)(HEADU + so) = uu; *(f32x4*)(HEADGV + so) = gg; } }
                    if (ai == 1 && m == 3) { if (wr == 1 && fr >= 14) { const size_t so = (size_t)(u.pm * 2 + (fr - 14)) * FF + ch0 + 4 * n; *(f32x4*)(TAILU + so) = uu; } }
                }
                *(u32x4*)(ACT + (size_t)grow * FF + ch0) = w;
            }
        }
    } };
__device__ __forceinline__ void phase_ffn_fix(const Params& p, const Ctx& c) {
    unsigned char* ws = p.ws;
    const float* TAILU = (const float*)(ws + WS_TAILU); const float* HEADU = (const float*)(ws + WS_HEADU); const float* HEADGV = (const float*)(ws + WS_HEADGV); bf16_t* ACT = (bf16_t*)(ws + WS_ACT);
    const float* cw = p.in[I_CONVW]; const float* cb = p.in[I_CONVB];
    const int nit = (MTOK / 256) * 2 * (FF / 4);
    for (int idx = blockIdx.x * NTHREADS + c.tid; idx < nit; idx += gridDim.x * NTHREADS) {
        const int col = 4 * (idx % (FF / 4)), pr = idx / (FF / 4), pm = pr >> 1, rr = pr & 1;
        if ((pm & 15) == 0) continue;
        const f32x4 u0 = *(const f32x4*)(HEADU + (size_t)(pm * 2 + rr) * FF + col), gg = *(const f32x4*)(HEADGV + (size_t)(pm * 2 + rr) * FF + col);
        const f32x4 t1 = *(const f32x4*)(TAILU + (size_t)((pm - 1) * 2 + 1) * FF + col), t0 = *(const f32x4*)(TAILU + (size_t)((pm - 1) * 2 + 0) * FF + col);
        f32x4 u1, u2; if (rr == 0) { u1 = t1; u2 = t0; } else { u1 = *(const f32x4*)(HEADU + (size_t)(pm * 2) * FF + col); u2 = t1; }
        const f32x4 uc = *(const f32x4*)(cw + col) * u2 + *(const f32x4*)(cw + FF + col) * u1 + *(const f32x4*)(cw + 2 * FF + col) * u0 + *(const f32x4*)(cb + col);
        const f32x2 ga = gelu_pk((f32x2){uc[0], uc[1]}), gb = gelu_pk((f32x2){uc[2], uc[3]});
        u32x2 w; w.x = pk2(ga.x * gg[0], ga.y * gg[1]); w.y = pk2(gb.x * gg[2], gb.y * gg[3]);
        *(u32x2*)(ACT + (size_t)(pm * 256 + rr) * FF + col) = w;
    }
}

__device__ __forceinline__ void wave_gemm_32x64(const bf16_t* A, int lda, const bf16_t* Bt, int ldb, int K, int m0, int n0, int fr, int fq, f32x4 (&acc)[2][4]) {
    const bf16_t* ap = A + (size_t)(m0 + fr) * lda + 8 * fq;
    const bf16_t* bp = Bt + (size_t)(n0 + fr) * ldb + 8 * fq;
    for (int k0 = 0; k0 < K; k0 += 32) {
        const bf16x8 a0 = *(const bf16x8*)(ap + k0), a1 = *(const bf16x8*)(ap + (size_t)16 * lda + k0);
        bf16x8 b[4];
#pragma unroll
        for (int j = 0; j < 4; ++j) b[j] = *(const bf16x8*)(bp + (size_t)(16 * j) * ldb + k0);
#pragma unroll
        for (int j = 0; j < 4; ++j) { acc[0][j] = __builtin_amdgcn_mfma_f32_16x16x32_bf16(b[j], a0, acc[0][j], 0, 0, 0); acc[1][j] = __builtin_amdgcn_mfma_f32_16x16x32_bf16(b[j], a1, acc[1][j], 0, 0, 0); }
    }
}
template <class Epi>
__device__ __forceinline__ void gemm_simple(const Ctx& c, const bf16_t* A, int lda, const bf16_t* Bt, int ldb, int M, int N, int K, const Epi& epi) {
    const int nMt = M / 256, nNt = N / 64, ntiles = nMt * nNt;
    for (int tile = blockIdx.x; tile < ntiles; tile += gridDim.x) {
        const int tm = tile % nMt, tn = tile / nMt, m0 = tm * 256 + c.wave * 32, n0 = tn * 64;
        f32x4 acc[2][4];
#pragma unroll
        for (int i = 0; i < 2; ++i)
#pragma unroll
            for (int j = 0; j < 4; ++j) acc[i][j] = (f32x4){0.f, 0.f, 0.f, 0.f};
        wave_gemm_32x64(A, lda, Bt, ldb, K, m0, n0, c.fr, c.fq, acc);
#pragma unroll
        for (int i = 0; i < 2; ++i)
#pragma unroll
            for (int j = 0; j < 4; ++j) epi(m0 + 16 * i + c.fr, n0 + 16 * j + 4 * c.fq, acc[i][j]);
    }
}

struct EpiBf16 { bf16_t* O; int ld; __device__ __forceinline__ void operator()(int row, int col, f32x4 v) const { *(u32x2*)(O + (size_t)row * ld + col) = pk4(v); } };
struct EpiKV { bf16_t* KB; bf16_t* VT;
    __device__ __forceinline__ void operator()(int row, int col, f32x4 v) const {
        if (col < 256) { *(u32x2*)(KB + (size_t)row * 256 + col) = pk4(v); }
        else { const int cc = col - 256, h = cc >> 6, d = cc & 63, b = row >> 8, key = row & 255;
#pragma unroll
            for (int j = 0; j < 4; ++j) VT[((size_t)((b * 4 + h) * 64 + d + j)) * 256 + key] = (bf16_t)f2bf(v[j]); }
    } };
struct EpiDecay { float* W; const float* w0;
    __device__ __forceinline__ void operator()(int row, int col, f32x4 v) const {
        const f32x4 z = v + *(const f32x4*)(w0 + col); f32x4 o;
#pragma unroll
        for (int j = 0; j < 4; ++j) o[j] = 0.60653065971f * sigmoidf_(z[j]);
        *(f32x4*)(W + (size_t)row * RD + col) = o; } };
struct EpiSigBias { bf16_t* O; int ld; const float* bias;
    __device__ __forceinline__ void operator()(int row, int col, f32x4 v) const {
        const f32x4 z = v + *(const f32x4*)(bias + col); f32x4 o;
#pragma unroll
        for (int j = 0; j < 4; ++j) o[j] = sigmoidf_(z[j]);
        *(u32x2*)(O + (size_t)row * ld + col) = pk4(o); } };
struct EpiPool { bf16_t* Y; const float* scale; int gi;
    __device__ __forceinline__ void operator()(int row, int col, f32x4 v) const {
        const f32x4 s = *(const f32x4*)(scale + 64 * gi + col); *(u32x2*)(Y + (size_t)row * DM + 512 + 64 * gi + col) = pk4(v * s); } };
struct EpiOut { const float* x; float* x1; bf16_t* x1b;
    __device__ __forceinline__ void operator()(int row, int col, f32x4 v) const {
        const size_t off = (size_t)row * DM + col; const f32x4 o = *(const f32x4*)(x + off) + v; *(f32x4*)(x1 + off) = o; *(u32x2*)(x1b + off) = pk4(o); } };
struct EpiAddOut { float* x;
    __device__ __forceinline__ void operator()(int row, int col, f32x4 v) const { const size_t off = (size_t)row * DM + col; *(f32x4*)(x + off) = *(const f32x4*)(x + off) + v; } };

__device__ __forceinline__ void phase_mix(const Params& p, const Ctx& c) {
    unsigned char* ws = p.ws;
    const bf16_t* P = (const bf16_t*)(ws + WS_P); const float* mu = p.in[I_MU];
    bf16_t* R = (bf16_t*)(ws + WS_R); bf16_t* KR = (bf16_t*)(ws + WS_KRAW); bf16_t* V = (bf16_t*)(ws + WS_V);
    bf16_t* LW = (bf16_t*)(ws + WS_LW); bf16_t* LA = (bf16_t*)(ws + WS_LA); bf16_t* LG = (bf16_t*)(ws + WS_LG);
    for (int row = c.gw; row < MTOK; row += c.ngw) {
        const int t = row & (SEQ - 1); const bf16_t* cur = P + (size_t)row * MIXIN;
#pragma unroll
        for (int i = 0; i < 7; ++i) {
            const int col = 4 * c.lane + 256 * i;
            const f32x4 cv = unpk4(*(const u32x2*)(cur + col));
            f32x4 pv = (f32x4){0.f, 0.f, 0.f, 0.f}; if (t > 0) pv = unpk4(*(const u32x2*)(cur - MIXIN + col));
            const f32x4 m4 = *(const f32x4*)(mu + col);
            f32x4 pm = cv + (pv - cv) * m4;
            if (i < 2) *(u32x2*)(R + (size_t)row * RD + col) = pk4(pm);
            else if (i < 4) *(u32x2*)(KR + (size_t)row * RD + (col - 512)) = pk4(pm);
            else if (i < 6) *(u32x2*)(V + (size_t)row * RD + (col - 1024)) = pk4(pm);
            else {
                const int cc = col - 1536;
                if (cc < 64) { f32x4 o; o[0] = tanhf(pm[0]); o[1] = tanhf(pm[1]); o[2] = tanhf(pm[2]); o[3] = tanhf(pm[3]); *(u32x2*)(LW + (size_t)row * 64 + cc) = pk4(o); }
                else if (cc < 128) { *(u32x2*)(LA + (size_t)row * 64 + (cc - 64)) = pk4(pm); }
                else { f32x4 o; o[0] = sigmoidf_(pm[0]); o[1] = sigmoidf_(pm[1]); o[2] = sigmoidf_(pm[2]); o[3] = sigmoidf_(pm[3]); *(u32x2*)(LG + (size_t)row * 128 + (cc - 128)) = pk4(o); }
            }
        }
    }
}
__device__ __forceinline__ void phase_pooldiff(const Params& p, const Ctx& c) {
    unsigned char* ws = p.ws;
    const bf16_t* P = (const bf16_t*)(ws + WS_P); bf16_t* DP = (bf16_t*)(ws + WS_DPOOL);
    const int col = 4 * c.lane, gi = c.lane >> 4, win = 2 << gi;
    for (int row = c.gw; row < MTOK; row += c.ngw) {
        const int t = row & (SEQ - 1); const bf16_t* cur = P + (size_t)row * MIXIN + RWKVIN + col;
        const f32x4 x0 = unpk4(*(const u32x2*)cur); f32x4 s = x0;
        for (int j = 1; j < 16; ++j) if (j < win && j <= t) s += unpk4(*(const u32x2*)(cur - (size_t)j * MIXIN));
        const int cnt = (t + 1) < win ? (t + 1) : win;
        *(u32x2*)(DP + (size_t)row * 256 + col) = pk4(s * (1.0f / (float)cnt) - x0);
    }
}
__device__ __forceinline__ void phase_memattn(const Params& p, const Ctx& c) {
    unsigned char* ws = p.ws;
    const bf16_t* P = (const bf16_t*)(ws + WS_P); const bf16_t* KB = (const bf16_t*)(ws + WS_KB); const bf16_t* VT = (const bf16_t*)(ws + WS_VT); bf16_t* Y = (bf16_t*)(ws + WS_YCAT);
    const int fr = c.fr, fq = c.fq;
    for (int unit = blockIdx.x; unit < BATCH * 4 * 16; unit += gridDim.x) {
        const int qt = unit & 15, h = (unit >> 4) & 3, b = unit >> 6;
#pragma unroll 1
        for (int qg = 0; qg < 2; ++qg) {
            const int row = b * SEQ + qt * 256 + c.wave * 32 + 16 * qg + fr;
            const bf16x8 q0 = *(const bf16x8*)(P + (size_t)row * MIXIN + 2048 + h * 64 + 8 * fq), q1 = *(const bf16x8*)(P + (size_t)row * MIXIN + 2048 + h * 64 + 32 + 8 * fq);
            f32x4 sc[16];
#pragma unroll
            for (int kg = 0; kg < 16; ++kg) {
                const bf16_t* kp = KB + (size_t)(b * 256 + 16 * kg + fr) * 256 + h * 64 + 8 * fq;
                const bf16x8 k0 = *(const bf16x8*)kp, k1 = *(const bf16x8*)(kp + 32);
                f32x4 a = (f32x4){0.f, 0.f, 0.f, 0.f};
                a = __builtin_amdgcn_mfma_f32_16x16x32_bf16(k0, q0, a, 0, 0, 0); a = __builtin_amdgcn_mfma_f32_16x16x32_bf16(k1, q1, a, 0, 0, 0); sc[kg] = a;
                if ((kg & 3) == 3) asm volatile("" ::: "memory");
            }
            float m = -1e30f;
#pragma unroll
            for (int kg = 0; kg < 16; ++kg) m = fmaxf(m, fmaxf(fmaxf(sc[kg][0], sc[kg][1]), fmaxf(sc[kg][2], sc[kg][3])));
            m = fmaxf(m, __shfl_xor(m, 16)); m = fmaxf(m, __shfl_xor(m, 32));
            float l = 0.f;
#pragma unroll
            for (int kg = 0; kg < 16; ++kg)
#pragma unroll
                for (int j = 0; j < 4; ++j) { const float e = __expf((sc[kg][j] - m) * 0.125f); sc[kg][j] = e; l += e; }
            l += __shfl_xor(l, 16); l += __shfl_xor(l, 32);
            const float linv = 1.0f / l;
            f32x4 o[4];
#pragma unroll
            for (int dg = 0; dg < 4; ++dg) o[dg] = (f32x4){0.f, 0.f, 0.f, 0.f};
#pragma unroll
            for (int s = 0; s < 8; ++s) {
                u32x4 w; w.x = pk2(sc[2 * s][0], sc[2 * s][1]); w.y = pk2(sc[2 * s][2], sc[2 * s][3]); w.z = pk2(sc[2 * s + 1][0], sc[2 * s + 1][1]); w.w = pk2(sc[2 * s + 1][2], sc[2 * s + 1][3]);
                const bf16x8 pf = __builtin_bit_cast(bf16x8, w);
#pragma unroll
                for (int dg = 0; dg < 4; ++dg) {
                    const bf16_t* vp = VT + ((size_t)((b * 4 + h) * 64 + 16 * dg + fr)) * 256 + 32 * s + 4 * fq;
                    u32x4 v; const u32x2 lo = *(const u32x2*)vp, hi = *(const u32x2*)(vp + 16); v.x = lo.x; v.y = lo.y; v.z = hi.x; v.w = hi.y;
                    o[dg] = __builtin_amdgcn_mfma_f32_16x16x32_bf16(__builtin_bit_cast(bf16x8, v), pf, o[dg], 0, 0, 0);
                }
                if (s & 1) asm volatile("" ::: "memory");
            }
#pragma unroll
            for (int dg = 0; dg < 4; ++dg) *(u32x2*)(Y + (size_t)row * DM + 768 + h * 64 + 16 * dg + 4 * fq) = pk4(o[dg] * linv);
        }
    }
}

#define MF16(a, b, c) __builtin_amdgcn_mfma_f32_16x16x32_bf16((a), (b), (c), 0, 0, 0)
__device__ __forceinline__ bf16x8 pack4z(f32x4 x) { u32x4 w; w.x = pk2(x[0], x[1]); w.y = pk2(x[2], x[3]); w.z = 0u; w.w = 0u; return __builtin_bit_cast(bf16x8, w); }
__device__ __forceinline__ bf16x8 frag4z(const LAS bf16_t* p) { const u32x2 v = *(const LAS u32x2*)p; u32x4 w; w.x = v.x; w.y = v.y; w.z = 0u; w.w = 0u; return __builtin_bit_cast(bf16x8, w); }
__device__ __forceinline__ bf16x8 raw4z(u32x2 v) { u32x4 w; w.x = v.x; w.y = v.y; w.z = 0u; w.w = 0u; return __builtin_bit_cast(bf16x8, w); }
__device__ __forceinline__ float sum8(float x) { x += dpp_f<0xB1>(x); x += dpp_f<0x4E>(x); x += dpp_f<0x141>(x); return x; }
constexpr int CH = 64, NCHUNK = SEQ / CH, NTASK = BATCH * 8 * NCHUNK;
constexpr int RS = 72;
constexpr int S1_QK = 0, S1_QR = 9216, S1_QB = 18432, S1_QKH = 27648, S1_BTN = 36864, S1_KHT = 46080, S1_VT = 55296;
constexpr int S1_AAB = 64512, S1_AAK = 73728, S1_ARB = 82944, S1_ARK = 92160, S1_EC = 101376, S1_DG = 117760, S1_DI = 121856, S1_GC = 124928, S1_SEG = 125184;
constexpr int DIS = 24;
__device__ __forceinline__ void phase_s1(const Params& p, const Ctx& c) {
    unsigned char* ws = p.ws;
    const bf16_t* R = (const bf16_t*)(ws + WS_R); const bf16_t* KR = (const bf16_t*)(ws + WS_KRAW); const bf16_t* V = (const bf16_t*)(ws + WS_V); const bf16_t* AA = (const bf16_t*)(ws + WS_AA);
    const float* EW = (const float*)(ws + WS_W); float* BON = (float*)(ws + WS_BONUS);
    u32x2* RTT = (u32x2*)((unsigned char*)p.out + DO_RTT); u32x2* MTT = (u32x2*)((unsigned char*)p.out + DO_MTT); u32x2* Y0D = (u32x2*)((unsigned char*)p.out + DO_Y0D); u32x2* ND = (u32x2*)((unsigned char*)p.out + DO_ND);
    LAS unsigned char* L = c.lds;
    LAS bf16_t* QK = (LAS bf16_t*)(L + S1_QK); LAS bf16_t* QR = (LAS bf16_t*)(L + S1_QR); LAS bf16_t* QB = (LAS bf16_t*)(L + S1_QB); LAS bf16_t* QKH = (LAS bf16_t*)(L + S1_QKH);
    LAS bf16_t* BTN = (LAS bf16_t*)(L + S1_BTN); LAS bf16_t* KHT = (LAS bf16_t*)(L + S1_KHT); LAS bf16_t* VT = (LAS bf16_t*)(L + S1_VT);
    LAS bf16_t* AAB = (LAS bf16_t*)(L + S1_AAB); LAS bf16_t* AAK = (LAS bf16_t*)(L + S1_AAK); LAS bf16_t* ARB = (LAS bf16_t*)(L + S1_ARB); LAS bf16_t* ARK = (LAS bf16_t*)(L + S1_ARK);
    LAS float* EC = (LAS float*)(L + S1_EC); LAS float* DG = (LAS float*)(L + S1_DG); LAS bf16_t* DI = (LAS bf16_t*)(L + S1_DI); LAS float* GC = (LAS float*)(L + S1_GC); LAS float* SEG = (LAS float*)(L + S1_SEG);
    const int tid = c.tid, fr = c.fr, fq = c.fq, wave = c.wave, lane = c.lane;
    const int st = tid >> 3, cg = tid & 7;
    for (int task = blockIdx.x; task < NTASK; task += gridDim.x) {
        const int bh = task >> 6, ch = task & 63, b = bh >> 3, h = bh & 7;
        const size_t grow = (size_t)b * SEQ + ch * CH + st, goff = grow * RD + h * 64 + 8 * cg;
        __syncthreads();
        float r8[8], k8[8], v8[8], a8[8], e8[8];
        { const u32x4 ur = *(const u32x4*)(R + goff), uk = *(const u32x4*)(KR + goff), uv = *(const u32x4*)(V + goff), ua = *(const u32x4*)(AA + goff);
          const f32x4 e0 = *(const f32x4*)(EW + goff), e1 = *(const f32x4*)(EW + goff + 4);
          const unsigned wr_[4] = {ur.x, ur.y, ur.z, ur.w}, wk_[4] = {uk.x, uk.y, uk.z, uk.w}, wv_[4] = {uv.x, uv.y, uv.z, uv.w}, wa_[4] = {ua.x, ua.y, ua.z, ua.w};
#pragma unroll
          for (int i = 0; i < 4; ++i) { r8[2 * i] = bf2f(wr_[i] & 0xffffu); r8[2 * i + 1] = bf2f(wr_[i] >> 16); k8[2 * i] = bf2f(wk_[i] & 0xffffu); k8[2 * i + 1] = bf2f(wk_[i] >> 16);
              v8[2 * i] = bf2f(wv_[i] & 0xffffu); v8[2 * i + 1] = bf2f(wv_[i] >> 16); a8[2 * i] = bf2f(wa_[i] & 0xffffu); a8[2 * i + 1] = bf2f(wa_[i] >> 16); e8[i] = e0[i]; e8[4 + i] = e1[i]; } }
        float kap8[8], bb8[8], kf8[8]; float nrm = 0.f, bon = 0.f;
#pragma unroll
        for (int i = 0; i < 8; ++i) { const int col = h * 64 + 8 * cg + i; const float kkv = k8[i] * p.in[I_KK][col]; kap8[i] = kkv; nrm += kkv * kkv;
            kf8[i] = k8[i] * (1.0f + (a8[i] - 1.0f) * p.in[I_KA][col]); bon += r8[i] * kf8[i] * p.in[I_RK][col]; }
        nrm = sum8(nrm); bon = sum8(bon);
        const float rn = rsqrtf(nrm + 1e-12f);
#pragma unroll
        for (int i = 0; i < 8; ++i) { kap8[i] *= rn; bb8[i] = kap8[i] * a8[i]; }
        if (cg == 0) BON[grow * 8 + h] = bon;
        *(LAS f32x4*)(EC + st * 64 + 8 * cg) = (f32x4){e8[0], e8[1], e8[2], e8[3]}; *(LAS f32x4*)(EC + st * 64 + 8 * cg + 4) = (f32x4){e8[4], e8[5], e8[6], e8[7]};
        __syncthreads();
        { const int cc = tid & 63, sg = tid >> 6; float run = 0.f;
#pragma unroll
          for (int i = 0; i < 8; ++i) { run += EC[(8 * sg + i) * 64 + cc]; EC[(8 * sg + i) * 64 + cc] = run; }
          SEG[sg * 64 + cc] = run;
          __syncthreads();
          float off = 0.f;
#pragma unroll
          for (int s2 = 0; s2 < 7; ++s2) off += (s2 < sg) ? SEG[s2 * 64 + cc] : 0.f;
#pragma unroll
          for (int i = 0; i < 8; ++i) EC[(8 * sg + i) * 64 + cc] += off;
          if (sg == 7) GC[cc] = __expf(-(run + off)); }
        __syncthreads();
        { float cum[8]; const f32x4 c0 = *(const LAS f32x4*)(EC + st * 64 + 8 * cg), c1 = *(const LAS f32x4*)(EC + st * 64 + 8 * cg + 4);
#pragma unroll
          for (int i = 0; i < 4; ++i) { cum[i] = c0[i]; cum[4 + i] = c1[i]; }
          float kh[8], rh[8], bh8[8], kk8[8];
#pragma unroll
          for (int i = 0; i < 8; ++i) { const float gi = __expf(cum[i]); kh[i] = kap8[i] * __expf(e8[i] - cum[i]); rh[i] = r8[i] * __expf(-cum[i]); bh8[i] = bb8[i] * gi; kk8[i] = kf8[i] * gi; }
          u32x4 w;
          w.x = pk2(kh[0], kh[1]); w.y = pk2(kh[2], kh[3]); w.z = pk2(kh[4], kh[5]); w.w = pk2(kh[6], kh[7]); *(LAS u32x4*)(QK + st * RS + 8 * cg) = w;
          w.x = pk2(rh[0], rh[1]); w.y = pk2(rh[2], rh[3]); w.z = pk2(rh[4], rh[5]); w.w = pk2(rh[6], rh[7]); *(LAS u32x4*)(QR + st * RS + 8 * cg) = w;
          w.x = pk2(bh8[0], bh8[1]); w.y = pk2(bh8[2], bh8[3]); w.z = pk2(bh8[4], bh8[5]); w.w = pk2(bh8[6], bh8[7]); *(LAS u32x4*)(QB + st * RS + 8 * cg) = w;
          w.x = pk2(kk8[0], kk8[1]); w.y = pk2(kk8[2], kk8[3]); w.z = pk2(kk8[4], kk8[5]); w.w = pk2(kk8[6], kk8[7]); *(LAS u32x4*)(QKH + st * RS + 8 * cg) = w;
#pragma unroll
          for (int i = 0; i < 8; ++i) { BTN[(8 * cg + i) * RS + st] = (bf16_t)f2bf(-bh8[i]); KHT[(8 * cg + i) * RS + st] = (bf16_t)f2bf(kk8[i]); VT[(8 * cg + i) * RS + st] = (bf16_t)f2bf(v8[i]); } }
        __syncthreads();
        { const int mat = wave >> 1; const LAS bf16_t* Am = (mat < 2) ? QK : QR; const LAS bf16_t* Bm = (mat & 1) ? QKH : QB; LAS bf16_t* Om = (mat == 0) ? AAB : (mat == 1) ? AAK : (mat == 2) ? ARB : ARK;
          const bool strict = mat < 2; const float sgn = (mat & 1) ? 1.0f : -1.0f;
#pragma unroll
          for (int jj = 0; jj < 2; ++jj) { const int j = 2 * (wave & 1) + jj;
              const bf16x8 bt0 = *(const LAS bf16x8*)(Am + (16 * j + fr) * RS + 8 * fq), bt1 = *(const LAS bf16x8*)(Am + (16 * j + fr) * RS + 32 + 8 * fq);
#pragma unroll
              for (int l = 0; l < 4; ++l) {
                  f32x4 d = (f32x4){0.f, 0.f, 0.f, 0.f};
                  d = MF16(*(const LAS bf16x8*)(Bm + (16 * l + fr) * RS + 8 * fq), bt0, d); d = MF16(*(const LAS bf16x8*)(Bm + (16 * l + fr) * RS + 32 + 8 * fq), bt1, d);
                  const int t = 16 * j + fr, i0 = 16 * l + 4 * fq;
#pragma unroll
                  for (int rg = 0; rg < 4; ++rg) { const bool keep = strict ? (i0 + rg < t) : (i0 + rg <= t); d[rg] = keep ? d[rg] : 0.f; }
                  if (mat == 0 && l == j) *(LAS f32x4*)(DG + (j * 16 + fr) * 16 + 4 * fq) = d;
                  *(LAS u32x2*)(Om + t * RS + i0) = pk4(d * sgn);
              } } }
        __syncthreads();
        f32x4 Z[4], Z1[4], Ee[4];
        if (wave == 0) {
            const int j = lane >> 4, col = lane & 15; float x[16];
#pragma unroll
            for (int t = 0; t < 16; ++t) { float sacc = (t == col) ? 1.0f : 0.0f;
#pragma unroll
                for (int i = 0; i < t; ++i) sacc -= DG[(j * 16 + t) * 16 + i] * x[i];
                x[t] = sacc; }
#pragma unroll
            for (int t = 0; t < 16; ++t) DI[(j * 16 + t) * DIS + col] = (bf16_t)f2bf(x[t]);
        }
        if (wave >= 4) { const int vb = wave - 4;
#pragma unroll
            for (int j = 0; j < 4; ++j) { Z[j] = Z1[j] = Ee[j] = (f32x4){0.f, 0.f, 0.f, 0.f};
#pragma unroll
                for (int s2 = 0; s2 < 2; ++s2) { const bf16x8 bv = *(const LAS bf16x8*)(VT + (16 * vb + fr) * RS + 32 * s2 + 8 * fq);
                    Z[j] = MF16(*(const LAS bf16x8*)(AAK + (16 * j + fr) * RS + 32 * s2 + 8 * fq), bv, Z[j]);
                    Z1[j] = MF16(*(const LAS bf16x8*)(ARK + (16 * j + fr) * RS + 32 * s2 + 8 * fq), bv, Z1[j]);
                    Ee[j] = MF16(*(const LAS bf16x8*)(KHT + (16 * j + fr) * RS + 32 * s2 + 8 * fq), bv, Ee[j]); } } }
        else {
#pragma unroll
            for (int j = 0; j < 4; ++j)
#pragma unroll
                for (int rg = 0; rg < 4; ++rg) Z[j][rg] = bf2f(QK[(16 * j + 4 * fq + rg) * RS + 16 * wave + fr]); }
        __syncthreads();
        f32x4 X[4];
#pragma unroll
        for (int j = 0; j < 4; ++j) { f32x4 acc = Z[j];
#pragma unroll
            for (int l = 0; l < 4; ++l) if (l < j) acc = MF16(frag4z(AAB + (16 * j + fr) * RS + 16 * l + 4 * fq), pack4z(X[l]), acc);
            X[j] = MF16(frag4z(DI + (j * 16 + fr) * DIS + 4 * fq), pack4z(acc), ((f32x4){0.f, 0.f, 0.f, 0.f})); }
        const size_t dbase = ((size_t)task * 4 + (wave & 3)) * 4 * 64 + lane;
        if (wave >= 4) {
#pragma unroll
            for (int j = 0; j < 4; ++j) { f32x4 y0 = Z1[j];
#pragma unroll
                for (int l = 0; l < 4; ++l) if (l <= j) y0 = MF16(frag4z(ARB + (16 * j + fr) * RS + 16 * l + 4 * fq), pack4z(X[l]), y0);
                Y0D[dbase + j * 64] = pk4(y0);
                f32x4 nn = Ee[j];
#pragma unroll
                for (int l = 0; l < 4; ++l) nn = MF16(frag4z(BTN + (16 * j + fr) * RS + 16 * l + 4 * fq), pack4z(X[l]), nn);
#pragma unroll
                for (int rg = 0; rg < 4; ++rg) nn[rg] *= GC[16 * j + 4 * fq + rg];
                ND[dbase + j * 64] = pk4(nn); } }
        else {
#pragma unroll
            for (int j = 0; j < 4; ++j) { f32x4 rt = unpk4(*(const LAS u32x2*)(QR + (16 * j + fr) * RS + 16 * wave + 4 * fq));
#pragma unroll
                for (int l = 0; l < 4; ++l) if (l <= j) rt = MF16(pack4z(X[l]), frag4z(ARB + (16 * j + fr) * RS + 16 * l + 4 * fq), rt);
                RTT[dbase + j * 64] = pk4(rt);
                f32x4 mt;
#pragma unroll
                for (int rg = 0; rg < 4; ++rg) mt[rg] = (16 * wave + 4 * fq + rg == 16 * j + fr) ? 1.0f : 0.0f;
#pragma unroll
                for (int l = 0; l < 4; ++l) mt = MF16(pack4z(X[l]), frag4z(BTN + (16 * j + fr) * RS + 16 * l + 4 * fq), mt);
                MTT[dbase + j * 64] = pk4(mt * GC[16 * j + fr]); } }
    }
}
__device__ __forceinline__ void phase_s2(const Params& p, const Ctx& c) {
    if (c.wave != 0) return;
    const u32x2* MTT = (const u32x2*)((unsigned char*)p.out + DO_MTT); const u32x2* ND = (const u32x2*)((unsigned char*)p.out + DO_ND); u32x2* SP = (u32x2*)(p.ws + WS_SP);
    const int lane = c.lane;
    for (int unit = blockIdx.x; unit < BATCH * 8 * 4; unit += gridDim.x) {
        const int vb = unit & 3, bh = unit >> 2;
        f32x4 S[4];
#pragma unroll
        for (int j = 0; j < 4; ++j) S[j] = (f32x4){0.f, 0.f, 0.f, 0.f};
        u32x2 mc[4][4], nc[4];
        { const size_t task = (size_t)bh * NCHUNK;
#pragma unroll
          for (int l = 0; l < 4; ++l)
#pragma unroll
              for (int j = 0; j < 4; ++j) mc[l][j] = MTT[((task * 4 + l) * 4 + j) * 64 + lane];
#pragma unroll
          for (int j = 0; j < 4; ++j) nc[j] = ND[((task * 4 + vb) * 4 + j) * 64 + lane]; }
        for (int ch = 0; ch < NCHUNK; ++ch) {
            const size_t task = (size_t)bh * NCHUNK + ch, tn = (ch + 1 < NCHUNK) ? task + 1 : task;
            u32x2 mn[4][4], nn[4];
#pragma unroll
            for (int l = 0; l < 4; ++l)
#pragma unroll
                for (int j = 0; j < 4; ++j) mn[l][j] = MTT[((tn * 4 + l) * 4 + j) * 64 + lane];
#pragma unroll
            for (int j = 0; j < 4; ++j) nn[j] = ND[((tn * 4 + vb) * 4 + j) * 64 + lane];
            bf16x8 sp[4];
#pragma unroll
            for (int l = 0; l < 4; ++l) { const u32x2 w = pk4(S[l]); SP[((task * 4 + vb) * 4 + l) * 64 + lane] = w; sp[l] = raw4z(w); }
#pragma unroll
            for (int j = 0; j < 4; ++j) { f32x4 acc = unpk4(nc[j]);
#pragma unroll
                for (int l = 0; l < 4; ++l) acc = MF16(raw4z(mc[l][j]), sp[l], acc);
                S[j] = acc; }
#pragma unroll
            for (int l = 0; l < 4; ++l)
#pragma unroll
                for (int j = 0; j < 4; ++j) mc[l][j] = mn[l][j];
#pragma unroll
            for (int j = 0; j < 4; ++j) nc[j] = nn[j];
        }
    }
}
__device__ __forceinline__ void phase_s3(const Params& p, const Ctx& c) {
    unsigned char* ws = p.ws;
    const u32x2* RTT = (const u32x2*)((unsigned char*)p.out + DO_RTT); const u32x2* Y0D = (const u32x2*)((unsigned char*)p.out + DO_Y0D); const u32x2* SP = (const u32x2*)(ws + WS_SP);
    const float* BON = (const float*)(ws + WS_BONUS); const bf16_t* V = (const bf16_t*)(ws + WS_V); const bf16_t* G = (const bf16_t*)(ws + WS_G); bf16_t* Y = (bf16_t*)(ws + WS_YCAT);
    const int lane = c.lane, fr = c.fr, fq = c.fq;
    for (int it = c.gw; it < NTASK * 4; it += c.ngw) {
        const size_t task = (size_t)(it >> 2); const int j = it & 3, bh = (int)(task >> 6), ch = (int)(task & 63), b = bh >> 3, h = bh & 7;
        bf16x8 rt[4];
#pragma unroll
        for (int l = 0; l < 4; ++l) rt[l] = raw4z(RTT[((task * 4 + l) * 4 + j) * 64 + lane]);
        f32x4 acc[4];
#pragma unroll
        for (int vb = 0; vb < 4; ++vb) { acc[vb] = unpk4(Y0D[((task * 4 + vb) * 4 + j) * 64 + lane]);
#pragma unroll
            for (int l = 0; l < 4; ++l) acc[vb] = MF16(rt[l], raw4z(SP[((task * 4 + vb) * 4 + l) * 64 + lane]), acc[vb]); }
#pragma unroll
        for (int rg = 0; rg < 4; ++rg) {
            const size_t row = (size_t)b * SEQ + ch * CH + 16 * j + 4 * fq + rg;
            const float mean = row_sum16((acc[0][rg] + acc[1][rg]) + (acc[2][rg] + acc[3][rg])) * (1.0f / 64.0f);
            float d[4], q = 0.f;
#pragma unroll
            for (int vb = 0; vb < 4; ++vb) { d[vb] = acc[vb][rg] - mean; q += d[vb] * d[vb]; }
            const float rstd = rsqrtf(row_sum16(q) * (1.0f / 64.0f) + GN_EPS), bon = BON[row * 8 + h];
#pragma unroll
            for (int vb = 0; vb < 4; ++vb) { const int col = h * 64 + 16 * vb + fr;
                const float yn = d[vb] * rstd * p.in[I_LNW][col] + p.in[I_LNB][col];
                Y[row * DM + col] = (bf16_t)f2bf((yn + bon * bf2f(V[row * RD + col])) * bf2f(G[row * RD + col])); }
        }
    }
}

__device__ __forceinline__ void phase_rowstat(const Params& p, const Ctx& c) {
    float* RS = (float*)(p.ws + WS_RSTD2);
    for (int m = c.gw; m < MTOK; m += c.ngw) {
        const f32x4* xr = (const f32x4*)(p.out + (size_t)m * DM) + c.lane; float s = 0.f;
#pragma unroll
        for (int j = 0; j < 4; ++j) { const f32x4 v = xr[64 * j]; s += (v[0] * v[0] + v[1] * v[1]) + (v[2] * v[2] + v[3] * v[3]); }
        s = wave_sum(s);
        if (c.lane == 0) RS[m] = rsqrtf(s * (1.f / DM) + NORM_EPS);
    }
}
__device__ __forceinline__ void phase_final_norm(const Params& p, const Ctx& c) {
    const float* g = p.in[I_NFING];
    for (int m = c.gw; m < MTOK; m += c.ngw) {
        f32x4* xr = (f32x4*)(p.out + (size_t)m * DM) + c.lane; const f32x4* gr = (const f32x4*)g + c.lane;
        f32x4 v[4]; float s = 0.f;
#pragma unroll
        for (int j = 0; j < 4; ++j) { v[j] = xr[64 * j]; s += (v[j][0] * v[j][0] + v[j][1] * v[j][1]) + (v[j][2] * v[j][2] + v[j][3] * v[j][3]); }
        const float rstd = rsqrtf(wave_sum(s) * (1.f / DM) + NORM_EPS);
#pragma unroll
        for (int j = 0; j < 4; ++j) xr[64 * j] = v[j] * rstd * gr[64 * j];
    }
}

constexpr int NPHASES = 15;
__global__ void __launch_bounds__(NTHREADS, 2) fwd_kernel(Params p) {
    extern __shared__ __attribute__((aligned(16))) unsigned char lds_raw[];
    Ctx c; c.tid = threadIdx.x; c.lane = c.tid & 63; c.wave = __builtin_amdgcn_readfirstlane(c.tid >> 6); c.fr = c.lane & 15; c.fq = c.lane >> 4;
    c.gw = blockIdx.x * NWAVES + c.wave; c.ngw = gridDim.x * NWAVES; c.lds = (LAS unsigned char*)lds_raw;
    unsigned char* ws = p.ws;
#if ONE_LAUNCH
    cg::grid_group grid = cg::this_grid();
    volatile LAS unsigned* misc = (volatile LAS unsigned*)(c.lds + LDS_MISC_OFF);
    if (c.tid < 4) misc[c.tid] = 0u;
    __syncthreads();
    const XcdBarrier xbar = xcd_barrier_post((unsigned*)(ws + WS_BAR), misc);
    bool first_seam = true;
#define SEAM() do { if (first_seam) { grid.sync(); first_seam = false; } else xcd_barrier(xbar); } while (0)
#else
#define SEAM() do {} while (0)
#endif
#define IN(k) (p.ph_lo <= (k) && (k) < p.ph_hi)
#define END(k) do { if (IN((k) + 1)) SEAM(); } while (0)
#define REP_ON(k) ((REP_MASK >> (k)) & 1u)
#define PHASE(k, ...) if (IN(k)) { __VA_ARGS__ if (REP_ON(k)) { SEAM(); __VA_ARGS__ } END(k); }
    PHASE(0, phase_prologue(p, c);)
    PHASE(1,
        gemm_pg8_8(c, (const bf16_t*)(ws + WS_H), DM, (const bf16_t*)(ws + WS_WG1T), DM, MTOK, MIXIN, DM, F8Store{(bf16_t*)(ws + WS_P), MIXIN});
        gemm_simple(c, (const bf16_t*)(ws + WS_MEMN), DM, (const bf16_t*)(ws + WS_WKVT), DM, BATCH * NMEM, 512, DM, EpiKV{(bf16_t*)(ws + WS_KB), (bf16_t*)(ws + WS_VT)});)
    PHASE(2, phase_mix(p, c); phase_pooldiff(p, c); phase_memattn(p, c);)
    PHASE(3,
        gemm_simple(c, (const bf16_t*)(ws + WS_LW), 64, (const bf16_t*)(ws + WS_WLWT), 64, MTOK, RD, 64, EpiDecay{(float*)(ws + WS_W), p.in[I_W0]});
        gemm_simple(c, (const bf16_t*)(ws + WS_LA), 64, (const bf16_t*)(ws + WS_WLAT), 64, MTOK, RD, 64, EpiSigBias{(bf16_t*)(ws + WS_AA), RD, p.in[I_A0]});
        gemm_simple(c, (const bf16_t*)(ws + WS_LG), 128, (const bf16_t*)(ws + WS_WLGT), 128, MTOK, RD, 128, EpiBf16{(bf16_t*)(ws + WS_G), RD});
        _Pragma("unroll 1") for (int gi = 0; gi < 4; ++gi)
            gemm_simple(c, (const bf16_t*)(ws + WS_DPOOL) + 64 * gi, 256, (const bf16_t*)(ws + WS_WPT) + 4096 * gi, 64, MTOK, 64, 64, EpiPool{(bf16_t*)(ws + WS_YCAT), p.in[I_POOLS], gi});)
    PHASE(4, phase_s1(p, c);)
    PHASE(5, phase_s2(p, c);)
    PHASE(6, phase_s3(p, c);)
    PHASE(7,
        gemm_pg8_8(c, (const bf16_t*)(ws + WS_H), DM, (const bf16_t*)(ws + WS_WG1T) + (size_t)MIXIN * DM, DM, MTOK, 3 * DM, DM, F8SigBias{(bf16_t*)(ws + WS_GATES), 3 * DM, p.in[I_BGATE]});)
    PHASE(8, {
        pg8::Gemm g{(const bf16_t*)(ws + WS_YCAT), (const bf16_t*)(ws + WS_WUPT), MTOK, DM, DM, DM, DM}; pg8::StaticOrder S; S.init(MTOK, DM, (int)gridDim.x, (int)blockIdx.x);
        EpiFn8<F8UpFinal> E{F8UpFinal{(bf16_t*)(ws + WS_MERGED), (const bf16_t*)(ws + WS_GATES)}};
        pg8::gemm_phase_h<EpiFn8<F8UpFinal>, pg8::StaticOrder, true, true, UpHook>(c.lds, g, S, E, UpHook{(const bf16_t*)(ws + WS_GATES)}); })
    PHASE(9,
        gemm_pg8_4(c, (const bf16_t*)(ws + WS_MERGED), DM, (const bf16_t*)(ws + WS_WOT), DM, MTOK, DM, DM, EpiOut{p.in[I_X], p.out, (bf16_t*)(ws + WS_X1B)});)
    PHASE(10, phase_rowstat(p, c);)
    PHASE(11, {
        pg8::Gemm g{(const bf16_t*)(ws + WS_X1B), (const bf16_t*)(ws + WS_WF1T), MTOK, 2 * FF, DM, DM, DM}; pg8::StaticOrder S; S.init(MTOK, 2 * FF, (int)gridDim.x, (int)blockIdx.x);
        EpiFfnAct E{(bf16_t*)(ws + WS_ACT), (const float*)(ws + WS_RSTD2), p.in[I_CONVW], p.in[I_CONVB], (float*)(ws + WS_TAILU), (float*)(ws + WS_HEADU), (float*)(ws + WS_HEADGV), (LAS float*)(c.lds + LDS_HALO_OFF)};
        pg8::gemm_phase<EpiFfnAct, pg8::StaticOrder, true, true>(c.lds, g, S, E); })
    PHASE(12, phase_ffn_fix(p, c);)
    PHASE(13,
        gemm_pg8_4(c, (const bf16_t*)(ws + WS_ACT), FF, (const bf16_t*)(ws + WS_WF2T), FF, MTOK, DM, FF, EpiAddOut{p.out});)
    if (IN(14)) { phase_final_norm(p, c); }
#undef IN
#undef END
}

__global__ void nan_fill(float* o, int n) { const int i = blockIdx.x * blockDim.x + threadIdx.x; if (i < n) o[i] = __builtin_nanf(""); }

extern "C" void kernel_launch(void* const* d_in, const int* in_sizes, int n_in, void* d_out, int out_size, void* d_ws, size_t ws_size, hipStream_t stream) {
    static int grid = 0;
    if (grid == 0) {
        int dev = 0, cus = 0, per_cu = 0;
        if (hipGetDevice(&dev) != hipSuccess || hipDeviceGetAttribute(&cus, hipDeviceAttributeMultiprocessorCount, dev) != hipSuccess) cus = 256;
        (void)hipFuncSetAttribute((const void*)fwd_kernel, hipFuncAttributeMaxDynamicSharedMemorySize, LDS_BYTES);
        if (hipOccupancyMaxActiveBlocksPerMultiprocessor(&per_cu, (const void*)fwd_kernel, NTHREADS, LDS_BYTES) != hipSuccess || per_cu < 1) per_cu = 1;
        (void)hipGetLastError();
        grid = cus;
        if (n_in != 31 || out_size != MTOK * DM || ws_size < WS_END) grid = -1;
    }
    if (grid < 0) { nan_fill<<<(out_size + 255) / 256, 256, 0, stream>>>((float*)d_out, out_size); return; }
    Params p{};
    for (int i = 0; i < 31; ++i) p.in[i] = (const float*)d_in[i];
    p.out = (float*)d_out; p.ws = (unsigned char*)d_ws;
#if ONE_LAUNCH
    (void)hipMemsetAsync((unsigned char*)d_ws + WS_BAR, 0, WS_CTL_BYTES, stream);
    p.ph_lo = 0; p.ph_hi = NPHASES;
    void* args[] = {&p};
    hipError_t e = hipLaunchCooperativeKernel((const void*)fwd_kernel, dim3(grid), dim3(NTHREADS), args, LDS_BYTES, stream);
    if (e != hipSuccess) fprintf(stderr, "cooperative launch failed: %s (grid %d)\n", hipGetErrorString(e), grid);
#else
    for (int ph = 0; ph < NPHASES; ++ph) { p.ph_lo = ph; p.ph_hi = ph + 1; hipLaunchKernelGGL(fwd_kernel, dim3(grid), dim3(NTHREADS), LDS_BYTES, stream, p); }
#endif
}
```

```cpp
#include <hip/hip_runtime.h>
#include <hip/hip_cooperative_groups.h>
#include <cstdio>
#include <cstdint>
namespace cg = cooperative_groups;

#ifndef ONE_LAUNCH
#define ONE_LAUNCH 1
#endif
#ifndef PH_MASK
#define PH_MASK 0xFFFFFFFFu
#endif
#define PH_ON(k) ((PH_MASK >> (k)) & 1u)
#ifndef REP_MASK
#define REP_MASK 0u
#endif

#define LAS __attribute__((address_space(3)))
typedef unsigned short bf16_t;
typedef short bf16x8 __attribute__((ext_vector_type(8)));
typedef float f32x4 __attribute__((ext_vector_type(4)));
typedef float f32x2 __attribute__((ext_vector_type(2)));
typedef unsigned u32x4 __attribute__((ext_vector_type(4)));
typedef unsigned u32x2 __attribute__((ext_vector_type(2)));

constexpr int BATCH = 8, SEQ = 4096, DM = 1024, MTOK = BATCH * SEQ;
constexpr int NMEM = 256, RD = 512, MIXIN = 2304, RWKVIN = 1792, FF = 2816, NG1 = MIXIN + 3 * DM;
constexpr int NWAVES = 8, NTHREADS = 512;
constexpr float NORM_EPS = 1e-6f, GN_EPS = 64e-5f;

constexpr size_t MiB = 1u << 20;
constexpr size_t WS_WG1T = 1 * MiB;
constexpr size_t WS_WKVT = WS_WG1T + (size_t)NG1 * DM * 2;
constexpr size_t WS_WUPT = WS_WKVT + (size_t)512 * DM * 2;
constexpr size_t WS_WOT = WS_WUPT + (size_t)DM * DM * 2;
constexpr size_t WS_WF1T = WS_WOT + (size_t)DM * DM * 2;
constexpr size_t WS_WF2T = WS_WF1T + (size_t)2 * FF * DM * 2;
constexpr size_t WS_WLWT = WS_WF2T + (size_t)DM * FF * 2;
constexpr size_t WS_WLAT = WS_WLWT + (size_t)RD * 64 * 2;
constexpr size_t WS_WLGT = WS_WLAT + (size_t)RD * 64 * 2;
constexpr size_t WS_WPT = WS_WLGT + (size_t)RD * 128 * 2;
constexpr size_t WS_WEND = WS_WPT + (size_t)4 * 64 * 64 * 2;
static_assert(WS_WEND <= 34 * MiB, "weights region");
constexpr size_t WS_BONUS = 34 * MiB;
constexpr size_t WS_RSTD2 = 35 * MiB;
constexpr size_t WS_KB = 36 * MiB;
constexpr size_t WS_VT = 37 * MiB;
constexpr size_t WS_MEMN = 38 * MiB;
constexpr size_t WS_H = 42 * MiB;
constexpr size_t WS_YCAT = 106 * MiB;
constexpr size_t WS_P = 170 * MiB;
constexpr size_t WS_W = 170 * MiB;
constexpr size_t WS_G = 234 * MiB;
constexpr size_t WS_AA = 266 * MiB;
constexpr size_t WS_KRAW = 314 * MiB;
constexpr size_t WS_YRAW = 266 * MiB;
constexpr size_t WS_R = 346 * MiB;
constexpr size_t WS_V = 378 * MiB;
constexpr size_t WS_LW = 410 * MiB;
constexpr size_t WS_LA = 414 * MiB;
constexpr size_t WS_LG = 418 * MiB;
constexpr size_t WS_DPOOL = 426 * MiB;
constexpr size_t WS_SP = 442 * MiB;
constexpr size_t WS_GATES = 170 * MiB;
constexpr size_t WS_MERGED = 362 * MiB;
constexpr size_t WS_X1B = 426 * MiB;
constexpr size_t WS_TAILU = 42 * MiB, WS_HEADU = 45 * MiB, WS_HEADGV = 48 * MiB;
constexpr size_t WS_ACT = 218 * MiB;
constexpr size_t WS_END = 490 * MiB;
constexpr size_t DO_RTT = 0, DO_MTT = 32 * MiB, DO_Y0D = 64 * MiB, DO_ND = 96 * MiB;

constexpr int LDS_BYTES = 147456;
constexpr int LDS_HALO_OFF = 131072 + 1024;
constexpr int LDS_MISC_OFF = 131072 + 320;
constexpr size_t WS_BAR = 0, WS_CTL_BYTES = 65536;

__device__ __forceinline__ unsigned f2bf(float f) { unsigned u = __float_as_uint(f); return (u + 0x7fffu + ((u >> 16) & 1u)) >> 16; }
__device__ __forceinline__ float bf2f(unsigned h) { return __uint_as_float(h << 16); }
__device__ __forceinline__ unsigned pk2(float lo, float hi) { return f2bf(lo) | (f2bf(hi) << 16); }
__device__ __forceinline__ u32x2 pk4(f32x4 v) { u32x2 r; r.x = pk2(v[0], v[1]); r.y = pk2(v[2], v[3]); return r; }
__device__ __forceinline__ f32x4 unpk4(u32x2 u) { f32x4 r; r[0] = bf2f(u.x & 0xffffu); r[1] = bf2f(u.x >> 16); r[2] = bf2f(u.y & 0xffffu); r[3] = bf2f(u.y >> 16); return r; }
__device__ __forceinline__ float wave_sum(float v) {
#pragma unroll
    for (int o = 1; o < 64; o <<= 1) v += __shfl_xor(v, o);
    return v;
}
__device__ __forceinline__ float sigmoidf_(float x) { return 1.0f / (1.0f + __expf(-x)); }
template <int CTRL> __device__ __forceinline__ float dpp_f(float x) { return __builtin_bit_cast(float, __builtin_amdgcn_update_dpp(0, __builtin_bit_cast(int, x), CTRL, 0xF, 0xF, false)); }
__device__ __forceinline__ float row_sum16(float x) {
    x += dpp_f<0xB1>(x);
    x += dpp_f<0x4E>(x);
    x += dpp_f<0x141>(x);
    x += dpp_f<0x140>(x);
    return x;
}

#define XB_TMO      128
#define XB_XCNT(j)  (256  + 64 * (j))
#define XB_XSUB(j)  (1280 + 64 * (j))
#define XB_XGEN(j)  (2304 + 64 * (j))
#define XB_TOP      3328
#define XB_TOPGEN   3392
#define XCD_BAR_WORDS 3456
#define XB_SPIN_CAP (1u << 18)

__device__ __forceinline__ unsigned xb_ld(unsigned* p)              { return __hip_atomic_load(p, __ATOMIC_RELAXED, __HIP_MEMORY_SCOPE_AGENT); }
__device__ __forceinline__ unsigned xb_add(unsigned* p, unsigned v) { return __hip_atomic_fetch_add(p, v, __ATOMIC_RELAXED, __HIP_MEMORY_SCOPE_AGENT); }
__device__ __forceinline__ unsigned xb_xcc_id() { return (unsigned)__builtin_amdgcn_s_getreg((3 << 11) | 20) & 0xFu; }
#define XB_SPIN(cond, bar) do { unsigned _sp = 0; while (cond) { __builtin_amdgcn_s_sleep(1); \
    if ((++_sp & 255u) == 0u) { if (xb_ld(&(bar)[XB_TMO])) break; if (_sp > XB_SPIN_CAP) { atomicAdd(&(bar)[XB_TMO], 1u); break; } } } } while (0)

struct XcdBarrier {
    unsigned* bar; unsigned x;
    volatile LAS unsigned* st;
};

__device__ __forceinline__ XcdBarrier xcd_barrier_post(unsigned* bar, volatile LAS unsigned* st) {
    XcdBarrier b; b.bar = bar; b.x = xb_xcc_id(); b.st = st;
    if (threadIdx.x == 0) (void)xb_add(&bar[XB_XCNT(b.x)], 1u);
    return b;
}
__device__ __forceinline__ void xcd_barrier_complete(unsigned* bar, unsigned x, unsigned& nloc, unsigned& nx) {
    const unsigned G = gridDim.x * gridDim.y * gridDim.z;
    unsigned sum, cnt, mine, sp = 0u;
    for (;;) {
        sum = 0u; cnt = 0u; mine = 0u;
#pragma unroll
        for (unsigned j = 0; j < 16; ++j) { const unsigned c = xb_ld(&bar[XB_XCNT(j)]); sum += c; cnt += (c > 0u) ? 1u : 0u; mine = (j == x) ? c : mine; }
        if (sum == G) break;
        __builtin_amdgcn_s_sleep(1);
        if ((++sp & 255u) == 0u) { if (xb_ld(&bar[XB_TMO])) break; if (sp > XB_SPIN_CAP) { atomicAdd(&bar[XB_TMO], 1u); break; } }
    }
    nloc = mine > 0u ? mine : 1u; nx = cnt > 0u ? cnt : 1u;
}

__device__ __forceinline__ void xcd_barrier(const XcdBarrier& b) {
    asm volatile("s_waitcnt vmcnt(0)" ::: "memory");
    __syncthreads();
    if (threadIdx.x == 0) {
        unsigned* bar = b.bar;
        __builtin_amdgcn_s_waitcnt(0);
        unsigned nloc = b.st[0], nx = b.st[1];
        if (nloc == 0u) { xcd_barrier_complete(bar, b.x, nloc, nx); b.st[0] = nloc; b.st[1] = nx; }
        const unsigned old = xb_add(&bar[XB_XSUB(b.x)], 1u);
        const unsigned gen = old / nloc;
        if (old + 1u == (gen + 1u) * nloc) {
            __builtin_amdgcn_fence(__ATOMIC_RELEASE, "agent");
            asm volatile("s_waitcnt vmcnt(0)" ::: "memory");
            const unsigned og = xb_add(&bar[XB_TOP], 1u);
            const unsigned tg = og / nx;
            if (og + 1u == (tg + 1u) * nx) xb_add(&bar[XB_TOPGEN], 1u);
            else XB_SPIN(xb_ld(&bar[XB_TOPGEN]) == tg, bar);
            __builtin_amdgcn_fence(__ATOMIC_ACQUIRE, "agent");
            xb_add(&bar[XB_XGEN(b.x)], 1u);
            asm volatile("s_waitcnt vmcnt(0)" ::: "memory");
        } else {
            XB_SPIN(xb_ld(&bar[XB_XGEN(b.x)]) == gen, bar);
            __builtin_amdgcn_fence(__ATOMIC_ACQUIRE, "agent");
            asm volatile("s_waitcnt vmcnt(0)" ::: "memory");
        }
    }
    __syncthreads();
}


struct Params { const float* in[31]; float* out; unsigned char* ws; int ph_lo, ph_hi; };
enum { I_X = 0, I_MEM, I_NMIXG, I_WINMIX, I_MU, I_W0, I_WLORAB, I_A0, I_ALORAB, I_GLORAB, I_KK, I_KA, I_RK, I_LNW, I_LNB, I_POOLW, I_POOLS, I_NMEMG, I_WMEMKV,
       I_WUPR, I_WUPP, I_WUPM, I_WGATE, I_BGATE, I_WO, I_NFFNG, I_WFFNIN, I_CONVW, I_CONVB, I_WFFNOUT, I_NFING };

struct Ctx { int tid, lane, wave, fr, fq, gw, ngw; LAS unsigned char* lds; };

__device__ __forceinline__ int rowmap(int mode, int n) {
    if (mode == 0) return n;
    const int half = n >= FF ? 1 : 0, c = n - half * FF;
    return (c >> 7) * 256 + half * 128 + (c & 127);
}
__device__ __forceinline__ void transpose_item(const float* W, int K, int N, bf16_t* WT, int ldd, int koff, int mode, const float* kscale, LAS float* scr, int item, int lane) {
    const int nblk = N / 32, kb = item / nblk, nb = item % nblk, k0 = 64 * kb, n0 = 32 * nb;
#pragma unroll 8
    for (int i = 0; i < 32; ++i) { const int kk = 2 * i + (lane >> 5); float v = W[(size_t)(k0 + kk) * N + n0 + (lane & 31)]; if (kscale) v *= kscale[k0 + kk]; scr[kk * 33 + (lane & 31)] = v; }
    asm volatile("s_waitcnt lgkmcnt(0)" ::: "memory");
    const int c = lane & 7;
#pragma unroll
    for (int j = 0; j < 4; ++j) { const int n = (lane >> 3) + 8 * j; const LAS float* s = scr + (8 * c) * 33 + n;
        u32x4 o; o.x = pk2(s[0 * 33], s[1 * 33]); o.y = pk2(s[2 * 33], s[3 * 33]); o.z = pk2(s[4 * 33], s[5 * 33]); o.w = pk2(s[6 * 33], s[7 * 33]);
        *(u32x4*)(WT + (size_t)rowmap(mode, n0 + n) * ldd + koff + k0 + 8 * c) = o; }
    asm volatile("s_waitcnt lgkmcnt(0)" ::: "memory");
}
__device__ __forceinline__ void rmsnorm_row_bf16(const float* xrow, const float* g, bf16_t* orow, int lane) {
    const f32x4* xr = (const f32x4*)xrow + lane; const f32x4* gr = (const f32x4*)g + lane;
    f32x4 v[4]; float s = 0.f;
#pragma unroll
    for (int j = 0; j < 4; ++j) { v[j] = xr[64 * j]; s += (v[j][0] * v[j][0] + v[j][1] * v[j][1]) + (v[j][2] * v[j][2] + v[j][3] * v[j][3]); }
    const float rstd = rsqrtf(wave_sum(s) * (1.f / DM) + NORM_EPS);
    u32x2* o = (u32x2*)orow + lane;
#pragma unroll
    for (int j = 0; j < 4; ++j) { const f32x4 gg = gr[64 * j]; o[64 * j] = pk4(v[j] * rstd * gg); }
}

__device__ __forceinline__ void phase_prologue(const Params& p, const Ctx& c) {
    LAS float* scr = (LAS float*)(c.lds + c.wave * 16384);
    unsigned char* ws = p.ws;
#define TR(Wp, K_, N_, WTp, ldd_, koff_, mode_, sc_) { const int ni_ = ((K_) / 64) * ((N_) / 32); if (r < ni_) { transpose_item(Wp, K_, N_, (bf16_t*)(WTp), ldd_, koff_, mode_, sc_, scr, r, c.lane); continue; } r -= ni_; }
    constexpr int NIT = (DM / 64) * (MIXIN / 32) + (DM / 64) * (3 * DM / 32) + (DM / 64) * (512 / 32) + (512 / 64) * (DM / 32) + 2 * (256 / 64) * (DM / 32) + (DM / 64) * (DM / 32)
                      + (DM / 64) * (2 * FF / 32) + (FF / 64) * (DM / 32) + 2 * (RD / 32) + 2 * (RD / 32) + 4 * 2;
    for (int it = c.gw; it < NIT; it += c.ngw) {
        int r = it;
        TR(p.in[I_WINMIX], DM, MIXIN, ws + WS_WG1T, DM, 0, 0, nullptr)
        TR(p.in[I_WGATE], DM, 3 * DM, ws + WS_WG1T + (size_t)MIXIN * DM * 2, DM, 0, 0, nullptr)
        TR(p.in[I_WMEMKV], DM, 512, ws + WS_WKVT, DM, 0, 0, nullptr)
        TR(p.in[I_WUPR], 512, DM, ws + WS_WUPT, DM, 0, 0, nullptr)
        TR(p.in[I_WUPP], 256, DM, ws + WS_WUPT, DM, 512, 0, nullptr)
        TR(p.in[I_WUPM], 256, DM, ws + WS_WUPT, DM, 768, 0, nullptr)
        TR(p.in[I_WO], DM, DM, ws + WS_WOT, DM, 0, 0, nullptr)
        TR(p.in[I_WFFNIN], DM, 2 * FF, ws + WS_WF1T, DM, 0, 1, p.in[I_NFFNG])
        TR(p.in[I_WFFNOUT], FF, DM, ws + WS_WF2T, FF, 0, 0, nullptr)
        TR(p.in[I_WLORAB], 64, RD, ws + WS_WLWT, 64, 0, 0, nullptr)
        TR(p.in[I_ALORAB], 64, RD, ws + WS_WLAT, 64, 0, 0, nullptr)
        TR(p.in[I_GLORAB], 128, RD, ws + WS_WLGT, 128, 0, 0, nullptr)
        TR(p.in[I_POOLW] + 0 * 4096, 64, 64, ws + WS_WPT + 0 * 8192, 64, 0, 0, nullptr)
        TR(p.in[I_POOLW] + 1 * 4096, 64, 64, ws + WS_WPT + 1 * 8192, 64, 0, 0, nullptr)
        TR(p.in[I_POOLW] + 2 * 4096, 64, 64, ws + WS_WPT + 2 * 8192, 64, 0, 0, nullptr)
        TR(p.in[I_POOLW] + 3 * 4096, 64, 64, ws + WS_WPT + 3 * 8192, 64, 0, 0, nullptr)
    }
#undef TR
    for (int m = c.gw; m < MTOK; m += c.ngw) rmsnorm_row_bf16(p.in[I_X] + (size_t)m * DM, p.in[I_NMIXG], (bf16_t*)(ws + WS_H) + (size_t)m * DM, c.lane);
    for (int m = c.gw; m < BATCH * NMEM; m += c.ngw) rmsnorm_row_bf16(p.in[I_MEM] + (size_t)m * DM, p.in[I_NMEMG], (bf16_t*)(ws + WS_MEMN) + (size_t)m * DM, c.lane);
}

namespace pg8 {
#define PG8_LAS __attribute__((address_space(3)))
typedef unsigned short bf16_t;
typedef short bf16x8 __attribute__((ext_vector_type(8)));
typedef float f32x4 __attribute__((ext_vector_type(4)));
typedef unsigned u32x4 __attribute__((ext_vector_type(4)));
constexpr int BM = 256, BK = 64, HALF = 128, HTB = HALF * BK * 2  , STAGE_BYTES = 8 * HTB, NXCD = 8, WGM = 8;

__host__ __device__ __forceinline__ int lds_byte(int r, int c) { const int st = (r >> 4) * 2 + (c >> 5), rr = r & 15, cc = c & 31, ob = rr * 64 + cc * 2; return st * 1024 + (ob ^ (((ob >> 9) & 1) << 5)); }
__host__ __device__ __forceinline__ void stage_rc(int b, int& R, int& C) { const int st = b / 1024, sb = b % 1024, swz = sb ^ (((sb >> 9) & 1) << 5); R = (st >> 1) * 16 + swz / 64; C = (st & 1) * 32 + (swz % 64) / 2; }
__host__ __device__ __forceinline__ int perm32(int rho) { const int n = rho >> 4, i = rho & 15; return 8 * (i >> 2) + 4 * n + (i & 3); }

struct Unit { int pm, pn; };
struct Gemm { const bf16_t* A; const bf16_t* Bt; int M, N, K, lda, ldb; };

struct StaticOrder {
    int nM, nN, nwg, G, c;
    __host__ __device__ void init(int M, int N, int G_, int c_) { nM = M / BM; nN = N / BM; nwg = nM * nN; G = G_; c = c_; }
    __host__ __device__ bool next(int i, Unit& u) const {
        const long L = (long)i * G + c; if (L >= nwg) return false;
        int wgid = (int)L; { const int q = nwg / NXCD, r = nwg % NXCD, xcd = wgid % NXCD, off = wgid / NXCD; wgid = (xcd < r ? xcd * (q + 1) : r * (q + 1) + (xcd - r) * q) + off; }
        const int nig = WGM * nN, gid = wgid / nig, fm = gid * WGM, gsz = (nM - fm) < WGM ? (nM - fm) : WGM;
        u.pm = fm + ((wgid % nig) % gsz); u.pn = (wgid % nig) / gsz; return true;
    }
    __device__ __forceinline__ void a_ready(const Unit&) const {}
    __device__ __forceinline__ void done(const Unit&) const {}
};


struct NoHook { __device__ __forceinline__ void operator()(f32x4 (&)[2][2][4][2], const Unit&, int, int, int, int, int) const {} };
template <class Epi, class Sched, bool ALIGN_EPI, bool SP2, class Hook>
__device__ __forceinline__ void gemm_phase_h(PG8_LAS unsigned char* lds, const Gemm g, const Sched& S, const Epi& E, const Hook& H) {
    int tid_ = threadIdx.x; asm volatile("" : "+v"(tid_));
    const int tid = tid_, wid = __builtin_amdgcn_readfirstlane(tid >> 6), lane = tid & 63, wr = wid >> 2, wc = wid & 3, fr = lane & 15, fq = lane >> 4;
    const int K = g.K, nt = K / BK;
    unsigned voffA[2], voffB[2];
#pragma unroll
    for (int i = 0; i < 2; ++i) { int R, C; stage_rc(tid * 16 + i * 8192, R, C); const int Rb = Epi::PERM ? ((R & ~31) + perm32(R & 31)) : R;
        voffA[i] = (unsigned)(R * g.lda + C) * 2u; voffB[i] = (unsigned)(Rb * g.ldb + C) * 2u; }
    const size_t kstep = (size_t)(BK * 2);
    const size_t hstepA = (size_t)HALF * g.lda * 2, hstepB = (size_t)HALF * g.ldb * 2;
    const size_t tstepA = 2 * hstepA, tstepB = 2 * hstepB;
    const unsigned ldsw = (unsigned)wid * 1024u;
    const int aoff = lds_byte(wr * 64 + fr, fq * 8), boff = lds_byte(wc * 32 + fr, fq * 8);
#define PG8_SA(b, h) (((b) * 2 + (h)) * HTB)
#define PG8_SB(b, h) ((4 + (b) * 2 + (h)) * HTB)
#define PG8_STAGE(bufoff, gbase, voff) do { _Pragma("unroll") for (int _i = 0; _i < 2; ++_i) \
        __builtin_amdgcn_global_load_lds((const unsigned*)((const char*)(gbase) + (voff)[_i]), (PG8_LAS unsigned*)(lds + (bufoff) + ldsw + _i * 8192), 16, 0, 0); } while (0)
#define PG8_LDA(dst, b, h) do { _Pragma("unroll") for (int m = 0; m < 4; ++m) _Pragma("unroll") for (int k = 0; k < 2; ++k) dst[m][k] = *(const PG8_LAS bf16x8*)(lds + PG8_SA(b, h) + aoff + m * 2048 + k * 1024); } while (0)
#define PG8_LDB(dst, b, h) do { _Pragma("unroll") for (int n = 0; n < 2; ++n) _Pragma("unroll") for (int k = 0; k < 2; ++k) dst[n][k] = *(const PG8_LAS bf16x8*)(lds + PG8_SB(b, h) + boff + n * 2048 + k * 1024); } while (0)
#define PG8_MMA(ai, bj, At, Bt) do { __builtin_amdgcn_s_setprio(1); _Pragma("unroll") for (int m = 0; m < 4; ++m) _Pragma("unroll") for (int n = 0; n < 2; ++n) _Pragma("unroll") for (int k = 0; k < 2; ++k) \
        acc[ai][bj][m][n] = __builtin_amdgcn_mfma_f32_16x16x32_bf16(Bt[n][k], At[m][k], acc[ai][bj][m][n], 0, 0, 0); __builtin_amdgcn_s_setprio(0); } while (0)
#define PG8_WAIT_V(n) asm volatile("s_waitcnt vmcnt(" #n ")" ::: "memory")
#define PG8_WAIT_L(n) asm volatile("s_waitcnt lgkmcnt(" #n ")" ::: "memory")
#define PG8_BAR __builtin_amdgcn_s_barrier()
#define PG8_SCHED __builtin_amdgcn_sched_barrier(0)
    Unit cur, nxt; int ui = 0;
    if (!S.next(0, cur)) return;
    f32x4 acc[2][2][4][2];
#pragma unroll
    for (int a = 0; a < 2; ++a)
#pragma unroll
        for (int b = 0; b < 2; ++b)
#pragma unroll
            for (int m = 0; m < 4; ++m)
#pragma unroll
                for (int n = 0; n < 2; ++n) acc[a][b][m][n] = (f32x4){0.f, 0.f, 0.f, 0.f};
    bf16x8 At[4][2], B0[2][2], B1[2][2];
    const char* cA = (const char*)g.A + (size_t)cur.pm * tstepA; const char* cB = (const char*)g.Bt + (size_t)cur.pn * tstepB;
    S.a_ready(cur);
    if constexpr (SP2) {
        PG8_STAGE(PG8_SB(0, 0), cB, voffB); PG8_STAGE(PG8_SB(0, 1), cB + hstepB, voffB); PG8_STAGE(PG8_SA(0, 0), cA, voffA); PG8_STAGE(PG8_SA(0, 1), cA + hstepA, voffA);
        if (wr == 1) PG8_BAR;
        PG8_WAIT_V(2); PG8_BAR;
        PG8_STAGE(PG8_SB(1, 0), cB + kstep, voffB); PG8_STAGE(PG8_SA(1, 0), cA + kstep, voffA); PG8_STAGE(PG8_SB(1, 1), cB + hstepB + kstep, voffB);
        PG8_WAIT_V(6); PG8_BAR;
    } else {
        PG8_STAGE(PG8_SB(0, 0), cB, voffB); PG8_STAGE(PG8_SA(0, 0), cA, voffA); PG8_STAGE(PG8_SB(0, 1), cB + hstepB, voffB); PG8_STAGE(PG8_SA(0, 1), cA + hstepA, voffA);
        if (wr == 1) PG8_BAR;
        PG8_WAIT_V(4); PG8_BAR;
        PG8_STAGE(PG8_SB(1, 0), cB + kstep, voffB); PG8_STAGE(PG8_SA(1, 0), cA + kstep, voffA); PG8_STAGE(PG8_SB(1, 1), cB + hstepB + kstep, voffB);
        PG8_WAIT_V(6); PG8_BAR;
    }
    for (;;) {
        const bool has_next = S.next(ui + 1, nxt);
        const char* nA = has_next ? (const char*)g.A + (size_t)nxt.pm * tstepA : cA; const char* nB = has_next ? (const char*)g.Bt + (size_t)nxt.pn * tstepB : cB;
        for (int t = 0; t < nt; t += 2) {
            H(acc, cur, t, wr, wc, fr, fq);
            const bool last = (t == nt - 2);
            const char* a1 = cA + (size_t)(t + 1) * kstep;
            const char* a2 = last ? nA : cA + (size_t)(t + 2) * kstep; const char* b2 = last ? nB : cB + (size_t)(t + 2) * kstep;
            const char* a3 = a2 + kstep; const char* b3 = b2 + kstep;
            if (last && has_next) S.a_ready(nxt);
            if constexpr (SP2) {
            PG8_LDB(B0, 0, 0); PG8_LDB(B1, 0, 1); PG8_SCHED; PG8_LDA(At, 0, 0); PG8_STAGE(PG8_SA(1, 1), a1 + hstepA, voffA);
            PG8_WAIT_V(8); PG8_WAIT_L(0); PG8_BAR; PG8_MMA(0, 0, At, B0); PG8_MMA(0, 1, At, B1); PG8_BAR; PG8_SCHED;
            PG8_LDA(At, 0, 1); PG8_STAGE(PG8_SB(0, 0), b2, voffB); PG8_STAGE(PG8_SB(0, 1), b2 + hstepB, voffB); PG8_STAGE(PG8_SA(0, 0), a2, voffA);
            PG8_WAIT_V(8); PG8_WAIT_L(0); PG8_BAR; PG8_MMA(1, 0, At, B0); PG8_MMA(1, 1, At, B1); PG8_BAR; PG8_SCHED;
            PG8_LDB(B0, 1, 0); PG8_LDB(B1, 1, 1); PG8_SCHED; PG8_LDA(At, 1, 0); PG8_STAGE(PG8_SA(0, 1), a2 + hstepA, voffA);
            PG8_WAIT_V(8); PG8_WAIT_L(0); PG8_BAR; PG8_MMA(0, 0, At, B0); PG8_MMA(0, 1, At, B1); PG8_BAR; PG8_SCHED;
            PG8_LDA(At, 1, 1); PG8_STAGE(PG8_SB(1, 0), b3, voffB); PG8_STAGE(PG8_SB(1, 1), b3 + hstepB, voffB); PG8_STAGE(PG8_SA(1, 0), a3, voffA);
            PG8_WAIT_V(8); PG8_WAIT_L(0); PG8_BAR; PG8_MMA(1, 0, At, B0); PG8_MMA(1, 1, At, B1); PG8_BAR; PG8_SCHED;
            } else {
            PG8_LDB(B0, 0, 0); PG8_SCHED; PG8_LDA(At, 0, 0); PG8_STAGE(PG8_SA(1, 1), a1 + hstepA, voffA);
            PG8_WAIT_L(8); PG8_BAR; PG8_WAIT_L(0); PG8_MMA(0, 0, At, B0); PG8_BAR; PG8_SCHED;
            PG8_LDB(B1, 0, 1); PG8_STAGE(PG8_SB(0, 0), b2, voffB);
            PG8_BAR; PG8_WAIT_L(0); PG8_MMA(0, 1, At, B1); PG8_BAR;
            PG8_LDA(At, 0, 1); PG8_STAGE(PG8_SA(0, 0), a2, voffA);
            PG8_BAR; PG8_WAIT_L(0); PG8_MMA(1, 0, At, B0); PG8_BAR; PG8_SCHED;
            PG8_STAGE(PG8_SB(0, 1), b2 + hstepB, voffB);
            PG8_WAIT_V(6); PG8_BAR; PG8_MMA(1, 1, At, B1); PG8_BAR;
            PG8_LDB(B0, 1, 0); PG8_SCHED; PG8_LDA(At, 1, 0); PG8_STAGE(PG8_SA(0, 1), a2 + hstepA, voffA);
            PG8_WAIT_L(8); PG8_BAR; PG8_WAIT_L(0); PG8_MMA(0, 0, At, B0); PG8_BAR; PG8_SCHED;
            PG8_LDB(B1, 1, 1); PG8_STAGE(PG8_SB(1, 0), b3, voffB);
            PG8_BAR; PG8_WAIT_L(0); PG8_MMA(0, 1, At, B1); PG8_BAR;
            PG8_LDA(At, 1, 1); PG8_STAGE(PG8_SA(1, 0), a3, voffA);
            PG8_BAR; PG8_WAIT_L(0); PG8_MMA(1, 0, At, B0); PG8_BAR; PG8_SCHED;
            PG8_STAGE(PG8_SB(1, 1), b3 + hstepB, voffB);
            PG8_WAIT_V(6); PG8_BAR; PG8_MMA(1, 1, At, B1); PG8_BAR;
            }
        }
        if constexpr (ALIGN_EPI) { if (wr == 0) PG8_BAR; }
        if constexpr (!Epi::AFTER_DRAIN) { E(acc, cur, wr, wc, fr, fq); S.done(cur); }
        if (!has_next) break;
#pragma unroll
        for (int a = 0; a < 2; ++a)
#pragma unroll
            for (int b = 0; b < 2; ++b)
#pragma unroll
                for (int m = 0; m < 4; ++m)
#pragma unroll
                    for (int n = 0; n < 2; ++n) acc[a][b][m][n] = (f32x4){0.f, 0.f, 0.f, 0.f};
        cur = nxt; cA = nA; cB = nB; ++ui;
        if constexpr (ALIGN_EPI) { if (wr == 1) PG8_BAR; }
    }
    PG8_WAIT_V(0);
    if constexpr (!ALIGN_EPI) { if (wr == 0) PG8_BAR; }
    PG8_BAR;
    if constexpr (Epi::AFTER_DRAIN) { E.fused(acc, cur, wr, wc, fr, fq, lds, wid, lane); S.done(cur); }
#undef PG8_SA
#undef PG8_SB
#undef PG8_STAGE
#undef PG8_LDA
#undef PG8_LDB
#undef PG8_MMA
#undef PG8_WAIT_V
#undef PG8_WAIT_L
#undef PG8_BAR
#undef PG8_SCHED
}
template <class Epi, class Sched, bool ALIGN_EPI = false, bool SP2 = false>
__device__ __forceinline__ void gemm_phase(PG8_LAS unsigned char* lds, const Gemm g, const Sched& S, const Epi& E) { gemm_phase_h<Epi, Sched, ALIGN_EPI, SP2, NoHook>(lds, g, S, E, NoHook{}); }
}


template <class F> struct EpiFn4 { static constexpr bool PERM = false, AFTER_DRAIN = false; F f;
    __device__ __forceinline__ void operator()(const f32x4 (&acc)[2][2][4][2], const pg8::Unit& u, int wr, int wc, int fr, int fq) const {
        const int row0 = u.pm * 256 + wr * 64 + fr, col0 = u.pn * 256 + wc * 32 + 4 * fq;
#pragma unroll
        for (int ai = 0; ai < 2; ++ai)
#pragma unroll
            for (int m = 0; m < 4; ++m)
#pragma unroll
                for (int bj = 0; bj < 2; ++bj)
#pragma unroll
                    for (int n = 0; n < 2; ++n) f(row0 + ai * 128 + m * 16, col0 + bj * 128 + n * 16, acc[ai][bj][m][n]);
    } };
template <class F> struct EpiFn8 { static constexpr bool PERM = true, AFTER_DRAIN = false; F f;
    __device__ __forceinline__ void operator()(const f32x4 (&acc)[2][2][4][2], const pg8::Unit& u, int wr, int wc, int fr, int fq) const {
        const int row0 = u.pm * 256 + wr * 64 + fr, col0 = u.pn * 256 + wc * 32 + 8 * fq;
#pragma unroll
        for (int ai = 0; ai < 2; ++ai)
#pragma unroll
            for (int m = 0; m < 4; ++m)
#pragma unroll
                for (int bj = 0; bj < 2; ++bj) f(row0 + ai * 128 + m * 16, col0 + bj * 128, acc[ai][bj][m][0], acc[ai][bj][m][1]);
    } };
template <class F> __device__ __forceinline__ void gemm_pg8_4(const Ctx& c, const bf16_t* A, int lda, const bf16_t* Bt, int ldb, int M, int N, int K, const F& f) {
    pg8::Gemm g{A, Bt, M, N, K, lda, ldb}; pg8::StaticOrder S; S.init(M, N, (int)gridDim.x, (int)blockIdx.x); EpiFn4<F> E{f};
    pg8::gemm_phase<EpiFn4<F>, pg8::StaticOrder, true, true>(c.lds, g, S, E);
}
template <class F> __device__ __forceinline__ void gemm_pg8_8(const Ctx& c, const bf16_t* A, int lda, const bf16_t* Bt, int ldb, int M, int N, int K, const F& f) {
    pg8::Gemm g{A, Bt, M, N, K, lda, ldb}; pg8::StaticOrder S; S.init(M, N, (int)gridDim.x, (int)blockIdx.x); EpiFn8<F> E{f};
    pg8::gemm_phase<EpiFn8<F>, pg8::StaticOrder, true, true>(c.lds, g, S, E);
}
__device__ __forceinline__ u32x4 pk8(f32x4 lo, f32x4 hi) { u32x4 w; w.x = pk2(lo[0], lo[1]); w.y = pk2(lo[2], lo[3]); w.z = pk2(hi[0], hi[1]); w.w = pk2(hi[2], hi[3]); return w; }
struct F8Store { bf16_t* O; int ld; __device__ __forceinline__ void operator()(int row, int col, f32x4 lo, f32x4 hi) const { *(u32x4*)(O + (size_t)row * ld + col) = pk8(lo, hi); } };
struct F8SigBias { bf16_t* O; int ld; const float* bias;
    __device__ __forceinline__ void operator()(int row, int col, f32x4 lo, f32x4 hi) const {
        lo += *(const f32x4*)(bias + col); hi += *(const f32x4*)(bias + col + 4);
#pragma unroll
        for (int j = 0; j < 4; ++j) { lo[j] = sigmoidf_(lo[j]); hi[j] = sigmoidf_(hi[j]); }
        *(u32x4*)(O + (size_t)row * ld + col) = pk8(lo, hi); } };
struct UpHook { const bf16_t* GT;
    __device__ __forceinline__ void operator()(f32x4 (&acc)[2][2][4][2], const pg8::Unit& u, int t, int wr, int wc, int fr, int fq) const {
        if (t != 8 && t != 12) return;
        const int sa = (t == 8) ? 0 : 1;
        const bf16_t* gp0 = GT + (size_t)(u.pm * 256 + wr * 64 + fr) * (3 * DM) + sa * DM + u.pn * 256 + wc * 32 + 8 * fq;
#pragma unroll
        for (int ai = 0; ai < 2; ++ai)
#pragma unroll
            for (int m = 0; m < 4; ++m) { const bf16_t* gp = gp0 + (size_t)(ai * 128 + m * 16) * (3 * DM);
#pragma unroll
                for (int bj = 0; bj < 2; ++bj) { const u32x4 ga = *(const u32x4*)(gp + bj * 128), gb = *(const u32x4*)(gp + DM + bj * 128);
                    const f32x4 a0 = unpk4((u32x2){ga.x, ga.y}), a1 = unpk4((u32x2){ga.z, ga.w}), b0 = unpk4((u32x2){gb.x, gb.y}), b1 = unpk4((u32x2){gb.z, gb.w});
#pragma unroll
                    for (int j = 0; j < 4; ++j) { acc[ai][bj][m][0][j] *= a0[j] * __builtin_amdgcn_rcpf(b0[j]); acc[ai][bj][m][1][j] *= a1[j] * __builtin_amdgcn_rcpf(b1[j]); } }
                asm volatile("" ::: "memory"); }
    } };
struct F8UpFinal { bf16_t* MG; const bf16_t* GT;
    __device__ __forceinline__ void operator()(int row, int col, f32x4 lo, f32x4 hi) const {
        const u32x4 g = *(const u32x4*)(GT + (size_t)row * (3 * DM) + 2 * DM + col);
        *(u32x4*)(MG + (size_t)row * DM + col) = pk8(lo * unpk4((u32x2){g.x, g.y}), hi * unpk4((u32x2){g.z, g.w})); } };

__device__ __forceinline__ f32x2 gelu_pk(f32x2 v) {
    const f32x2 av = __builtin_elementwise_abs(v), d = av * 0.2316418882f + 1.0f;
    f32x2 t; t.x = __builtin_amdgcn_rcpf(d.x); t.y = __builtin_amdgcn_rcpf(d.y);
    f32x2 q = t * 0.5307027145f + (-0.7265760135f); q = q * t + 0.7107068705f; q = q * t + (-0.142248368f); q = q * t + 0.127414796f; q = q * t;
    const f32x2 s = (v * v) * (-0.72134752044f);
    f32x2 e; e.x = __builtin_amdgcn_exp2f(s.x); e.y = __builtin_amdgcn_exp2f(s.y);
    const f32x2 m = v * (q * e), r = v - m;
    f32x2 o; o.x = v.x < 0.f ? m.x : r.x; o.y = v.y < 0.f ? m.y : r.y; return o;
}
struct EpiFfnAct { static constexpr bool PERM = true, AFTER_DRAIN = false;
    bf16_t* ACT; const float* rstd; const float* cw; const float* cb; float* TAILU; float* HEADU; float* HEADGV; LAS float* halo;
    __device__ __forceinline__ void operator()(const f32x4 (&acc)[2][2][4][2], const pg8::Unit& u, int wr, int wc, int fr, int fq) const {
        const int ch0 = u.pn * 128 + wc * 32 + 8 * fq, rowt = wr * 64 + fr, grow0 = u.pm * 256 + rowt;
        f32x4 c0[2], c1[2], c2[2], cbv[2];
#pragma unroll
        for (int n = 0; n < 2; ++n) { c0[n] = *(const f32x4*)(cw + ch0 + 4 * n); c1[n] = *(const f32x4*)(cw + FF + ch0 + 4 * n); c2[n] = *(const f32x4*)(cw + 2 * FF + ch0 + 4 * n); cbv[n] = *(const f32x4*)(cb + ch0 + 4 * n); }
#pragma unroll
        for (int ai = 0; ai < 2; ++ai) { const float rs3 = rstd[grow0 + ai * 128 + 48];
            if (fr >= 14) {
#pragma unroll
                for (int n = 0; n < 2; ++n) *(LAS f32x4*)(halo + (((((ai * 2 + wr) * 2 + (fr - 14)) * 4 + wc) * 4 + fq) * 8 + 4 * n)) = acc[ai][0][3][n] * rs3; } }
        asm volatile("s_waitcnt lgkmcnt(0)" ::: "memory"); __builtin_amdgcn_s_barrier(); asm volatile("" ::: "memory");
#pragma unroll
        for (int ai = 0; ai < 2; ++ai) {
            f32x4 r1p[2], r2p[2];
            if (wr == 1 || ai == 1) { const int src = (wr == 1) ? (ai * 2) : ((ai - 1) * 2 + 1);
#pragma unroll
                for (int n = 0; n < 2; ++n) { const f32x4 hv0 = *(const LAS f32x4*)(halo + ((((src * 2 + 0) * 4 + wc) * 4 + fq) * 8 + 4 * n)), hv1 = *(const LAS f32x4*)(halo + ((((src * 2 + 1) * 4 + wc) * 4 + fq) * 8 + 4 * n));
                    r1p[n] = hv1; r2p[n] = (fr == 0) ? hv0 : hv1; } }
            else { r1p[0] = r1p[1] = r2p[0] = r2p[1] = (f32x4){0.f, 0.f, 0.f, 0.f}; }
#pragma unroll
            for (int m = 0; m < 4; ++m) {
                const int grow = grow0 + ai * 128 + 16 * m; const float rs = rstd[grow];
                u32x4 w;
#pragma unroll
                for (int n = 0; n < 2; ++n) {
                    const f32x4 uu = acc[ai][0][m][n] * rs, gg = acc[ai][1][m][n] * rs;
                    f32x4 R1, R2;
#pragma unroll
                    for (int j = 0; j < 4; ++j) { R1[j] = dpp_f<0x121>(uu[j]); R2[j] = dpp_f<0x122>(uu[j]); }
                    const f32x4 p1 = (fr >= 1) ? R1 : r1p[n], p2 = (fr >= 2) ? R2 : r2p[n];
                    r1p[n] = R1; r2p[n] = R2;
                    const f32x4 uc = c0[n] * p2 + c1[n] * p1 + c2[n] * uu + cbv[n];
                    const f32x2 ga = gelu_pk((f32x2){uc[0], uc[1]}), gb = gelu_pk((f32x2){uc[2], uc[3]});
                    const unsigned lo = pk2(ga.x * gg[0], ga.y * gg[1]), hi = pk2(gb.x * gg[2], gb.y * gg[3]);
                    if (n == 0) { w.x = lo; w.y = hi; } else { w.z = lo; w.w = hi; }
                    if (ai == 0 && m == 0) { if (wr == 0 && fr < 2) { const size_t so = (size_t)(u.pm * 2 + fr) * FF + ch0 + 4 * n; *(f32x4*)(HEADU + so) = uu; *(f32x4*)(HEADGV + so) = gg; } }
                    if (ai == 1 && m == 3) { if (wr == 1 && fr >= 14) { const size_t so = (size_t)(u.pm * 2 + (fr - 14)) * FF + ch0 + 4 * n; *(f32x4*)(TAILU + so) = uu; } }
                }
                *(u32x4*)(ACT + (size_t)grow * FF + ch0) = w;
            }
        }
    } };
__device__ __forceinline__ void phase_ffn_fix(const Params& p, const Ctx& c) {
    unsigned char* ws = p.ws;
    const float* TAILU = (const float*)(ws + WS_TAILU); const float* HEADU = (const float*)(ws + WS_HEADU); const float* HEADGV = (const float*)(ws + WS_HEADGV); bf16_t* ACT = (bf16_t*)(ws + WS_ACT);
    const float* cw = p.in[I_CONVW]; const float* cb = p.in[I_CONVB];
    const int nit = (MTOK / 256) * 2 * (FF / 4);
    for (int idx = blockIdx.x * NTHREADS + c.tid; idx < nit; idx += gridDim.x * NTHREADS) {
        const int col = 4 * (idx % (FF / 4)), pr = idx / (FF / 4), pm = pr >> 1, rr = pr & 1;
        if ((pm & 15) == 0) continue;
        const f32x4 u0 = *(const f32x4*)(HEADU + (size_t)(pm * 2 + rr) * FF + col), gg = *(const f32x4*)(HEADGV + (size_t)(pm * 2 + rr) * FF + col);
        const f32x4 t1 = *(const f32x4*)(TAILU + (size_t)((pm - 1) * 2 + 1) * FF + col), t0 = *(const f32x4*)(TAILU + (size_t)((pm - 1) * 2 + 0) * FF + col);
        f32x4 u1, u2; if (rr == 0) { u1 = t1; u2 = t0; } else { u1 = *(const f32x4*)(HEADU + (size_t)(pm * 2) * FF + col); u2 = t1; }
        const f32x4 uc = *(const f32x4*)(cw + col) * u2 + *(const f32x4*)(cw + FF + col) * u1 + *(const f32x4*)(cw + 2 * FF + col) * u0 + *(const f32x4*)(cb + col);
        const f32x2 ga = gelu_pk((f32x2){uc[0], uc[1]}), gb = gelu_pk((f32x2){uc[2], uc[3]});
        u32x2 w; w.x = pk2(ga.x * gg[0], ga.y * gg[1]); w.y = pk2(gb.x * gg[2], gb.y * gg[3]);
        *(u32x2*)(ACT + (size_t)(pm * 256 + rr) * FF + col) = w;
    }
}

__device__ __forceinline__ void wave_gemm_32x64(const bf16_t* A, int lda, const bf16_t* Bt, int ldb, int K, int m0, int n0, int fr, int fq, f32x4 (&acc)[2][4]) {
    const bf16_t* ap = A + (size_t)(m0 + fr) * lda + 8 * fq;
    const bf16_t* bp = Bt + (size_t)(n0 + fr) * ldb + 8 * fq;
    for (int k0 = 0; k0 < K; k0 += 32) {
        const bf16x8 a0 = *(const bf16x8*)(ap + k0), a1 = *(const bf16x8*)(ap + (size_t)16 * lda + k0);
        bf16x8 b[4];
#pragma unroll
        for (int j = 0; j < 4; ++j) b[j] = *(const bf16x8*)(bp + (size_t)(16 * j) * ldb + k0);
#pragma unroll
        for (int j = 0; j < 4; ++j) { acc[0][j] = __builtin_amdgcn_mfma_f32_16x16x32_bf16(b[j], a0, acc[0][j], 0, 0, 0); acc[1][j] = __builtin_amdgcn_mfma_f32_16x16x32_bf16(b[j], a1, acc[1][j], 0, 0, 0); }
    }
}
template <class Epi>
__device__ __forceinline__ void gemm_simple(const Ctx& c, const bf16_t* A, int lda, const bf16_t* Bt, int ldb, int M, int N, int K, const Epi& epi) {
    const int nMt = M / 256, nNt = N / 64, ntiles = nMt * nNt;
    for (int tile = blockIdx.x; tile < ntiles; tile += gridDim.x) {
        const int tm = tile % nMt, tn = tile / nMt, m0 = tm * 256 + c.wave * 32, n0 = tn * 64;
        f32x4 acc[2][4];
#pragma unroll
        for (int i = 0; i < 2; ++i)
#pragma unroll
            for (int j = 0; j < 4; ++j) acc[i][j] = (f32x4){0.f, 0.f, 0.f, 0.f};
        wave_gemm_32x64(A, lda, Bt, ldb, K, m0, n0, c.fr, c.fq, acc);
#pragma unroll
        for (int i = 0; i < 2; ++i)
#pragma unroll
            for (int j = 0; j < 4; ++j) epi(m0 + 16 * i + c.fr, n0 + 16 * j + 4 * c.fq, acc[i][j]);
    }
}

struct EpiBf16 { bf16_t* O; int ld; __device__ __forceinline__ void operator()(int row, int col, f32x4 v) const { *(u32x2*)(O + (size_t)row * ld + col) = pk4(v); } };
struct EpiKV { bf16_t* KB; bf16_t* VT;
    __device__ __forceinline__ void operator()(int row, int col, f32x4 v) const {
        if (col < 256) { *(u32x2*)(KB + (size_t)row * 256 + col) = pk4(v); }
        else { const int cc = col - 256, h = cc >> 6, d = cc & 63, b = row >> 8, key = row & 255;
#pragma unroll
            for (int j = 0; j < 4; ++j) VT[((size_t)((b * 4 + h) * 64 + d + j)) * 256 + key] = (bf16_t)f2bf(v[j]); }
    } };
struct EpiDecay { float* W; const float* w0;
    __device__ __forceinline__ void operator()(int row, int col, f32x4 v) const {
        const f32x4 z = v + *(const f32x4*)(w0 + col); f32x4 o;
#pragma unroll
        for (int j = 0; j < 4; ++j) o[j] = 0.60653065971f * sigmoidf_(z[j]);
        *(f32x4*)(W + (size_t)row * RD + col) = o; } };
struct EpiSigBias { bf16_t* O; int ld; const float* bias;
    __device__ __forceinline__ void operator()(int row, int col, f32x4 v) const {
        const f32x4 z = v + *(const f32x4*)(bias + col); f32x4 o;
#pragma unroll
        for (int j = 0; j < 4; ++j) o[j] = sigmoidf_(z[j]);
        *(u32x2*)(O + (size_t)row * ld + col) = pk4(o); } };
struct EpiPool { bf16_t* Y; const float* scale; int gi;
    __device__ __forceinline__ void operator()(int row, int col, f32x4 v) const {
        const f32x4 s = *(const f32x4*)(scale + 64 * gi + col); *(u32x2*)(Y + (size_t)row * DM + 512 + 64 * gi + col) = pk4(v * s); } };
struct EpiOut { const float* x; float* x1; bf16_t* x1b;
    __device__ __forceinline__ void operator()(int row, int col, f32x4 v) const {
        const size_t off = (size_t)row * DM + col; const f32x4 o = *(const f32x4*)(x + off) + v; *(f32x4*)(x1 + off) = o; *(u32x2*)(x1b + off) = pk4(o); } };
struct EpiAddOut { float* x;
    __device__ __forceinline__ void operator()(int row, int col, f32x4 v) const { const size_t off = (size_t)row * DM + col; *(f32x4*)(x + off) = *(const f32x4*)(x + off) + v; } };

__device__ __forceinline__ void phase_mix(const Params& p, const Ctx& c) {
    unsigned char* ws = p.ws;
    const bf16_t* P = (const bf16_t*)(ws + WS_P); const float* mu = p.in[I_MU];
    bf16_t* R = (bf16_t*)(ws + WS_R); bf16_t* KR = (bf16_t*)(ws + WS_KRAW); bf16_t* V = (bf16_t*)(ws + WS_V);
    bf16_t* LW = (bf16_t*)(ws + WS_LW); bf16_t* LA = (bf16_t*)(ws + WS_LA); bf16_t* LG = (bf16_t*)(ws + WS_LG);
    constexpr int RPW = 16;
    f32x4 m4[7];
#pragma unroll
    for (int i = 0; i < 7; ++i) m4[i] = *(const f32x4*)(mu + 4 * c.lane + 256 * i);
    for (int blk = c.gw; blk < MTOK / RPW; blk += c.ngw) {
        const int row0 = blk * RPW;
        f32x4 pv[7];
#pragma unroll
        for (int i = 0; i < 7; ++i) pv[i] = (row0 & (SEQ - 1)) ? unpk4(*(const u32x2*)(P + (size_t)(row0 - 1) * MIXIN + 4 * c.lane + 256 * i)) : (f32x4){0.f, 0.f, 0.f, 0.f};
#pragma unroll 2
        for (int rr = 0; rr < RPW; ++rr) {
            const int row = row0 + rr; const bf16_t* cur = P + (size_t)row * MIXIN;
            u32x2 cu[7];
#pragma unroll
            for (int i = 0; i < 7; ++i) cu[i] = *(const u32x2*)(cur + 4 * c.lane + 256 * i);
#pragma unroll
            for (int i = 0; i < 7; ++i) {
                const int col = 4 * c.lane + 256 * i;
                const f32x4 cv = unpk4(cu[i]);
                const f32x4 pm = cv + (pv[i] - cv) * m4[i];
                pv[i] = cv;
                if (i < 2) *(u32x2*)(R + (size_t)row * RD + col) = pk4(pm);
                else if (i < 4) *(u32x2*)(KR + (size_t)row * RD + (col - 512)) = pk4(pm);
                else if (i < 6) *(u32x2*)(V + (size_t)row * RD + (col - 1024)) = pk4(pm);
                else {
                    const int cc = col - 1536;
                    if (cc < 64) { f32x4 o; o[0] = tanhf(pm[0]); o[1] = tanhf(pm[1]); o[2] = tanhf(pm[2]); o[3] = tanhf(pm[3]); *(u32x2*)(LW + (size_t)row * 64 + cc) = pk4(o); }
                    else if (cc < 128) { *(u32x2*)(LA + (size_t)row * 64 + (cc - 64)) = pk4(pm); }
                    else { f32x4 o; o[0] = sigmoidf_(pm[0]); o[1] = sigmoidf_(pm[1]); o[2] = sigmoidf_(pm[2]); o[3] = sigmoidf_(pm[3]); *(u32x2*)(LG + (size_t)row * 128 + (cc - 128)) = pk4(o); }
                }
            }
        }
    }
}
__device__ __forceinline__ void phase_pooldiff(const Params& p, const Ctx& c) {
    unsigned char* ws = p.ws;
    const bf16_t* P = (const bf16_t*)(ws + WS_P); bf16_t* DP = (bf16_t*)(ws + WS_DPOOL);
    const int col = 4 * c.lane, gi = c.lane >> 4, win = 2 << gi;
    constexpr int RPW = 16;
    for (int blk = c.gw; blk < MTOK / RPW; blk += c.ngw) {
        const int row0 = blk * RPW, t0 = row0 & (SEQ - 1);
        const bf16_t* base = P + (size_t)row0 * MIXIN + RWKVIN + col;
        f32x4 s = (f32x4){0.f, 0.f, 0.f, 0.f};
#pragma unroll
        for (int j = 1; j < 16; ++j) if (j < win && j <= t0) s += unpk4(*(const u32x2*)(base - (size_t)j * MIXIN));
#pragma unroll 4
        for (int rr = 0; rr < RPW; ++rr) {
            const int t = t0 + rr; const bf16_t* cur = base + (size_t)rr * MIXIN;
            const f32x4 x0 = unpk4(*(const u32x2*)cur);
            f32x4 xo = (f32x4){0.f, 0.f, 0.f, 0.f}; if (t - win + 1 >= 0) xo = unpk4(*(const u32x2*)(cur - (size_t)(win - 1) * MIXIN));
            s += x0;
            const int cnt = (t + 1) < win ? (t + 1) : win;
            *(u32x2*)(DP + (size_t)(row0 + rr) * 256 + col) = pk4(s * (1.0f / (float)cnt) - x0);
            s -= xo;
        }
    }
}
__device__ __forceinline__ void phase_memattn(const Params& p, const Ctx& c) {
    unsigned char* ws = p.ws;
    const bf16_t* P = (const bf16_t*)(ws + WS_P); const bf16_t* KB = (const bf16_t*)(ws + WS_KB); const bf16_t* VT = (const bf16_t*)(ws + WS_VT); bf16_t* Y = (bf16_t*)(ws + WS_YCAT);
    constexpr int KS = 72, VS = 264;
    LAS bf16_t* LK = (LAS bf16_t*)c.lds; LAS bf16_t* LV = (LAS bf16_t*)(c.lds + 256 * KS * 2);
    const int fr = c.fr, fq = c.fq, tid = c.tid;
    for (int grp = blockIdx.x; grp < BATCH * 4 * 8; grp += gridDim.x) {
        const int pp = grp & 7, h = (grp >> 3) & 3, b = grp >> 5;
        __syncthreads();
        { const int row = tid >> 1, hf = tid & 1; const u32x4* src = (const u32x4*)(KB + (size_t)(b * 256 + row) * 256 + h * 64 + 32 * hf);
#pragma unroll
          for (int i = 0; i < 4; ++i) *(LAS u32x4*)(LK + row * KS + 32 * hf + 8 * i) = src[i];
          const int d = tid >> 3, sg = tid & 7; const u32x4* sv = (const u32x4*)(VT + ((size_t)((b * 4 + h) * 64 + d)) * 256 + 32 * sg);
#pragma unroll
          for (int i = 0; i < 4; ++i) *(LAS u32x4*)(LV + d * VS + 32 * sg + 8 * i) = sv[i]; }
        __syncthreads();
#pragma unroll 1
        for (int it = 0; it < 4; ++it) {
            const int qt = 2 * pp + (it >> 1), qg = it & 1;
            const int row = b * SEQ + qt * 256 + c.wave * 32 + 16 * qg + fr;
            const bf16x8 q0 = *(const bf16x8*)(P + (size_t)row * MIXIN + 2048 + h * 64 + 8 * fq), q1 = *(const bf16x8*)(P + (size_t)row * MIXIN + 2048 + h * 64 + 32 + 8 * fq);
            f32x4 sc[16];
#pragma unroll
            for (int kg = 0; kg < 16; ++kg) {
                const LAS bf16_t* kp = LK + (16 * kg + fr) * KS + 8 * fq;
                f32x4 a = (f32x4){0.f, 0.f, 0.f, 0.f};
                a = __builtin_amdgcn_mfma_f32_16x16x32_bf16(*(const LAS bf16x8*)kp, q0, a, 0, 0, 0); a = __builtin_amdgcn_mfma_f32_16x16x32_bf16(*(const LAS bf16x8*)(kp + 32), q1, a, 0, 0, 0); sc[kg] = a;
                if ((kg & 3) == 3) asm volatile("" ::: "memory");
            }
            float m = -1e30f;
#pragma unroll
            for (int kg = 0; kg < 16; ++kg) m = fmaxf(m, fmaxf(fmaxf(sc[kg][0], sc[kg][1]), fmaxf(sc[kg][2], sc[kg][3])));
            m = fmaxf(m, __shfl_xor(m, 16)); m = fmaxf(m, __shfl_xor(m, 32));
            float l = 0.f;
#pragma unroll
            for (int kg = 0; kg < 16; ++kg)
#pragma unroll
                for (int j = 0; j < 4; ++j) { const float e = __expf((sc[kg][j] - m) * 0.125f); sc[kg][j] = e; l += e; }
            l += __shfl_xor(l, 16); l += __shfl_xor(l, 32);
            const float linv = 1.0f / l;
            f32x4 o[4];
#pragma unroll
            for (int dg = 0; dg < 4; ++dg) o[dg] = (f32x4){0.f, 0.f, 0.f, 0.f};
#pragma unroll
            for (int s2 = 0; s2 < 8; ++s2) {
                u32x4 w; w.x = pk2(sc[2 * s2][0], sc[2 * s2][1]); w.y = pk2(sc[2 * s2][2], sc[2 * s2][3]); w.z = pk2(sc[2 * s2 + 1][0], sc[2 * s2 + 1][1]); w.w = pk2(sc[2 * s2 + 1][2], sc[2 * s2 + 1][3]);
                const bf16x8 pf = __builtin_bit_cast(bf16x8, w);
#pragma unroll
                for (int dg = 0; dg < 4; ++dg) {
                    const LAS bf16_t* vp = LV + (16 * dg + fr) * VS + 32 * s2 + 4 * fq;
                    u32x4 v; const u32x2 lo = *(const LAS u32x2*)vp, hi = *(const LAS u32x2*)(vp + 16); v.x = lo.x; v.y = lo.y; v.z = hi.x; v.w = hi.y;
                    o[dg] = __builtin_amdgcn_mfma_f32_16x16x32_bf16(__builtin_bit_cast(bf16x8, v), pf, o[dg], 0, 0, 0);
                }
                if (s2 & 1) asm volatile("" ::: "memory");
            }
#pragma unroll
            for (int dg = 0; dg < 4; ++dg) *(u32x2*)(Y + (size_t)row * DM + 768 + h * 64 + 16 * dg + 4 * fq) = pk4(o[dg] * linv);
        }
    }
}

#define MF16(a, b, c) __builtin_amdgcn_mfma_f32_16x16x32_bf16((a), (b), (c), 0, 0, 0)
__device__ __forceinline__ bf16x8 pack4z(f32x4 x) { u32x4 w; w.x = pk2(x[0], x[1]); w.y = pk2(x[2], x[3]); w.z = 0u; w.w = 0u; return __builtin_bit_cast(bf16x8, w); }
__device__ __forceinline__ bf16x8 frag4z(const LAS bf16_t* p) { const u32x2 v = *(const LAS u32x2*)p; u32x4 w; w.x = v.x; w.y = v.y; w.z = 0u; w.w = 0u; return __builtin_bit_cast(bf16x8, w); }
__device__ __forceinline__ bf16x8 raw4z(u32x2 v) { u32x4 w; w.x = v.x; w.y = v.y; w.z = 0u; w.w = 0u; return __builtin_bit_cast(bf16x8, w); }
__device__ __forceinline__ float sum8(float x) { x += dpp_f<0xB1>(x); x += dpp_f<0x4E>(x); x += dpp_f<0x141>(x); return x; }
constexpr int CH = 64, NCHUNK = SEQ / CH, NTASK = BATCH * 8 * NCHUNK;
constexpr int RS = 72;
constexpr int S1_QK = 0, S1_QR = 9216, S1_QB = 18432, S1_QKH = 27648, S1_BTN = 36864, S1_KHT = 46080, S1_VT = 55296;
constexpr int S1_AAB = 64512, S1_AAK = 73728, S1_ARB = 82944, S1_ARK = 92160, S1_EC = 101376, S1_DG = 117760, S1_DI = 121856, S1_GC = 124928, S1_SEG = 125184;
constexpr int DIS = 24;
__device__ __forceinline__ void phase_s1(const Params& p, const Ctx& c) {
    unsigned char* ws = p.ws;
    const bf16_t* R = (const bf16_t*)(ws + WS_R); const bf16_t* KR = (const bf16_t*)(ws + WS_KRAW); const bf16_t* V = (const bf16_t*)(ws + WS_V); const bf16_t* AA = (const bf16_t*)(ws + WS_AA);
    const float* EW = (const float*)(ws + WS_W); float* BON = (float*)(ws + WS_BONUS);
    u32x2* RTT = (u32x2*)((unsigned char*)p.out + DO_RTT); u32x2* MTT = (u32x2*)((unsigned char*)p.out + DO_MTT); u32x2* Y0D = (u32x2*)((unsigned char*)p.out + DO_Y0D); u32x2* ND = (u32x2*)((unsigned char*)p.out + DO_ND);
    LAS unsigned char* L = c.lds;
    LAS bf16_t* QK = (LAS bf16_t*)(L + S1_QK); LAS bf16_t* QR = (LAS bf16_t*)(L + S1_QR); LAS bf16_t* QB = (LAS bf16_t*)(L + S1_QB); LAS bf16_t* QKH = (LAS bf16_t*)(L + S1_QKH);
    LAS bf16_t* BTN = (LAS bf16_t*)(L + S1_BTN); LAS bf16_t* KHT = (LAS bf16_t*)(L + S1_KHT); LAS bf16_t* VT = (LAS bf16_t*)(L + S1_VT);
    LAS bf16_t* AAB = (LAS bf16_t*)(L + S1_AAB); LAS bf16_t* AAK = (LAS bf16_t*)(L + S1_AAK); LAS bf16_t* ARB = (LAS bf16_t*)(L + S1_ARB); LAS bf16_t* ARK = (LAS bf16_t*)(L + S1_ARK);
    LAS float* EC = (LAS float*)(L + S1_EC); LAS float* DG = (LAS float*)(L + S1_DG); LAS bf16_t* DI = (LAS bf16_t*)(L + S1_DI); LAS float* GC = (LAS float*)(L + S1_GC); LAS float* SEG = (LAS float*)(L + S1_SEG);
    const int tid = c.tid, fr = c.fr, fq = c.fq, wave = c.wave, lane = c.lane;
    const int st = tid >> 3, cg = tid & 7;
    for (int task = blockIdx.x; task < NTASK; task += gridDim.x) {
        const int bh = task >> 6, ch = task & 63, b = bh >> 3, h = bh & 7;
        const size_t grow = (size_t)b * SEQ + ch * CH + st, goff = grow * RD + h * 64 + 8 * cg;
        __syncthreads();
        float r8[8], k8[8], v8[8], a8[8], e8[8];
        { const u32x4 ur = *(const u32x4*)(R + goff), uk = *(const u32x4*)(KR + goff), uv = *(const u32x4*)(V + goff), ua = *(const u32x4*)(AA + goff);
          const f32x4 e0 = *(const f32x4*)(EW + goff), e1 = *(const f32x4*)(EW + goff + 4);
          const unsigned wr_[4] = {ur.x, ur.y, ur.z, ur.w}, wk_[4] = {uk.x, uk.y, uk.z, uk.w}, wv_[4] = {uv.x, uv.y, uv.z, uv.w}, wa_[4] = {ua.x, ua.y, ua.z, ua.w};
#pragma unroll
          for (int i = 0; i < 4; ++i) { r8[2 * i] = bf2f(wr_[i] & 0xffffu); r8[2 * i + 1] = bf2f(wr_[i] >> 16); k8[2 * i] = bf2f(wk_[i] & 0xffffu); k8[2 * i + 1] = bf2f(wk_[i] >> 16);
              v8[2 * i] = bf2f(wv_[i] & 0xffffu); v8[2 * i + 1] = bf2f(wv_[i] >> 16); a8[2 * i] = bf2f(wa_[i] & 0xffffu); a8[2 * i + 1] = bf2f(wa_[i] >> 16); e8[i] = e0[i]; e8[4 + i] = e1[i]; } }
        float kap8[8], bb8[8], kf8[8]; float nrm = 0.f, bon = 0.f;
#pragma unroll
        for (int i = 0; i < 8; ++i) { const int col = h * 64 + 8 * cg + i; const float kkv = k8[i] * p.in[I_KK][col]; kap8[i] = kkv; nrm += kkv * kkv;
            kf8[i] = k8[i] * (1.0f + (a8[i] - 1.0f) * p.in[I_KA][col]); bon += r8[i] * kf8[i] * p.in[I_RK][col]; }
        nrm = sum8(nrm); bon = sum8(bon);
        const float rn = rsqrtf(nrm + 1e-12f);
#pragma unroll
        for (int i = 0; i < 8; ++i) { kap8[i] *= rn; bb8[i] = kap8[i] * a8[i]; }
        if (cg == 0) BON[grow * 8 + h] = bon;
        *(LAS f32x4*)(EC + st * 64 + 8 * cg) = (f32x4){e8[0], e8[1], e8[2], e8[3]}; *(LAS f32x4*)(EC + st * 64 + 8 * cg + 4) = (f32x4){e8[4], e8[5], e8[6], e8[7]};
        __syncthreads();
        { const int cc = tid & 63, sg = tid >> 6; float run = 0.f;
#pragma unroll
          for (int i = 0; i < 8; ++i) { run += EC[(8 * sg + i) * 64 + cc]; EC[(8 * sg + i) * 64 + cc] = run; }
          SEG[sg * 64 + cc] = run;
          __syncthreads();
          float off = 0.f;
#pragma unroll
          for (int s2 = 0; s2 < 7; ++s2) off += (s2 < sg) ? SEG[s2 * 64 + cc] : 0.f;
#pragma unroll
          for (int i = 0; i < 8; ++i) EC[(8 * sg + i) * 64 + cc] += off;
          if (sg == 7) GC[cc] = __expf(-(run + off)); }
        __syncthreads();
        { float cum[8]; const f32x4 c0 = *(const LAS f32x4*)(EC + st * 64 + 8 * cg), c1 = *(const LAS f32x4*)(EC + st * 64 + 8 * cg + 4);
#pragma unroll
          for (int i = 0; i < 4; ++i) { cum[i] = c0[i]; cum[4 + i] = c1[i]; }
          float kh[8], rh[8], bh8[8], kk8[8];
#pragma unroll
          for (int i = 0; i < 8; ++i) { const float gi = __expf(cum[i]); kh[i] = kap8[i] * __expf(e8[i] - cum[i]); rh[i] = r8[i] * __expf(-cum[i]); bh8[i] = bb8[i] * gi; kk8[i] = kf8[i] * gi; }
          u32x4 w;
          w.x = pk2(kh[0], kh[1]); w.y = pk2(kh[2], kh[3]); w.z = pk2(kh[4], kh[5]); w.w = pk2(kh[6], kh[7]); *(LAS u32x4*)(QK + st * RS + 8 * cg) = w;
          w.x = pk2(rh[0], rh[1]); w.y = pk2(rh[2], rh[3]); w.z = pk2(rh[4], rh[5]); w.w = pk2(rh[6], rh[7]); *(LAS u32x4*)(QR + st * RS + 8 * cg) = w;
          w.x = pk2(bh8[0], bh8[1]); w.y = pk2(bh8[2], bh8[3]); w.z = pk2(bh8[4], bh8[5]); w.w = pk2(bh8[6], bh8[7]); *(LAS u32x4*)(QB + st * RS + 8 * cg) = w;
          w.x = pk2(kk8[0], kk8[1]); w.y = pk2(kk8[2], kk8[3]); w.z = pk2(kk8[4], kk8[5]); w.w = pk2(kk8[6], kk8[7]); *(LAS u32x4*)(QKH + st * RS + 8 * cg) = w;
#pragma unroll
          for (int i = 0; i < 8; ++i) { BTN[(8 * cg + i) * RS + st] = (bf16_t)f2bf(-bh8[i]); KHT[(8 * cg + i) * RS + st] = (bf16_t)f2bf(kk8[i]); VT[(8 * cg + i) * RS + st] = (bf16_t)f2bf(v8[i]); } }
        __syncthreads();
        { const int mat = wave >> 1; const LAS bf16_t* Am = (mat < 2) ? QK : QR; const LAS bf16_t* Bm = (mat & 1) ? QKH : QB; LAS bf16_t* Om = (mat == 0) ? AAB : (mat == 1) ? AAK : (mat == 2) ? ARB : ARK;
          const bool strict = mat < 2; const float sgn = (mat & 1) ? 1.0f : -1.0f;
#pragma unroll
          for (int jj = 0; jj < 2; ++jj) { const int j = 2 * (wave & 1) + jj;
              const bf16x8 bt0 = *(const LAS bf16x8*)(Am + (16 * j + fr) * RS + 8 * fq), bt1 = *(const LAS bf16x8*)(Am + (16 * j + fr) * RS + 32 + 8 * fq);
#pragma unroll
              for (int l = 0; l < 4; ++l) {
                  f32x4 d = (f32x4){0.f, 0.f, 0.f, 0.f};
                  d = MF16(*(const LAS bf16x8*)(Bm + (16 * l + fr) * RS + 8 * fq), bt0, d); d = MF16(*(const LAS bf16x8*)(Bm + (16 * l + fr) * RS + 32 + 8 * fq), bt1, d);
                  const int t = 16 * j + fr, i0 = 16 * l + 4 * fq;
#pragma unroll
                  for (int rg = 0; rg < 4; ++rg) { const bool keep = strict ? (i0 + rg < t) : (i0 + rg <= t); d[rg] = keep ? d[rg] : 0.f; }
                  if (mat == 0 && l == j) *(LAS f32x4*)(DG + (j * 16 + fr) * 16 + 4 * fq) = d;
                  *(LAS u32x2*)(Om + t * RS + i0) = pk4(d * sgn);
              } } }
        __syncthreads();
        f32x4 Z[4], Z1[4], Ee[4];
        if (wave == 0) {
            const int j = lane >> 4, col = lane & 15; float x[16];
#pragma unroll
            for (int t = 0; t < 16; ++t) { float sacc = (t == col) ? 1.0f : 0.0f;
#pragma unroll
                for (int i = 0; i < t; ++i) sacc -= DG[(j * 16 + t) * 16 + i] * x[i];
                x[t] = sacc; }
#pragma unroll
            for (int t = 0; t < 16; ++t) DI[(j * 16 + t) * DIS + col] = (bf16_t)f2bf(x[t]);
        }
        if (wave >= 4) { const int vb = wave - 4;
#pragma unroll
            for (int j = 0; j < 4; ++j) { Z[j] = Z1[j] = Ee[j] = (f32x4){0.f, 0.f, 0.f, 0.f};
#pragma unroll
                for (int s2 = 0; s2 < 2; ++s2) { const bf16x8 bv = *(const LAS bf16x8*)(VT + (16 * vb + fr) * RS + 32 * s2 + 8 * fq);
                    Z[j] = MF16(*(const LAS bf16x8*)(AAK + (16 * j + fr) * RS + 32 * s2 + 8 * fq), bv, Z[j]);
                    Z1[j] = MF16(*(const LAS bf16x8*)(ARK + (16 * j + fr) * RS + 32 * s2 + 8 * fq), bv, Z1[j]);
                    Ee[j] = MF16(*(const LAS bf16x8*)(KHT + (16 * j + fr) * RS + 32 * s2 + 8 * fq), bv, Ee[j]); } } }
        else {
#pragma unroll
            for (int j = 0; j < 4; ++j)
#pragma unroll
                for (int rg = 0; rg < 4; ++rg) Z[j][rg] = bf2f(QK[(16 * j + 4 * fq + rg) * RS + 16 * wave + fr]); }
        __syncthreads();
        f32x4 X[4];
#pragma unroll
        for (int j = 0; j < 4; ++j) { f32x4 acc = Z[j];
#pragma unroll
            for (int l = 0; l < 4; ++l) if (l < j) acc = MF16(frag4z(AAB + (16 * j + fr) * RS + 16 * l + 4 * fq), pack4z(X[l]), acc);
            X[j] = MF16(frag4z(DI + (j * 16 + fr) * DIS + 4 * fq), pack4z(acc), ((f32x4){0.f, 0.f, 0.f, 0.f})); }
        const size_t dbase = ((size_t)task * 4 + (wave & 3)) * 4 * 64 + lane;
        if (wave >= 4) {
#pragma unroll
            for (int j = 0; j < 4; ++j) { f32x4 y0 = Z1[j];
#pragma unroll
                for (int l = 0; l < 4; ++l) if (l <= j) y0 = MF16(frag4z(ARB + (16 * j + fr) * RS + 16 * l + 4 * fq), pack4z(X[l]), y0);
                Y0D[dbase + j * 64] = pk4(y0);
                f32x4 nn = Ee[j];
#pragma unroll
                for (int l = 0; l < 4; ++l) nn = MF16(frag4z(BTN + (16 * j + fr) * RS + 16 * l + 4 * fq), pack4z(X[l]), nn);
#pragma unroll
                for (int rg = 0; rg < 4; ++rg) nn[rg] *= GC[16 * j + 4 * fq + rg];
                ND[dbase + j * 64] = pk4(nn); } }
        else {
#pragma unroll
            for (int j = 0; j < 4; ++j) { f32x4 rt = unpk4(*(const LAS u32x2*)(QR + (16 * j + fr) * RS + 16 * wave + 4 * fq));
#pragma unroll
                for (int l = 0; l < 4; ++l) if (l <= j) rt = MF16(pack4z(X[l]), frag4z(ARB + (16 * j + fr) * RS + 16 * l + 4 * fq), rt);
                RTT[dbase + j * 64] = pk4(rt);
                f32x4 mt;
#pragma unroll
                for (int rg = 0; rg < 4; ++rg) mt[rg] = (16 * wave + 4 * fq + rg == 16 * j + fr) ? 1.0f : 0.0f;
#pragma unroll
                for (int l = 0; l < 4; ++l) mt = MF16(pack4z(X[l]), frag4z(BTN + (16 * j + fr) * RS + 16 * l + 4 * fq), mt);
                MTT[dbase + j * 64] = pk4(mt * GC[16 * j + fr]); } }
    }
}
__device__ __forceinline__ void phase_s2(const Params& p, const Ctx& c) {
    if (c.wave != 0) return;
    const u32x2* MTT = (const u32x2*)((unsigned char*)p.out + DO_MTT); const u32x2* ND = (const u32x2*)((unsigned char*)p.out + DO_ND); u32x2* SP = (u32x2*)(p.ws + WS_SP);
    const int lane = c.lane;
    for (int unit = blockIdx.x; unit < BATCH * 8 * 4; unit += gridDim.x) {
        const int vb = unit & 3, bh = unit >> 2;
        f32x4 S[4];
#pragma unroll
        for (int j = 0; j < 4; ++j) S[j] = (f32x4){0.f, 0.f, 0.f, 0.f};
        u32x2 mc[4][4], nc[4];
        { const size_t task = (size_t)bh * NCHUNK;
#pragma unroll
          for (int l = 0; l < 4; ++l)
#pragma unroll
              for (int j = 0; j < 4; ++j) mc[l][j] = MTT[((task * 4 + l) * 4 + j) * 64 + lane];
#pragma unroll
          for (int j = 0; j < 4; ++j) nc[j] = ND[((task * 4 + vb) * 4 + j) * 64 + lane]; }
        for (int ch = 0; ch < NCHUNK; ++ch) {
            const size_t task = (size_t)bh * NCHUNK + ch, tn = (ch + 1 < NCHUNK) ? task + 1 : task;
            u32x2 mn[4][4], nn[4];
#pragma unroll
            for (int l = 0; l < 4; ++l)
#pragma unroll
                for (int j = 0; j < 4; ++j) mn[l][j] = MTT[((tn * 4 + l) * 4 + j) * 64 + lane];
#pragma unroll
            for (int j = 0; j < 4; ++j) nn[j] = ND[((tn * 4 + vb) * 4 + j) * 64 + lane];
            bf16x8 sp[4];
#pragma unroll
            for (int l = 0; l < 4; ++l) { const u32x2 w = pk4(S[l]); SP[((task * 4 + vb) * 4 + l) * 64 + lane] = w; sp[l] = raw4z(w); }
#pragma unroll
            for (int j = 0; j < 4; ++j) { f32x4 acc = unpk4(nc[j]);
#pragma unroll
                for (int l = 0; l < 4; ++l) acc = MF16(raw4z(mc[l][j]), sp[l], acc);
                S[j] = acc; }
#pragma unroll
            for (int l = 0; l < 4; ++l)
#pragma unroll
                for (int j = 0; j < 4; ++j) mc[l][j] = mn[l][j];
#pragma unroll
            for (int j = 0; j < 4; ++j) nc[j] = nn[j];
        }
    }
}
__device__ __forceinline__ void phase_s3(const Params& p, const Ctx& c) {
    unsigned char* ws = p.ws;
    const u32x2* RTT = (const u32x2*)((unsigned char*)p.out + DO_RTT); const u32x2* Y0D = (const u32x2*)((unsigned char*)p.out + DO_Y0D); const u32x2* SP = (const u32x2*)(ws + WS_SP);
    const float* BON = (const float*)(ws + WS_BONUS); const bf16_t* V = (const bf16_t*)(ws + WS_V); const bf16_t* G = (const bf16_t*)(ws + WS_G); bf16_t* Y = (bf16_t*)(ws + WS_YCAT);
    const int lane = c.lane, fr = c.fr, fq = c.fq;
    for (int it = c.gw; it < NTASK * 4; it += c.ngw) {
        const size_t task = (size_t)(it >> 2); const int j = it & 3, bh = (int)(task >> 6), ch = (int)(task & 63), b = bh >> 3, h = bh & 7;
        bf16x8 rt[4];
#pragma unroll
        for (int l = 0; l < 4; ++l) rt[l] = raw4z(RTT[((task * 4 + l) * 4 + j) * 64 + lane]);
        f32x4 acc[4];
#pragma unroll
        for (int vb = 0; vb < 4; ++vb) { acc[vb] = unpk4(Y0D[((task * 4 + vb) * 4 + j) * 64 + lane]);
#pragma unroll
            for (int l = 0; l < 4; ++l) acc[vb] = MF16(rt[l], raw4z(SP[((task * 4 + vb) * 4 + l) * 64 + lane]), acc[vb]); }
#pragma unroll
        for (int rg = 0; rg < 4; ++rg) {
            const size_t row = (size_t)b * SEQ + ch * CH + 16 * j + 4 * fq + rg;
            const float mean = row_sum16((acc[0][rg] + acc[1][rg]) + (acc[2][rg] + acc[3][rg])) * (1.0f / 64.0f);
            float d[4], q = 0.f;
#pragma unroll
            for (int vb = 0; vb < 4; ++vb) { d[vb] = acc[vb][rg] - mean; q += d[vb] * d[vb]; }
            const float rstd = rsqrtf(row_sum16(q) * (1.0f / 64.0f) + GN_EPS), bon = BON[row * 8 + h];
#pragma unroll
            for (int vb = 0; vb < 4; ++vb) { const int col = h * 64 + 16 * vb + fr;
                const float yn = d[vb] * rstd * p.in[I_LNW][col] + p.in[I_LNB][col];
                Y[row * DM + col] = (bf16_t)f2bf((yn + bon * bf2f(V[row * RD + col])) * bf2f(G[row * RD + col])); }
        }
    }
}

__device__ __forceinline__ void phase_rowstat(const Params& p, const Ctx& c) {
    float* RS = (float*)(p.ws + WS_RSTD2);
    for (int m = c.gw; m < MTOK; m += c.ngw) {
        const f32x4* xr = (const f32x4*)(p.out + (size_t)m * DM) + c.lane; float s = 0.f;
#pragma unroll
        for (int j = 0; j < 4; ++j) { const f32x4 v = xr[64 * j]; s += (v[0] * v[0] + v[1] * v[1]) + (v[2] * v[2] + v[3] * v[3]); }
        s = wave_sum(s);
        if (c.lane == 0) RS[m] = rsqrtf(s * (1.f / DM) + NORM_EPS);
    }
}
__device__ __forceinline__ void phase_final_norm(const Params& p, const Ctx& c) {
    const float* g = p.in[I_NFING];
    for (int m = c.gw; m < MTOK; m += c.ngw) {
        f32x4* xr = (f32x4*)(p.out + (size_t)m * DM) + c.lane; const f32x4* gr = (const f32x4*)g + c.lane;
        f32x4 v[4]; float s = 0.f;
#pragma unroll
        for (int j = 0; j < 4; ++j) { v[j] = xr[64 * j]; s += (v[j][0] * v[j][0] + v[j][1] * v[j][1]) + (v[j][2] * v[j][2] + v[j][3] * v[j][3]); }
        const float rstd = rsqrtf(wave_sum(s) * (1.f / DM) + NORM_EPS);
#pragma unroll
        for (int j = 0; j < 4; ++j) xr[64 * j] = v[j] * rstd * gr[64 * j];
    }
}

constexpr int NPHASES = 15;
__global__ void __launch_bounds__(NTHREADS, 2) fwd_kernel(Params p) {
    extern __shared__ __attribute__((aligned(16))) unsigned char lds_raw[];
    Ctx c; c.tid = threadIdx.x; c.lane = c.tid & 63; c.wave = __builtin_amdgcn_readfirstlane(c.tid >> 6); c.fr = c.lane & 15; c.fq = c.lane >> 4;
    c.gw = blockIdx.x * NWAVES + c.wave; c.ngw = gridDim.x * NWAVES; c.lds = (LAS unsigned char*)lds_raw;
    unsigned char* ws = p.ws;
#if ONE_LAUNCH
    cg::grid_group grid = cg::this_grid();
    volatile LAS unsigned* misc = (volatile LAS unsigned*)(c.lds + LDS_MISC_OFF);
    if (c.tid < 4) misc[c.tid] = 0u;
    __syncthreads();
    const XcdBarrier xbar = xcd_barrier_post((unsigned*)(ws + WS_BAR), misc);
    bool first_seam = true;
#define SEAM() do { if (first_seam) { grid.sync(); first_seam = false; } else xcd_barrier(xbar); } while (0)
#else
#define SEAM() do {} while (0)
#endif
#define IN(k) (p.ph_lo <= (k) && (k) < p.ph_hi)
#define END(k) do { if (IN((k) + 1)) SEAM(); } while (0)
#define REP_ON(k) ((REP_MASK >> (k)) & 1u)
#define PHASE(k, ...) if (IN(k)) { __VA_ARGS__ if (REP_ON(k)) { SEAM(); __VA_ARGS__ } END(k); }
    PHASE(0, phase_prologue(p, c);)
    PHASE(1,
        gemm_pg8_8(c, (const bf16_t*)(ws + WS_H), DM, (const bf16_t*)(ws + WS_WG1T), DM, MTOK, MIXIN, DM, F8Store{(bf16_t*)(ws + WS_P), MIXIN});
        gemm_simple(c, (const bf16_t*)(ws + WS_MEMN), DM, (const bf16_t*)(ws + WS_WKVT), DM, BATCH * NMEM, 512, DM, EpiKV{(bf16_t*)(ws + WS_KB), (bf16_t*)(ws + WS_VT)});)
    PHASE(2, phase_mix(p, c); phase_pooldiff(p, c); phase_memattn(p, c);)
    PHASE(3,
        gemm_simple(c, (const bf16_t*)(ws + WS_LW), 64, (const bf16_t*)(ws + WS_WLWT), 64, MTOK, RD, 64, EpiDecay{(float*)(ws + WS_W), p.in[I_W0]});
        gemm_simple(c, (const bf16_t*)(ws + WS_LA), 64, (const bf16_t*)(ws + WS_WLAT), 64, MTOK, RD, 64, EpiSigBias{(bf16_t*)(ws + WS_AA), RD, p.in[I_A0]});
        gemm_simple(c, (const bf16_t*)(ws + WS_LG), 128, (const bf16_t*)(ws + WS_WLGT), 128, MTOK, RD, 128, EpiBf16{(bf16_t*)(ws + WS_G), RD});
        _Pragma("unroll 1") for (int gi = 0; gi < 4; ++gi)
            gemm_simple(c, (const bf16_t*)(ws + WS_DPOOL) + 64 * gi, 256, (const bf16_t*)(ws + WS_WPT) + 4096 * gi, 64, MTOK, 64, 64, EpiPool{(bf16_t*)(ws + WS_YCAT), p.in[I_POOLS], gi});)
    PHASE(4, phase_s1(p, c);)
    PHASE(5, phase_s2(p, c);)
    PHASE(6, phase_s3(p, c);)
    PHASE(7,
        gemm_pg8_8(c, (const bf16_t*)(ws + WS_H), DM, (const bf16_t*)(ws + WS_WG1T) + (size_t)MIXIN * DM, DM, MTOK, 3 * DM, DM, F8SigBias{(bf16_t*)(ws + WS_GATES), 3 * DM, p.in[I_BGATE]});)
    PHASE(8, {
        pg8::Gemm g{(const bf16_t*)(ws + WS_YCAT), (const bf16_t*)(ws + WS_WUPT), MTOK, DM, DM, DM, DM}; pg8::StaticOrder S; S.init(MTOK, DM, (int)gridDim.x, (int)blockIdx.x);
        EpiFn8<F8UpFinal> E{F8UpFinal{(bf16_t*)(ws + WS_MERGED), (const bf16_t*)(ws + WS_GATES)}};
        pg8::gemm_phase_h<EpiFn8<F8UpFinal>, pg8::StaticOrder, true, true, UpHook>(c.lds, g, S, E, UpHook{(const bf16_t*)(ws + WS_GATES)}); })
    PHASE(9,
        gemm_pg8_4(c, (const bf16_t*)(ws + WS_MERGED), DM, (const bf16_t*)(ws + WS_WOT), DM, MTOK, DM, DM, EpiOut{p.in[I_X], p.out, (bf16_t*)(ws + WS_X1B)});)
    PHASE(10, phase_rowstat(p, c);)
    PHASE(11, {
        pg8::Gemm g{(const bf16_t*)(ws + WS_X1B), (const bf16_t*)(ws + WS_WF1T), MTOK, 2 * FF, DM, DM, DM}; pg8::StaticOrder S; S.init(MTOK, 2 * FF, (int)gridDim.x, (int)blockIdx.x);
        EpiFfnAct E{(bf16_t*)(ws + WS_ACT), (const float*)(ws + WS_RSTD2), p.in[I_CONVW], p.in[I_CONVB], (float*)(ws + WS_TAILU), (float*)(ws + WS_HEADU), (float*)(ws + WS_HEADGV), (LAS float*)(c.lds + LDS_HALO_OFF)};
        pg8::gemm_phase<EpiFfnAct, pg8::StaticOrder, true, true>(c.lds, g, S, E); })
    PHASE(12, phase_ffn_fix(p, c);)
    PHASE(13,
        gemm_pg8_4(c, (const bf16_t*)(ws + WS_ACT), FF, (const bf16_t*)(ws + WS_WF2T), FF, MTOK, DM, FF, EpiAddOut{p.out});)
    if (IN(14)) { phase_final_norm(p, c); }
#undef IN
#undef END
}

__global__ void nan_fill(float* o, int n) { const int i = blockIdx.x * blockDim.x + threadIdx.x; if (i < n) o[i] = __builtin_nanf(""); }

extern "C" void kernel_launch(void* const* d_in, const int* in_sizes, int n_in, void* d_out, int out_size, void* d_ws, size_t ws_size, hipStream_t stream) {
    static int grid = 0;
    if (grid == 0) {
        int dev = 0, cus = 0, per_cu = 0;
        if (hipGetDevice(&dev) != hipSuccess || hipDeviceGetAttribute(&cus, hipDeviceAttributeMultiprocessorCount, dev) != hipSuccess) cus = 256;
        (void)hipFuncSetAttribute((const void*)fwd_kernel, hipFuncAttributeMaxDynamicSharedMemorySize, LDS_BYTES);
        if (hipOccupancyMaxActiveBlocksPerMultiprocessor(&per_cu, (const void*)fwd_kernel, NTHREADS, LDS_BYTES) != hipSuccess || per_cu < 1) per_cu = 1;
        (void)hipGetLastError();
        grid = cus;
        if (n_in != 31 || out_size != MTOK * DM || ws_size < WS_END) grid = -1;
    }
    if (grid < 0) { nan_fill<<<(out_size + 255) / 256, 256, 0, stream>>>((float*)d_out, out_size); return; }
    Params p{};
    for (int i = 0; i < 31; ++i) p.in[i] = (const float*)d_in[i];
    p.out = (float*)d_out; p.ws = (unsigned char*)d_ws;
#if ONE_LAUNCH
    (void)hipMemsetAsync((unsigned char*)d_ws + WS_BAR, 0, WS_CTL_BYTES, stream);
    p.ph_lo = 0; p.ph_hi = NPHASES;
    void* args[] = {&p};
    hipError_t e = hipLaunchCooperativeKernel((const void*)fwd_kernel, dim3(grid), dim3(NTHREADS), args, LDS_BYTES, stream);
    if (e != hipSuccess) fprintf(stderr, "cooperative launch failed: %s (grid %d)\n", hipGetErrorString(e), grid);
#else
    for (int ph = 0; ph < NPHASES; ++ph) { p.ph_lo = ph; p.ph_hi = ph + 1; hipLaunchKernelGGL(fwd_kernel, dim3(grid), dim3(NTHREADS), LDS_BYTES, stream, p); }
#endif
}
```

```cpp
#include <hip/hip_runtime.h>
#include <hip/hip_cooperative_groups.h>
#include <cstdio>
#include <cstdint>
namespace cg = cooperative_groups;

#ifndef ONE_LAUNCH
#define ONE_LAUNCH 1
#endif
#ifndef PH_MASK
#define PH_MASK 0xFFFFFFFFu
#endif
#define PH_ON(k) ((PH_MASK >> (k)) & 1u)
#ifndef REP_MASK
#define REP_MASK 0u
#endif

#define LAS __attribute__((address_space(3)))
typedef unsigned short bf16_t;
typedef short bf16x8 __attribute__((ext_vector_type(8)));
typedef float f32x4 __attribute__((ext_vector_type(4)));
typedef float f32x2 __attribute__((ext_vector_type(2)));
typedef unsigned u32x4 __attribute__((ext_vector_type(4)));
typedef unsigned u32x2 __attribute__((ext_vector_type(2)));

constexpr int BATCH = 8, SEQ = 4096, DM = 1024, MTOK = BATCH * SEQ;
constexpr int NMEM = 256, RD = 512, MIXIN = 2304, RWKVIN = 1792, FF = 2816, NG1 = MIXIN + 3 * DM;
constexpr int NWAVES = 8, NTHREADS = 512;
constexpr float NORM_EPS = 1e-6f, GN_EPS = 64e-5f;

constexpr size_t MiB = 1u << 20;
constexpr size_t WS_WG1T = 1 * MiB;
constexpr size_t WS_WKVT = WS_WG1T + (size_t)NG1 * DM * 2;
constexpr size_t WS_WUPT = WS_WKVT + (size_t)512 * DM * 2;
constexpr size_t WS_WOT = WS_WUPT + (size_t)DM * DM * 2;
constexpr size_t WS_WF1T = WS_WOT + (size_t)DM * DM * 2;
constexpr size_t WS_WF2T = WS_WF1T + (size_t)2 * FF * DM * 2;
constexpr size_t WS_WLWT = WS_WF2T + (size_t)DM * FF * 2;
constexpr size_t WS_WLAT = WS_WLWT + (size_t)RD * 64 * 2;
constexpr size_t WS_WLGT = WS_WLAT + (size_t)RD * 64 * 2;
constexpr size_t WS_WPT = WS_WLGT + (size_t)RD * 128 * 2;
constexpr size_t WS_WEND = WS_WPT + (size_t)4 * 64 * 64 * 2;
static_assert(WS_WEND <= 34 * MiB, "weights region");
constexpr size_t WS_BONUS = 34 * MiB;
constexpr size_t WS_SS2 = 35 * MiB, WS_SS3 = 35 * MiB + 256 * 1024;
constexpr size_t WS_KB = 36 * MiB;
constexpr size_t WS_VT = 37 * MiB;
constexpr size_t WS_MEMN = 38 * MiB;
constexpr size_t WS_H = 42 * MiB;
constexpr size_t WS_YCAT = 106 * MiB;
constexpr size_t WS_P = 170 * MiB;
constexpr size_t WS_W = 170 * MiB;
constexpr size_t WS_G = 234 * MiB;
constexpr size_t WS_AA = 266 * MiB;
constexpr size_t WS_KRAW = 314 * MiB;
constexpr size_t WS_YRAW = 266 * MiB;
constexpr size_t WS_R = 346 * MiB;
constexpr size_t WS_V = 378 * MiB;
constexpr size_t WS_LW = 410 * MiB;
constexpr size_t WS_LA = 414 * MiB;
constexpr size_t WS_LG = 418 * MiB;
constexpr size_t WS_DPOOL = 426 * MiB;
constexpr size_t WS_SP = 442 * MiB;
constexpr size_t WS_GATES = 170 * MiB;
constexpr size_t WS_MERGED = 362 * MiB;
constexpr size_t WS_X1B = 426 * MiB;
constexpr size_t WS_TAILU = 42 * MiB, WS_HEADU = 45 * MiB, WS_HEADGV = 48 * MiB;
constexpr size_t WS_ACT = 218 * MiB;
constexpr size_t WS_END = 490 * MiB;
constexpr size_t DO_RTT = 0, DO_MTT = 32 * MiB, DO_Y0D = 64 * MiB, DO_ND = 96 * MiB;

constexpr int LDS_BYTES = 147456;
constexpr int LDS_HALO_OFF = 131072 + 1024;
constexpr int LDS_MISC_OFF = 131072 + 320;
constexpr size_t WS_BAR = 0, WS_CTL_BYTES = 65536;

__device__ __forceinline__ unsigned f2bf(float f) { unsigned u = __float_as_uint(f); return (u + 0x7fffu + ((u >> 16) & 1u)) >> 16; }
__device__ __forceinline__ float bf2f(unsigned h) { return __uint_as_float(h << 16); }
__device__ __forceinline__ unsigned pk2(float lo, float hi) { return f2bf(lo) | (f2bf(hi) << 16); }
__device__ __forceinline__ u32x2 pk4(f32x4 v) { u32x2 r; r.x = pk2(v[0], v[1]); r.y = pk2(v[2], v[3]); return r; }
__device__ __forceinline__ f32x4 unpk4(u32x2 u) { f32x4 r; r[0] = bf2f(u.x & 0xffffu); r[1] = bf2f(u.x >> 16); r[2] = bf2f(u.y & 0xffffu); r[3] = bf2f(u.y >> 16); return r; }
__device__ __forceinline__ float wave_sum(float v) {
#pragma unroll
    for (int o = 1; o < 64; o <<= 1) v += __shfl_xor(v, o);
    return v;
}
__device__ __forceinline__ float sigmoidf_(float x) { return 1.0f / (1.0f + __expf(-x)); }
template <int CTRL> __device__ __forceinline__ float dpp_f(float x) { return __builtin_bit_cast(float, __builtin_amdgcn_update_dpp(0, __builtin_bit_cast(int, x), CTRL, 0xF, 0xF, false)); }
__device__ __forceinline__ float row_sum16(float x) {
    x += dpp_f<0xB1>(x);
    x += dpp_f<0x4E>(x);
    x += dpp_f<0x141>(x);
    x += dpp_f<0x140>(x);
    return x;
}

#define XB_TMO      128
#define XB_XCNT(j)  (256  + 64 * (j))
#define XB_XSUB(j)  (1280 + 64 * (j))
#define XB_XGEN(j)  (2304 + 64 * (j))
#define XB_TOP      3328
#define XB_TOPGEN   3392
#define XCD_BAR_WORDS 3456
#define XB_SPIN_CAP (1u << 18)

__device__ __forceinline__ unsigned xb_ld(unsigned* p)              { return __hip_atomic_load(p, __ATOMIC_RELAXED, __HIP_MEMORY_SCOPE_AGENT); }
__device__ __forceinline__ unsigned xb_add(unsigned* p, unsigned v) { return __hip_atomic_fetch_add(p, v, __ATOMIC_RELAXED, __HIP_MEMORY_SCOPE_AGENT); }
__device__ __forceinline__ unsigned xb_xcc_id() { return (unsigned)__builtin_amdgcn_s_getreg((3 << 11) | 20) & 0xFu; }
#define XB_SPIN(cond, bar) do { unsigned _sp = 0; while (cond) { __builtin_amdgcn_s_sleep(1); \
    if ((++_sp & 255u) == 0u) { if (xb_ld(&(bar)[XB_TMO])) break; if (_sp > XB_SPIN_CAP) { atomicAdd(&(bar)[XB_TMO], 1u); break; } } } } while (0)

struct XcdBarrier {
    unsigned* bar; unsigned x;
    volatile LAS unsigned* st;
};

__device__ __forceinline__ XcdBarrier xcd_barrier_post(unsigned* bar, volatile LAS unsigned* st) {
    XcdBarrier b; b.bar = bar; b.x = xb_xcc_id(); b.st = st;
    if (threadIdx.x == 0) (void)xb_add(&bar[XB_XCNT(b.x)], 1u);
    return b;
}
__device__ __forceinline__ void xcd_barrier_complete(unsigned* bar, unsigned x, unsigned& nloc, unsigned& nx) {
    const unsigned G = gridDim.x * gridDim.y * gridDim.z;
    unsigned sum, cnt, mine, sp = 0u;
    for (;;) {
        sum = 0u; cnt = 0u; mine = 0u;
#pragma unroll
        for (unsigned j = 0; j < 16; ++j) { const unsigned c = xb_ld(&bar[XB_XCNT(j)]); sum += c; cnt += (c > 0u) ? 1u : 0u; mine = (j == x) ? c : mine; }
        if (sum == G) break;
        __builtin_amdgcn_s_sleep(1);
        if ((++sp & 255u) == 0u) { if (xb_ld(&bar[XB_TMO])) break; if (sp > XB_SPIN_CAP) { atomicAdd(&bar[XB_TMO], 1u); break; } }
    }
    nloc = mine > 0u ? mine : 1u; nx = cnt > 0u ? cnt : 1u;
}

__device__ __forceinline__ void xcd_barrier(const XcdBarrier& b) {
    asm volatile("s_waitcnt vmcnt(0)" ::: "memory");
    __syncthreads();
    if (threadIdx.x == 0) {
        unsigned* bar = b.bar;
        __builtin_amdgcn_s_waitcnt(0);
        unsigned nloc = b.st[0], nx = b.st[1];
        if (nloc == 0u) { xcd_barrier_complete(bar, b.x, nloc, nx); b.st[0] = nloc; b.st[1] = nx; }
        const unsigned old = xb_add(&bar[XB_XSUB(b.x)], 1u);
        const unsigned gen = old / nloc;
        if (old + 1u == (gen + 1u) * nloc) {
            __builtin_amdgcn_fence(__ATOMIC_RELEASE, "agent");
            asm volatile("s_waitcnt vmcnt(0)" ::: "memory");
            const unsigned og = xb_add(&bar[XB_TOP], 1u);
            const unsigned tg = og / nx;
            if (og + 1u == (tg + 1u) * nx) xb_add(&bar[XB_TOPGEN], 1u);
            else XB_SPIN(xb_ld(&bar[XB_TOPGEN]) == tg, bar);
            __builtin_amdgcn_fence(__ATOMIC_ACQUIRE, "agent");
            xb_add(&bar[XB_XGEN(b.x)], 1u);
            asm volatile("s_waitcnt vmcnt(0)" ::: "memory");
        } else {
            XB_SPIN(xb_ld(&bar[XB_XGEN(b.x)]) == gen, bar);
            __builtin_amdgcn_fence(__ATOMIC_ACQUIRE, "agent");
            asm volatile("s_waitcnt vmcnt(0)" ::: "memory");
        }
    }
    __syncthreads();
}


struct Params { const float* in[31]; float* out; unsigned char* ws; int ph_lo, ph_hi; };
enum { I_X = 0, I_MEM, I_NMIXG, I_WINMIX, I_MU, I_W0, I_WLORAB, I_A0, I_ALORAB, I_GLORAB, I_KK, I_KA, I_RK, I_LNW, I_LNB, I_POOLW, I_POOLS, I_NMEMG, I_WMEMKV,
       I_WUPR, I_WUPP, I_WUPM, I_WGATE, I_BGATE, I_WO, I_NFFNG, I_WFFNIN, I_CONVW, I_CONVB, I_WFFNOUT, I_NFING };

struct Ctx { int tid, lane, wave, fr, fq, gw, ngw; LAS unsigned char* lds; };

__device__ __forceinline__ int rowmap(int mode, int n) {
    if (mode == 0) return n;
    const int half = n >= FF ? 1 : 0, c = n - half * FF;
    return (c >> 7) * 256 + half * 128 + (c & 127);
}
__device__ __forceinline__ void transpose_item(const float* W, int K, int N, bf16_t* WT, int ldd, int koff, int mode, const float* kscale, LAS float* scr, int item, int lane) {
    const int nblk = N / 32, kb = item / nblk, nb = item % nblk, k0 = 64 * kb, n0 = 32 * nb;
#pragma unroll 8
    for (int i = 0; i < 32; ++i) { const int kk = 2 * i + (lane >> 5); float v = W[(size_t)(k0 + kk) * N + n0 + (lane & 31)]; if (kscale) v *= kscale[k0 + kk]; scr[kk * 33 + (lane & 31)] = v; }
    asm volatile("s_waitcnt lgkmcnt(0)" ::: "memory");
    const int c = lane & 7;
#pragma unroll
    for (int j = 0; j < 4; ++j) { const int n = (lane >> 3) + 8 * j; const LAS float* s = scr + (8 * c) * 33 + n;
        u32x4 o; o.x = pk2(s[0 * 33], s[1 * 33]); o.y = pk2(s[2 * 33], s[3 * 33]); o.z = pk2(s[4 * 33], s[5 * 33]); o.w = pk2(s[6 * 33], s[7 * 33]);
        *(u32x4*)(WT + (size_t)rowmap(mode, n0 + n) * ldd + koff + k0 + 8 * c) = o; }
    asm volatile("s_waitcnt lgkmcnt(0)" ::: "memory");
}
__device__ __forceinline__ void rmsnorm_row_bf16(const float* xrow, const float* g, bf16_t* orow, int lane) {
    const f32x4* xr = (const f32x4*)xrow + lane; const f32x4* gr = (const f32x4*)g + lane;
    f32x4 v[4]; float s = 0.f;
#pragma unroll
    for (int j = 0; j < 4; ++j) { v[j] = xr[64 * j]; s += (v[j][0] * v[j][0] + v[j][1] * v[j][1]) + (v[j][2] * v[j][2] + v[j][3] * v[j][3]); }
    const float rstd = rsqrtf(wave_sum(s) * (1.f / DM) + NORM_EPS);
    u32x2* o = (u32x2*)orow + lane;
#pragma unroll
    for (int j = 0; j < 4; ++j) { const f32x4 gg = gr[64 * j]; o[64 * j] = pk4(v[j] * rstd * gg); }
}

__device__ __forceinline__ void phase_prologue(const Params& p, const Ctx& c) {
    LAS float* scr = (LAS float*)(c.lds + c.wave * 16384);
    unsigned char* ws = p.ws;
#define TR(Wp, K_, N_, WTp, ldd_, koff_, mode_, sc_) { const int ni_ = ((K_) / 64) * ((N_) / 32); if (r < ni_) { transpose_item(Wp, K_, N_, (bf16_t*)(WTp), ldd_, koff_, mode_, sc_, scr, r, c.lane); continue; } r -= ni_; }
    constexpr int NIT = (DM / 64) * (MIXIN / 32) + (DM / 64) * (3 * DM / 32) + (DM / 64) * (512 / 32) + (512 / 64) * (DM / 32) + 2 * (256 / 64) * (DM / 32) + (DM / 64) * (DM / 32)
                      + (DM / 64) * (2 * FF / 32) + (FF / 64) * (DM / 32) + 2 * (RD / 32) + 2 * (RD / 32) + 4 * 2;
    for (int it = c.gw; it < NIT; it += c.ngw) {
        int r = it;
        TR(p.in[I_WINMIX], DM, MIXIN, ws + WS_WG1T, DM, 0, 0, nullptr)
        TR(p.in[I_WGATE], DM, 3 * DM, ws + WS_WG1T + (size_t)MIXIN * DM * 2, DM, 0, 0, nullptr)
        TR(p.in[I_WMEMKV], DM, 512, ws + WS_WKVT, DM, 0, 0, nullptr)
        TR(p.in[I_WUPR], 512, DM, ws + WS_WUPT, DM, 0, 0, nullptr)
        TR(p.in[I_WUPP], 256, DM, ws + WS_WUPT, DM, 512, 0, nullptr)
        TR(p.in[I_WUPM], 256, DM, ws + WS_WUPT, DM, 768, 0, nullptr)
        TR(p.in[I_WO], DM, DM, ws + WS_WOT, DM, 0, 0, nullptr)
        TR(p.in[I_WFFNIN], DM, 2 * FF, ws + WS_WF1T, DM, 0, 1, p.in[I_NFFNG])
        TR(p.in[I_WFFNOUT], FF, DM, ws + WS_WF2T, FF, 0, 0, nullptr)
        TR(p.in[I_WLORAB], 64, RD, ws + WS_WLWT, 64, 0, 0, nullptr)
        TR(p.in[I_ALORAB], 64, RD, ws + WS_WLAT, 64, 0, 0, nullptr)
        TR(p.in[I_GLORAB], 128, RD, ws + WS_WLGT, 128, 0, 0, nullptr)
        TR(p.in[I_POOLW] + 0 * 4096, 64, 64, ws + WS_WPT + 0 * 8192, 64, 0, 0, nullptr)
        TR(p.in[I_POOLW] + 1 * 4096, 64, 64, ws + WS_WPT + 1 * 8192, 64, 0, 0, nullptr)
        TR(p.in[I_POOLW] + 2 * 4096, 64, 64, ws + WS_WPT + 2 * 8192, 64, 0, 0, nullptr)
        TR(p.in[I_POOLW] + 3 * 4096, 64, 64, ws + WS_WPT + 3 * 8192, 64, 0, 0, nullptr)
    }
#undef TR
    for (int m = c.gw; m < MTOK; m += c.ngw) rmsnorm_row_bf16(p.in[I_X] + (size_t)m * DM, p.in[I_NMIXG], (bf16_t*)(ws + WS_H) + (size_t)m * DM, c.lane);
    for (int i = blockIdx.x * NTHREADS + c.tid; i < (2 * 256 * 1024) / 4; i += gridDim.x * NTHREADS) ((float*)(ws + WS_SS2))[i] = 0.f;
    for (int m = c.gw; m < BATCH * NMEM; m += c.ngw) rmsnorm_row_bf16(p.in[I_MEM] + (size_t)m * DM, p.in[I_NMEMG], (bf16_t*)(ws + WS_MEMN) + (size_t)m * DM, c.lane);
}

namespace pg8 {
#define PG8_LAS __attribute__((address_space(3)))
typedef unsigned short bf16_t;
typedef short bf16x8 __attribute__((ext_vector_type(8)));
typedef float f32x4 __attribute__((ext_vector_type(4)));
typedef unsigned u32x4 __attribute__((ext_vector_type(4)));
constexpr int BM = 256, BK = 64, HALF = 128, HTB = HALF * BK * 2  , STAGE_BYTES = 8 * HTB, NXCD = 8, WGM = 8;

__host__ __device__ __forceinline__ int lds_byte(int r, int c) { const int st = (r >> 4) * 2 + (c >> 5), rr = r & 15, cc = c & 31, ob = rr * 64 + cc * 2; return st * 1024 + (ob ^ (((ob >> 9) & 1) << 5)); }
__host__ __device__ __forceinline__ void stage_rc(int b, int& R, int& C) { const int st = b / 1024, sb = b % 1024, swz = sb ^ (((sb >> 9) & 1) << 5); R = (st >> 1) * 16 + swz / 64; C = (st & 1) * 32 + (swz % 64) / 2; }
__host__ __device__ __forceinline__ int perm32(int rho) { const int n = rho >> 4, i = rho & 15; return 8 * (i >> 2) + 4 * n + (i & 3); }

struct Unit { int pm, pn; };
struct Gemm { const bf16_t* A; const bf16_t* Bt; int M, N, K, lda, ldb; };

struct StaticOrder {
    int nM, nN, nwg, G, c;
    __host__ __device__ void init(int M, int N, int G_, int c_) { nM = M / BM; nN = N / BM; nwg = nM * nN; G = G_; c = c_; }
    __host__ __device__ bool next(int i, Unit& u) const {
        const long L = (long)i * G + c; if (L >= nwg) return false;
        int wgid = (int)L; { const int q = nwg / NXCD, r = nwg % NXCD, xcd = wgid % NXCD, off = wgid / NXCD; wgid = (xcd < r ? xcd * (q + 1) : r * (q + 1) + (xcd - r) * q) + off; }
        const int nig = WGM * nN, gid = wgid / nig, fm = gid * WGM, gsz = (nM - fm) < WGM ? (nM - fm) : WGM;
        u.pm = fm + ((wgid % nig) % gsz); u.pn = (wgid % nig) / gsz; return true;
    }
    __device__ __forceinline__ void a_ready(const Unit&) const {}
    __device__ __forceinline__ void done(const Unit&) const {}
};


struct NoHook { __device__ __forceinline__ void operator()(f32x4 (&)[2][2][4][2], const Unit&, int, int, int, int, int) const {} };
template <class Epi, class Sched, bool ALIGN_EPI, bool SP2, class Hook>
__device__ __forceinline__ void gemm_phase_h(PG8_LAS unsigned char* lds, const Gemm g, const Sched& S, const Epi& E, const Hook& H) {
    int tid_ = threadIdx.x; asm volatile("" : "+v"(tid_));
    const int tid = tid_, wid = __builtin_amdgcn_readfirstlane(tid >> 6), lane = tid & 63, wr = wid >> 2, wc = wid & 3, fr = lane & 15, fq = lane >> 4;
    const int K = g.K, nt = K / BK;
    unsigned voffA[2], voffB[2];
#pragma unroll
    for (int i = 0; i < 2; ++i) { int R, C; stage_rc(tid * 16 + i * 8192, R, C); const int Rb = Epi::PERM ? ((R & ~31) + perm32(R & 31)) : R;
        voffA[i] = (unsigned)(R * g.lda + C) * 2u; voffB[i] = (unsigned)(Rb * g.ldb + C) * 2u; }
    const size_t kstep = (size_t)(BK * 2);
    const size_t hstepA = (size_t)HALF * g.lda * 2, hstepB = (size_t)HALF * g.ldb * 2;
    const size_t tstepA = 2 * hstepA, tstepB = 2 * hstepB;
    const unsigned ldsw = (unsigned)wid * 1024u;
    const int aoff = lds_byte(wr * 64 + fr, fq * 8), boff = lds_byte(wc * 32 + fr, fq * 8);
#define PG8_SA(b, h) (((b) * 2 + (h)) * HTB)
#define PG8_SB(b, h) ((4 + (b) * 2 + (h)) * HTB)
#define PG8_STAGE(bufoff, gbase, voff) do { _Pragma("unroll") for (int _i = 0; _i < 2; ++_i) \
        __builtin_amdgcn_global_load_lds((const unsigned*)((const char*)(gbase) + (voff)[_i]), (PG8_LAS unsigned*)(lds + (bufoff) + ldsw + _i * 8192), 16, 0, 0); } while (0)
#define PG8_LDA(dst, b, h) do { _Pragma("unroll") for (int m = 0; m < 4; ++m) _Pragma("unroll") for (int k = 0; k < 2; ++k) dst[m][k] = *(const PG8_LAS bf16x8*)(lds + PG8_SA(b, h) + aoff + m * 2048 + k * 1024); } while (0)
#define PG8_LDB(dst, b, h) do { _Pragma("unroll") for (int n = 0; n < 2; ++n) _Pragma("unroll") for (int k = 0; k < 2; ++k) dst[n][k] = *(const PG8_LAS bf16x8*)(lds + PG8_SB(b, h) + boff + n * 2048 + k * 1024); } while (0)
#define PG8_MMA(ai, bj, At, Bt) do { __builtin_amdgcn_s_setprio(1); _Pragma("unroll") for (int m = 0; m < 4; ++m) _Pragma("unroll") for (int n = 0; n < 2; ++n) _Pragma("unroll") for (int k = 0; k < 2; ++k) \
        acc[ai][bj][m][n] = __builtin_amdgcn_mfma_f32_16x16x32_bf16(Bt[n][k], At[m][k], acc[ai][bj][m][n], 0, 0, 0); __builtin_amdgcn_s_setprio(0); } while (0)
#define PG8_WAIT_V(n) asm volatile("s_waitcnt vmcnt(" #n ")" ::: "memory")
#define PG8_WAIT_L(n) asm volatile("s_waitcnt lgkmcnt(" #n ")" ::: "memory")
#define PG8_BAR __builtin_amdgcn_s_barrier()
#define PG8_SCHED __builtin_amdgcn_sched_barrier(0)
    Unit cur, nxt; int ui = 0;
    if (!S.next(0, cur)) return;
    f32x4 acc[2][2][4][2];
#pragma unroll
    for (int a = 0; a < 2; ++a)
#pragma unroll
        for (int b = 0; b < 2; ++b)
#pragma unroll
            for (int m = 0; m < 4; ++m)
#pragma unroll
                for (int n = 0; n < 2; ++n) acc[a][b][m][n] = (f32x4){0.f, 0.f, 0.f, 0.f};
    bf16x8 At[4][2], B0[2][2], B1[2][2];
    const char* cA = (const char*)g.A + (size_t)cur.pm * tstepA; const char* cB = (const char*)g.Bt + (size_t)cur.pn * tstepB;
    S.a_ready(cur);
    if constexpr (SP2) {
        PG8_STAGE(PG8_SB(0, 0), cB, voffB); PG8_STAGE(PG8_SB(0, 1), cB + hstepB, voffB); PG8_STAGE(PG8_SA(0, 0), cA, voffA); PG8_STAGE(PG8_SA(0, 1), cA + hstepA, voffA);
        if (wr == 1) PG8_BAR;
        PG8_WAIT_V(2); PG8_BAR;
        PG8_STAGE(PG8_SB(1, 0), cB + kstep, voffB); PG8_STAGE(PG8_SA(1, 0), cA + kstep, voffA); PG8_STAGE(PG8_SB(1, 1), cB + hstepB + kstep, voffB);
        PG8_WAIT_V(6); PG8_BAR;
    } else {
        PG8_STAGE(PG8_SB(0, 0), cB, voffB); PG8_STAGE(PG8_SA(0, 0), cA, voffA); PG8_STAGE(PG8_SB(0, 1), cB + hstepB, voffB); PG8_STAGE(PG8_SA(0, 1), cA + hstepA, voffA);
        if (wr == 1) PG8_BAR;
        PG8_WAIT_V(4); PG8_BAR;
        PG8_STAGE(PG8_SB(1, 0), cB + kstep, voffB); PG8_STAGE(PG8_SA(1, 0), cA + kstep, voffA); PG8_STAGE(PG8_SB(1, 1), cB + hstepB + kstep, voffB);
        PG8_WAIT_V(6); PG8_BAR;
    }
    for (;;) {
        const bool has_next = S.next(ui + 1, nxt);
        const char* nA = has_next ? (const char*)g.A + (size_t)nxt.pm * tstepA : cA; const char* nB = has_next ? (const char*)g.Bt + (size_t)nxt.pn * tstepB : cB;
        for (int t = 0; t < nt; t += 2) {
            H(acc, cur, t, wr, wc, fr, fq);
            const bool last = (t == nt - 2);
            const char* a1 = cA + (size_t)(t + 1) * kstep;
            const char* a2 = last ? nA : cA + (size_t)(t + 2) * kstep; const char* b2 = last ? nB : cB + (size_t)(t + 2) * kstep;
            const char* a3 = a2 + kstep; const char* b3 = b2 + kstep;
            if (last && has_next) S.a_ready(nxt);
            if constexpr (SP2) {
            PG8_LDB(B0, 0, 0); PG8_LDB(B1, 0, 1); PG8_SCHED; PG8_LDA(At, 0, 0); PG8_STAGE(PG8_SA(1, 1), a1 + hstepA, voffA);
            PG8_WAIT_V(8); PG8_WAIT_L(0); PG8_BAR; PG8_MMA(0, 0, At, B0); PG8_MMA(0, 1, At, B1); PG8_BAR; PG8_SCHED;
            PG8_LDA(At, 0, 1); PG8_STAGE(PG8_SB(0, 0), b2, voffB); PG8_STAGE(PG8_SB(0, 1), b2 + hstepB, voffB); PG8_STAGE(PG8_SA(0, 0), a2, voffA);
            PG8_WAIT_V(8); PG8_WAIT_L(0); PG8_BAR; PG8_MMA(1, 0, At, B0); PG8_MMA(1, 1, At, B1); PG8_BAR; PG8_SCHED;
            PG8_LDB(B0, 1, 0); PG8_LDB(B1, 1, 1); PG8_SCHED; PG8_LDA(At, 1, 0); PG8_STAGE(PG8_SA(0, 1), a2 + hstepA, voffA);
            PG8_WAIT_V(8); PG8_WAIT_L(0); PG8_BAR; PG8_MMA(0, 0, At, B0); PG8_MMA(0, 1, At, B1); PG8_BAR; PG8_SCHED;
            PG8_LDA(At, 1, 1); PG8_STAGE(PG8_SB(1, 0), b3, voffB); PG8_STAGE(PG8_SB(1, 1), b3 + hstepB, voffB); PG8_STAGE(PG8_SA(1, 0), a3, voffA);
            PG8_WAIT_V(8); PG8_WAIT_L(0); PG8_BAR; PG8_MMA(1, 0, At, B0); PG8_MMA(1, 1, At, B1); PG8_BAR; PG8_SCHED;
            } else {
            PG8_LDB(B0, 0, 0); PG8_SCHED; PG8_LDA(At, 0, 0); PG8_STAGE(PG8_SA(1, 1), a1 + hstepA, voffA);
            PG8_WAIT_L(8); PG8_BAR; PG8_WAIT_L(0); PG8_MMA(0, 0, At, B0); PG8_BAR; PG8_SCHED;
            PG8_LDB(B1, 0, 1); PG8_STAGE(PG8_SB(0, 0), b2, voffB);
            PG8_BAR; PG8_WAIT_L(0); PG8_MMA(0, 1, At, B1); PG8_BAR;
            PG8_LDA(At, 0, 1); PG8_STAGE(PG8_SA(0, 0), a2, voffA);
            PG8_BAR; PG8_WAIT_L(0); PG8_MMA(1, 0, At, B0); PG8_BAR; PG8_SCHED;
            PG8_STAGE(PG8_SB(0, 1), b2 + hstepB, voffB);
            PG8_WAIT_V(6); PG8_BAR; PG8_MMA(1, 1, At, B1); PG8_BAR;
            PG8_LDB(B0, 1, 0); PG8_SCHED; PG8_LDA(At, 1, 0); PG8_STAGE(PG8_SA(0, 1), a2 + hstepA, voffA);
            PG8_WAIT_L(8); PG8_BAR; PG8_WAIT_L(0); PG8_MMA(0, 0, At, B0); PG8_BAR; PG8_SCHED;
            PG8_LDB(B1, 1, 1); PG8_STAGE(PG8_SB(1, 0), b3, voffB);
            PG8_BAR; PG8_WAIT_L(0); PG8_MMA(0, 1, At, B1); PG8_BAR;
            PG8_LDA(At, 1, 1); PG8_STAGE(PG8_SA(1, 0), a3, voffA);
            PG8_BAR; PG8_WAIT_L(0); PG8_MMA(1, 0, At, B0); PG8_BAR; PG8_SCHED;
            PG8_STAGE(PG8_SB(1, 1), b3 + hstepB, voffB);
            PG8_WAIT_V(6); PG8_BAR; PG8_MMA(1, 1, At, B1); PG8_BAR;
            }
        }
        if constexpr (ALIGN_EPI) { if (wr == 0) PG8_BAR; }
        if constexpr (!Epi::AFTER_DRAIN) { E(acc, cur, wr, wc, fr, fq); S.done(cur); }
        if (!has_next) break;
#pragma unroll
        for (int a = 0; a < 2; ++a)
#pragma unroll
            for (int b = 0; b < 2; ++b)
#pragma unroll
                for (int m = 0; m < 4; ++m)
#pragma unroll
                    for (int n = 0; n < 2; ++n) acc[a][b][m][n] = (f32x4){0.f, 0.f, 0.f, 0.f};
        cur = nxt; cA = nA; cB = nB; ++ui;
        if constexpr (ALIGN_EPI) { if (wr == 1) PG8_BAR; }
    }
    PG8_WAIT_V(0);
    if constexpr (!ALIGN_EPI) { if (wr == 0) PG8_BAR; }
    PG8_BAR;
    if constexpr (Epi::AFTER_DRAIN) { E.fused(acc, cur, wr, wc, fr, fq, lds, wid, lane); S.done(cur); }
#undef PG8_SA
#undef PG8_SB
#undef PG8_STAGE
#undef PG8_LDA
#undef PG8_LDB
#undef PG8_MMA
#undef PG8_WAIT_V
#undef PG8_WAIT_L
#undef PG8_BAR
#undef PG8_SCHED
}
template <class Epi, class Sched, bool ALIGN_EPI = false, bool SP2 = false>
__device__ __forceinline__ void gemm_phase(PG8_LAS unsigned char* lds, const Gemm g, const Sched& S, const Epi& E) { gemm_phase_h<Epi, Sched, ALIGN_EPI, SP2, NoHook>(lds, g, S, E, NoHook{}); }
}


template <class F> struct EpiFn4 { static constexpr bool PERM = false, AFTER_DRAIN = false; F f;
    __device__ __forceinline__ void operator()(const f32x4 (&acc)[2][2][4][2], const pg8::Unit& u, int wr, int wc, int fr, int fq) const {
        const int row0 = u.pm * 256 + wr * 64 + fr, col0 = u.pn * 256 + wc * 32 + 4 * fq;
#pragma unroll
        for (int ai = 0; ai < 2; ++ai)
#pragma unroll
            for (int m = 0; m < 4; ++m)
#pragma unroll
                for (int bj = 0; bj < 2; ++bj)
#pragma unroll
                    for (int n = 0; n < 2; ++n) f(row0 + ai * 128 + m * 16, col0 + bj * 128 + n * 16, acc[ai][bj][m][n]);
    } };
template <class F> struct EpiFn8 { static constexpr bool PERM = true, AFTER_DRAIN = false; F f;
    __device__ __forceinline__ void operator()(const f32x4 (&acc)[2][2][4][2], const pg8::Unit& u, int wr, int wc, int fr, int fq) const {
        const int row0 = u.pm * 256 + wr * 64 + fr, col0 = u.pn * 256 + wc * 32 + 8 * fq;
#pragma unroll
        for (int ai = 0; ai < 2; ++ai)
#pragma unroll
            for (int m = 0; m < 4; ++m)
#pragma unroll
                for (int bj = 0; bj < 2; ++bj) f(row0 + ai * 128 + m * 16, col0 + bj * 128, acc[ai][bj][m][0], acc[ai][bj][m][1]);
    } };
template <class F> __device__ __forceinline__ void gemm_pg8_4(const Ctx& c, const bf16_t* A, int lda, const bf16_t* Bt, int ldb, int M, int N, int K, const F& f) {
    pg8::Gemm g{A, Bt, M, N, K, lda, ldb}; pg8::StaticOrder S; S.init(M, N, (int)gridDim.x, (int)blockIdx.x); EpiFn4<F> E{f};
    pg8::gemm_phase<EpiFn4<F>, pg8::StaticOrder, true, true>(c.lds, g, S, E);
}
template <class F> __device__ __forceinline__ void gemm_pg8_8(const Ctx& c, const bf16_t* A, int lda, const bf16_t* Bt, int ldb, int M, int N, int K, const F& f) {
    pg8::Gemm g{A, Bt, M, N, K, lda, ldb}; pg8::StaticOrder S; S.init(M, N, (int)gridDim.x, (int)blockIdx.x); EpiFn8<F> E{f};
    pg8::gemm_phase<EpiFn8<F>, pg8::StaticOrder, true, true>(c.lds, g, S, E);
}
__device__ __forceinline__ u32x4 pk8(f32x4 lo, f32x4 hi) { u32x4 w; w.x = pk2(lo[0], lo[1]); w.y = pk2(lo[2], lo[3]); w.z = pk2(hi[0], hi[1]); w.w = pk2(hi[2], hi[3]); return w; }
struct F8Store { bf16_t* O; int ld; __device__ __forceinline__ void operator()(int row, int col, f32x4 lo, f32x4 hi) const { *(u32x4*)(O + (size_t)row * ld + col) = pk8(lo, hi); } };
struct F8SigBias { bf16_t* O; int ld; const float* bias;
    __device__ __forceinline__ void operator()(int row, int col, f32x4 lo, f32x4 hi) const {
        lo += *(const f32x4*)(bias + col); hi += *(const f32x4*)(bias + col + 4);
#pragma unroll
        for (int j = 0; j < 4; ++j) { lo[j] = sigmoidf_(lo[j]); hi[j] = sigmoidf_(hi[j]); }
        *(u32x4*)(O + (size_t)row * ld + col) = pk8(lo, hi); } };
struct UpHook { const bf16_t* GT;
    __device__ __forceinline__ void operator()(f32x4 (&acc)[2][2][4][2], const pg8::Unit& u, int t, int wr, int wc, int fr, int fq) const {
        if (t != 8 && t != 12) return;
        const int sa = (t == 8) ? 0 : 1;
        const bf16_t* gp0 = GT + (size_t)(u.pm * 256 + wr * 64 + fr) * (3 * DM) + sa * DM + u.pn * 256 + wc * 32 + 8 * fq;
#pragma unroll
        for (int ai = 0; ai < 2; ++ai)
#pragma unroll
            for (int m = 0; m < 4; ++m) { const bf16_t* gp = gp0 + (size_t)(ai * 128 + m * 16) * (3 * DM);
#pragma unroll
                for (int bj = 0; bj < 2; ++bj) { const u32x4 ga = *(const u32x4*)(gp + bj * 128), gb = *(const u32x4*)(gp + DM + bj * 128);
                    const f32x4 a0 = unpk4((u32x2){ga.x, ga.y}), a1 = unpk4((u32x2){ga.z, ga.w}), b0 = unpk4((u32x2){gb.x, gb.y}), b1 = unpk4((u32x2){gb.z, gb.w});
#pragma unroll
                    for (int j = 0; j < 4; ++j) { acc[ai][bj][m][0][j] *= a0[j] * __builtin_amdgcn_rcpf(b0[j]); acc[ai][bj][m][1][j] *= a1[j] * __builtin_amdgcn_rcpf(b1[j]); } }
                asm volatile("" ::: "memory"); }
    } };
struct F8UpFinal { bf16_t* MG; const bf16_t* GT;
    __device__ __forceinline__ void operator()(int row, int col, f32x4 lo, f32x4 hi) const {
        const u32x4 g = *(const u32x4*)(GT + (size_t)row * (3 * DM) + 2 * DM + col);
        *(u32x4*)(MG + (size_t)row * DM + col) = pk8(lo * unpk4((u32x2){g.x, g.y}), hi * unpk4((u32x2){g.z, g.w})); } };

__device__ __forceinline__ f32x2 gelu_pk(f32x2 v) {
    const f32x2 av = __builtin_elementwise_abs(v), d = av * 0.2316418882f + 1.0f;
    f32x2 t; t.x = __builtin_amdgcn_rcpf(d.x); t.y = __builtin_amdgcn_rcpf(d.y);
    f32x2 q = t * 0.5307027145f + (-0.7265760135f); q = q * t + 0.7107068705f; q = q * t + (-0.142248368f); q = q * t + 0.127414796f; q = q * t;
    const f32x2 s = (v * v) * (-0.72134752044f);
    f32x2 e; e.x = __builtin_amdgcn_exp2f(s.x); e.y = __builtin_amdgcn_exp2f(s.y);
    const f32x2 m = v * (q * e), r = v - m;
    f32x2 o; o.x = v.x < 0.f ? m.x : r.x; o.y = v.y < 0.f ? m.y : r.y; return o;
}
struct EpiFfnAct { static constexpr bool PERM = true, AFTER_DRAIN = false;
    bf16_t* ACT; const float* rstd  ; const float* cw; const float* cb; float* TAILU; float* HEADU; float* HEADGV; LAS float* halo;
    __device__ __forceinline__ void operator()(const f32x4 (&acc)[2][2][4][2], const pg8::Unit& u, int wr, int wc, int fr, int fq) const {
        const int ch0 = u.pn * 128 + wc * 32 + 8 * fq, rowt = wr * 64 + fr, grow0 = u.pm * 256 + rowt;
        f32x4 c0[2], c1[2], c2[2], cbv[2];
#pragma unroll
        for (int n = 0; n < 2; ++n) { c0[n] = *(const f32x4*)(cw + ch0 + 4 * n); c1[n] = *(const f32x4*)(cw + FF + ch0 + 4 * n); c2[n] = *(const f32x4*)(cw + 2 * FF + ch0 + 4 * n); cbv[n] = *(const f32x4*)(cb + ch0 + 4 * n); }
#pragma unroll
        for (int ai = 0; ai < 2; ++ai) { const float rs3 = rsqrtf(rstd[grow0 + ai * 128 + 48] * (1.f / DM) + NORM_EPS);
            if (fr >= 14) {
#pragma unroll
                for (int n = 0; n < 2; ++n) *(LAS f32x4*)(halo + (((((ai * 2 + wr) * 2 + (fr - 14)) * 4 + wc) * 4 + fq) * 8 + 4 * n)) = acc[ai][0][3][n] * rs3; } }
        asm volatile("s_waitcnt lgkmcnt(0)" ::: "memory"); __builtin_amdgcn_s_barrier(); asm volatile("" ::: "memory");
#pragma unroll
        for (int ai = 0; ai < 2; ++ai) {
            f32x4 r1p[2], r2p[2];
            if (wr == 1 || ai == 1) { const int src = (wr == 1) ? (ai * 2) : ((ai - 1) * 2 + 1);
#pragma unroll
                for (int n = 0; n < 2; ++n) { const f32x4 hv0 = *(const LAS f32x4*)(halo + ((((src * 2 + 0) * 4 + wc) * 4 + fq) * 8 + 4 * n)), hv1 = *(const LAS f32x4*)(halo + ((((src * 2 + 1) * 4 + wc) * 4 + fq) * 8 + 4 * n));
                    r1p[n] = hv1; r2p[n] = (fr == 0) ? hv0 : hv1; } }
            else { r1p[0] = r1p[1] = r2p[0] = r2p[1] = (f32x4){0.f, 0.f, 0.f, 0.f}; }
#pragma unroll
            for (int m = 0; m < 4; ++m) {
                const int grow = grow0 + ai * 128 + 16 * m; const float rs = rsqrtf(rstd[grow] * (1.f / DM) + NORM_EPS);
                u32x4 w;
#pragma unroll
                for (int n = 0; n < 2; ++n) {
                    const f32x4 uu = acc[ai][0][m][n] * rs, gg = acc[ai][1][m][n] * rs;
                    f32x4 R1, R2;
#pragma unroll
                    for (int j = 0; j < 4; ++j) { R1[j] = dpp_f<0x121>(uu[j]); R2[j] = dpp_f<0x122>(uu[j]); }
                    const f32x4 p1 = (fr >= 1) ? R1 : r1p[n], p2 = (fr >= 2) ? R2 : r2p[n];
                    r1p[n] = R1; r2p[n] = R2;
                    const f32x4 uc = c0[n] * p2 + c1[n] * p1 + c2[n] * uu + cbv[n];
                    const f32x2 ga = gelu_pk((f32x2){uc[0], uc[1]}), gb = gelu_pk((f32x2){uc[2], uc[3]});
                    const unsigned lo = pk2(ga.x * gg[0], ga.y * gg[1]), hi = pk2(gb.x * gg[2], gb.y * gg[3]);
                    if (n == 0) { w.x = lo; w.y = hi; } else { w.z = lo; w.w = hi; }
                    if (ai == 0 && m == 0) { if (wr == 0 && fr < 2) { const size_t so = (size_t)(u.pm * 2 + fr) * FF + ch0 + 4 * n; *(f32x4*)(HEADU + so) = uu; *(f32x4*)(HEADGV + so) = gg; } }
                    if (ai == 1 && m == 3) { if (wr == 1 && fr >= 14) { const size_t so = (size_t)(u.pm * 2 + (fr - 14)) * FF + ch0 + 4 * n; *(f32x4*)(TAILU + so) = uu; } }
                }
                *(u32x4*)(ACT + (size_t)grow * FF + ch0) = w;
            }
        }
    } };
__device__ __forceinline__ void phase_ffn_fix(const Params& p, const Ctx& c) {
    unsigned char* ws = p.ws;
    const float* TAILU = (const float*)(ws + WS_TAILU); const float* HEADU = (const float*)(ws + WS_HEADU); const float* HEADGV = (const float*)(ws + WS_HEADGV); bf16_t* ACT = (bf16_t*)(ws + WS_ACT);
    const float* cw = p.in[I_CONVW]; const float* cb = p.in[I_CONVB];
    const int nit = (MTOK / 256) * 2 * (FF / 4);
    for (int idx = blockIdx.x * NTHREADS + c.tid; idx < nit; idx += gridDim.x * NTHREADS) {
        const int col = 4 * (idx % (FF / 4)), pr = idx / (FF / 4), pm = pr >> 1, rr = pr & 1;
        if ((pm & 15) == 0) continue;
        const f32x4 u0 = *(const f32x4*)(HEADU + (size_t)(pm * 2 + rr) * FF + col), gg = *(const f32x4*)(HEADGV + (size_t)(pm * 2 + rr) * FF + col);
        const f32x4 t1 = *(const f32x4*)(TAILU + (size_t)((pm - 1) * 2 + 1) * FF + col), t0 = *(const f32x4*)(TAILU + (size_t)((pm - 1) * 2 + 0) * FF + col);
        f32x4 u1, u2; if (rr == 0) { u1 = t1; u2 = t0; } else { u1 = *(const f32x4*)(HEADU + (size_t)(pm * 2) * FF + col); u2 = t1; }
        const f32x4 uc = *(const f32x4*)(cw + col) * u2 + *(const f32x4*)(cw + FF + col) * u1 + *(const f32x4*)(cw + 2 * FF + col) * u0 + *(const f32x4*)(cb + col);
        const f32x2 ga = gelu_pk((f32x2){uc[0], uc[1]}), gb = gelu_pk((f32x2){uc[2], uc[3]});
        u32x2 w; w.x = pk2(ga.x * gg[0], ga.y * gg[1]); w.y = pk2(gb.x * gg[2], gb.y * gg[3]);
        *(u32x2*)(ACT + (size_t)(pm * 256 + rr) * FF + col) = w;
    }
}

struct EpiOutB { static constexpr bool PERM = true, AFTER_DRAIN = false; const float* x; bf16_t* x1b; float* SS;
    __device__ __forceinline__ void operator()(const f32x4 (&acc)[2][2][4][2], const pg8::Unit& u, int wr, int wc, int fr, int fq) const {
        const int row0 = u.pm * 256 + wr * 64 + fr, col0 = u.pn * 256 + wc * 32 + 8 * fq;
#pragma unroll
        for (int ai = 0; ai < 2; ++ai)
#pragma unroll
            for (int m = 0; m < 4; ++m) { const int row = row0 + ai * 128 + m * 16; float ss = 0.f;
#pragma unroll
                for (int bj = 0; bj < 2; ++bj) { const size_t off = (size_t)row * DM + col0 + bj * 128;
                    const f32x4 lo = acc[ai][bj][m][0] + *(const f32x4*)(x + off), hi = acc[ai][bj][m][1] + *(const f32x4*)(x + off + 4);
                    ss += (lo[0] * lo[0] + lo[1] * lo[1]) + (lo[2] * lo[2] + lo[3] * lo[3]) + (hi[0] * hi[0] + hi[1] * hi[1]) + (hi[2] * hi[2] + hi[3] * hi[3]);
                    *(u32x4*)(x1b + off) = pk8(lo, hi); }
                ss += __shfl_xor(ss, 16); ss += __shfl_xor(ss, 32);
                if (fq == 0) atomicAdd(SS + row, ss); }
    } };
struct EpiFfnOut { static constexpr bool PERM = false, AFTER_DRAIN = false; const bf16_t* x1b; float* out; float* SS;
    __device__ __forceinline__ void operator()(const f32x4 (&acc)[2][2][4][2], const pg8::Unit& u, int wr, int wc, int fr, int fq) const {
        const int row0 = u.pm * 256 + wr * 64 + fr, col0 = u.pn * 256 + wc * 32 + 4 * fq;
#pragma unroll
        for (int ai = 0; ai < 2; ++ai)
#pragma unroll
            for (int m = 0; m < 4; ++m) { const int row = row0 + ai * 128 + m * 16; float ss = 0.f;
#pragma unroll
                for (int bj = 0; bj < 2; ++bj)
#pragma unroll
                    for (int n = 0; n < 2; ++n) { const size_t off = (size_t)row * DM + col0 + bj * 128 + n * 16;
                        const f32x4 v = acc[ai][bj][m][n] + unpk4(*(const u32x2*)(x1b + off));
                        ss += (v[0] * v[0] + v[1] * v[1]) + (v[2] * v[2] + v[3] * v[3]);
                        *(f32x4*)(out + off) = v; }
                ss += __shfl_xor(ss, 16); ss += __shfl_xor(ss, 32);
                if (fq == 0) atomicAdd(SS + row, ss); }
    } };

__device__ __forceinline__ void wave_gemm_32x64(const bf16_t* A, int lda, const bf16_t* Bt, int ldb, int K, int m0, int n0, int fr, int fq, f32x4 (&acc)[2][4]) {
    const bf16_t* ap = A + (size_t)(m0 + fr) * lda + 8 * fq;
    const bf16_t* bp = Bt + (size_t)(n0 + fr) * ldb + 8 * fq;
    for (int k0 = 0; k0 < K; k0 += 32) {
        const bf16x8 a0 = *(const bf16x8*)(ap + k0), a1 = *(const bf16x8*)(ap + (size_t)16 * lda + k0);
        bf16x8 b[4];
#pragma unroll
        for (int j = 0; j < 4; ++j) b[j] = *(const bf16x8*)(bp + (size_t)(16 * j) * ldb + k0);
#pragma unroll
        for (int j = 0; j < 4; ++j) { acc[0][j] = __builtin_amdgcn_mfma_f32_16x16x32_bf16(b[j], a0, acc[0][j], 0, 0, 0); acc[1][j] = __builtin_amdgcn_mfma_f32_16x16x32_bf16(b[j], a1, acc[1][j], 0, 0, 0); }
    }
}
template <class Epi>
__device__ __forceinline__ void gemm_simple(const Ctx& c, const bf16_t* A, int lda, const bf16_t* Bt, int ldb, int M, int N, int K, const Epi& epi) {
    const int nMt = M / 256, nNt = N / 64, ntiles = nMt * nNt;
    for (int tile = blockIdx.x; tile < ntiles; tile += gridDim.x) {
        const int tm = tile % nMt, tn = tile / nMt, m0 = tm * 256 + c.wave * 32, n0 = tn * 64;
        f32x4 acc[2][4];
#pragma unroll
        for (int i = 0; i < 2; ++i)
#pragma unroll
            for (int j = 0; j < 4; ++j) acc[i][j] = (f32x4){0.f, 0.f, 0.f, 0.f};
        wave_gemm_32x64(A, lda, Bt, ldb, K, m0, n0, c.fr, c.fq, acc);
#pragma unroll
        for (int i = 0; i < 2; ++i)
#pragma unroll
            for (int j = 0; j < 4; ++j) epi(m0 + 16 * i + c.fr, n0 + 16 * j + 4 * c.fq, acc[i][j]);
    }
}

struct EpiBf16 { bf16_t* O; int ld; __device__ __forceinline__ void operator()(int row, int col, f32x4 v) const { *(u32x2*)(O + (size_t)row * ld + col) = pk4(v); } };
struct EpiKV { bf16_t* KB; bf16_t* VT;
    __device__ __forceinline__ void operator()(int row, int col, f32x4 v) const {
        if (col < 256) { *(u32x2*)(KB + (size_t)row * 256 + col) = pk4(v); }
        else { const int cc = col - 256, h = cc >> 6, d = cc & 63, b = row >> 8, key = row & 255;
#pragma unroll
            for (int j = 0; j < 4; ++j) VT[((size_t)((b * 4 + h) * 64 + d + j)) * 256 + key] = (bf16_t)f2bf(v[j]); }
    } };
struct EpiDecay { float* W; const float* w0;
    __device__ __forceinline__ void operator()(int row, int col, f32x4 v) const {
        const f32x4 z = v + *(const f32x4*)(w0 + col); f32x4 o;
#pragma unroll
        for (int j = 0; j < 4; ++j) o[j] = 0.60653065971f * sigmoidf_(z[j]);
        *(f32x4*)(W + (size_t)row * RD + col) = o; } };
struct EpiSigBias { bf16_t* O; int ld; const float* bias;
    __device__ __forceinline__ void operator()(int row, int col, f32x4 v) const {
        const f32x4 z = v + *(const f32x4*)(bias + col); f32x4 o;
#pragma unroll
        for (int j = 0; j < 4; ++j) o[j] = sigmoidf_(z[j]);
        *(u32x2*)(O + (size_t)row * ld + col) = pk4(o); } };
struct EpiPool { bf16_t* Y; const float* scale; int gi;
    __device__ __forceinline__ void operator()(int row, int col, f32x4 v) const {
        const f32x4 s = *(const f32x4*)(scale + 64 * gi + col); *(u32x2*)(Y + (size_t)row * DM + 512 + 64 * gi + col) = pk4(v * s); } };
struct EpiOut { const float* x; float* x1; bf16_t* x1b;
    __device__ __forceinline__ void operator()(int row, int col, f32x4 v) const {
        const size_t off = (size_t)row * DM + col; const f32x4 o = *(const f32x4*)(x + off) + v; *(f32x4*)(x1 + off) = o; *(u32x2*)(x1b + off) = pk4(o); } };
struct EpiAddOut { float* x;
    __device__ __forceinline__ void operator()(int row, int col, f32x4 v) const { const size_t off = (size_t)row * DM + col; *(f32x4*)(x + off) = *(const f32x4*)(x + off) + v; } };

__device__ __forceinline__ void phase_mix(const Params& p, const Ctx& c) {
    unsigned char* ws = p.ws;
    const bf16_t* P = (const bf16_t*)(ws + WS_P); const float* mu = p.in[I_MU];
    bf16_t* R = (bf16_t*)(ws + WS_R); bf16_t* KR = (bf16_t*)(ws + WS_KRAW); bf16_t* V = (bf16_t*)(ws + WS_V);
    bf16_t* LW = (bf16_t*)(ws + WS_LW); bf16_t* LA = (bf16_t*)(ws + WS_LA); bf16_t* LG = (bf16_t*)(ws + WS_LG);
    constexpr int RPW = 16;
    f32x4 m4[7];
#pragma unroll
    for (int i = 0; i < 7; ++i) m4[i] = *(const f32x4*)(mu + 4 * c.lane + 256 * i);
    for (int blk = c.gw; blk < MTOK / RPW; blk += c.ngw) {
        const int row0 = blk * RPW;
        f32x4 pv[7];
#pragma unroll
        for (int i = 0; i < 7; ++i) pv[i] = (row0 & (SEQ - 1)) ? unpk4(*(const u32x2*)(P + (size_t)(row0 - 1) * MIXIN + 4 * c.lane + 256 * i)) : (f32x4){0.f, 0.f, 0.f, 0.f};
#pragma unroll 2
        for (int rr = 0; rr < RPW; ++rr) {
            const int row = row0 + rr; const bf16_t* cur = P + (size_t)row * MIXIN;
            u32x2 cu[7];
#pragma unroll
            for (int i = 0; i < 7; ++i) cu[i] = *(const u32x2*)(cur + 4 * c.lane + 256 * i);
#pragma unroll
            for (int i = 0; i < 7; ++i) {
                const int col = 4 * c.lane + 256 * i;
                const f32x4 cv = unpk4(cu[i]);
                const f32x4 pm = cv + (pv[i] - cv) * m4[i];
                pv[i] = cv;
                if (i < 2) *(u32x2*)(R + (size_t)row * RD + col) = pk4(pm);
                else if (i < 4) *(u32x2*)(KR + (size_t)row * RD + (col - 512)) = pk4(pm);
                else if (i < 6) *(u32x2*)(V + (size_t)row * RD + (col - 1024)) = pk4(pm);
                else {
                    const int cc = col - 1536;
                    if (cc < 64) { f32x4 o; o[0] = tanhf(pm[0]); o[1] = tanhf(pm[1]); o[2] = tanhf(pm[2]); o[3] = tanhf(pm[3]); *(u32x2*)(LW + (size_t)row * 64 + cc) = pk4(o); }
                    else if (cc < 128) { *(u32x2*)(LA + (size_t)row * 64 + (cc - 64)) = pk4(pm); }
                    else { f32x4 o; o[0] = sigmoidf_(pm[0]); o[1] = sigmoidf_(pm[1]); o[2] = sigmoidf_(pm[2]); o[3] = sigmoidf_(pm[3]); *(u32x2*)(LG + (size_t)row * 128 + (cc - 128)) = pk4(o); }
                }
            }
        }
    }
}
__device__ __forceinline__ void phase_pooldiff(const Params& p, const Ctx& c) {
    unsigned char* ws = p.ws;
    const bf16_t* P = (const bf16_t*)(ws + WS_P); bf16_t* DP = (bf16_t*)(ws + WS_DPOOL);
    const int col = 4 * c.lane, gi = c.lane >> 4, win = 2 << gi;
    constexpr int RPW = 16;
    for (int blk = c.gw; blk < MTOK / RPW; blk += c.ngw) {
        const int row0 = blk * RPW, t0 = row0 & (SEQ - 1);
        const bf16_t* base = P + (size_t)row0 * MIXIN + RWKVIN + col;
        f32x4 s = (f32x4){0.f, 0.f, 0.f, 0.f};
#pragma unroll
        for (int j = 1; j < 16; ++j) if (j < win && j <= t0) s += unpk4(*(const u32x2*)(base - (size_t)j * MIXIN));
#pragma unroll 4
        for (int rr = 0; rr < RPW; ++rr) {
            const int t = t0 + rr; const bf16_t* cur = base + (size_t)rr * MIXIN;
            const f32x4 x0 = unpk4(*(const u32x2*)cur);
            f32x4 xo = (f32x4){0.f, 0.f, 0.f, 0.f}; if (t - win + 1 >= 0) xo = unpk4(*(const u32x2*)(cur - (size_t)(win - 1) * MIXIN));
            s += x0;
            const int cnt = (t + 1) < win ? (t + 1) : win;
            *(u32x2*)(DP + (size_t)(row0 + rr) * 256 + col) = pk4(s * (1.0f / (float)cnt) - x0);
            s -= xo;
        }
    }
}
__device__ __forceinline__ void phase_memattn(const Params& p, const Ctx& c) {
    unsigned char* ws = p.ws;
    const bf16_t* P = (const bf16_t*)(ws + WS_P); const bf16_t* KB = (const bf16_t*)(ws + WS_KB); const bf16_t* VT = (const bf16_t*)(ws + WS_VT); bf16_t* Y = (bf16_t*)(ws + WS_YCAT);
    constexpr int KS = 72, VS = 264;
    LAS bf16_t* LK = (LAS bf16_t*)c.lds; LAS bf16_t* LV = (LAS bf16_t*)(c.lds + 256 * KS * 2);
    const int fr = c.fr, fq = c.fq, tid = c.tid;
    for (int grp = blockIdx.x; grp < BATCH * 4 * 8; grp += gridDim.x) {
        const int pp = grp & 7, h = (grp >> 3) & 3, b = grp >> 5;
        __syncthreads();
        { const int row = tid >> 1, hf = tid & 1; const u32x4* src = (const u32x4*)(KB + (size_t)(b * 256 + row) * 256 + h * 64 + 32 * hf);
#pragma unroll
          for (int i = 0; i < 4; ++i) *(LAS u32x4*)(LK + row * KS + 32 * hf + 8 * i) = src[i];
          const int d = tid >> 3, sg = tid & 7; const u32x4* sv = (const u32x4*)(VT + ((size_t)((b * 4 + h) * 64 + d)) * 256 + 32 * sg);
#pragma unroll
          for (int i = 0; i < 4; ++i) *(LAS u32x4*)(LV + d * VS + 32 * sg + 8 * i) = sv[i]; }
        __syncthreads();
#pragma unroll 1
        for (int it = 0; it < 4; ++it) {
            const int qt = 2 * pp + (it >> 1), qg = it & 1;
            const int row = b * SEQ + qt * 256 + c.wave * 32 + 16 * qg + fr;
            const bf16x8 q0 = *(const bf16x8*)(P + (size_t)row * MIXIN + 2048 + h * 64 + 8 * fq), q1 = *(const bf16x8*)(P + (size_t)row * MIXIN + 2048 + h * 64 + 32 + 8 * fq);
            f32x4 sc[16];
#pragma unroll
            for (int kg = 0; kg < 16; ++kg) {
                const LAS bf16_t* kp = LK + (16 * kg + fr) * KS + 8 * fq;
                f32x4 a = (f32x4){0.f, 0.f, 0.f, 0.f};
                a = __builtin_amdgcn_mfma_f32_16x16x32_bf16(*(const LAS bf16x8*)kp, q0, a, 0, 0, 0); a = __builtin_amdgcn_mfma_f32_16x16x32_bf16(*(const LAS bf16x8*)(kp + 32), q1, a, 0, 0, 0); sc[kg] = a;
                if ((kg & 3) == 3) asm volatile("" ::: "memory");
            }
            float m = -1e30f;
#pragma unroll
            for (int kg = 0; kg < 16; ++kg) m = fmaxf(m, fmaxf(fmaxf(sc[kg][0], sc[kg][1]), fmaxf(sc[kg][2], sc[kg][3])));
            m = fmaxf(m, __shfl_xor(m, 16)); m = fmaxf(m, __shfl_xor(m, 32));
            float l = 0.f;
#pragma unroll
            for (int kg = 0; kg < 16; ++kg)
#pragma unroll
                for (int j = 0; j < 4; ++j) { const float e = __expf((sc[kg][j] - m) * 0.125f); sc[kg][j] = e; l += e; }
            l += __shfl_xor(l, 16); l += __shfl_xor(l, 32);
            const float linv = 1.0f / l;
            f32x4 o[4];
#pragma unroll
            for (int dg = 0; dg < 4; ++dg) o[dg] = (f32x4){0.f, 0.f, 0.f, 0.f};
#pragma unroll
            for (int s2 = 0; s2 < 8; ++s2) {
                u32x4 w; w.x = pk2(sc[2 * s2][0], sc[2 * s2][1]); w.y = pk2(sc[2 * s2][2], sc[2 * s2][3]); w.z = pk2(sc[2 * s2 + 1][0], sc[2 * s2 + 1][1]); w.w = pk2(sc[2 * s2 + 1][2], sc[2 * s2 + 1][3]);
                const bf16x8 pf = __builtin_bit_cast(bf16x8, w);
#pragma unroll
                for (int dg = 0; dg < 4; ++dg) {
                    const LAS bf16_t* vp = LV + (16 * dg + fr) * VS + 32 * s2 + 4 * fq;
                    u32x4 v; const u32x2 lo = *(const LAS u32x2*)vp, hi = *(const LAS u32x2*)(vp + 16); v.x = lo.x; v.y = lo.y; v.z = hi.x; v.w = hi.y;
                    o[dg] = __builtin_amdgcn_mfma_f32_16x16x32_bf16(__builtin_bit_cast(bf16x8, v), pf, o[dg], 0, 0, 0);
                }
                if (s2 & 1) asm volatile("" ::: "memory");
            }
#pragma unroll
            for (int dg = 0; dg < 4; ++dg) *(u32x2*)(Y + (size_t)row * DM + 768 + h * 64 + 16 * dg + 4 * fq) = pk4(o[dg] * linv);
        }
    }
}

#define MF16(a, b, c) __builtin_amdgcn_mfma_f32_16x16x32_bf16((a), (b), (c), 0, 0, 0)
__device__ __forceinline__ bf16x8 pack4z(f32x4 x) { u32x4 w; w.x = pk2(x[0], x[1]); w.y = pk2(x[2], x[3]); w.z = 0u; w.w = 0u; return __builtin_bit_cast(bf16x8, w); }
__device__ __forceinline__ bf16x8 frag4z(const LAS bf16_t* p) { const u32x2 v = *(const LAS u32x2*)p; u32x4 w; w.x = v.x; w.y = v.y; w.z = 0u; w.w = 0u; return __builtin_bit_cast(bf16x8, w); }
__device__ __forceinline__ bf16x8 raw4z(u32x2 v) { u32x4 w; w.x = v.x; w.y = v.y; w.z = 0u; w.w = 0u; return __builtin_bit_cast(bf16x8, w); }
__device__ __forceinline__ float sum8(float x) { x += dpp_f<0xB1>(x); x += dpp_f<0x4E>(x); x += dpp_f<0x141>(x); return x; }
constexpr int CH = 64, NCHUNK = SEQ / CH, NTASK = BATCH * 8 * NCHUNK;
constexpr int RS = 72;
constexpr int S1_QK = 0, S1_QR = 9216, S1_QB = 18432, S1_QKH = 27648, S1_BTN = 36864, S1_KHT = 46080, S1_VT = 55296;
constexpr int S1_AAB = 64512, S1_AAK = 73728, S1_ARB = 82944, S1_ARK = 92160, S1_EC = 101376, S1_DG = 117760, S1_DI = 121856, S1_GC = 124928, S1_SEG = 125184;
constexpr int DIS = 24;
__device__ __forceinline__ void phase_s1(const Params& p, const Ctx& c) {
    unsigned char* ws = p.ws;
    const bf16_t* R = (const bf16_t*)(ws + WS_R); const bf16_t* KR = (const bf16_t*)(ws + WS_KRAW); const bf16_t* V = (const bf16_t*)(ws + WS_V); const bf16_t* AA = (const bf16_t*)(ws + WS_AA);
    const float* EW = (const float*)(ws + WS_W); float* BON = (float*)(ws + WS_BONUS);
    u32x2* RTT = (u32x2*)((unsigned char*)p.out + DO_RTT); u32x2* MTT = (u32x2*)((unsigned char*)p.out + DO_MTT); u32x2* Y0D = (u32x2*)((unsigned char*)p.out + DO_Y0D); u32x2* ND = (u32x2*)((unsigned char*)p.out + DO_ND);
    LAS unsigned char* L = c.lds;
    LAS bf16_t* QK = (LAS bf16_t*)(L + S1_QK); LAS bf16_t* QR = (LAS bf16_t*)(L + S1_QR); LAS bf16_t* QB = (LAS bf16_t*)(L + S1_QB); LAS bf16_t* QKH = (LAS bf16_t*)(L + S1_QKH);
    LAS bf16_t* BTN = (LAS bf16_t*)(L + S1_BTN); LAS bf16_t* KHT = (LAS bf16_t*)(L + S1_KHT); LAS bf16_t* VT = (LAS bf16_t*)(L + S1_VT);
    LAS bf16_t* AAB = (LAS bf16_t*)(L + S1_AAB); LAS bf16_t* AAK = (LAS bf16_t*)(L + S1_AAK); LAS bf16_t* ARB = (LAS bf16_t*)(L + S1_ARB); LAS bf16_t* ARK = (LAS bf16_t*)(L + S1_ARK);
    LAS float* EC = (LAS float*)(L + S1_EC); LAS float* DG = (LAS float*)(L + S1_DG); LAS bf16_t* DI = (LAS bf16_t*)(L + S1_DI); LAS float* GC = (LAS float*)(L + S1_GC); LAS float* SEG = (LAS float*)(L + S1_SEG);
    const int tid = c.tid, fr = c.fr, fq = c.fq, wave = c.wave, lane = c.lane;
    const int st = tid >> 3, cg = tid & 7;
    for (int task = blockIdx.x; task < NTASK; task += gridDim.x) {
        const int bh = task >> 6, ch = task & 63, b = bh >> 3, h = bh & 7;
        const size_t grow = (size_t)b * SEQ + ch * CH + st, goff = grow * RD + h * 64 + 8 * cg;
        __syncthreads();
        float r8[8], k8[8], v8[8], a8[8], e8[8];
        { const u32x4 ur = *(const u32x4*)(R + goff), uk = *(const u32x4*)(KR + goff), uv = *(const u32x4*)(V + goff), ua = *(const u32x4*)(AA + goff);
          const f32x4 e0 = *(const f32x4*)(EW + goff), e1 = *(const f32x4*)(EW + goff + 4);
          const unsigned wr_[4] = {ur.x, ur.y, ur.z, ur.w}, wk_[4] = {uk.x, uk.y, uk.z, uk.w}, wv_[4] = {uv.x, uv.y, uv.z, uv.w}, wa_[4] = {ua.x, ua.y, ua.z, ua.w};
#pragma unroll
          for (int i = 0; i < 4; ++i) { r8[2 * i] = bf2f(wr_[i] & 0xffffu); r8[2 * i + 1] = bf2f(wr_[i] >> 16); k8[2 * i] = bf2f(wk_[i] & 0xffffu); k8[2 * i + 1] = bf2f(wk_[i] >> 16);
              v8[2 * i] = bf2f(wv_[i] & 0xffffu); v8[2 * i + 1] = bf2f(wv_[i] >> 16); a8[2 * i] = bf2f(wa_[i] & 0xffffu); a8[2 * i + 1] = bf2f(wa_[i] >> 16); e8[i] = e0[i]; e8[4 + i] = e1[i]; } }
        float kap8[8], bb8[8], kf8[8]; float nrm = 0.f, bon = 0.f;
#pragma unroll
        for (int i = 0; i < 8; ++i) { const int col = h * 64 + 8 * cg + i; const float kkv = k8[i] * p.in[I_KK][col]; kap8[i] = kkv; nrm += kkv * kkv;
            kf8[i] = k8[i] * (1.0f + (a8[i] - 1.0f) * p.in[I_KA][col]); bon += r8[i] * kf8[i] * p.in[I_RK][col]; }
        nrm = sum8(nrm); bon = sum8(bon);
        const float rn = rsqrtf(nrm + 1e-12f);
#pragma unroll
        for (int i = 0; i < 8; ++i) { kap8[i] *= rn; bb8[i] = kap8[i] * a8[i]; }
        if (cg == 0) BON[grow * 8 + h] = bon;
        *(LAS f32x4*)(EC + st * 64 + 8 * cg) = (f32x4){e8[0], e8[1], e8[2], e8[3]}; *(LAS f32x4*)(EC + st * 64 + 8 * cg + 4) = (f32x4){e8[4], e8[5], e8[6], e8[7]};
        __syncthreads();
        { const int cc = tid & 63, sg = tid >> 6; float run = 0.f;
#pragma unroll
          for (int i = 0; i < 8; ++i) { run += EC[(8 * sg + i) * 64 + cc]; EC[(8 * sg + i) * 64 + cc] = run; }
          SEG[sg * 64 + cc] = run;
          __syncthreads();
          float off = 0.f;
#pragma unroll
          for (int s2 = 0; s2 < 7; ++s2) off += (s2 < sg) ? SEG[s2 * 64 + cc] : 0.f;
#pragma unroll
          for (int i = 0; i < 8; ++i) EC[(8 * sg + i) * 64 + cc] += off;
          if (sg == 7) GC[cc] = __expf(-(run + off)); }
        __syncthreads();
        { float cum[8]; const f32x4 c0 = *(const LAS f32x4*)(EC + st * 64 + 8 * cg), c1 = *(const LAS f32x4*)(EC + st * 64 + 8 * cg + 4);
#pragma unroll
          for (int i = 0; i < 4; ++i) { cum[i] = c0[i]; cum[4 + i] = c1[i]; }
          float kh[8], rh[8], bh8[8], kk8[8];
#pragma unroll
          for (int i = 0; i < 8; ++i) { const float gi = __expf(cum[i]); kh[i] = kap8[i] * __expf(e8[i] - cum[i]); rh[i] = r8[i] * __expf(-cum[i]); bh8[i] = bb8[i] * gi; kk8[i] = kf8[i] * gi; }
          u32x4 w;
          w.x = pk2(kh[0], kh[1]); w.y = pk2(kh[2], kh[3]); w.z = pk2(kh[4], kh[5]); w.w = pk2(kh[6], kh[7]); *(LAS u32x4*)(QK + st * RS + 8 * cg) = w;
          w.x = pk2(rh[0], rh[1]); w.y = pk2(rh[2], rh[3]); w.z = pk2(rh[4], rh[5]); w.w = pk2(rh[6], rh[7]); *(LAS u32x4*)(QR + st * RS + 8 * cg) = w;
          w.x = pk2(bh8[0], bh8[1]); w.y = pk2(bh8[2], bh8[3]); w.z = pk2(bh8[4], bh8[5]); w.w = pk2(bh8[6], bh8[7]); *(LAS u32x4*)(QB + st * RS + 8 * cg) = w;
          w.x = pk2(kk8[0], kk8[1]); w.y = pk2(kk8[2], kk8[3]); w.z = pk2(kk8[4], kk8[5]); w.w = pk2(kk8[6], kk8[7]); *(LAS u32x4*)(QKH + st * RS + 8 * cg) = w;
#pragma unroll
          for (int i = 0; i < 8; ++i) { BTN[(8 * cg + i) * RS + st] = (bf16_t)f2bf(-bh8[i]); KHT[(8 * cg + i) * RS + st] = (bf16_t)f2bf(kk8[i]); VT[(8 * cg + i) * RS + st] = (bf16_t)f2bf(v8[i]); } }
        __syncthreads();
        { const int mat = wave >> 1; const LAS bf16_t* Am = (mat < 2) ? QK : QR; const LAS bf16_t* Bm = (mat & 1) ? QKH : QB; LAS bf16_t* Om = (mat == 0) ? AAB : (mat == 1) ? AAK : (mat == 2) ? ARB : ARK;
          const bool strict = mat < 2; const float sgn = (mat & 1) ? 1.0f : -1.0f;
#pragma unroll
          for (int jj = 0; jj < 2; ++jj) { const int j = 2 * (wave & 1) + jj;
              const bf16x8 bt0 = *(const LAS bf16x8*)(Am + (16 * j + fr) * RS + 8 * fq), bt1 = *(const LAS bf16x8*)(Am + (16 * j + fr) * RS + 32 + 8 * fq);
#pragma unroll
              for (int l = 0; l < 4; ++l) {
                  f32x4 d = (f32x4){0.f, 0.f, 0.f, 0.f};
                  d = MF16(*(const LAS bf16x8*)(Bm + (16 * l + fr) * RS + 8 * fq), bt0, d); d = MF16(*(const LAS bf16x8*)(Bm + (16 * l + fr) * RS + 32 + 8 * fq), bt1, d);
                  const int t = 16 * j + fr, i0 = 16 * l + 4 * fq;
#pragma unroll
                  for (int rg = 0; rg < 4; ++rg) { const bool keep = strict ? (i0 + rg < t) : (i0 + rg <= t); d[rg] = keep ? d[rg] : 0.f; }
                  if (mat == 0 && l == j) *(LAS f32x4*)(DG + (j * 16 + fr) * 16 + 4 * fq) = d;
                  *(LAS u32x2*)(Om + t * RS + i0) = pk4(d * sgn);
              } } }
        __syncthreads();
        f32x4 Z[4], Z1[4], Ee[4];
        if (wave == 0) {
            const int j = lane >> 4, col = lane & 15; float x[16];
#pragma unroll
            for (int t = 0; t < 16; ++t) { float sacc = (t == col) ? 1.0f : 0.0f;
#pragma unroll
                for (int i = 0; i < t; ++i) sacc -= DG[(j * 16 + t) * 16 + i] * x[i];
                x[t] = sacc; }
#pragma unroll
            for (int t = 0; t < 16; ++t) DI[(j * 16 + t) * DIS + col] = (bf16_t)f2bf(x[t]);
        }
        if (wave >= 4) { const int vb = wave - 4;
#pragma unroll
            for (int j = 0; j < 4; ++j) { Z[j] = Z1[j] = Ee[j] = (f32x4){0.f, 0.f, 0.f, 0.f};
#pragma unroll
                for (int s2 = 0; s2 < 2; ++s2) { const bf16x8 bv = *(const LAS bf16x8*)(VT + (16 * vb + fr) * RS + 32 * s2 + 8 * fq);
                    Z[j] = MF16(*(const LAS bf16x8*)(AAK + (16 * j + fr) * RS + 32 * s2 + 8 * fq), bv, Z[j]);
                    Z1[j] = MF16(*(const LAS bf16x8*)(ARK + (16 * j + fr) * RS + 32 * s2 + 8 * fq), bv, Z1[j]);
                    Ee[j] = MF16(*(const LAS bf16x8*)(KHT + (16 * j + fr) * RS + 32 * s2 + 8 * fq), bv, Ee[j]); } } }
        else {
#pragma unroll
            for (int j = 0; j < 4; ++j)
#pragma unroll
                for (int rg = 0; rg < 4; ++rg) Z[j][rg] = bf2f(QK[(16 * j + 4 * fq + rg) * RS + 16 * wave + fr]); }
        __syncthreads();
        f32x4 X[4];
#pragma unroll
        for (int j = 0; j < 4; ++j) { f32x4 acc = Z[j];
#pragma unroll
            for (int l = 0; l < 4; ++l) if (l < j) acc = MF16(frag4z(AAB + (16 * j + fr) * RS + 16 * l + 4 * fq), pack4z(X[l]), acc);
            X[j] = MF16(frag4z(DI + (j * 16 + fr) * DIS + 4 * fq), pack4z(acc), ((f32x4){0.f, 0.f, 0.f, 0.f})); }
        const size_t dbase = ((size_t)task * 4 + (wave & 3)) * 4 * 64 + lane;
        if (wave >= 4) {
#pragma unroll
            for (int j = 0; j < 4; ++j) { f32x4 y0 = Z1[j];
#pragma unroll
                for (int l = 0; l < 4; ++l) if (l <= j) y0 = MF16(frag4z(ARB + (16 * j + fr) * RS + 16 * l + 4 * fq), pack4z(X[l]), y0);
                Y0D[dbase + j * 64] = pk4(y0);
                f32x4 nn = Ee[j];
#pragma unroll
                for (int l = 0; l < 4; ++l) nn = MF16(frag4z(BTN + (16 * j + fr) * RS + 16 * l + 4 * fq), pack4z(X[l]), nn);
#pragma unroll
                for (int rg = 0; rg < 4; ++rg) nn[rg] *= GC[16 * j + 4 * fq + rg];
                ND[dbase + j * 64] = pk4(nn); } }
        else {
#pragma unroll
            for (int j = 0; j < 4; ++j) { f32x4 rt = unpk4(*(const LAS u32x2*)(QR + (16 * j + fr) * RS + 16 * wave + 4 * fq));
#pragma unroll
                for (int l = 0; l < 4; ++l) if (l <= j) rt = MF16(pack4z(X[l]), frag4z(ARB + (16 * j + fr) * RS + 16 * l + 4 * fq), rt);
                RTT[dbase + j * 64] = pk4(rt);
                f32x4 mt;
#pragma unroll
                for (int rg = 0; rg < 4; ++rg) mt[rg] = (16 * wave + 4 * fq + rg == 16 * j + fr) ? 1.0f : 0.0f;
#pragma unroll
                for (int l = 0; l < 4; ++l) mt = MF16(pack4z(X[l]), frag4z(BTN + (16 * j + fr) * RS + 16 * l + 4 * fq), mt);
                MTT[dbase + j * 64] = pk4(mt * GC[16 * j + fr]); } }
    }
}
__device__ __forceinline__ void phase_s2(const Params& p, const Ctx& c) {
    if (c.wave != 0) return;
    const u32x2* MTT = (const u32x2*)((unsigned char*)p.out + DO_MTT); const u32x2* ND = (const u32x2*)((unsigned char*)p.out + DO_ND); u32x2* SP = (u32x2*)(p.ws + WS_SP);
    const int lane = c.lane;
    for (int unit = blockIdx.x; unit < BATCH * 8 * 4; unit += gridDim.x) {
        const int vb = unit & 3, bh = unit >> 2;
        f32x4 S[4];
#pragma unroll
        for (int j = 0; j < 4; ++j) S[j] = (f32x4){0.f, 0.f, 0.f, 0.f};
        u32x2 mc[4][4], nc[4];
        { const size_t task = (size_t)bh * NCHUNK;
#pragma unroll
          for (int l = 0; l < 4; ++l)
#pragma unroll
              for (int j = 0; j < 4; ++j) mc[l][j] = MTT[((task * 4 + l) * 4 + j) * 64 + lane];
#pragma unroll
          for (int j = 0; j < 4; ++j) nc[j] = ND[((task * 4 + vb) * 4 + j) * 64 + lane]; }
        for (int ch = 0; ch < NCHUNK; ++ch) {
            const size_t task = (size_t)bh * NCHUNK + ch, tn = (ch + 1 < NCHUNK) ? task + 1 : task;
            u32x2 mn[4][4], nn[4];
#pragma unroll
            for (int l = 0; l < 4; ++l)
#pragma unroll
                for (int j = 0; j < 4; ++j) mn[l][j] = MTT[((tn * 4 + l) * 4 + j) * 64 + lane];
#pragma unroll
            for (int j = 0; j < 4; ++j) nn[j] = ND[((tn * 4 + vb) * 4 + j) * 64 + lane];
            bf16x8 sp[4];
#pragma unroll
            for (int l = 0; l < 4; ++l) { const u32x2 w = pk4(S[l]); SP[((task * 4 + vb) * 4 + l) * 64 + lane] = w; sp[l] = raw4z(w); }
#pragma unroll
            for (int j = 0; j < 4; ++j) { f32x4 acc = unpk4(nc[j]);
#pragma unroll
                for (int l = 0; l < 4; ++l) acc = MF16(raw4z(mc[l][j]), sp[l], acc);
                S[j] = acc; }
#pragma unroll
            for (int l = 0; l < 4; ++l)
#pragma unroll
                for (int j = 0; j < 4; ++j) mc[l][j] = mn[l][j];
#pragma unroll
            for (int j = 0; j < 4; ++j) nc[j] = nn[j];
        }
    }
}
__device__ __forceinline__ void phase_s3(const Params& p, const Ctx& c) {
    unsigned char* ws = p.ws;
    const u32x2* RTT = (const u32x2*)((unsigned char*)p.out + DO_RTT); const u32x2* Y0D = (const u32x2*)((unsigned char*)p.out + DO_Y0D); const u32x2* SP = (const u32x2*)(ws + WS_SP);
    const float* BON = (const float*)(ws + WS_BONUS); const bf16_t* V = (const bf16_t*)(ws + WS_V); const bf16_t* G = (const bf16_t*)(ws + WS_G); bf16_t* Y = (bf16_t*)(ws + WS_YCAT);
    const int lane = c.lane, fr = c.fr, fq = c.fq;
    for (int it = c.gw; it < NTASK * 4; it += c.ngw) {
        const size_t task = (size_t)(it >> 2); const int j = it & 3, bh = (int)(task >> 6), ch = (int)(task & 63), b = bh >> 3, h = bh & 7;
        bf16x8 rt[4];
#pragma unroll
        for (int l = 0; l < 4; ++l) rt[l] = raw4z(RTT[((task * 4 + l) * 4 + j) * 64 + lane]);
        f32x4 acc[4];
#pragma unroll
        for (int vb = 0; vb < 4; ++vb) { acc[vb] = unpk4(Y0D[((task * 4 + vb) * 4 + j) * 64 + lane]);
#pragma unroll
            for (int l = 0; l < 4; ++l) acc[vb] = MF16(rt[l], raw4z(SP[((task * 4 + vb) * 4 + l) * 64 + lane]), acc[vb]); }
#pragma unroll
        for (int rg = 0; rg < 4; ++rg) {
            const size_t row = (size_t)b * SEQ + ch * CH + 16 * j + 4 * fq + rg;
            const float mean = row_sum16((acc[0][rg] + acc[1][rg]) + (acc[2][rg] + acc[3][rg])) * (1.0f / 64.0f);
            float d[4], q = 0.f;
#pragma unroll
            for (int vb = 0; vb < 4; ++vb) { d[vb] = acc[vb][rg] - mean; q += d[vb] * d[vb]; }
            const float rstd = rsqrtf(row_sum16(q) * (1.0f / 64.0f) + GN_EPS), bon = BON[row * 8 + h];
#pragma unroll
            for (int vb = 0; vb < 4; ++vb) { const int col = h * 64 + 16 * vb + fr;
                const float yn = d[vb] * rstd * p.in[I_LNW][col] + p.in[I_LNB][col];
                Y[row * DM + col] = (bf16_t)f2bf((yn + bon * bf2f(V[row * RD + col])) * bf2f(G[row * RD + col])); }
        }
    }
}

__device__ __forceinline__ void phase_final_norm(const Params& p, const Ctx& c) {
    const float* g = p.in[I_NFING]; const float* SS = (const float*)(p.ws + WS_SS3);
    const f32x4 g0 = *((const f32x4*)g + c.lane), g1 = *((const f32x4*)g + c.lane + 64), g2 = *((const f32x4*)g + c.lane + 128), g3 = *((const f32x4*)g + c.lane + 192);
#pragma unroll 4
    for (int m = c.gw; m < MTOK; m += c.ngw) {
        f32x4* xr = (f32x4*)(p.out + (size_t)m * DM) + c.lane;
        const float rstd = rsqrtf(SS[m] * (1.f / DM) + NORM_EPS);
        const f32x4 v0 = xr[0], v1 = xr[64], v2 = xr[128], v3 = xr[192];
        xr[0] = v0 * rstd * g0; xr[64] = v1 * rstd * g1; xr[128] = v2 * rstd * g2; xr[192] = v3 * rstd * g3;
    }
}

constexpr int NPHASES = 14;
__global__ void __launch_bounds__(NTHREADS, 2) fwd_kernel(Params p) {
    extern __shared__ __attribute__((aligned(16))) unsigned char lds_raw[];
    Ctx c; c.tid = threadIdx.x; c.lane = c.tid & 63; c.wave = __builtin_amdgcn_readfirstlane(c.tid >> 6); c.fr = c.lane & 15; c.fq = c.lane >> 4;
    c.gw = blockIdx.x * NWAVES + c.wave; c.ngw = gridDim.x * NWAVES; c.lds = (LAS unsigned char*)lds_raw;
    unsigned char* ws = p.ws;
#if ONE_LAUNCH
    cg::grid_group grid = cg::this_grid();
    volatile LAS unsigned* misc = (volatile LAS unsigned*)(c.lds + LDS_MISC_OFF);
    if (c.tid < 4) misc[c.tid] = 0u;
    __syncthreads();
    const XcdBarrier xbar = xcd_barrier_post((unsigned*)(ws + WS_BAR), misc);
    bool first_seam = true;
#define SEAM() do { if (first_seam) { grid.sync(); first_seam = false; } else xcd_barrier(xbar); } while (0)
#else
#define SEAM() do {} while (0)
#endif
#define IN(k) (p.ph_lo <= (k) && (k) < p.ph_hi)
#define END(k) do { if (IN((k) + 1)) SEAM(); } while (0)
#define REP_ON(k) ((REP_MASK >> (k)) & 1u)
#define PHASE(k, ...) if (IN(k)) { __VA_ARGS__ if (REP_ON(k)) { SEAM(); __VA_ARGS__ } END(k); }
    PHASE(0, phase_prologue(p, c);)
    PHASE(1,
        gemm_pg8_8(c, (const bf16_t*)(ws + WS_H), DM, (const bf16_t*)(ws + WS_WG1T), DM, MTOK, MIXIN, DM, F8Store{(bf16_t*)(ws + WS_P), MIXIN});
        gemm_simple(c, (const bf16_t*)(ws + WS_MEMN), DM, (const bf16_t*)(ws + WS_WKVT), DM, BATCH * NMEM, 512, DM, EpiKV{(bf16_t*)(ws + WS_KB), (bf16_t*)(ws + WS_VT)});)
    PHASE(2, phase_mix(p, c); phase_pooldiff(p, c); phase_memattn(p, c);)
    PHASE(3,
        gemm_simple(c, (const bf16_t*)(ws + WS_LW), 64, (const bf16_t*)(ws + WS_WLWT), 64, MTOK, RD, 64, EpiDecay{(float*)(ws + WS_W), p.in[I_W0]});
        gemm_simple(c, (const bf16_t*)(ws + WS_LA), 64, (const bf16_t*)(ws + WS_WLAT), 64, MTOK, RD, 64, EpiSigBias{(bf16_t*)(ws + WS_AA), RD, p.in[I_A0]});
        gemm_simple(c, (const bf16_t*)(ws + WS_LG), 128, (const bf16_t*)(ws + WS_WLGT), 128, MTOK, RD, 128, EpiBf16{(bf16_t*)(ws + WS_G), RD});
        _Pragma("unroll 1") for (int gi = 0; gi < 4; ++gi)
            gemm_simple(c, (const bf16_t*)(ws + WS_DPOOL) + 64 * gi, 256, (const bf16_t*)(ws + WS_WPT) + 4096 * gi, 64, MTOK, 64, 64, EpiPool{(bf16_t*)(ws + WS_YCAT), p.in[I_POOLS], gi});)
    PHASE(4, phase_s1(p, c);)
    PHASE(5, phase_s2(p, c);)
    PHASE(6, phase_s3(p, c);)
    PHASE(7,
        gemm_pg8_8(c, (const bf16_t*)(ws + WS_H), DM, (const bf16_t*)(ws + WS_WG1T) + (size_t)MIXIN * DM, DM, MTOK, 3 * DM, DM, F8SigBias{(bf16_t*)(ws + WS_GATES), 3 * DM, p.in[I_BGATE]});)
    PHASE(8, {
        pg8::Gemm g{(const bf16_t*)(ws + WS_YCAT), (const bf16_t*)(ws + WS_WUPT), MTOK, DM, DM, DM, DM}; pg8::StaticOrder S; S.init(MTOK, DM, (int)gridDim.x, (int)blockIdx.x);
        EpiFn8<F8UpFinal> E{F8UpFinal{(bf16_t*)(ws + WS_MERGED), (const bf16_t*)(ws + WS_GATES)}};
        pg8::gemm_phase_h<EpiFn8<F8UpFinal>, pg8::StaticOrder, true, true, UpHook>(c.lds, g, S, E, UpHook{(const bf16_t*)(ws + WS_GATES)}); })
    PHASE(9, {
        pg8::Gemm g{(const bf16_t*)(ws + WS_MERGED), (const bf16_t*)(ws + WS_WOT), MTOK, DM, DM, DM, DM}; pg8::StaticOrder S; S.init(MTOK, DM, (int)gridDim.x, (int)blockIdx.x);
        EpiOutB E{p.in[I_X], (bf16_t*)(ws + WS_X1B), (float*)(ws + WS_SS2)};
        pg8::gemm_phase<EpiOutB, pg8::StaticOrder, true, true>(c.lds, g, S, E); })
    PHASE(10, {
        pg8::Gemm g{(const bf16_t*)(ws + WS_X1B), (const bf16_t*)(ws + WS_WF1T), MTOK, 2 * FF, DM, DM, DM}; pg8::StaticOrder S; S.init(MTOK, 2 * FF, (int)gridDim.x, (int)blockIdx.x);
        EpiFfnAct E{(bf16_t*)(ws + WS_ACT), (const float*)(ws + WS_SS2), p.in[I_CONVW], p.in[I_CONVB], (float*)(ws + WS_TAILU), (float*)(ws + WS_HEADU), (float*)(ws + WS_HEADGV), (LAS float*)(c.lds + LDS_HALO_OFF)};
        pg8::gemm_phase<EpiFfnAct, pg8::StaticOrder, true, true>(c.lds, g, S, E); })
    PHASE(11, phase_ffn_fix(p, c);)
    PHASE(12, {
        pg8::Gemm g{(const bf16_t*)(ws + WS_ACT), (const bf16_t*)(ws + WS_WF2T), MTOK, DM, FF, FF, FF}; pg8::StaticOrder S; S.init(MTOK, DM, (int)gridDim.x, (int)blockIdx.x);
        EpiFfnOut E{(const bf16_t*)(ws + WS_X1B), p.out, (float*)(ws + WS_SS3)};
        pg8::gemm_phase<EpiFfnOut, pg8::StaticOrder, true, true>(c.lds, g, S, E); })
    if (IN(13)) { phase_final_norm(p, c); }
#undef IN
#undef END
}

__global__ void nan_fill(float* o, int n) { const int i = blockIdx.x * blockDim.x + threadIdx.x; if (i < n) o[i] = __builtin_nanf(""); }

extern "C" void kernel_launch(void* const* d_in, const int* in_sizes, int n_in, void* d_out, int out_size, void* d_ws, size_t ws_size, hipStream_t stream) {
    static int grid = 0;
    if (grid == 0) {
        int dev = 0, cus = 0, per_cu = 0;
        if (hipGetDevice(&dev) != hipSuccess || hipDeviceGetAttribute(&cus, hipDeviceAttributeMultiprocessorCount, dev) != hipSuccess) cus = 256;
        (void)hipFuncSetAttribute((const void*)fwd_kernel, hipFuncAttributeMaxDynamicSharedMemorySize, LDS_BYTES);
        if (hipOccupancyMaxActiveBlocksPerMultiprocessor(&per_cu, (const void*)fwd_kernel, NTHREADS, LDS_BYTES) != hipSuccess || per_cu < 1) per_cu = 1;
        (void)hipGetLastError();
        grid = cus;
        if (n_in != 31 || out_size != MTOK * DM || ws_size < WS_END) grid = -1;
    }
    if (grid < 0) { nan_fill<<<(out_size + 255) / 256, 256, 0, stream>>>((float*)d_out, out_size); return; }
    Params p{};
    for (int i = 0; i < 31; ++i) p.in[i] = (const float*)d_in[i];
    p.out = (float*)d_out; p.ws = (unsigned char*)d_ws;
#if ONE_LAUNCH
    (void)hipMemsetAsync((unsigned char*)d_ws + WS_BAR, 0, WS_CTL_BYTES, stream);
    p.ph_lo = 0; p.ph_hi = NPHASES;
    void* args[] = {&p};
    hipError_t e = hipLaunchCooperativeKernel((const void*)fwd_kernel, dim3(grid), dim3(NTHREADS), args, LDS_BYTES, stream);
    if (e != hipSuccess) fprintf(stderr, "cooperative launch failed: %s (grid %d)\n", hipGetErrorString(e), grid);
#else
    for (int ph = 0; ph < NPHASES; ++ph) { p.ph_lo = ph; p.ph_hi = ph + 1; hipLaunchKernelGGL(fwd_kernel, dim3(grid), dim3(NTHREADS), LDS_BYTES, stream, p); }
#endif
}
```

```cpp
#include <hip/hip_runtime.h>
#include <hip/hip_cooperative_groups.h>
#include <cstdio>
#include <cstdint>
namespace cg = cooperative_groups;

#ifndef ONE_LAUNCH
#define ONE_LAUNCH 1
#endif
#ifndef PH_MASK
#define PH_MASK 0xFFFFFFFFu
#endif
#define PH_ON(k) ((PH_MASK >> (k)) & 1u)
#ifndef REP_MASK
#define REP_MASK 0u
#endif

#define LAS __attribute__((address_space(3)))
typedef unsigned short bf16_t;
typedef short bf16x8 __attribute__((ext_vector_type(8)));
typedef float f32x4 __attribute__((ext_vector_type(4)));
typedef float f32x2 __attribute__((ext_vector_type(2)));
typedef unsigned u32x4 __attribute__((ext_vector_type(4)));
typedef unsigned u32x2 __attribute__((ext_vector_type(2)));

constexpr int BATCH = 8, SEQ = 4096, DM = 1024, MTOK = BATCH * SEQ;
constexpr int NMEM = 256, RD = 512, MIXIN = 2304, RWKVIN = 1792, FF = 2816, NG1 = MIXIN + 3 * DM;
constexpr int NWAVES = 8, NTHREADS = 512;
constexpr float NORM_EPS = 1e-6f, GN_EPS = 64e-5f;

constexpr size_t MiB = 1u << 20;
constexpr size_t WS_WG1T = 1 * MiB;
constexpr size_t WS_WKVT = WS_WG1T + (size_t)NG1 * DM * 2;
constexpr size_t WS_WUPT = WS_WKVT + (size_t)512 * DM * 2;
constexpr size_t WS_WOT = WS_WUPT + (size_t)DM * DM * 2;
constexpr size_t WS_WF1T = WS_WOT + (size_t)DM * DM * 2;
constexpr size_t WS_WF2T = WS_WF1T + (size_t)2 * FF * DM * 2;
constexpr size_t WS_WLWT = WS_WF2T + (size_t)DM * FF * 2;
constexpr size_t WS_WLAT = WS_WLWT + (size_t)RD * 64 * 2;
constexpr size_t WS_WLGT = WS_WLAT + (size_t)RD * 64 * 2;
constexpr size_t WS_WPT = WS_WLGT + (size_t)RD * 128 * 2;
constexpr size_t WS_WEND = WS_WPT + (size_t)4 * 64 * 64 * 2;
static_assert(WS_WEND <= 34 * MiB, "weights region");
constexpr size_t WS_BONUS = 34 * MiB;
constexpr size_t WS_SS2 = 35 * MiB, WS_SS3 = 35 * MiB + 256 * 1024;
constexpr size_t WS_KB = 36 * MiB;
constexpr size_t WS_VT = 37 * MiB;
constexpr size_t WS_MEMN = 38 * MiB;
constexpr size_t WS_H = 42 * MiB;
constexpr size_t WS_YCAT = 106 * MiB;
constexpr size_t WS_P = 170 * MiB;
constexpr size_t WS_W = 170 * MiB;
constexpr size_t WS_G = 234 * MiB;
constexpr size_t WS_AA = 266 * MiB;
constexpr size_t WS_KRAW = 314 * MiB;
constexpr size_t WS_YRAW = 266 * MiB;
constexpr size_t WS_R = 346 * MiB;
constexpr size_t WS_V = 378 * MiB;
constexpr size_t WS_LW = 410 * MiB;
constexpr size_t WS_LA = 414 * MiB;
constexpr size_t WS_LG = 418 * MiB;
constexpr size_t WS_DPOOL = 426 * MiB;
constexpr size_t WS_SP = 442 * MiB;
constexpr size_t WS_GATES = 170 * MiB;
constexpr size_t WS_MERGED = 362 * MiB;
constexpr size_t WS_X1B = 426 * MiB;
constexpr size_t WS_TAILU = 42 * MiB, WS_HEADU = 45 * MiB, WS_HEADGV = 48 * MiB;
constexpr size_t WS_ACT = 218 * MiB;
constexpr size_t WS_END = 490 * MiB;
constexpr size_t DO_RTT = 0, DO_MTT = 32 * MiB, DO_Y0D = 64 * MiB, DO_ND = 96 * MiB;

constexpr int LDS_BYTES = 147456;
constexpr int LDS_HALO_OFF = 131072 + 1024;
constexpr int LDS_MISC_OFF = 131072 + 320;
constexpr size_t WS_BAR = 0, WS_CTL_BYTES = 65536;

__device__ __forceinline__ unsigned f2bf(float f) { unsigned u = __float_as_uint(f); return (u + 0x7fffu + ((u >> 16) & 1u)) >> 16; }
__device__ __forceinline__ float bf2f(unsigned h) { return __uint_as_float(h << 16); }
__device__ __forceinline__ unsigned pk2(float lo, float hi) { return f2bf(lo) | (f2bf(hi) << 16); }
__device__ __forceinline__ u32x2 pk4(f32x4 v) { u32x2 r; r.x = pk2(v[0], v[1]); r.y = pk2(v[2], v[3]); return r; }
__device__ __forceinline__ f32x4 unpk4(u32x2 u) { f32x4 r; r[0] = bf2f(u.x & 0xffffu); r[1] = bf2f(u.x >> 16); r[2] = bf2f(u.y & 0xffffu); r[3] = bf2f(u.y >> 16); return r; }
__device__ __forceinline__ float wave_sum(float v) {
#pragma unroll
    for (int o = 1; o < 64; o <<= 1) v += __shfl_xor(v, o);
    return v;
}
__device__ __forceinline__ float sigmoidf_(float x) { return __builtin_amdgcn_rcpf(1.0f + __expf(-x)); }
template <int CTRL> __device__ __forceinline__ float dpp_f(float x) { return __builtin_bit_cast(float, __builtin_amdgcn_update_dpp(0, __builtin_bit_cast(int, x), CTRL, 0xF, 0xF, false)); }
__device__ __forceinline__ float row_sum16(float x) {
    x += dpp_f<0xB1>(x);
    x += dpp_f<0x4E>(x);
    x += dpp_f<0x141>(x);
    x += dpp_f<0x140>(x);
    return x;
}

#define XB_TMO      128
#define XB_XCNT(j)  (256  + 64 * (j))
#define XB_XSUB(j)  (1280 + 64 * (j))
#define XB_XGEN(j)  (2304 + 64 * (j))
#define XB_TOP      3328
#define XB_TOPGEN   3392
#define XCD_BAR_WORDS 3456
#define XB_SPIN_CAP (1u << 18)

__device__ __forceinline__ unsigned xb_ld(unsigned* p)              { return __hip_atomic_load(p, __ATOMIC_RELAXED, __HIP_MEMORY_SCOPE_AGENT); }
__device__ __forceinline__ unsigned xb_add(unsigned* p, unsigned v) { return __hip_atomic_fetch_add(p, v, __ATOMIC_RELAXED, __HIP_MEMORY_SCOPE_AGENT); }
__device__ __forceinline__ unsigned xb_xcc_id() { return (unsigned)__builtin_amdgcn_s_getreg((3 << 11) | 20) & 0xFu; }
#define XB_SPIN(cond, bar) do { unsigned _sp = 0; while (cond) { __builtin_amdgcn_s_sleep(1); \
    if ((++_sp & 255u) == 0u) { if (xb_ld(&(bar)[XB_TMO])) break; if (_sp > XB_SPIN_CAP) { atomicAdd(&(bar)[XB_TMO], 1u); break; } } } } while (0)

struct XcdBarrier {
    unsigned* bar; unsigned x;
    volatile LAS unsigned* st;
};

__device__ __forceinline__ XcdBarrier xcd_barrier_post(unsigned* bar, volatile LAS unsigned* st) {
    XcdBarrier b; b.bar = bar; b.x = xb_xcc_id(); b.st = st;
    if (threadIdx.x == 0) (void)xb_add(&bar[XB_XCNT(b.x)], 1u);
    return b;
}
__device__ __forceinline__ void xcd_barrier_complete(unsigned* bar, unsigned x, unsigned& nloc, unsigned& nx) {
    const unsigned G = gridDim.x * gridDim.y * gridDim.z;
    unsigned sum, cnt, mine, sp = 0u;
    for (;;) {
        sum = 0u; cnt = 0u; mine = 0u;
#pragma unroll
        for (unsigned j = 0; j < 16; ++j) { const unsigned c = xb_ld(&bar[XB_XCNT(j)]); sum += c; cnt += (c > 0u) ? 1u : 0u; mine = (j == x) ? c : mine; }
        if (sum == G) break;
        __builtin_amdgcn_s_sleep(1);
        if ((++sp & 255u) == 0u) { if (xb_ld(&bar[XB_TMO])) break; if (sp > XB_SPIN_CAP) { atomicAdd(&bar[XB_TMO], 1u); break; } }
    }
    nloc = mine > 0u ? mine : 1u; nx = cnt > 0u ? cnt : 1u;
}

__device__ __forceinline__ void xcd_barrier(const XcdBarrier& b) {
    asm volatile("s_waitcnt vmcnt(0)" ::: "memory");
    __syncthreads();
    if (threadIdx.x == 0) {
        unsigned* bar = b.bar;
        __builtin_amdgcn_s_waitcnt(0);
        unsigned nloc = b.st[0], nx = b.st[1];
        if (nloc == 0u) { xcd_barrier_complete(bar, b.x, nloc, nx); b.st[0] = nloc; b.st[1] = nx; }
        const unsigned old = xb_add(&bar[XB_XSUB(b.x)], 1u);
        const unsigned gen = old / nloc;
        if (old + 1u == (gen + 1u) * nloc) {
            __builtin_amdgcn_fence(__ATOMIC_RELEASE, "agent");
            asm volatile("s_waitcnt vmcnt(0)" ::: "memory");
            const unsigned og = xb_add(&bar[XB_TOP], 1u);
            const unsigned tg = og / nx;
            if (og + 1u == (tg + 1u) * nx) xb_add(&bar[XB_TOPGEN], 1u);
            else XB_SPIN(xb_ld(&bar[XB_TOPGEN]) == tg, bar);
            __builtin_amdgcn_fence(__ATOMIC_ACQUIRE, "agent");
            xb_add(&bar[XB_XGEN(b.x)], 1u);
            asm volatile("s_waitcnt vmcnt(0)" ::: "memory");
        } else {
            XB_SPIN(xb_ld(&bar[XB_XGEN(b.x)]) == gen, bar);
            __builtin_amdgcn_fence(__ATOMIC_ACQUIRE, "agent");
            asm volatile("s_waitcnt vmcnt(0)" ::: "memory");
        }
    }
    __syncthreads();
}


struct Params { const float* in[31]; float* out; unsigned char* ws; int ph_lo, ph_hi; };
enum { I_X = 0, I_MEM, I_NMIXG, I_WINMIX, I_MU, I_W0, I_WLORAB, I_A0, I_ALORAB, I_GLORAB, I_KK, I_KA, I_RK, I_LNW, I_LNB, I_POOLW, I_POOLS, I_NMEMG, I_WMEMKV,
       I_WUPR, I_WUPP, I_WUPM, I_WGATE, I_BGATE, I_WO, I_NFFNG, I_WFFNIN, I_CONVW, I_CONVB, I_WFFNOUT, I_NFING };

struct Ctx { int tid, lane, wave, fr, fq, gw, ngw; LAS unsigned char* lds; };

__device__ __forceinline__ int rowmap(int mode, int n) {
    if (mode == 0) return n;
    const int half = n >= FF ? 1 : 0, c = n - half * FF;
    return (c >> 7) * 256 + half * 128 + (c & 127);
}
__device__ __forceinline__ void transpose_item(const float* W, int K, int N, bf16_t* WT, int ldd, int koff, int mode, const float* kscale, LAS float* scr, int item, int lane) {
    const int nblk = N / 32, kb = item / nblk, nb = item % nblk, k0 = 64 * kb, n0 = 32 * nb;
#pragma unroll 8
    for (int i = 0; i < 32; ++i) { const int kk = 2 * i + (lane >> 5); float v = W[(size_t)(k0 + kk) * N + n0 + (lane & 31)]; if (kscale) v *= kscale[k0 + kk]; scr[kk * 33 + (lane & 31)] = v; }
    asm volatile("s_waitcnt lgkmcnt(0)" ::: "memory");
    const int c = lane & 7;
#pragma unroll
    for (int j = 0; j < 4; ++j) { const int n = (lane >> 3) + 8 * j; const LAS float* s = scr + (8 * c) * 33 + n;
        u32x4 o; o.x = pk2(s[0 * 33], s[1 * 33]); o.y = pk2(s[2 * 33], s[3 * 33]); o.z = pk2(s[4 * 33], s[5 * 33]); o.w = pk2(s[6 * 33], s[7 * 33]);
        *(u32x4*)(WT + (size_t)rowmap(mode, n0 + n) * ldd + koff + k0 + 8 * c) = o; }
    asm volatile("s_waitcnt lgkmcnt(0)" ::: "memory");
}
__device__ __forceinline__ void rmsnorm_row_bf16(const float* xrow, const float* g, bf16_t* orow, int lane) {
    const f32x4* xr = (const f32x4*)xrow + lane; const f32x4* gr = (const f32x4*)g + lane;
    f32x4 v[4]; float s = 0.f;
#pragma unroll
    for (int j = 0; j < 4; ++j) { v[j] = xr[64 * j]; s += (v[j][0] * v[j][0] + v[j][1] * v[j][1]) + (v[j][2] * v[j][2] + v[j][3] * v[j][3]); }
    const float rstd = rsqrtf(wave_sum(s) * (1.f / DM) + NORM_EPS);
    u32x2* o = (u32x2*)orow + lane;
#pragma unroll
    for (int j = 0; j < 4; ++j) { const f32x4 gg = gr[64 * j]; o[64 * j] = pk4(v[j] * rstd * gg); }
}

__device__ __forceinline__ void phase_prologue(const Params& p, const Ctx& c) {
    LAS float* scr = (LAS float*)(c.lds + c.wave * 16384);
    unsigned char* ws = p.ws;
#define TR(Wp, K_, N_, WTp, ldd_, koff_, mode_, sc_) { const int ni_ = ((K_) / 64) * ((N_) / 32); if (r < ni_) { transpose_item(Wp, K_, N_, (bf16_t*)(WTp), ldd_, koff_, mode_, sc_, scr, r, c.lane); continue; } r -= ni_; }
    constexpr int NIT = (DM / 64) * (MIXIN / 32) + (DM / 64) * (3 * DM / 32) + (DM / 64) * (512 / 32) + (512 / 64) * (DM / 32) + 2 * (256 / 64) * (DM / 32) + (DM / 64) * (DM / 32)
                      + (DM / 64) * (2 * FF / 32) + (FF / 64) * (DM / 32) + 2 * (RD / 32) + 2 * (RD / 32) + 4 * 2;
    for (int it = c.gw; it < NIT; it += c.ngw) {
        int r = it;
        TR(p.in[I_WINMIX], DM, MIXIN, ws + WS_WG1T, DM, 0, 0, nullptr)
        TR(p.in[I_WGATE], DM, 3 * DM, ws + WS_WG1T + (size_t)MIXIN * DM * 2, DM, 0, 0, nullptr)
        TR(p.in[I_WMEMKV], DM, 512, ws + WS_WKVT, DM, 0, 0, nullptr)
        TR(p.in[I_WUPR], 512, DM, ws + WS_WUPT, DM, 0, 0, nullptr)
        TR(p.in[I_WUPP], 256, DM, ws + WS_WUPT, DM, 512, 0, nullptr)
        TR(p.in[I_WUPM], 256, DM, ws + WS_WUPT, DM, 768, 0, nullptr)
        TR(p.in[I_WO], DM, DM, ws + WS_WOT, DM, 0, 0, nullptr)
        TR(p.in[I_WFFNIN], DM, 2 * FF, ws + WS_WF1T, DM, 0, 1, p.in[I_NFFNG])
        TR(p.in[I_WFFNOUT], FF, DM, ws + WS_WF2T, FF, 0, 0, nullptr)
        TR(p.in[I_WLORAB], 64, RD, ws + WS_WLWT, 64, 0, 0, nullptr)
        TR(p.in[I_ALORAB], 64, RD, ws + WS_WLAT, 64, 0, 0, nullptr)
        TR(p.in[I_GLORAB], 128, RD, ws + WS_WLGT, 128, 0, 0, nullptr)
        TR(p.in[I_POOLW] + 0 * 4096, 64, 64, ws + WS_WPT + 0 * 8192, 64, 0, 0, nullptr)
        TR(p.in[I_POOLW] + 1 * 4096, 64, 64, ws + WS_WPT + 1 * 8192, 64, 0, 0, nullptr)
        TR(p.in[I_POOLW] + 2 * 4096, 64, 64, ws + WS_WPT + 2 * 8192, 64, 0, 0, nullptr)
        TR(p.in[I_POOLW] + 3 * 4096, 64, 64, ws + WS_WPT + 3 * 8192, 64, 0, 0, nullptr)
    }
#undef TR
    for (int m = c.gw; m < MTOK; m += c.ngw) rmsnorm_row_bf16(p.in[I_X] + (size_t)m * DM, p.in[I_NMIXG], (bf16_t*)(ws + WS_H) + (size_t)m * DM, c.lane);
    for (int i = blockIdx.x * NTHREADS + c.tid; i < (2 * 256 * 1024) / 4; i += gridDim.x * NTHREADS) ((float*)(ws + WS_SS2))[i] = 0.f;
    for (int m = c.gw; m < BATCH * NMEM; m += c.ngw) rmsnorm_row_bf16(p.in[I_MEM] + (size_t)m * DM, p.in[I_NMEMG], (bf16_t*)(ws + WS_MEMN) + (size_t)m * DM, c.lane);
}

namespace pg8 {
#define PG8_LAS __attribute__((address_space(3)))
typedef unsigned short bf16_t;
typedef short bf16x8 __attribute__((ext_vector_type(8)));
typedef float f32x4 __attribute__((ext_vector_type(4)));
typedef unsigned u32x4 __attribute__((ext_vector_type(4)));
constexpr int BM = 256, BK = 64, HALF = 128, HTB = HALF * BK * 2  , STAGE_BYTES = 8 * HTB, NXCD = 8, WGM = 8;

__host__ __device__ __forceinline__ int lds_byte(int r, int c) { const int st = (r >> 4) * 2 + (c >> 5), rr = r & 15, cc = c & 31, ob = rr * 64 + cc * 2; return st * 1024 + (ob ^ (((ob >> 9) & 1) << 5)); }
__host__ __device__ __forceinline__ void stage_rc(int b, int& R, int& C) { const int st = b / 1024, sb = b % 1024, swz = sb ^ (((sb >> 9) & 1) << 5); R = (st >> 1) * 16 + swz / 64; C = (st & 1) * 32 + (swz % 64) / 2; }
__host__ __device__ __forceinline__ int perm32(int rho) { const int n = rho >> 4, i = rho & 15; return 8 * (i >> 2) + 4 * n + (i & 3); }

struct Unit { int pm, pn; };
struct Gemm { const bf16_t* A; const bf16_t* Bt; int M, N, K, lda, ldb; };

struct StaticOrder {
    int nM, nN, nwg, G, c;
    __host__ __device__ void init(int M, int N, int G_, int c_) { nM = M / BM; nN = N / BM; nwg = nM * nN; G = G_; c = c_; }
    __host__ __device__ bool next(int i, Unit& u) const {
        const long L = (long)i * G + c; if (L >= nwg) return false;
        int wgid = (int)L; { const int q = nwg / NXCD, r = nwg % NXCD, xcd = wgid % NXCD, off = wgid / NXCD; wgid = (xcd < r ? xcd * (q + 1) : r * (q + 1) + (xcd - r) * q) + off; }
        const int nig = WGM * nN, gid = wgid / nig, fm = gid * WGM, gsz = (nM - fm) < WGM ? (nM - fm) : WGM;
        u.pm = fm + ((wgid % nig) % gsz); u.pn = (wgid % nig) / gsz; return true;
    }
    __device__ __forceinline__ void a_ready(const Unit&) const {}
    __device__ __forceinline__ void done(const Unit&) const {}
};


struct NoHook { __device__ __forceinline__ void operator()(f32x4 (&)[2][2][4][2], const Unit&, int, int, int, int, int) const {} };
template <class Epi, class Sched, bool ALIGN_EPI, bool SP2, class Hook>
__device__ __forceinline__ void gemm_phase_h(PG8_LAS unsigned char* lds, const Gemm g, const Sched& S, const Epi& E, const Hook& H) {
    int tid_ = threadIdx.x; asm volatile("" : "+v"(tid_));
    const int tid = tid_, wid = __builtin_amdgcn_readfirstlane(tid >> 6), lane = tid & 63, wr = wid >> 2, wc = wid & 3, fr = lane & 15, fq = lane >> 4;
    const int K = g.K, nt = K / BK;
    unsigned voffA[2], voffB[2];
#pragma unroll
    for (int i = 0; i < 2; ++i) { int R, C; stage_rc(tid * 16 + i * 8192, R, C); const int Rb = Epi::PERM ? ((R & ~31) + perm32(R & 31)) : R;
        voffA[i] = (unsigned)(R * g.lda + C) * 2u; voffB[i] = (unsigned)(Rb * g.ldb + C) * 2u; }
    const size_t kstep = (size_t)(BK * 2);
    const size_t hstepA = (size_t)HALF * g.lda * 2, hstepB = (size_t)HALF * g.ldb * 2;
    const size_t tstepA = 2 * hstepA, tstepB = 2 * hstepB;
    const unsigned ldsw = (unsigned)wid * 1024u;
    const int aoff = lds_byte(wr * 64 + fr, fq * 8), boff = lds_byte(wc * 32 + fr, fq * 8);
#define PG8_SA(b, h) (((b) * 2 + (h)) * HTB)
#define PG8_SB(b, h) ((4 + (b) * 2 + (h)) * HTB)
#define PG8_STAGE(bufoff, gbase, voff) do { _Pragma("unroll") for (int _i = 0; _i < 2; ++_i) \
        __builtin_amdgcn_global_load_lds((const unsigned*)((const char*)(gbase) + (voff)[_i]), (PG8_LAS unsigned*)(lds + (bufoff) + ldsw + _i * 8192), 16, 0, 0); } while (0)
#define PG8_LDA(dst, b, h) do { _Pragma("unroll") for (int m = 0; m < 4; ++m) _Pragma("unroll") for (int k = 0; k < 2; ++k) dst[m][k] = *(const PG8_LAS bf16x8*)(lds + PG8_SA(b, h) + aoff + m * 2048 + k * 1024); } while (0)
#define PG8_LDB(dst, b, h) do { _Pragma("unroll") for (int n = 0; n < 2; ++n) _Pragma("unroll") for (int k = 0; k < 2; ++k) dst[n][k] = *(const PG8_LAS bf16x8*)(lds + PG8_SB(b, h) + boff + n * 2048 + k * 1024); } while (0)
#define PG8_MMA(ai, bj, At, Bt) do { __builtin_amdgcn_s_setprio(1); _Pragma("unroll") for (int m = 0; m < 4; ++m) _Pragma("unroll") for (int n = 0; n < 2; ++n) _Pragma("unroll") for (int k = 0; k < 2; ++k) \
        acc[ai][bj][m][n] = __builtin_amdgcn_mfma_f32_16x16x32_bf16(Bt[n][k], At[m][k], acc[ai][bj][m][n], 0, 0, 0); __builtin_amdgcn_s_setprio(0); } while (0)
#define PG8_WAIT_V(n) asm volatile("s_waitcnt vmcnt(" #n ")" ::: "memory")
#define PG8_WAIT_L(n) asm volatile("s_waitcnt lgkmcnt(" #n ")" ::: "memory")
#define PG8_BAR __builtin_amdgcn_s_barrier()
#define PG8_SCHED __builtin_amdgcn_sched_barrier(0)
    Unit cur, nxt; int ui = 0;
    if (!S.next(0, cur)) return;
    f32x4 acc[2][2][4][2];
#pragma unroll
    for (int a = 0; a < 2; ++a)
#pragma unroll
        for (int b = 0; b < 2; ++b)
#pragma unroll
            for (int m = 0; m < 4; ++m)
#pragma unroll
                for (int n = 0; n < 2; ++n) acc[a][b][m][n] = (f32x4){0.f, 0.f, 0.f, 0.f};
    bf16x8 At[4][2], B0[2][2], B1[2][2];
    const char* cA = (const char*)g.A + (size_t)cur.pm * tstepA; const char* cB = (const char*)g.Bt + (size_t)cur.pn * tstepB;
    S.a_ready(cur);
    if constexpr (SP2) {
        PG8_STAGE(PG8_SB(0, 0), cB, voffB); PG8_STAGE(PG8_SB(0, 1), cB + hstepB, voffB); PG8_STAGE(PG8_SA(0, 0), cA, voffA); PG8_STAGE(PG8_SA(0, 1), cA + hstepA, voffA);
        if (wr == 1) PG8_BAR;
        PG8_WAIT_V(2); PG8_BAR;
        PG8_STAGE(PG8_SB(1, 0), cB + kstep, voffB); PG8_STAGE(PG8_SA(1, 0), cA + kstep, voffA); PG8_STAGE(PG8_SB(1, 1), cB + hstepB + kstep, voffB);
        PG8_WAIT_V(6); PG8_BAR;
    } else {
        PG8_STAGE(PG8_SB(0, 0), cB, voffB); PG8_STAGE(PG8_SA(0, 0), cA, voffA); PG8_STAGE(PG8_SB(0, 1), cB + hstepB, voffB); PG8_STAGE(PG8_SA(0, 1), cA + hstepA, voffA);
        if (wr == 1) PG8_BAR;
        PG8_WAIT_V(4); PG8_BAR;
        PG8_STAGE(PG8_SB(1, 0), cB + kstep, voffB); PG8_STAGE(PG8_SA(1, 0), cA + kstep, voffA); PG8_STAGE(PG8_SB(1, 1), cB + hstepB + kstep, voffB);
        PG8_WAIT_V(6); PG8_BAR;
    }
    for (;;) {
        const bool has_next = S.next(ui + 1, nxt);
        const char* nA = has_next ? (const char*)g.A + (size_t)nxt.pm * tstepA : cA; const char* nB = has_next ? (const char*)g.Bt + (size_t)nxt.pn * tstepB : cB;
        for (int t = 0; t < nt; t += 2) {
            H(acc, cur, t, wr, wc, fr, fq);
            const bool last = (t == nt - 2);
            const char* a1 = cA + (size_t)(t + 1) * kstep;
            const char* a2 = last ? nA : cA + (size_t)(t + 2) * kstep; const char* b2 = last ? nB : cB + (size_t)(t + 2) * kstep;
            const char* a3 = a2 + kstep; const char* b3 = b2 + kstep;
            if (last && has_next) S.a_ready(nxt);
            if constexpr (SP2) {
            PG8_LDB(B0, 0, 0); PG8_LDB(B1, 0, 1); PG8_SCHED; PG8_LDA(At, 0, 0); PG8_STAGE(PG8_SA(1, 1), a1 + hstepA, voffA);
            PG8_WAIT_V(8); PG8_WAIT_L(0); PG8_BAR; PG8_MMA(0, 0, At, B0); PG8_MMA(0, 1, At, B1); PG8_BAR; PG8_SCHED;
            PG8_LDA(At, 0, 1); PG8_STAGE(PG8_SB(0, 0), b2, voffB); PG8_STAGE(PG8_SB(0, 1), b2 + hstepB, voffB); PG8_STAGE(PG8_SA(0, 0), a2, voffA);
            PG8_WAIT_V(8); PG8_WAIT_L(0); PG8_BAR; PG8_MMA(1, 0, At, B0); PG8_MMA(1, 1, At, B1); PG8_BAR; PG8_SCHED;
            PG8_LDB(B0, 1, 0); PG8_LDB(B1, 1, 1); PG8_SCHED; PG8_LDA(At, 1, 0); PG8_STAGE(PG8_SA(0, 1), a2 + hstepA, voffA);
            PG8_WAIT_V(8); PG8_WAIT_L(0); PG8_BAR; PG8_MMA(0, 0, At, B0); PG8_MMA(0, 1, At, B1); PG8_BAR; PG8_SCHED;
            PG8_LDA(At, 1, 1); PG8_STAGE(PG8_SB(1, 0), b3, voffB); PG8_STAGE(PG8_SB(1, 1), b3 + hstepB, voffB); PG8_STAGE(PG8_SA(1, 0), a3, voffA);
            PG8_WAIT_V(8); PG8_WAIT_L(0); PG8_BAR; PG8_MMA(1, 0, At, B0); PG8_MMA(1, 1, At, B1); PG8_BAR; PG8_SCHED;
            } else {
            PG8_LDB(B0, 0, 0); PG8_SCHED; PG8_LDA(At, 0, 0); PG8_STAGE(PG8_SA(1, 1), a1 + hstepA, voffA);
            PG8_WAIT_L(8); PG8_BAR; PG8_WAIT_L(0); PG8_MMA(0, 0, At, B0); PG8_BAR; PG8_SCHED;
            PG8_LDB(B1, 0, 1); PG8_STAGE(PG8_SB(0, 0), b2, voffB);
            PG8_BAR; PG8_WAIT_L(0); PG8_MMA(0, 1, At, B1); PG8_BAR;
            PG8_LDA(At, 0, 1); PG8_STAGE(PG8_SA(0, 0), a2, voffA);
            PG8_BAR; PG8_WAIT_L(0); PG8_MMA(1, 0, At, B0); PG8_BAR; PG8_SCHED;
            PG8_STAGE(PG8_SB(0, 1), b2 + hstepB, voffB);
            PG8_WAIT_V(6); PG8_BAR; PG8_MMA(1, 1, At, B1); PG8_BAR;
            PG8_LDB(B0, 1, 0); PG8_SCHED; PG8_LDA(At, 1, 0); PG8_STAGE(PG8_SA(0, 1), a2 + hstepA, voffA);
            PG8_WAIT_L(8); PG8_BAR; PG8_WAIT_L(0); PG8_MMA(0, 0, At, B0); PG8_BAR; PG8_SCHED;
            PG8_LDB(B1, 1, 1); PG8_STAGE(PG8_SB(1, 0), b3, voffB);
            PG8_BAR; PG8_WAIT_L(0); PG8_MMA(0, 1, At, B1); PG8_BAR;
            PG8_LDA(At, 1, 1); PG8_STAGE(PG8_SA(1, 0), a3, voffA);
            PG8_BAR; PG8_WAIT_L(0); PG8_MMA(1, 0, At, B0); PG8_BAR; PG8_SCHED;
            PG8_STAGE(PG8_SB(1, 1), b3 + hstepB, voffB);
            PG8_WAIT_V(6); PG8_BAR; PG8_MMA(1, 1, At, B1); PG8_BAR;
            }
        }
        if constexpr (ALIGN_EPI) { if (wr == 0) PG8_BAR; }
        if constexpr (!Epi::AFTER_DRAIN) { E(acc, cur, wr, wc, fr, fq); S.done(cur); }
        if (!has_next) break;
#pragma unroll
        for (int a = 0; a < 2; ++a)
#pragma unroll
            for (int b = 0; b < 2; ++b)
#pragma unroll
                for (int m = 0; m < 4; ++m)
#pragma unroll
                    for (int n = 0; n < 2; ++n) acc[a][b][m][n] = (f32x4){0.f, 0.f, 0.f, 0.f};
        cur = nxt; cA = nA; cB = nB; ++ui;
        if constexpr (ALIGN_EPI) { if (wr == 1) PG8_BAR; }
    }
    PG8_WAIT_V(0);
    if constexpr (!ALIGN_EPI) { if (wr == 0) PG8_BAR; }
    PG8_BAR;
    if constexpr (Epi::AFTER_DRAIN) { E.fused(acc, cur, wr, wc, fr, fq, lds, wid, lane); S.done(cur); }
#undef PG8_SA
#undef PG8_SB
#undef PG8_STAGE
#undef PG8_LDA
#undef PG8_LDB
#undef PG8_MMA
#undef PG8_WAIT_V
#undef PG8_WAIT_L
#undef PG8_BAR
#undef PG8_SCHED
}
template <class Epi, class Sched, bool ALIGN_EPI = false, bool SP2 = false>
__device__ __forceinline__ void gemm_phase(PG8_LAS unsigned char* lds, const Gemm g, const Sched& S, const Epi& E) { gemm_phase_h<Epi, Sched, ALIGN_EPI, SP2, NoHook>(lds, g, S, E, NoHook{}); }
}


template <class F> struct EpiFn4 { static constexpr bool PERM = false, AFTER_DRAIN = false; F f;
    __device__ __forceinline__ void operator()(const f32x4 (&acc)[2][2][4][2], const pg8::Unit& u, int wr, int wc, int fr, int fq) const {
        const int row0 = u.pm * 256 + wr * 64 + fr, col0 = u.pn * 256 + wc * 32 + 4 * fq;
#pragma unroll
        for (int ai = 0; ai < 2; ++ai)
#pragma unroll
            for (int m = 0; m < 4; ++m)
#pragma unroll
                for (int bj = 0; bj < 2; ++bj)
#pragma unroll
                    for (int n = 0; n < 2; ++n) f(row0 + ai * 128 + m * 16, col0 + bj * 128 + n * 16, acc[ai][bj][m][n]);
    } };
template <class F> struct EpiFn8 { static constexpr bool PERM = true, AFTER_DRAIN = false; F f;
    __device__ __forceinline__ void operator()(const f32x4 (&acc)[2][2][4][2], const pg8::Unit& u, int wr, int wc, int fr, int fq) const {
        const int row0 = u.pm * 256 + wr * 64 + fr, col0 = u.pn * 256 + wc * 32 + 8 * fq;
#pragma unroll
        for (int ai = 0; ai < 2; ++ai)
#pragma unroll
            for (int m = 0; m < 4; ++m)
#pragma unroll
                for (int bj = 0; bj < 2; ++bj) f(row0 + ai * 128 + m * 16, col0 + bj * 128, acc[ai][bj][m][0], acc[ai][bj][m][1]);
    } };
template <class F> __device__ __forceinline__ void gemm_pg8_4(const Ctx& c, const bf16_t* A, int lda, const bf16_t* Bt, int ldb, int M, int N, int K, const F& f) {
    pg8::Gemm g{A, Bt, M, N, K, lda, ldb}; pg8::StaticOrder S; S.init(M, N, (int)gridDim.x, (int)blockIdx.x); EpiFn4<F> E{f};
    pg8::gemm_phase<EpiFn4<F>, pg8::StaticOrder, true, true>(c.lds, g, S, E);
}
template <class F> __device__ __forceinline__ void gemm_pg8_8(const Ctx& c, const bf16_t* A, int lda, const bf16_t* Bt, int ldb, int M, int N, int K, const F& f) {
    pg8::Gemm g{A, Bt, M, N, K, lda, ldb}; pg8::StaticOrder S; S.init(M, N, (int)gridDim.x, (int)blockIdx.x); EpiFn8<F> E{f};
    pg8::gemm_phase<EpiFn8<F>, pg8::StaticOrder, true, true>(c.lds, g, S, E);
}
__device__ __forceinline__ u32x4 pk8(f32x4 lo, f32x4 hi) { u32x4 w; w.x = pk2(lo[0], lo[1]); w.y = pk2(lo[2], lo[3]); w.z = pk2(hi[0], hi[1]); w.w = pk2(hi[2], hi[3]); return w; }
struct F8Store { bf16_t* O; int ld; __device__ __forceinline__ void operator()(int row, int col, f32x4 lo, f32x4 hi) const { *(u32x4*)(O + (size_t)row * ld + col) = pk8(lo, hi); } };
struct F8SigBias { bf16_t* O; int ld; const float* bias;
    __device__ __forceinline__ void operator()(int row, int col, f32x4 lo, f32x4 hi) const {
        lo += *(const f32x4*)(bias + col); hi += *(const f32x4*)(bias + col + 4);
#pragma unroll
        for (int j = 0; j < 4; ++j) { lo[j] = sigmoidf_(lo[j]); hi[j] = sigmoidf_(hi[j]); }
        *(u32x4*)(O + (size_t)row * ld + col) = pk8(lo, hi); } };
struct UpHook { const bf16_t* GT;
    __device__ __forceinline__ void operator()(f32x4 (&acc)[2][2][4][2], const pg8::Unit& u, int t, int wr, int wc, int fr, int fq) const {
        if (t != 8 && t != 12) return;
        const int sa = (t == 8) ? 0 : 1;
        const bf16_t* gp0 = GT + (size_t)(u.pm * 256 + wr * 64 + fr) * (3 * DM) + sa * DM + u.pn * 256 + wc * 32 + 8 * fq;
#pragma unroll
        for (int ai = 0; ai < 2; ++ai)
#pragma unroll
            for (int m = 0; m < 4; ++m) { const bf16_t* gp = gp0 + (size_t)(ai * 128 + m * 16) * (3 * DM);
#pragma unroll
                for (int bj = 0; bj < 2; ++bj) { const u32x4 ga = *(const u32x4*)(gp + bj * 128), gb = *(const u32x4*)(gp + DM + bj * 128);
                    const f32x4 a0 = unpk4((u32x2){ga.x, ga.y}), a1 = unpk4((u32x2){ga.z, ga.w}), b0 = unpk4((u32x2){gb.x, gb.y}), b1 = unpk4((u32x2){gb.z, gb.w});
#pragma unroll
                    for (int j = 0; j < 4; ++j) { acc[ai][bj][m][0][j] *= a0[j] * __builtin_amdgcn_rcpf(b0[j]); acc[ai][bj][m][1][j] *= a1[j] * __builtin_amdgcn_rcpf(b1[j]); } }
                asm volatile("" ::: "memory"); }
    } };
struct F8UpFinal { bf16_t* MG; const bf16_t* GT;
    __device__ __forceinline__ void operator()(int row, int col, f32x4 lo, f32x4 hi) const {
        const u32x4 g = *(const u32x4*)(GT + (size_t)row * (3 * DM) + 2 * DM + col);
        *(u32x4*)(MG + (size_t)row * DM + col) = pk8(lo * unpk4((u32x2){g.x, g.y}), hi * unpk4((u32x2){g.z, g.w})); } };

__device__ __forceinline__ f32x2 gelu_pk(f32x2 v) {
    const f32x2 av = __builtin_elementwise_abs(v), d = av * 0.2316418882f + 1.0f;
    f32x2 t; t.x = __builtin_amdgcn_rcpf(d.x); t.y = __builtin_amdgcn_rcpf(d.y);
    f32x2 q = t * 0.5307027145f + (-0.7265760135f); q = q * t + 0.7107068705f; q = q * t + (-0.142248368f); q = q * t + 0.127414796f; q = q * t;
    const f32x2 s = (v * v) * (-0.72134752044f);
    f32x2 e; e.x = __builtin_amdgcn_exp2f(s.x); e.y = __builtin_amdgcn_exp2f(s.y);
    const f32x2 m = v * (q * e), r = v - m;
    f32x2 o; o.x = v.x < 0.f ? m.x : r.x; o.y = v.y < 0.f ? m.y : r.y; return o;
}
struct EpiFfnAct { static constexpr bool PERM = true, AFTER_DRAIN = false;
    bf16_t* ACT; const float* rstd  ; const float* cw; const float* cb; float* TAILU; float* HEADU; float* HEADGV; LAS float* halo;
    __device__ __forceinline__ void operator()(const f32x4 (&acc)[2][2][4][2], const pg8::Unit& u, int wr, int wc, int fr, int fq) const {
        const int ch0 = u.pn * 128 + wc * 32 + 8 * fq, rowt = wr * 64 + fr, grow0 = u.pm * 256 + rowt;
        f32x4 c0[2], c1[2], c2[2], cbv[2];
#pragma unroll
        for (int n = 0; n < 2; ++n) { c0[n] = *(const f32x4*)(cw + ch0 + 4 * n); c1[n] = *(const f32x4*)(cw + FF + ch0 + 4 * n); c2[n] = *(const f32x4*)(cw + 2 * FF + ch0 + 4 * n); cbv[n] = *(const f32x4*)(cb + ch0 + 4 * n); }
#pragma unroll
        for (int ai = 0; ai < 2; ++ai) { const float rs3 = rsqrtf(rstd[grow0 + ai * 128 + 48] * (1.f / DM) + NORM_EPS);
            if (fr >= 14) {
#pragma unroll
                for (int n = 0; n < 2; ++n) *(LAS f32x4*)(halo + (((((ai * 2 + wr) * 2 + (fr - 14)) * 4 + wc) * 4 + fq) * 8 + 4 * n)) = acc[ai][0][3][n] * rs3; } }
        asm volatile("s_waitcnt lgkmcnt(0)" ::: "memory"); __builtin_amdgcn_s_barrier(); asm volatile("" ::: "memory");
#pragma unroll
        for (int ai = 0; ai < 2; ++ai) {
            f32x4 r1p[2], r2p[2];
            if (wr == 1 || ai == 1) { const int src = (wr == 1) ? (ai * 2) : ((ai - 1) * 2 + 1);
#pragma unroll
                for (int n = 0; n < 2; ++n) { const f32x4 hv0 = *(const LAS f32x4*)(halo + ((((src * 2 + 0) * 4 + wc) * 4 + fq) * 8 + 4 * n)), hv1 = *(const LAS f32x4*)(halo + ((((src * 2 + 1) * 4 + wc) * 4 + fq) * 8 + 4 * n));
                    r1p[n] = hv1; r2p[n] = (fr == 0) ? hv0 : hv1; } }
            else { r1p[0] = r1p[1] = r2p[0] = r2p[1] = (f32x4){0.f, 0.f, 0.f, 0.f}; }
#pragma unroll
            for (int m = 0; m < 4; ++m) {
                const int grow = grow0 + ai * 128 + 16 * m; const float rs = rsqrtf(rstd[grow] * (1.f / DM) + NORM_EPS);
                u32x4 w;
#pragma unroll
                for (int n = 0; n < 2; ++n) {
                    const f32x4 uu = acc[ai][0][m][n] * rs, gg = acc[ai][1][m][n] * rs;
                    f32x4 R1, R2;
#pragma unroll
                    for (int j = 0; j < 4; ++j) { R1[j] = dpp_f<0x121>(uu[j]); R2[j] = dpp_f<0x122>(uu[j]); }
                    const f32x4 p1 = (fr >= 1) ? R1 : r1p[n], p2 = (fr >= 2) ? R2 : r2p[n];
                    r1p[n] = R1; r2p[n] = R2;
                    const f32x4 uc = c0[n] * p2 + c1[n] * p1 + c2[n] * uu + cbv[n];
                    const f32x2 ga = gelu_pk((f32x2){uc[0], uc[1]}), gb = gelu_pk((f32x2){uc[2], uc[3]});
                    const unsigned lo = pk2(ga.x * gg[0], ga.y * gg[1]), hi = pk2(gb.x * gg[2], gb.y * gg[3]);
                    if (n == 0) { w.x = lo; w.y = hi; } else { w.z = lo; w.w = hi; }
                    if (ai == 0 && m == 0) { if (wr == 0 && fr < 2) { const size_t so = (size_t)(u.pm * 2 + fr) * FF + ch0 + 4 * n; *(f32x4*)(HEADU + so) = uu; *(f32x4*)(HEADGV + so) = gg; } }
                    if (ai == 1 && m == 3) { if (wr == 1 && fr >= 14) { const size_t so = (size_t)(u.pm * 2 + (fr - 14)) * FF + ch0 + 4 * n; *(f32x4*)(TAILU + so) = uu; } }
                }
                *(u32x4*)(ACT + (size_t)grow * FF + ch0) = w;
            }
        }
    } };
__device__ __forceinline__ void phase_ffn_fix(const Params& p, const Ctx& c) {
    unsigned char* ws = p.ws;
    const float* TAILU = (const float*)(ws + WS_TAILU); const float* HEADU = (const float*)(ws + WS_HEADU); const float* HEADGV = (const float*)(ws + WS_HEADGV); bf16_t* ACT = (bf16_t*)(ws + WS_ACT);
    const float* cw = p.in[I_CONVW]; const float* cb = p.in[I_CONVB];
    const int nit = (MTOK / 256) * 2 * (FF / 4);
    for (int idx = blockIdx.x * NTHREADS + c.tid; idx < nit; idx += gridDim.x * NTHREADS) {
        const int col = 4 * (idx % (FF / 4)), pr = idx / (FF / 4), pm = pr >> 1, rr = pr & 1;
        if ((pm & 15) == 0) continue;
        const f32x4 u0 = *(const f32x4*)(HEADU + (size_t)(pm * 2 + rr) * FF + col), gg = *(const f32x4*)(HEADGV + (size_t)(pm * 2 + rr) * FF + col);
        const f32x4 t1 = *(const f32x4*)(TAILU + (size_t)((pm - 1) * 2 + 1) * FF + col), t0 = *(const f32x4*)(TAILU + (size_t)((pm - 1) * 2 + 0) * FF + col);
        f32x4 u1, u2; if (rr == 0) { u1 = t1; u2 = t0; } else { u1 = *(const f32x4*)(HEADU + (size_t)(pm * 2) * FF + col); u2 = t1; }
        const f32x4 uc = *(const f32x4*)(cw + col) * u2 + *(const f32x4*)(cw + FF + col) * u1 + *(const f32x4*)(cw + 2 * FF + col) * u0 + *(const f32x4*)(cb + col);
        const f32x2 ga = gelu_pk((f32x2){uc[0], uc[1]}), gb = gelu_pk((f32x2){uc[2], uc[3]});
        u32x2 w; w.x = pk2(ga.x * gg[0], ga.y * gg[1]); w.y = pk2(gb.x * gg[2], gb.y * gg[3]);
        *(u32x2*)(ACT + (size_t)(pm * 256 + rr) * FF + col) = w;
    }
}

struct EpiOutB { static constexpr bool PERM = true, AFTER_DRAIN = false; const float* x; bf16_t* x1b; float* SS;
    __device__ __forceinline__ void operator()(const f32x4 (&acc)[2][2][4][2], const pg8::Unit& u, int wr, int wc, int fr, int fq) const {
        const int row0 = u.pm * 256 + wr * 64 + fr, col0 = u.pn * 256 + wc * 32 + 8 * fq;
#pragma unroll
        for (int ai = 0; ai < 2; ++ai)
#pragma unroll
            for (int m = 0; m < 4; ++m) { const int row = row0 + ai * 128 + m * 16; float ss = 0.f;
#pragma unroll
                for (int bj = 0; bj < 2; ++bj) { const size_t off = (size_t)row * DM + col0 + bj * 128;
                    const f32x4 lo = acc[ai][bj][m][0] + *(const f32x4*)(x + off), hi = acc[ai][bj][m][1] + *(const f32x4*)(x + off + 4);
                    ss += (lo[0] * lo[0] + lo[1] * lo[1]) + (lo[2] * lo[2] + lo[3] * lo[3]) + (hi[0] * hi[0] + hi[1] * hi[1]) + (hi[2] * hi[2] + hi[3] * hi[3]);
                    *(u32x4*)(x1b + off) = pk8(lo, hi); }
                ss += __shfl_xor(ss, 16); ss += __shfl_xor(ss, 32);
                if (fq == 0) atomicAdd(SS + row, ss); }
    } };
struct EpiFfnOut { static constexpr bool PERM = false, AFTER_DRAIN = false; const bf16_t* x1b; float* out; float* SS;
    __device__ __forceinline__ void operator()(const f32x4 (&acc)[2][2][4][2], const pg8::Unit& u, int wr, int wc, int fr, int fq) const {
        const int row0 = u.pm * 256 + wr * 64 + fr, col0 = u.pn * 256 + wc * 32 + 4 * fq;
#pragma unroll
        for (int ai = 0; ai < 2; ++ai)
#pragma unroll
            for (int m = 0; m < 4; ++m) { const int row = row0 + ai * 128 + m * 16; float ss = 0.f;
#pragma unroll
                for (int bj = 0; bj < 2; ++bj)
#pragma unroll
                    for (int n = 0; n < 2; ++n) { const size_t off = (size_t)row * DM + col0 + bj * 128 + n * 16;
                        const f32x4 v = acc[ai][bj][m][n] + unpk4(*(const u32x2*)(x1b + off));
                        ss += (v[0] * v[0] + v[1] * v[1]) + (v[2] * v[2] + v[3] * v[3]);
                        *(f32x4*)(out + off) = v; }
                ss += __shfl_xor(ss, 16); ss += __shfl_xor(ss, 32);
                if (fq == 0) atomicAdd(SS + row, ss); }
    } };

template <int KU> __device__ __forceinline__ void wave_gemm_32x64(const bf16_t* A, int lda, const bf16_t* Bt, int ldb, int K, int m0, int n0, int fr, int fq, f32x4 (&acc)[2][4]) {
    const bf16_t* ap = A + (size_t)(m0 + fr) * lda + 8 * fq;
    const bf16_t* bp = Bt + (size_t)(n0 + fr) * ldb + 8 * fq;
    if (KU > 0) {
        constexpr int NK = KU > 0 ? KU / 32 : 1;
        bf16x8 a0[NK], a1[NK], b[NK][4];
#pragma unroll
        for (int ks = 0; ks < NK; ++ks) { a0[ks] = *(const bf16x8*)(ap + 32 * ks); a1[ks] = *(const bf16x8*)(ap + (size_t)16 * lda + 32 * ks);
#pragma unroll
            for (int j = 0; j < 4; ++j) b[ks][j] = *(const bf16x8*)(bp + (size_t)(16 * j) * ldb + 32 * ks); }
#pragma unroll
        for (int ks = 0; ks < NK; ++ks)
#pragma unroll
            for (int j = 0; j < 4; ++j) { acc[0][j] = __builtin_amdgcn_mfma_f32_16x16x32_bf16(b[ks][j], a0[ks], acc[0][j], 0, 0, 0); acc[1][j] = __builtin_amdgcn_mfma_f32_16x16x32_bf16(b[ks][j], a1[ks], acc[1][j], 0, 0, 0); }
        return;
    }
    for (int k0 = 0; k0 < K; k0 += 32) {
        const bf16x8 a0 = *(const bf16x8*)(ap + k0), a1 = *(const bf16x8*)(ap + (size_t)16 * lda + k0);
        bf16x8 b[4];
#pragma unroll
        for (int j = 0; j < 4; ++j) b[j] = *(const bf16x8*)(bp + (size_t)(16 * j) * ldb + k0);
#pragma unroll
        for (int j = 0; j < 4; ++j) { acc[0][j] = __builtin_amdgcn_mfma_f32_16x16x32_bf16(b[j], a0, acc[0][j], 0, 0, 0); acc[1][j] = __builtin_amdgcn_mfma_f32_16x16x32_bf16(b[j], a1, acc[1][j], 0, 0, 0); }
    }
}
template <int KU = 0, class Epi>
__device__ __forceinline__ void gemm_simple(const Ctx& c, const bf16_t* A, int lda, const bf16_t* Bt, int ldb, int M, int N, int K, const Epi& epi) {
    const int nMt = M / 256, nNt = N / 64, ntiles = nMt * nNt;
    for (int tile = blockIdx.x; tile < ntiles; tile += gridDim.x) {
        const int tm = tile % nMt, tn = tile / nMt, m0 = tm * 256 + c.wave * 32, n0 = tn * 64;
        f32x4 acc[2][4];
#pragma unroll
        for (int i = 0; i < 2; ++i)
#pragma unroll
            for (int j = 0; j < 4; ++j) acc[i][j] = (f32x4){0.f, 0.f, 0.f, 0.f};
        wave_gemm_32x64<KU>(A, lda, Bt, ldb, K, m0, n0, c.fr, c.fq, acc);
#pragma unroll
        for (int i = 0; i < 2; ++i)
#pragma unroll
            for (int j = 0; j < 4; ++j) epi(m0 + 16 * i + c.fr, n0 + 16 * j + 4 * c.fq, acc[i][j]);
    }
}

struct EpiBf16 { bf16_t* O; int ld; __device__ __forceinline__ void operator()(int row, int col, f32x4 v) const { *(u32x2*)(O + (size_t)row * ld + col) = pk4(v); } };
struct EpiKV { bf16_t* KB; bf16_t* VT;
    __device__ __forceinline__ void operator()(int row, int col, f32x4 v) const {
        if (col < 256) { *(u32x2*)(KB + (size_t)row * 256 + col) = pk4(v); }
        else { const int cc = col - 256, h = cc >> 6, d = cc & 63, b = row >> 8, key = row & 255;
#pragma unroll
            for (int j = 0; j < 4; ++j) VT[((size_t)((b * 4 + h) * 64 + d + j)) * 256 + key] = (bf16_t)f2bf(v[j]); }
    } };
struct EpiDecay { float* W; const float* w0;
    __device__ __forceinline__ void operator()(int row, int col, f32x4 v) const {
        const f32x4 z = v + *(const f32x4*)(w0 + col); f32x4 o;
#pragma unroll
        for (int j = 0; j < 4; ++j) o[j] = 0.60653065971f * sigmoidf_(z[j]);
        *(f32x4*)(W + (size_t)row * RD + col) = o; } };
struct EpiSigBias { bf16_t* O; int ld; const float* bias;
    __device__ __forceinline__ void operator()(int row, int col, f32x4 v) const {
        const f32x4 z = v + *(const f32x4*)(bias + col); f32x4 o;
#pragma unroll
        for (int j = 0; j < 4; ++j) o[j] = sigmoidf_(z[j]);
        *(u32x2*)(O + (size_t)row * ld + col) = pk4(o); } };
struct EpiPool { bf16_t* Y; const float* scale; int gi;
    __device__ __forceinline__ void operator()(int row, int col, f32x4 v) const {
        const f32x4 s = *(const f32x4*)(scale + 64 * gi + col); *(u32x2*)(Y + (size_t)row * DM + 512 + 64 * gi + col) = pk4(v * s); } };
struct EpiOut { const float* x; float* x1; bf16_t* x1b;
    __device__ __forceinline__ void operator()(int row, int col, f32x4 v) const {
        const size_t off = (size_t)row * DM + col; const f32x4 o = *(const f32x4*)(x + off) + v; *(f32x4*)(x1 + off) = o; *(u32x2*)(x1b + off) = pk4(o); } };
struct EpiAddOut { float* x;
    __device__ __forceinline__ void operator()(int row, int col, f32x4 v) const { const size_t off = (size_t)row * DM + col; *(f32x4*)(x + off) = *(const f32x4*)(x + off) + v; } };

__device__ __forceinline__ void phase_mix(const Params& p, const Ctx& c) {
    unsigned char* ws = p.ws;
    const bf16_t* P = (const bf16_t*)(ws + WS_P); const float* mu = p.in[I_MU];
    bf16_t* R = (bf16_t*)(ws + WS_R); bf16_t* KR = (bf16_t*)(ws + WS_KRAW); bf16_t* V = (bf16_t*)(ws + WS_V);
    bf16_t* LW = (bf16_t*)(ws + WS_LW); bf16_t* LA = (bf16_t*)(ws + WS_LA); bf16_t* LG = (bf16_t*)(ws + WS_LG);
    constexpr int RPW = 16;
    f32x4 m4[7];
#pragma unroll
    for (int i = 0; i < 7; ++i) m4[i] = *(const f32x4*)(mu + 4 * c.lane + 256 * i);
    for (int blk = c.gw; blk < MTOK / RPW; blk += c.ngw) {
        const int row0 = blk * RPW;
        f32x4 pv[7];
#pragma unroll
        for (int i = 0; i < 7; ++i) pv[i] = (row0 & (SEQ - 1)) ? unpk4(*(const u32x2*)(P + (size_t)(row0 - 1) * MIXIN + 4 * c.lane + 256 * i)) : (f32x4){0.f, 0.f, 0.f, 0.f};
#pragma unroll 2
        for (int rr = 0; rr < RPW; ++rr) {
            const int row = row0 + rr; const bf16_t* cur = P + (size_t)row * MIXIN;
            u32x2 cu[7];
#pragma unroll
            for (int i = 0; i < 7; ++i) cu[i] = *(const u32x2*)(cur + 4 * c.lane + 256 * i);
#pragma unroll
            for (int i = 0; i < 7; ++i) {
                const int col = 4 * c.lane + 256 * i;
                const f32x4 cv = unpk4(cu[i]);
                const f32x4 pm = cv + (pv[i] - cv) * m4[i];
                pv[i] = cv;
                if (i < 2) *(u32x2*)(R + (size_t)row * RD + col) = pk4(pm);
                else if (i < 4) *(u32x2*)(KR + (size_t)row * RD + (col - 512)) = pk4(pm);
                else if (i < 6) *(u32x2*)(V + (size_t)row * RD + (col - 1024)) = pk4(pm);
                else {
                    const int cc = col - 1536;
                    if (cc < 64) { f32x4 o; o[0] = tanhf(pm[0]); o[1] = tanhf(pm[1]); o[2] = tanhf(pm[2]); o[3] = tanhf(pm[3]); *(u32x2*)(LW + (size_t)row * 64 + cc) = pk4(o); }
                    else if (cc < 128) { *(u32x2*)(LA + (size_t)row * 64 + (cc - 64)) = pk4(pm); }
                    else { f32x4 o; o[0] = sigmoidf_(pm[0]); o[1] = sigmoidf_(pm[1]); o[2] = sigmoidf_(pm[2]); o[3] = sigmoidf_(pm[3]); *(u32x2*)(LG + (size_t)row * 128 + (cc - 128)) = pk4(o); }
                }
            }
        }
    }
}
__device__ __forceinline__ void phase_pooldiff(const Params& p, const Ctx& c) {
    unsigned char* ws = p.ws;
    const bf16_t* P = (const bf16_t*)(ws + WS_P); bf16_t* DP = (bf16_t*)(ws + WS_DPOOL);
    const int col = 4 * c.lane, gi = c.lane >> 4, win = 2 << gi;
    constexpr int RPW = 16;
    for (int blk = c.gw; blk < MTOK / RPW; blk += c.ngw) {
        const int row0 = blk * RPW, t0 = row0 & (SEQ - 1);
        const bf16_t* base = P + (size_t)row0 * MIXIN + RWKVIN + col;
        f32x4 s = (f32x4){0.f, 0.f, 0.f, 0.f};
#pragma unroll
        for (int j = 1; j < 16; ++j) if (j < win && j <= t0) s += unpk4(*(const u32x2*)(base - (size_t)j * MIXIN));
#pragma unroll 4
        for (int rr = 0; rr < RPW; ++rr) {
            const int t = t0 + rr; const bf16_t* cur = base + (size_t)rr * MIXIN;
            const f32x4 x0 = unpk4(*(const u32x2*)cur);
            f32x4 xo = (f32x4){0.f, 0.f, 0.f, 0.f}; if (t - win + 1 >= 0) xo = unpk4(*(const u32x2*)(cur - (size_t)(win - 1) * MIXIN));
            s += x0;
            const int cnt = (t + 1) < win ? (t + 1) : win;
            *(u32x2*)(DP + (size_t)(row0 + rr) * 256 + col) = pk4(s * (1.0f / (float)cnt) - x0);
            s -= xo;
        }
    }
}
__device__ __forceinline__ void phase_memattn(const Params& p, const Ctx& c) {
    unsigned char* ws = p.ws;
    const bf16_t* P = (const bf16_t*)(ws + WS_P); const bf16_t* KB = (const bf16_t*)(ws + WS_KB); const bf16_t* VT = (const bf16_t*)(ws + WS_VT); bf16_t* Y = (bf16_t*)(ws + WS_YCAT);
    constexpr int KS = 72, VS = 264;
    LAS bf16_t* LK = (LAS bf16_t*)c.lds; LAS bf16_t* LV = (LAS bf16_t*)(c.lds + 256 * KS * 2);
    const int fr = c.fr, fq = c.fq, tid = c.tid;
    for (int grp = blockIdx.x; grp < BATCH * 4 * 8; grp += gridDim.x) {
        const int pp = grp & 7, h = (grp >> 3) & 3, b = grp >> 5;
        __syncthreads();
        { const int row = tid >> 1, hf = tid & 1; const u32x4* src = (const u32x4*)(KB + (size_t)(b * 256 + row) * 256 + h * 64 + 32 * hf);
#pragma unroll
          for (int i = 0; i < 4; ++i) *(LAS u32x4*)(LK + row * KS + 32 * hf + 8 * i) = src[i];
          const int d = tid >> 3, sg = tid & 7; const u32x4* sv = (const u32x4*)(VT + ((size_t)((b * 4 + h) * 64 + d)) * 256 + 32 * sg);
#pragma unroll
          for (int i = 0; i < 4; ++i) *(LAS u32x4*)(LV + d * VS + 32 * sg + 8 * i) = sv[i]; }
        __syncthreads();
#pragma unroll 1
        for (int it = 0; it < 4; ++it) {
            const int qt = 2 * pp + (it >> 1), qg = it & 1;
            const int row = b * SEQ + qt * 256 + c.wave * 32 + 16 * qg + fr;
            const bf16x8 q0 = *(const bf16x8*)(P + (size_t)row * MIXIN + 2048 + h * 64 + 8 * fq), q1 = *(const bf16x8*)(P + (size_t)row * MIXIN + 2048 + h * 64 + 32 + 8 * fq);
            f32x4 sc[16];
#pragma unroll
            for (int kg = 0; kg < 16; ++kg) {
                const LAS bf16_t* kp = LK + (16 * kg + fr) * KS + 8 * fq;
                f32x4 a = (f32x4){0.f, 0.f, 0.f, 0.f};
                a = __builtin_amdgcn_mfma_f32_16x16x32_bf16(*(const LAS bf16x8*)kp, q0, a, 0, 0, 0); a = __builtin_amdgcn_mfma_f32_16x16x32_bf16(*(const LAS bf16x8*)(kp + 32), q1, a, 0, 0, 0); sc[kg] = a;
                if ((kg & 3) == 3) asm volatile("" ::: "memory");
            }
            float m = -1e30f;
#pragma unroll
            for (int kg = 0; kg < 16; ++kg) m = fmaxf(m, fmaxf(fmaxf(sc[kg][0], sc[kg][1]), fmaxf(sc[kg][2], sc[kg][3])));
            m = fmaxf(m, __shfl_xor(m, 16)); m = fmaxf(m, __shfl_xor(m, 32));
            float l = 0.f;
#pragma unroll
            for (int kg = 0; kg < 16; ++kg)
#pragma unroll
                for (int j = 0; j < 4; ++j) { const float e = __expf((sc[kg][j] - m) * 0.125f); sc[kg][j] = e; l += e; }
            l += __shfl_xor(l, 16); l += __shfl_xor(l, 32);
            const float linv = 1.0f / l;
            f32x4 o[4];
#pragma unroll
            for (int dg = 0; dg < 4; ++dg) o[dg] = (f32x4){0.f, 0.f, 0.f, 0.f};
#pragma unroll
            for (int s2 = 0; s2 < 8; ++s2) {
                u32x4 w; w.x = pk2(sc[2 * s2][0], sc[2 * s2][1]); w.y = pk2(sc[2 * s2][2], sc[2 * s2][3]); w.z = pk2(sc[2 * s2 + 1][0], sc[2 * s2 + 1][1]); w.w = pk2(sc[2 * s2 + 1][2], sc[2 * s2 + 1][3]);
                const bf16x8 pf = __builtin_bit_cast(bf16x8, w);
#pragma unroll
                for (int dg = 0; dg < 4; ++dg) {
                    const LAS bf16_t* vp = LV + (16 * dg + fr) * VS + 32 * s2 + 4 * fq;
                    u32x4 v; const u32x2 lo = *(const LAS u32x2*)vp, hi = *(const LAS u32x2*)(vp + 16); v.x = lo.x; v.y = lo.y; v.z = hi.x; v.w = hi.y;
                    o[dg] = __builtin_amdgcn_mfma_f32_16x16x32_bf16(__builtin_bit_cast(bf16x8, v), pf, o[dg], 0, 0, 0);
                }
                if (s2 & 1) asm volatile("" ::: "memory");
            }
#pragma unroll
            for (int dg = 0; dg < 4; ++dg) *(u32x2*)(Y + (size_t)row * DM + 768 + h * 64 + 16 * dg + 4 * fq) = pk4(o[dg] * linv);
        }
    }
}

#define MF16(a, b, c) __builtin_amdgcn_mfma_f32_16x16x32_bf16((a), (b), (c), 0, 0, 0)
__device__ __forceinline__ bf16x8 pack4z(f32x4 x) { u32x4 w; w.x = pk2(x[0], x[1]); w.y = pk2(x[2], x[3]); w.z = 0u; w.w = 0u; return __builtin_bit_cast(bf16x8, w); }
__device__ __forceinline__ bf16x8 frag4z(const LAS bf16_t* p) { const u32x2 v = *(const LAS u32x2*)p; u32x4 w; w.x = v.x; w.y = v.y; w.z = 0u; w.w = 0u; return __builtin_bit_cast(bf16x8, w); }
__device__ __forceinline__ bf16x8 raw4z(u32x2 v) { u32x4 w; w.x = v.x; w.y = v.y; w.z = 0u; w.w = 0u; return __builtin_bit_cast(bf16x8, w); }
__device__ __forceinline__ float sum8(float x) { x += dpp_f<0xB1>(x); x += dpp_f<0x4E>(x); x += dpp_f<0x141>(x); return x; }
constexpr int CH = 64, NCHUNK = SEQ / CH, NTASK = BATCH * 8 * NCHUNK;
constexpr int RS = 72;
constexpr int S1_QK = 0, S1_QR = 9216, S1_QB = 18432, S1_QKH = 27648, S1_BTN = 36864, S1_KHT = 46080, S1_VT = 55296;
constexpr int S1_AAB = 64512, S1_AAK = 73728, S1_ARB = 82944, S1_ARK = 92160, S1_EC = 101376, S1_DG = 117760, S1_DI = 121856, S1_GC = 124928, S1_SEG = 125184;
constexpr int DIS = 24;
template <int STOP> __device__ __forceinline__ void phase_s1(const Params& p, const Ctx& c) {
    unsigned char* ws = p.ws;
    const bf16_t* R = (const bf16_t*)(ws + WS_R); const bf16_t* KR = (const bf16_t*)(ws + WS_KRAW); const bf16_t* V = (const bf16_t*)(ws + WS_V); const bf16_t* AA = (const bf16_t*)(ws + WS_AA);
    const float* EW = (const float*)(ws + WS_W); float* BON = (float*)(ws + WS_BONUS);
    u32x2* RTT = (u32x2*)((unsigned char*)p.out + DO_RTT); u32x2* MTT = (u32x2*)((unsigned char*)p.out + DO_MTT); u32x2* Y0D = (u32x2*)((unsigned char*)p.out + DO_Y0D); u32x2* ND = (u32x2*)((unsigned char*)p.out + DO_ND);
    LAS unsigned char* L = c.lds;
    LAS bf16_t* QK = (LAS bf16_t*)(L + S1_QK); LAS bf16_t* QR = (LAS bf16_t*)(L + S1_QR); LAS bf16_t* QB = (LAS bf16_t*)(L + S1_QB); LAS bf16_t* QKH = (LAS bf16_t*)(L + S1_QKH);
    LAS bf16_t* BTN = (LAS bf16_t*)(L + S1_BTN); LAS bf16_t* KHT = (LAS bf16_t*)(L + S1_KHT); LAS bf16_t* VT = (LAS bf16_t*)(L + S1_VT);
    LAS bf16_t* AAB = (LAS bf16_t*)(L + S1_AAB); LAS bf16_t* AAK = (LAS bf16_t*)(L + S1_AAK); LAS bf16_t* ARB = (LAS bf16_t*)(L + S1_ARB); LAS bf16_t* ARK = (LAS bf16_t*)(L + S1_ARK);
    LAS float* EC = (LAS float*)(L + S1_EC); LAS float* DG = (LAS float*)(L + S1_DG); LAS bf16_t* DI = (LAS bf16_t*)(L + S1_DI); LAS float* GC = (LAS float*)(L + S1_GC); LAS float* SEG = (LAS float*)(L + S1_SEG);
    const int tid = c.tid, fr = c.fr, fq = c.fq, wave = c.wave, lane = c.lane;
    const int st = tid >> 3, cg = tid & 7;
    auto task_off = [&](int task) -> size_t { const int bh = task >> 6, ch = task & 63; return ((size_t)(bh >> 3) * SEQ + ch * CH + st) * RD + (bh & 7) * 64 + 8 * cg; };
    u32x4 ur, uk, uv, ua; f32x4 e0, e1;
    if ((int)blockIdx.x < NTASK) { const size_t o = task_off(blockIdx.x); ur = *(const u32x4*)(R + o); uk = *(const u32x4*)(KR + o); uv = *(const u32x4*)(V + o); ua = *(const u32x4*)(AA + o); e0 = *(const f32x4*)(EW + o); e1 = *(const f32x4*)(EW + o + 4); }
    for (int task = blockIdx.x; task < NTASK; task += gridDim.x) {
        const int bh = task >> 6, ch = task & 63, b = bh >> 3, h = bh & 7;
        const size_t grow = (size_t)b * SEQ + ch * CH + st;
        __syncthreads();
        float r8[8], k8[8], v8[8], a8[8], e8[8];
        { const unsigned wr_[4] = {ur.x, ur.y, ur.z, ur.w}, wk_[4] = {uk.x, uk.y, uk.z, uk.w}, wv_[4] = {uv.x, uv.y, uv.z, uv.w}, wa_[4] = {ua.x, ua.y, ua.z, ua.w};
#pragma unroll
          for (int i = 0; i < 4; ++i) { r8[2 * i] = bf2f(wr_[i] & 0xffffu); r8[2 * i + 1] = bf2f(wr_[i] >> 16); k8[2 * i] = bf2f(wk_[i] & 0xffffu); k8[2 * i + 1] = bf2f(wk_[i] >> 16);
              v8[2 * i] = bf2f(wv_[i] & 0xffffu); v8[2 * i + 1] = bf2f(wv_[i] >> 16); a8[2 * i] = bf2f(wa_[i] & 0xffffu); a8[2 * i + 1] = bf2f(wa_[i] >> 16); e8[i] = e0[i]; e8[4 + i] = e1[i]; } }
        if (task + (int)gridDim.x < NTASK) { const size_t o = task_off(task + gridDim.x); ur = *(const u32x4*)(R + o); uk = *(const u32x4*)(KR + o); uv = *(const u32x4*)(V + o); ua = *(const u32x4*)(AA + o); e0 = *(const f32x4*)(EW + o); e1 = *(const f32x4*)(EW + o + 4); }
        float kap8[8], bb8[8], kf8[8]; float nrm = 0.f, bon = 0.f;
#pragma unroll
        for (int i = 0; i < 8; ++i) { const int col = h * 64 + 8 * cg + i; const float kkv = k8[i] * p.in[I_KK][col]; kap8[i] = kkv; nrm += kkv * kkv;
            kf8[i] = k8[i] * (1.0f + (a8[i] - 1.0f) * p.in[I_KA][col]); bon += r8[i] * kf8[i] * p.in[I_RK][col]; }
        nrm = sum8(nrm); bon = sum8(bon);
        const float rn = rsqrtf(nrm + 1e-12f);
#pragma unroll
        for (int i = 0; i < 8; ++i) { kap8[i] *= rn; bb8[i] = kap8[i] * a8[i]; }
        if (cg == 0) BON[grow * 8 + h] = bon;
        *(LAS f32x4*)(EC + st * 64 + 8 * cg) = (f32x4){e8[0], e8[1], e8[2], e8[3]}; *(LAS f32x4*)(EC + st * 64 + 8 * cg + 4) = (f32x4){e8[4], e8[5], e8[6], e8[7]};
        __syncthreads();
        { const int cc = tid & 63, sg = tid >> 6; float run = 0.f;
#pragma unroll
          for (int i = 0; i < 8; ++i) { run += EC[(8 * sg + i) * 64 + cc]; EC[(8 * sg + i) * 64 + cc] = run; }
          SEG[sg * 64 + cc] = run;
          __syncthreads();
          float off = 0.f;
#pragma unroll
          for (int s2 = 0; s2 < 7; ++s2) off += (s2 < sg) ? SEG[s2 * 64 + cc] : 0.f;
#pragma unroll
          for (int i = 0; i < 8; ++i) EC[(8 * sg + i) * 64 + cc] += off;
          if (sg == 7) GC[cc] = __expf(-(run + off)); }
        __syncthreads();
        { float cum[8]; const f32x4 c0 = *(const LAS f32x4*)(EC + st * 64 + 8 * cg), c1 = *(const LAS f32x4*)(EC + st * 64 + 8 * cg + 4);
#pragma unroll
          for (int i = 0; i < 4; ++i) { cum[i] = c0[i]; cum[4 + i] = c1[i]; }
          float kh[8], rh[8], bh8[8], kk8[8];
#pragma unroll
          for (int i = 0; i < 8; ++i) { const float gi = __expf(cum[i]); kh[i] = kap8[i] * __expf(e8[i] - cum[i]); rh[i] = r8[i] * __expf(-cum[i]); bh8[i] = bb8[i] * gi; kk8[i] = kf8[i] * gi; }
          u32x4 w;
          w.x = pk2(kh[0], kh[1]); w.y = pk2(kh[2], kh[3]); w.z = pk2(kh[4], kh[5]); w.w = pk2(kh[6], kh[7]); *(LAS u32x4*)(QK + st * RS + 8 * cg) = w;
          w.x = pk2(rh[0], rh[1]); w.y = pk2(rh[2], rh[3]); w.z = pk2(rh[4], rh[5]); w.w = pk2(rh[6], rh[7]); *(LAS u32x4*)(QR + st * RS + 8 * cg) = w;
          w.x = pk2(bh8[0], bh8[1]); w.y = pk2(bh8[2], bh8[3]); w.z = pk2(bh8[4], bh8[5]); w.w = pk2(bh8[6], bh8[7]); *(LAS u32x4*)(QB + st * RS + 8 * cg) = w;
          w.x = pk2(kk8[0], kk8[1]); w.y = pk2(kk8[2], kk8[3]); w.z = pk2(kk8[4], kk8[5]); w.w = pk2(kk8[6], kk8[7]); *(LAS u32x4*)(QKH + st * RS + 8 * cg) = w;
#pragma unroll
          for (int i = 0; i < 8; ++i) { const int o = (8 * cg + i) * RS + ((st + 8 * cg) & 63);
              BTN[o] = (bf16_t)f2bf(-bh8[i]); KHT[o] = (bf16_t)f2bf(kk8[i]); VT[o] = (bf16_t)f2bf(v8[i]); } }
        __syncthreads();
        if (STOP == 1) continue;
        { const int mat = wave >> 1; const LAS bf16_t* Am = (mat < 2) ? QK : QR; const LAS bf16_t* Bm = (mat & 1) ? QKH : QB; LAS bf16_t* Om = (mat == 0) ? AAB : (mat == 1) ? AAK : (mat == 2) ? ARB : ARK;
          const bool strict = mat < 2; const float sgn = (mat & 1) ? 1.0f : -1.0f;
#pragma unroll
          for (int jj = 0; jj < 2; ++jj) { const int j = 2 * (wave & 1) + jj;
              const bf16x8 bt0 = *(const LAS bf16x8*)(Am + (16 * j + fr) * RS + 8 * fq), bt1 = *(const LAS bf16x8*)(Am + (16 * j + fr) * RS + 32 + 8 * fq);
#pragma unroll
              for (int l = 0; l < 4; ++l) {
                  f32x4 d = (f32x4){0.f, 0.f, 0.f, 0.f};
                  d = MF16(*(const LAS bf16x8*)(Bm + (16 * l + fr) * RS + 8 * fq), bt0, d); d = MF16(*(const LAS bf16x8*)(Bm + (16 * l + fr) * RS + 32 + 8 * fq), bt1, d);
                  const int t = 16 * j + fr, i0 = 16 * l + 4 * fq;
#pragma unroll
                  for (int rg = 0; rg < 4; ++rg) { const bool keep = strict ? (i0 + rg < t) : (i0 + rg <= t); d[rg] = keep ? d[rg] : 0.f; }
                  if (mat == 0 && l == j) *(LAS f32x4*)(DG + (j * 16 + fr) * 16 + 4 * fq) = d;
                  *(LAS u32x2*)(Om + t * RS + i0) = pk4(d * sgn);
              } } }
        __syncthreads();
        if (STOP == 2) continue;
        f32x4 Z[4], Z1[4], Ee[4];
        if (wave == 0) {
            const int j = lane >> 4, col = lane & 15; float x[16];
#pragma unroll
            for (int t = 0; t < 16; ++t) x[t] = (t == col) ? 1.0f : 0.0f;
#pragma unroll
            for (int i = 0; i < 15; ++i) {
#pragma unroll
                for (int t = i + 1; t < 16; ++t) x[t] -= DG[(j * 16 + t) * 16 + i] * x[i]; }
#pragma unroll
            for (int t = 0; t < 16; ++t) DI[(j * 16 + t) * DIS + col] = (bf16_t)f2bf(x[t]);
        }
        if (wave >= 4) { const int vb = wave - 4;
#pragma unroll
            for (int j = 0; j < 4; ++j) { Z[j] = Z1[j] = Ee[j] = (f32x4){0.f, 0.f, 0.f, 0.f};
#pragma unroll
                for (int s2 = 0; s2 < 2; ++s2) { const bf16x8 bv = *(const LAS bf16x8*)(VT + (16 * vb + fr) * RS + ((32 * s2 + 8 * fq + 8 * (2 * vb + (fr >> 3))) & 63));
                    Z[j] = MF16(*(const LAS bf16x8*)(AAK + (16 * j + fr) * RS + 32 * s2 + 8 * fq), bv, Z[j]);
                    Z1[j] = MF16(*(const LAS bf16x8*)(ARK + (16 * j + fr) * RS + 32 * s2 + 8 * fq), bv, Z1[j]);
                    Ee[j] = MF16(*(const LAS bf16x8*)(KHT + (16 * j + fr) * RS + ((32 * s2 + 8 * fq + 8 * (2 * j + (fr >> 3))) & 63)), bv, Ee[j]); } } }
        else {
#pragma unroll
            for (int j = 0; j < 4; ++j)
#pragma unroll
                for (int rg = 0; rg < 4; ++rg) Z[j][rg] = bf2f(QK[(16 * j + 4 * fq + rg) * RS + 16 * wave + fr]); }
        __syncthreads();
        if (STOP == 3) { asm volatile("" :: "v"(Z[0]), "v"(Z[1]), "v"(Z[2]), "v"(Z[3])); if (wave >= 4) asm volatile("" :: "v"(Z1[0]), "v"(Z1[3]), "v"(Ee[0]), "v"(Ee[3])); continue; }
        f32x4 X[4];
#pragma unroll
        for (int j = 0; j < 4; ++j) { f32x4 acc = Z[j];
#pragma unroll
            for (int l = 0; l < 4; ++l) if (l < j) acc = MF16(frag4z(AAB + (16 * j + fr) * RS + 16 * l + 4 * fq), pack4z(X[l]), acc);
            X[j] = MF16(frag4z(DI + (j * 16 + fr) * DIS + 4 * fq), pack4z(acc), ((f32x4){0.f, 0.f, 0.f, 0.f})); }
        const size_t dbase = ((size_t)task * 4 + (wave & 3)) * 4 * 64 + lane;
        if (wave >= 4) {
#pragma unroll
            for (int j = 0; j < 4; ++j) { f32x4 y0 = Z1[j];
#pragma unroll
                for (int l = 0; l < 4; ++l) if (l <= j) y0 = MF16(frag4z(ARB + (16 * j + fr) * RS + 16 * l + 4 * fq), pack4z(X[l]), y0);
                Y0D[dbase + j * 64] = pk4(y0);
                f32x4 nn = Ee[j];
#pragma unroll
                for (int l = 0; l < 4; ++l) nn = MF16(frag4z(BTN + (16 * j + fr) * RS + ((16 * l + 4 * fq + 8 * (2 * j + (fr >> 3))) & 63)), pack4z(X[l]), nn);
#pragma unroll
                for (int rg = 0; rg < 4; ++rg) nn[rg] *= GC[16 * j + 4 * fq + rg];
                ND[dbase + j * 64] = pk4(nn); } }
        else {
#pragma unroll
            for (int j = 0; j < 4; ++j) { f32x4 rt = unpk4(*(const LAS u32x2*)(QR + (16 * j + fr) * RS + 16 * wave + 4 * fq));
#pragma unroll
                for (int l = 0; l < 4; ++l) if (l <= j) rt = MF16(pack4z(X[l]), frag4z(ARB + (16 * j + fr) * RS + 16 * l + 4 * fq), rt);
                RTT[dbase + j * 64] = pk4(rt);
                f32x4 mt;
#pragma unroll
                for (int rg = 0; rg < 4; ++rg) mt[rg] = (16 * wave + 4 * fq + rg == 16 * j + fr) ? 1.0f : 0.0f;
#pragma unroll
                for (int l = 0; l < 4; ++l) mt = MF16(pack4z(X[l]), frag4z(BTN + (16 * j + fr) * RS + ((16 * l + 4 * fq + 8 * (2 * j + (fr >> 3))) & 63)), mt);
                MTT[dbase + j * 64] = pk4(mt * GC[16 * j + fr]); } }
    }
}
__device__ __forceinline__ void phase_s2(const Params& p, const Ctx& c) {
    if (c.wave != 0) return;
    const u32x2* MTT = (const u32x2*)((unsigned char*)p.out + DO_MTT); const u32x2* ND = (const u32x2*)((unsigned char*)p.out + DO_ND); u32x2* SP = (u32x2*)(p.ws + WS_SP);
    const int lane = c.lane;
    for (int unit = blockIdx.x; unit < BATCH * 8 * 4; unit += gridDim.x) {
        const int vb = unit & 3, bh = unit >> 2;
        f32x4 S[4];
#pragma unroll
        for (int j = 0; j < 4; ++j) S[j] = (f32x4){0.f, 0.f, 0.f, 0.f};
        u32x2 m0[4][4], n0[4], m1[4][4], n1[4], m2[4][4], n2[4];
#define S2_LOAD(mm, nn, tk) do { const size_t t_ = (tk); _Pragma("unroll") for (int l = 0; l < 4; ++l) _Pragma("unroll") for (int j = 0; j < 4; ++j) mm[l][j] = MTT[((t_ * 4 + l) * 4 + j) * 64 + lane]; \
        _Pragma("unroll") for (int j = 0; j < 4; ++j) nn[j] = ND[((t_ * 4 + vb) * 4 + j) * 64 + lane]; } while (0)
#define S2_STEP(mm, nn, tk) do { const size_t t_ = (tk); bf16x8 sp[4]; _Pragma("unroll") for (int l = 0; l < 4; ++l) { const u32x2 w = pk4(S[l]); SP[((t_ * 4 + vb) * 4 + l) * 64 + lane] = w; sp[l] = raw4z(w); } \
        _Pragma("unroll") for (int j = 0; j < 4; ++j) { f32x4 acc = unpk4(nn[j]); _Pragma("unroll") for (int l = 0; l < 4; ++l) acc = MF16(raw4z(mm[l][j]), sp[l], acc); S[j] = acc; } } while (0)
        const size_t t0 = (size_t)bh * NCHUNK, tl = t0 + NCHUNK - 1;
        S2_LOAD(m0, n0, t0); S2_LOAD(m1, n1, t0 + 1);
        for (int ch = 0; ch < NCHUNK; ch += 3) {
            const size_t tk = t0 + ch;
            S2_LOAD(m2, n2, tk + 2 < tl ? tk + 2 : tl); S2_STEP(m0, n0, tk);
            if (ch + 1 < NCHUNK) { S2_LOAD(m0, n0, tk + 3 < tl ? tk + 3 : tl); S2_STEP(m1, n1, tk + 1); }
            if (ch + 2 < NCHUNK) { S2_LOAD(m1, n1, tk + 4 < tl ? tk + 4 : tl); S2_STEP(m2, n2, tk + 2); }
        }
#undef S2_LOAD
#undef S2_STEP
    }
}
__device__ __forceinline__ void phase_s3(const Params& p, const Ctx& c) {
    unsigned char* ws = p.ws;
    const u32x2* RTT = (const u32x2*)((unsigned char*)p.out + DO_RTT); const u32x2* Y0D = (const u32x2*)((unsigned char*)p.out + DO_Y0D); const u32x2* SP = (const u32x2*)(ws + WS_SP);
    const float* BON = (const float*)(ws + WS_BONUS); const bf16_t* V = (const bf16_t*)(ws + WS_V); const bf16_t* G = (const bf16_t*)(ws + WS_G); bf16_t* Y = (bf16_t*)(ws + WS_YCAT);
    const int lane = c.lane, fr = c.fr, fq = c.fq;
    for (int it = c.gw; it < NTASK * 4; it += c.ngw) {
        const size_t task = (size_t)(it >> 2); const int j = it & 3, bh = (int)(task >> 6), ch = (int)(task & 63), b = bh >> 3, h = bh & 7;
        bf16x8 rt[4];
#pragma unroll
        for (int l = 0; l < 4; ++l) rt[l] = raw4z(RTT[((task * 4 + l) * 4 + j) * 64 + lane]);
        f32x4 acc[4];
#pragma unroll
        for (int vb = 0; vb < 4; ++vb) { acc[vb] = unpk4(Y0D[((task * 4 + vb) * 4 + j) * 64 + lane]);
#pragma unroll
            for (int l = 0; l < 4; ++l) acc[vb] = MF16(rt[l], raw4z(SP[((task * 4 + vb) * 4 + l) * 64 + lane]), acc[vb]); }
#pragma unroll
        for (int rg = 0; rg < 4; ++rg) {
            const size_t row = (size_t)b * SEQ + ch * CH + 16 * j + 4 * fq + rg;
            const float mean = row_sum16((acc[0][rg] + acc[1][rg]) + (acc[2][rg] + acc[3][rg])) * (1.0f / 64.0f);
            float d[4], q = 0.f;
#pragma unroll
            for (int vb = 0; vb < 4; ++vb) { d[vb] = acc[vb][rg] - mean; q += d[vb] * d[vb]; }
            const float rstd = rsqrtf(row_sum16(q) * (1.0f / 64.0f) + GN_EPS), bon = BON[row * 8 + h];
#pragma unroll
            for (int vb = 0; vb < 4; ++vb) { const int col = h * 64 + 16 * vb + fr;
                const float yn = d[vb] * rstd * p.in[I_LNW][col] + p.in[I_LNB][col];
                Y[row * DM + col] = (bf16_t)f2bf((yn + bon * bf2f(V[row * RD + col])) * bf2f(G[row * RD + col])); }
        }
    }
}

__device__ __forceinline__ void phase_final_norm(const Params& p, const Ctx& c) {
    const float* g = p.in[I_NFING]; const float* SS = (const float*)(p.ws + WS_SS3);
    const f32x4 g0 = *((const f32x4*)g + c.lane), g1 = *((const f32x4*)g + c.lane + 64), g2 = *((const f32x4*)g + c.lane + 128), g3 = *((const f32x4*)g + c.lane + 192);
#pragma unroll 4
    for (int m = c.gw; m < MTOK; m += c.ngw) {
        f32x4* xr = (f32x4*)(p.out + (size_t)m * DM) + c.lane;
        const float rstd = rsqrtf(SS[m] * (1.f / DM) + NORM_EPS);
        const f32x4 v0 = xr[0], v1 = xr[64], v2 = xr[128], v3 = xr[192];
        xr[0] = v0 * rstd * g0; xr[64] = v1 * rstd * g1; xr[128] = v2 * rstd * g2; xr[192] = v3 * rstd * g3;
    }
}

constexpr int NPHASES = 14;
__global__ void __launch_bounds__(NTHREADS, 2) fwd_kernel(Params p) {
    extern __shared__ __attribute__((aligned(16))) unsigned char lds_raw[];
    Ctx c; c.tid = threadIdx.x; c.lane = c.tid & 63; c.wave = __builtin_amdgcn_readfirstlane(c.tid >> 6); c.fr = c.lane & 15; c.fq = c.lane >> 4;
    c.gw = blockIdx.x * NWAVES + c.wave; c.ngw = gridDim.x * NWAVES; c.lds = (LAS unsigned char*)lds_raw;
    unsigned char* ws = p.ws;
#if ONE_LAUNCH
    cg::grid_group grid = cg::this_grid();
    volatile LAS unsigned* misc = (volatile LAS unsigned*)(c.lds + LDS_MISC_OFF);
    if (c.tid < 4) misc[c.tid] = 0u;
    __syncthreads();
    const XcdBarrier xbar = xcd_barrier_post((unsigned*)(ws + WS_BAR), misc);
    bool first_seam = true;
#define SEAM() do { if (first_seam) { grid.sync(); first_seam = false; } else xcd_barrier(xbar); } while (0)
#else
#define SEAM() do {} while (0)
#endif
#define IN(k) (p.ph_lo <= (k) && (k) < p.ph_hi)
#define END(k) do { if (IN((k) + 1)) SEAM(); } while (0)
#define REP_ON(k) ((REP_MASK >> (k)) & 1u)
#define PHASE(k, ...) if (IN(k)) { __VA_ARGS__ if (REP_ON(k)) { SEAM(); __VA_ARGS__ } END(k); }
    PHASE(0, phase_prologue(p, c);)
    PHASE(1,
        gemm_pg8_8(c, (const bf16_t*)(ws + WS_H), DM, (const bf16_t*)(ws + WS_WG1T), DM, MTOK, MIXIN, DM, F8Store{(bf16_t*)(ws + WS_P), MIXIN});
        gemm_simple(c, (const bf16_t*)(ws + WS_MEMN), DM, (const bf16_t*)(ws + WS_WKVT), DM, BATCH * NMEM, 512, DM, EpiKV{(bf16_t*)(ws + WS_KB), (bf16_t*)(ws + WS_VT)});)
    PHASE(2, phase_mix(p, c); phase_pooldiff(p, c); phase_memattn(p, c);)
    PHASE(3,
        gemm_simple<64>(c, (const bf16_t*)(ws + WS_LW), 64, (const bf16_t*)(ws + WS_WLWT), 64, MTOK, RD, 64, EpiDecay{(float*)(ws + WS_W), p.in[I_W0]});
        gemm_simple<64>(c, (const bf16_t*)(ws + WS_LA), 64, (const bf16_t*)(ws + WS_WLAT), 64, MTOK, RD, 64, EpiSigBias{(bf16_t*)(ws + WS_AA), RD, p.in[I_A0]});
        gemm_simple<128>(c, (const bf16_t*)(ws + WS_LG), 128, (const bf16_t*)(ws + WS_WLGT), 128, MTOK, RD, 128, EpiBf16{(bf16_t*)(ws + WS_G), RD});
        _Pragma("unroll 1") for (int gi = 0; gi < 4; ++gi)
            gemm_simple<64>(c, (const bf16_t*)(ws + WS_DPOOL) + 64 * gi, 256, (const bf16_t*)(ws + WS_WPT) + 4096 * gi, 64, MTOK, 64, 64, EpiPool{(bf16_t*)(ws + WS_YCAT), p.in[I_POOLS], gi});)
#ifndef S1_STOP
#define S1_STOP 0
#endif
    if (IN(4)) { phase_s1<0>(p, c); if (S1_STOP) { SEAM(); phase_s1<S1_STOP>(p, c); } END(4); }
    PHASE(5, phase_s2(p, c);)
    PHASE(6, phase_s3(p, c);)
    PHASE(7,
        gemm_pg8_8(c, (const bf16_t*)(ws + WS_H), DM, (const bf16_t*)(ws + WS_WG1T) + (size_t)MIXIN * DM, DM, MTOK, 3 * DM, DM, F8SigBias{(bf16_t*)(ws + WS_GATES), 3 * DM, p.in[I_BGATE]});)
    PHASE(8, {
        pg8::Gemm g{(const bf16_t*)(ws + WS_YCAT), (const bf16_t*)(ws + WS_WUPT), MTOK, DM, DM, DM, DM}; pg8::StaticOrder S; S.init(MTOK, DM, (int)gridDim.x, (int)blockIdx.x);
        EpiFn8<F8UpFinal> E{F8UpFinal{(bf16_t*)(ws + WS_MERGED), (const bf16_t*)(ws + WS_GATES)}};
        pg8::gemm_phase_h<EpiFn8<F8UpFinal>, pg8::StaticOrder, true, true, UpHook>(c.lds, g, S, E, UpHook{(const bf16_t*)(ws + WS_GATES)}); })
    PHASE(9, {
        pg8::Gemm g{(const bf16_t*)(ws + WS_MERGED), (const bf16_t*)(ws + WS_WOT), MTOK, DM, DM, DM, DM}; pg8::StaticOrder S; S.init(MTOK, DM, (int)gridDim.x, (int)blockIdx.x);
        EpiOutB E{p.in[I_X], (bf16_t*)(ws + WS_X1B), (float*)(ws + WS_SS2)};
        pg8::gemm_phase<EpiOutB, pg8::StaticOrder, true, true>(c.lds, g, S, E); })
    PHASE(10, {
        pg8::Gemm g{(const bf16_t*)(ws + WS_X1B), (const bf16_t*)(ws + WS_WF1T), MTOK, 2 * FF, DM, DM, DM}; pg8::StaticOrder S; S.init(MTOK, 2 * FF, (int)gridDim.x, (int)blockIdx.x);
        EpiFfnAct E{(bf16_t*)(ws + WS_ACT), (const float*)(ws + WS_SS2), p.in[I_CONVW], p.in[I_CONVB], (float*)(ws + WS_TAILU), (float*)(ws + WS_HEADU), (float*)(ws + WS_HEADGV), (LAS float*)(c.lds + LDS_HALO_OFF)};
        pg8::gemm_phase<EpiFfnAct, pg8::StaticOrder, true, true>(c.lds, g, S, E); })
    PHASE(11, phase_ffn_fix(p, c);)
    PHASE(12, {
        pg8::Gemm g{(const bf16_t*)(ws + WS_ACT), (const bf16_t*)(ws + WS_WF2T), MTOK, DM, FF, FF, FF}; pg8::StaticOrder S; S.init(MTOK, DM, (int)gridDim.x, (int)blockIdx.x);
        EpiFfnOut E{(const bf16_t*)(ws + WS_X1B), p.out, (float*)(ws + WS_SS3)};
        pg8::gemm_phase<EpiFfnOut, pg8::StaticOrder, true, true>(c.lds, g, S, E); })
    if (IN(13)) { phase_final_norm(p, c); }
#undef IN
#undef END
}

__global__ void nan_fill(float* o, int n) { const int i = blockIdx.x * blockDim.x + threadIdx.x; if (i < n) o[i] = __builtin_nanf(""); }

extern "C" void kernel_launch(void* const* d_in, const int* in_sizes, int n_in, void* d_out, int out_size, void* d_ws, size_t ws_size, hipStream_t stream) {
    static int grid = 0;
    if (grid == 0) {
        int dev = 0, cus = 0, per_cu = 0;
        if (hipGetDevice(&dev) != hipSuccess || hipDeviceGetAttribute(&cus, hipDeviceAttributeMultiprocessorCount, dev) != hipSuccess) cus = 256;
        (void)hipFuncSetAttribute((const void*)fwd_kernel, hipFuncAttributeMaxDynamicSharedMemorySize, LDS_BYTES);
        if (hipOccupancyMaxActiveBlocksPerMultiprocessor(&per_cu, (const void*)fwd_kernel, NTHREADS, LDS_BYTES) != hipSuccess || per_cu < 1) per_cu = 1;
        (void)hipGetLastError();
        grid = cus;
        if (n_in != 31 || out_size != MTOK * DM || ws_size < WS_END) grid = -1;
    }
    if (grid < 0) { nan_fill<<<(out_size + 255) / 256, 256, 0, stream>>>((float*)d_out, out_size); return; }
    Params p{};
    for (int i = 0; i < 31; ++i) p.in[i] = (const float*)d_in[i];
    p.out = (float*)d_out; p.ws = (unsigned char*)d_ws;
#if ONE_LAUNCH
    (void)hipMemsetAsync((unsigned char*)d_ws + WS_BAR, 0, WS_CTL_BYTES, stream);
    p.ph_lo = 0; p.ph_hi = NPHASES;
    void* args[] = {&p};
    hipError_t e = hipLaunchCooperativeKernel((const void*)fwd_kernel, dim3(grid), dim3(NTHREADS), args, LDS_BYTES, stream);
    if (e != hipSuccess) fprintf(stderr, "cooperative launch failed: %s (grid %d)\n", hipGetErrorString(e), grid);
#else
    for (int ph = 0; ph < NPHASES; ++ph) { p.ph_lo = ph; p.ph_hi = ph + 1; hipLaunchKernelGGL(fwd_kernel, dim3(grid), dim3(NTHREADS), LDS_BYTES, stream, p); }
#endif
}
```

```cpp
#include <hip/hip_runtime.h>
#include <hip/hip_cooperative_groups.h>
#include <cstdio>
#include <cstdint>
namespace cg = cooperative_groups;

#ifndef ONE_LAUNCH
#define ONE_LAUNCH 1
#endif
#ifndef PH_MASK
#define PH_MASK 0xFFFFFFFFu
#endif
#define PH_ON(k) ((PH_MASK >> (k)) & 1u)
#ifndef REP_MASK
#define REP_MASK 0u
#endif

#define LAS __attribute__((address_space(3)))
typedef unsigned short bf16_t;
typedef short bf16x8 __attribute__((ext_vector_type(8)));
typedef float f32x4 __attribute__((ext_vector_type(4)));
typedef float f32x2 __attribute__((ext_vector_type(2)));
typedef unsigned u32x4 __attribute__((ext_vector_type(4)));
typedef unsigned u32x2 __attribute__((ext_vector_type(2)));

constexpr int BATCH = 8, SEQ = 4096, DM = 1024, MTOK = BATCH * SEQ;
constexpr int NMEM = 256, RD = 512, MIXIN = 2304, RWKVIN = 1792, FF = 2816, NG1 = MIXIN + 3 * DM;
constexpr int NWAVES = 8, NTHREADS = 512;
constexpr float NORM_EPS = 1e-6f, GN_EPS = 64e-5f;

constexpr size_t MiB = 1u << 20;
constexpr size_t WS_WG1T = 1 * MiB;
constexpr size_t WS_WKVT = WS_WG1T + (size_t)NG1 * DM * 2;
constexpr size_t WS_WUPT = WS_WKVT + (size_t)512 * DM * 2;
constexpr size_t WS_WOT = WS_WUPT + (size_t)DM * DM * 2;
constexpr size_t WS_WF1T = WS_WOT + (size_t)DM * DM * 2;
constexpr size_t WS_WF2T = WS_WF1T + (size_t)2 * FF * DM * 2;
constexpr size_t WS_WLWT = WS_WF2T + (size_t)DM * FF * 2;
constexpr size_t WS_WLAT = WS_WLWT + (size_t)RD * 64 * 2;
constexpr size_t WS_WLGT = WS_WLAT + (size_t)RD * 64 * 2;
constexpr size_t WS_WPT = WS_WLGT + (size_t)RD * 128 * 2;
constexpr size_t WS_WEND = WS_WPT + (size_t)4 * 64 * 64 * 2;
static_assert(WS_WEND <= 34 * MiB, "weights region");
constexpr size_t WS_BONUS = 34 * MiB;
constexpr size_t WS_SS2 = 35 * MiB, WS_SS3 = 35 * MiB + 256 * 1024;
constexpr size_t WS_KB = 36 * MiB;
constexpr size_t WS_VT = 37 * MiB;
constexpr size_t WS_MEMN = 38 * MiB;
constexpr size_t WS_H = 42 * MiB;
constexpr size_t WS_YCAT = 106 * MiB;
constexpr size_t WS_P = 170 * MiB;
constexpr size_t WS_E = 442 * MiB;
constexpr size_t WS_G = 476 * MiB;
constexpr size_t WS_KRAW = 314 * MiB;
constexpr size_t WS_YRAW = 266 * MiB;
constexpr size_t WS_R = 346 * MiB;
constexpr size_t WS_V = 378 * MiB;
constexpr size_t WS_LW = 410 * MiB;
constexpr size_t WS_LA = 414 * MiB;
constexpr size_t WS_LG = 418 * MiB;
constexpr size_t WS_DPOOL = 426 * MiB;
constexpr size_t WS_SP = 442 * MiB;
constexpr size_t WS_GATES = 170 * MiB;
constexpr size_t WS_MERGED = 362 * MiB;
constexpr size_t WS_X1B = 426 * MiB;
constexpr size_t WS_TAILU = 42 * MiB, WS_HEADU = 45 * MiB, WS_HEADGV = 48 * MiB;
constexpr size_t WS_ACT = 218 * MiB;
constexpr size_t WS_END = 490 * MiB;
constexpr size_t DO_RTT = 0, DO_MTT = 32 * MiB, DO_Y0D = 64 * MiB, DO_ND = 96 * MiB;

constexpr int LDS_BYTES = 147456;
constexpr int LDS_HALO_OFF = 131072 + 1024;
constexpr int LDS_MISC_OFF = 131072 + 320;
constexpr size_t WS_BAR = 0, WS_CTL_BYTES = 65536;

__device__ __forceinline__ unsigned f2bf(float f) { unsigned u = __float_as_uint(f); return (u + 0x7fffu + ((u >> 16) & 1u)) >> 16; }
__device__ __forceinline__ float bf2f(unsigned h) { return __uint_as_float(h << 16); }
__device__ __forceinline__ unsigned pk2(float lo, float hi) { return f2bf(lo) | (f2bf(hi) << 16); }
__device__ __forceinline__ u32x2 pk4(f32x4 v) { u32x2 r; r.x = pk2(v[0], v[1]); r.y = pk2(v[2], v[3]); return r; }
__device__ __forceinline__ f32x4 unpk4(u32x2 u) { f32x4 r; r[0] = bf2f(u.x & 0xffffu); r[1] = bf2f(u.x >> 16); r[2] = bf2f(u.y & 0xffffu); r[3] = bf2f(u.y >> 16); return r; }
__device__ __forceinline__ float wave_sum(float v) {
#pragma unroll
    for (int o = 1; o < 64; o <<= 1) v += __shfl_xor(v, o);
    return v;
}
__device__ __forceinline__ float sigmoidf_(float x) { return __builtin_amdgcn_rcpf(1.0f + __expf(-x)); }
template <int CTRL> __device__ __forceinline__ float dpp_f(float x) { return __builtin_bit_cast(float, __builtin_amdgcn_update_dpp(0, __builtin_bit_cast(int, x), CTRL, 0xF, 0xF, false)); }
__device__ __forceinline__ float row_sum16(float x) {
    x += dpp_f<0xB1>(x);
    x += dpp_f<0x4E>(x);
    x += dpp_f<0x141>(x);
    x += dpp_f<0x140>(x);
    return x;
}

#define XB_TMO      128
#define XB_XCNT(j)  (256  + 64 * (j))
#define XB_XSUB(j)  (1280 + 64 * (j))
#define XB_XGEN(j)  (2304 + 64 * (j))
#define XB_TOP      3328
#define XB_TOPGEN   3392
#define XCD_BAR_WORDS 3456
#define XB_SPIN_CAP (1u << 18)

__device__ __forceinline__ unsigned xb_ld(unsigned* p)              { return __hip_atomic_load(p, __ATOMIC_RELAXED, __HIP_MEMORY_SCOPE_AGENT); }
__device__ __forceinline__ unsigned xb_add(unsigned* p, unsigned v) { return __hip_atomic_fetch_add(p, v, __ATOMIC_RELAXED, __HIP_MEMORY_SCOPE_AGENT); }
__device__ __forceinline__ unsigned xb_xcc_id() { return (unsigned)__builtin_amdgcn_s_getreg((3 << 11) | 20) & 0xFu; }
#define XB_SPIN(cond, bar) do { unsigned _sp = 0; while (cond) { __builtin_amdgcn_s_sleep(1); \
    if ((++_sp & 255u) == 0u) { if (xb_ld(&(bar)[XB_TMO])) break; if (_sp > XB_SPIN_CAP) { atomicAdd(&(bar)[XB_TMO], 1u); break; } } } } while (0)

struct XcdBarrier {
    unsigned* bar; unsigned x;
    volatile LAS unsigned* st;
};

__device__ __forceinline__ XcdBarrier xcd_barrier_post(unsigned* bar, volatile LAS unsigned* st) {
    XcdBarrier b; b.bar = bar; b.x = xb_xcc_id(); b.st = st;
    if (threadIdx.x == 0) (void)xb_add(&bar[XB_XCNT(b.x)], 1u);
    return b;
}
__device__ __forceinline__ void xcd_barrier_complete(unsigned* bar, unsigned x, unsigned& nloc, unsigned& nx) {
    const unsigned G = gridDim.x * gridDim.y * gridDim.z;
    unsigned sum, cnt, mine, sp = 0u;
    for (;;) {
        sum = 0u; cnt = 0u; mine = 0u;
#pragma unroll
        for (unsigned j = 0; j < 16; ++j) { const unsigned c = xb_ld(&bar[XB_XCNT(j)]); sum += c; cnt += (c > 0u) ? 1u : 0u; mine = (j == x) ? c : mine; }
        if (sum == G) break;
        __builtin_amdgcn_s_sleep(1);
        if ((++sp & 255u) == 0u) { if (xb_ld(&bar[XB_TMO])) break; if (sp > XB_SPIN_CAP) { atomicAdd(&bar[XB_TMO], 1u); break; } }
    }
    nloc = mine > 0u ? mine : 1u; nx = cnt > 0u ? cnt : 1u;
}

__device__ __forceinline__ void xcd_barrier(const XcdBarrier& b) {
    asm volatile("s_waitcnt vmcnt(0)" ::: "memory");
    __syncthreads();
    if (threadIdx.x == 0) {
        unsigned* bar = b.bar;
        __builtin_amdgcn_s_waitcnt(0);
        unsigned nloc = b.st[0], nx = b.st[1];
        if (nloc == 0u) { xcd_barrier_complete(bar, b.x, nloc, nx); b.st[0] = nloc; b.st[1] = nx; }
        const unsigned old = xb_add(&bar[XB_XSUB(b.x)], 1u);
        const unsigned gen = old / nloc;
        if (old + 1u == (gen + 1u) * nloc) {
            __builtin_amdgcn_fence(__ATOMIC_RELEASE, "agent");
            asm volatile("s_waitcnt vmcnt(0)" ::: "memory");
            const unsigned og = xb_add(&bar[XB_TOP], 1u);
            const unsigned tg = og / nx;
            if (og + 1u == (tg + 1u) * nx) xb_add(&bar[XB_TOPGEN], 1u);
            else XB_SPIN(xb_ld(&bar[XB_TOPGEN]) == tg, bar);
            __builtin_amdgcn_fence(__ATOMIC_ACQUIRE, "agent");
            xb_add(&bar[XB_XGEN(b.x)], 1u);
            asm volatile("s_waitcnt vmcnt(0)" ::: "memory");
        } else {
            XB_SPIN(xb_ld(&bar[XB_XGEN(b.x)]) == gen, bar);
            __builtin_amdgcn_fence(__ATOMIC_ACQUIRE, "agent");
            asm volatile("s_waitcnt vmcnt(0)" ::: "memory");
        }
    }
    __syncthreads();
}


struct Params { const float* in[31]; float* out; unsigned char* ws; int ph_lo, ph_hi; };
enum { I_X = 0, I_MEM, I_NMIXG, I_WINMIX, I_MU, I_W0, I_WLORAB, I_A0, I_ALORAB, I_GLORAB, I_KK, I_KA, I_RK, I_LNW, I_LNB, I_POOLW, I_POOLS, I_NMEMG, I_WMEMKV,
       I_WUPR, I_WUPP, I_WUPM, I_WGATE, I_BGATE, I_WO, I_NFFNG, I_WFFNIN, I_CONVW, I_CONVB, I_WFFNOUT, I_NFING };

struct Ctx { int tid, lane, wave, fr, fq, gw, ngw; LAS unsigned char* lds; };

__device__ __forceinline__ int rowmap(int mode, int n) {
    if (mode == 0) return n;
    const int half = n >= FF ? 1 : 0, c = n - half * FF;
    return (c >> 7) * 256 + half * 128 + (c & 127);
}
__device__ __forceinline__ void transpose_item(const float* W, int K, int N, bf16_t* WT, int ldd, int koff, int mode, const float* kscale, LAS float* scr, int item, int lane) {
    const int nblk = N / 32, kb = item / nblk, nb = item % nblk, k0 = 64 * kb, n0 = 32 * nb;
#pragma unroll 8
    for (int i = 0; i < 32; ++i) { const int kk = 2 * i + (lane >> 5); float v = W[(size_t)(k0 + kk) * N + n0 + (lane & 31)]; if (kscale) v *= kscale[k0 + kk]; scr[kk * 33 + (lane & 31)] = v; }
    asm volatile("s_waitcnt lgkmcnt(0)" ::: "memory");
    const int c = lane & 7;
#pragma unroll
    for (int j = 0; j < 4; ++j) { const int n = (lane >> 3) + 8 * j; const LAS float* s = scr + (8 * c) * 33 + n;
        u32x4 o; o.x = pk2(s[0 * 33], s[1 * 33]); o.y = pk2(s[2 * 33], s[3 * 33]); o.z = pk2(s[4 * 33], s[5 * 33]); o.w = pk2(s[6 * 33], s[7 * 33]);
        *(u32x4*)(WT + (size_t)rowmap(mode, n0 + n) * ldd + koff + k0 + 8 * c) = o; }
    asm volatile("s_waitcnt lgkmcnt(0)" ::: "memory");
}
__device__ __forceinline__ void rmsnorm_row_bf16(const float* xrow, const float* g, bf16_t* orow, int lane) {
    const f32x4* xr = (const f32x4*)xrow + lane; const f32x4* gr = (const f32x4*)g + lane;
    f32x4 v[4]; float s = 0.f;
#pragma unroll
    for (int j = 0; j < 4; ++j) { v[j] = xr[64 * j]; s += (v[j][0] * v[j][0] + v[j][1] * v[j][1]) + (v[j][2] * v[j][2] + v[j][3] * v[j][3]); }
    const float rstd = rsqrtf(wave_sum(s) * (1.f / DM) + NORM_EPS);
    u32x2* o = (u32x2*)orow + lane;
#pragma unroll
    for (int j = 0; j < 4; ++j) { const f32x4 gg = gr[64 * j]; o[64 * j] = pk4(v[j] * rstd * gg); }
}

__device__ __forceinline__ void phase_prologue(const Params& p, const Ctx& c) {
    LAS float* scr = (LAS float*)(c.lds + c.wave * 16384);
    unsigned char* ws = p.ws;
#define TR(Wp, K_, N_, WTp, ldd_, koff_, mode_, sc_) { const int ni_ = ((K_) / 64) * ((N_) / 32); if (r < ni_) { transpose_item(Wp, K_, N_, (bf16_t*)(WTp), ldd_, koff_, mode_, sc_, scr, r, c.lane); continue; } r -= ni_; }
    constexpr int NIT = (DM / 64) * (MIXIN / 32) + (DM / 64) * (3 * DM / 32) + (DM / 64) * (512 / 32) + (512 / 64) * (DM / 32) + 2 * (256 / 64) * (DM / 32) + (DM / 64) * (DM / 32)
                      + (DM / 64) * (2 * FF / 32) + (FF / 64) * (DM / 32) + 2 * (RD / 32) + 2 * (RD / 32) + 4 * 2;
    for (int it = c.gw; it < NIT; it += c.ngw) {
        int r = it;
        TR(p.in[I_WINMIX], DM, MIXIN, ws + WS_WG1T, DM, 0, 0, nullptr)
        TR(p.in[I_WGATE], DM, 3 * DM, ws + WS_WG1T + (size_t)MIXIN * DM * 2, DM, 0, 0, nullptr)
        TR(p.in[I_WMEMKV], DM, 512, ws + WS_WKVT, DM, 0, 0, nullptr)
        TR(p.in[I_WUPR], 512, DM, ws + WS_WUPT, DM, 0, 0, nullptr)
        TR(p.in[I_WUPP], 256, DM, ws + WS_WUPT, DM, 512, 0, nullptr)
        TR(p.in[I_WUPM], 256, DM, ws + WS_WUPT, DM, 768, 0, nullptr)
        TR(p.in[I_WO], DM, DM, ws + WS_WOT, DM, 0, 0, nullptr)
        TR(p.in[I_WFFNIN], DM, 2 * FF, ws + WS_WF1T, DM, 0, 1, p.in[I_NFFNG])
        TR(p.in[I_WFFNOUT], FF, DM, ws + WS_WF2T, FF, 0, 0, nullptr)
        TR(p.in[I_WLORAB], 64, RD, ws + WS_WLWT, 64, 0, 0, nullptr)
        TR(p.in[I_ALORAB], 64, RD, ws + WS_WLAT, 64, 0, 0, nullptr)
        TR(p.in[I_GLORAB], 128, RD, ws + WS_WLGT, 128, 0, 0, nullptr)
        TR(p.in[I_POOLW] + 0 * 4096, 64, 64, ws + WS_WPT + 0 * 8192, 64, 0, 0, nullptr)
        TR(p.in[I_POOLW] + 1 * 4096, 64, 64, ws + WS_WPT + 1 * 8192, 64, 0, 0, nullptr)
        TR(p.in[I_POOLW] + 2 * 4096, 64, 64, ws + WS_WPT + 2 * 8192, 64, 0, 0, nullptr)
        TR(p.in[I_POOLW] + 3 * 4096, 64, 64, ws + WS_WPT + 3 * 8192, 64, 0, 0, nullptr)
    }
#undef TR
    for (int m = c.gw; m < MTOK; m += c.ngw) rmsnorm_row_bf16(p.in[I_X] + (size_t)m * DM, p.in[I_NMIXG], (bf16_t*)(ws + WS_H) + (size_t)m * DM, c.lane);
    for (int i = blockIdx.x * NTHREADS + c.tid; i < (2 * 256 * 1024) / 4; i += gridDim.x * NTHREADS) ((float*)(ws + WS_SS2))[i] = 0.f;
    for (int m = c.gw; m < BATCH * NMEM; m += c.ngw) rmsnorm_row_bf16(p.in[I_MEM] + (size_t)m * DM, p.in[I_NMEMG], (bf16_t*)(ws + WS_MEMN) + (size_t)m * DM, c.lane);
}

namespace pg8 {
#define PG8_LAS __attribute__((address_space(3)))
typedef unsigned short bf16_t;
typedef short bf16x8 __attribute__((ext_vector_type(8)));
typedef float f32x4 __attribute__((ext_vector_type(4)));
typedef unsigned u32x4 __attribute__((ext_vector_type(4)));
constexpr int BM = 256, BK = 64, HALF = 128, HTB = HALF * BK * 2  , STAGE_BYTES = 8 * HTB, NXCD = 8, WGM = 8;

__host__ __device__ __forceinline__ int lds_byte(int r, int c) { const int st = (r >> 4) * 2 + (c >> 5), rr = r & 15, cc = c & 31, ob = rr * 64 + cc * 2; return st * 1024 + (ob ^ (((ob >> 9) & 1) << 5)); }
__host__ __device__ __forceinline__ void stage_rc(int b, int& R, int& C) { const int st = b / 1024, sb = b % 1024, swz = sb ^ (((sb >> 9) & 1) << 5); R = (st >> 1) * 16 + swz / 64; C = (st & 1) * 32 + (swz % 64) / 2; }
__host__ __device__ __forceinline__ int perm32(int rho) { const int n = rho >> 4, i = rho & 15; return 8 * (i >> 2) + 4 * n + (i & 3); }

struct Unit { int pm, pn; };
struct Gemm { const bf16_t* A; const bf16_t* Bt; int M, N, K, lda, ldb; };

struct StaticOrder {
    int nM, nN, nwg, G, c;
    __host__ __device__ void init(int M, int N, int G_, int c_) { nM = M / BM; nN = N / BM; nwg = nM * nN; G = G_; c = c_; }
    __host__ __device__ bool next(int i, Unit& u) const {
        const long L = (long)i * G + c; if (L >= nwg) return false;
        int wgid = (int)L; { const int q = nwg / NXCD, r = nwg % NXCD, xcd = wgid % NXCD, off = wgid / NXCD; wgid = (xcd < r ? xcd * (q + 1) : r * (q + 1) + (xcd - r) * q) + off; }
        const int nig = WGM * nN, gid = wgid / nig, fm = gid * WGM, gsz = (nM - fm) < WGM ? (nM - fm) : WGM;
        u.pm = fm + ((wgid % nig) % gsz); u.pn = (wgid % nig) / gsz; return true;
    }
    __device__ __forceinline__ void a_ready(const Unit&) const {}
    __device__ __forceinline__ void done(const Unit&) const {}
};


struct NoHook { __device__ __forceinline__ void operator()(f32x4 (&)[2][2][4][2], const Unit&, int, int, int, int, int) const {} };
template <class Epi, class Sched, bool ALIGN_EPI, bool SP2, class Hook>
__device__ __forceinline__ void gemm_phase_h(PG8_LAS unsigned char* lds, const Gemm g, const Sched& S, const Epi& E, const Hook& H) {
    int tid_ = threadIdx.x; asm volatile("" : "+v"(tid_));
    const int tid = tid_, wid = __builtin_amdgcn_readfirstlane(tid >> 6), lane = tid & 63, wr = wid >> 2, wc = wid & 3, fr = lane & 15, fq = lane >> 4;
    const int K = g.K, nt = K / BK;
    unsigned voffA[2], voffB[2];
#pragma unroll
    for (int i = 0; i < 2; ++i) { int R, C; stage_rc(tid * 16 + i * 8192, R, C); const int Rb = Epi::PERM ? ((R & ~31) + perm32(R & 31)) : R;
        voffA[i] = (unsigned)(R * g.lda + C) * 2u; voffB[i] = (unsigned)(Rb * g.ldb + C) * 2u; }
    const size_t kstep = (size_t)(BK * 2);
    const size_t hstepA = (size_t)HALF * g.lda * 2, hstepB = (size_t)HALF * g.ldb * 2;
    const size_t tstepA = 2 * hstepA, tstepB = 2 * hstepB;
    const unsigned ldsw = (unsigned)wid * 1024u;
    const int aoff = lds_byte(wr * 64 + fr, fq * 8), boff = lds_byte(wc * 32 + fr, fq * 8);
#define PG8_SA(b, h) (((b) * 2 + (h)) * HTB)
#define PG8_SB(b, h) ((4 + (b) * 2 + (h)) * HTB)
#define PG8_STAGE(bufoff, gbase, voff) do { _Pragma("unroll") for (int _i = 0; _i < 2; ++_i) \
        __builtin_amdgcn_global_load_lds((const unsigned*)((const char*)(gbase) + (voff)[_i]), (PG8_LAS unsigned*)(lds + (bufoff) + ldsw + _i * 8192), 16, 0, 0); } while (0)
#define PG8_LDA(dst, b, h) do { _Pragma("unroll") for (int m = 0; m < 4; ++m) _Pragma("unroll") for (int k = 0; k < 2; ++k) dst[m][k] = *(const PG8_LAS bf16x8*)(lds + PG8_SA(b, h) + aoff + m * 2048 + k * 1024); } while (0)
#define PG8_LDB(dst, b, h) do { _Pragma("unroll") for (int n = 0; n < 2; ++n) _Pragma("unroll") for (int k = 0; k < 2; ++k) dst[n][k] = *(const PG8_LAS bf16x8*)(lds + PG8_SB(b, h) + boff + n * 2048 + k * 1024); } while (0)
#define PG8_MMA(ai, bj, At, Bt) do { __builtin_amdgcn_s_setprio(1); _Pragma("unroll") for (int m = 0; m < 4; ++m) _Pragma("unroll") for (int n = 0; n < 2; ++n) _Pragma("unroll") for (int k = 0; k < 2; ++k) \
        acc[ai][bj][m][n] = __builtin_amdgcn_mfma_f32_16x16x32_bf16(Bt[n][k], At[m][k], acc[ai][bj][m][n], 0, 0, 0); __builtin_amdgcn_s_setprio(0); } while (0)
#define PG8_WAIT_V(n) asm volatile("s_waitcnt vmcnt(" #n ")" ::: "memory")
#define PG8_WAIT_L(n) asm volatile("s_waitcnt lgkmcnt(" #n ")" ::: "memory")
#define PG8_BAR __builtin_amdgcn_s_barrier()
#define PG8_SCHED __builtin_amdgcn_sched_barrier(0)
    Unit cur, nxt; int ui = 0;
    if (!S.next(0, cur)) return;
    f32x4 acc[2][2][4][2];
#pragma unroll
    for (int a = 0; a < 2; ++a)
#pragma unroll
        for (int b = 0; b < 2; ++b)
#pragma unroll
            for (int m = 0; m < 4; ++m)
#pragma unroll
                for (int n = 0; n < 2; ++n) acc[a][b][m][n] = (f32x4){0.f, 0.f, 0.f, 0.f};
    bf16x8 At[4][2], B0[2][2], B1[2][2];
    const char* cA = (const char*)g.A + (size_t)cur.pm * tstepA; const char* cB = (const char*)g.Bt + (size_t)cur.pn * tstepB;
    S.a_ready(cur);
    if constexpr (SP2) {
        PG8_STAGE(PG8_SB(0, 0), cB, voffB); PG8_STAGE(PG8_SB(0, 1), cB + hstepB, voffB); PG8_STAGE(PG8_SA(0, 0), cA, voffA); PG8_STAGE(PG8_SA(0, 1), cA + hstepA, voffA);
        if (wr == 1) PG8_BAR;
        PG8_WAIT_V(2); PG8_BAR;
        PG8_STAGE(PG8_SB(1, 0), cB + kstep, voffB); PG8_STAGE(PG8_SA(1, 0), cA + kstep, voffA); PG8_STAGE(PG8_SB(1, 1), cB + hstepB + kstep, voffB);
        PG8_WAIT_V(6); PG8_BAR;
    } else {
        PG8_STAGE(PG8_SB(0, 0), cB, voffB); PG8_STAGE(PG8_SA(0, 0), cA, voffA); PG8_STAGE(PG8_SB(0, 1), cB + hstepB, voffB); PG8_STAGE(PG8_SA(0, 1), cA + hstepA, voffA);
        if (wr == 1) PG8_BAR;
        PG8_WAIT_V(4); PG8_BAR;
        PG8_STAGE(PG8_SB(1, 0), cB + kstep, voffB); PG8_STAGE(PG8_SA(1, 0), cA + kstep, voffA); PG8_STAGE(PG8_SB(1, 1), cB + hstepB + kstep, voffB);
        PG8_WAIT_V(6); PG8_BAR;
    }
    for (;;) {
        const bool has_next = S.next(ui + 1, nxt);
        const char* nA = has_next ? (const char*)g.A + (size_t)nxt.pm * tstepA : cA; const char* nB = has_next ? (const char*)g.Bt + (size_t)nxt.pn * tstepB : cB;
        for (int t = 0; t < nt; t += 2) {
            H(acc, cur, t, wr, wc, fr, fq);
            const bool last = (t == nt - 2);
            const char* a1 = cA + (size_t)(t + 1) * kstep;
            const char* a2 = last ? nA : cA + (size_t)(t + 2) * kstep; const char* b2 = last ? nB : cB + (size_t)(t + 2) * kstep;
            const char* a3 = a2 + kstep; const char* b3 = b2 + kstep;
            if (last && has_next) S.a_ready(nxt);
            if constexpr (SP2) {
            PG8_LDB(B0, 0, 0); PG8_LDB(B1, 0, 1); PG8_SCHED; PG8_LDA(At, 0, 0); PG8_STAGE(PG8_SA(1, 1), a1 + hstepA, voffA);
            PG8_WAIT_V(8); PG8_WAIT_L(0); PG8_BAR; PG8_MMA(0, 0, At, B0); PG8_MMA(0, 1, At, B1); PG8_BAR; PG8_SCHED;
            PG8_LDA(At, 0, 1); PG8_STAGE(PG8_SB(0, 0), b2, voffB); PG8_STAGE(PG8_SB(0, 1), b2 + hstepB, voffB); PG8_STAGE(PG8_SA(0, 0), a2, voffA);
            PG8_WAIT_V(8); PG8_WAIT_L(0); PG8_BAR; PG8_MMA(1, 0, At, B0); PG8_MMA(1, 1, At, B1); PG8_BAR; PG8_SCHED;
            PG8_LDB(B0, 1, 0); PG8_LDB(B1, 1, 1); PG8_SCHED; PG8_LDA(At, 1, 0); PG8_STAGE(PG8_SA(0, 1), a2 + hstepA, voffA);
            PG8_WAIT_V(8); PG8_WAIT_L(0); PG8_BAR; PG8_MMA(0, 0, At, B0); PG8_MMA(0, 1, At, B1); PG8_BAR; PG8_SCHED;
            PG8_LDA(At, 1, 1); PG8_STAGE(PG8_SB(1, 0), b3, voffB); PG8_STAGE(PG8_SB(1, 1), b3 + hstepB, voffB); PG8_STAGE(PG8_SA(1, 0), a3, voffA);
            PG8_WAIT_V(8); PG8_WAIT_L(0); PG8_BAR; PG8_MMA(1, 0, At, B0); PG8_MMA(1, 1, At, B1); PG8_BAR; PG8_SCHED;
            } else {
            PG8_LDB(B0, 0, 0); PG8_SCHED; PG8_LDA(At, 0, 0); PG8_STAGE(PG8_SA(1, 1), a1 + hstepA, voffA);
            PG8_WAIT_L(8); PG8_BAR; PG8_WAIT_L(0); PG8_MMA(0, 0, At, B0); PG8_BAR; PG8_SCHED;
            PG8_LDB(B1, 0, 1); PG8_STAGE(PG8_SB(0, 0), b2, voffB);
            PG8_BAR; PG8_WAIT_L(0); PG8_MMA(0, 1, At, B1); PG8_BAR;
            PG8_LDA(At, 0, 1); PG8_STAGE(PG8_SA(0, 0), a2, voffA);
            PG8_BAR; PG8_WAIT_L(0); PG8_MMA(1, 0, At, B0); PG8_BAR; PG8_SCHED;
            PG8_STAGE(PG8_SB(0, 1), b2 + hstepB, voffB);
            PG8_WAIT_V(6); PG8_BAR; PG8_MMA(1, 1, At, B1); PG8_BAR;
            PG8_LDB(B0, 1, 0); PG8_SCHED; PG8_LDA(At, 1, 0); PG8_STAGE(PG8_SA(0, 1), a2 + hstepA, voffA);
            PG8_WAIT_L(8); PG8_BAR; PG8_WAIT_L(0); PG8_MMA(0, 0, At, B0); PG8_BAR; PG8_SCHED;
            PG8_LDB(B1, 1, 1); PG8_STAGE(PG8_SB(1, 0), b3, voffB);
            PG8_BAR; PG8_WAIT_L(0); PG8_MMA(0, 1, At, B1); PG8_BAR;
            PG8_LDA(At, 1, 1); PG8_STAGE(PG8_SA(1, 0), a3, voffA);
            PG8_BAR; PG8_WAIT_L(0); PG8_MMA(1, 0, At, B0); PG8_BAR; PG8_SCHED;
            PG8_STAGE(PG8_SB(1, 1), b3 + hstepB, voffB);
            PG8_WAIT_V(6); PG8_BAR; PG8_MMA(1, 1, At, B1); PG8_BAR;
            }
        }
        if constexpr (ALIGN_EPI) { if (wr == 0) PG8_BAR; }
        if constexpr (!Epi::AFTER_DRAIN) { E(acc, cur, wr, wc, fr, fq); S.done(cur); }
        if (!has_next) break;
#pragma unroll
        for (int a = 0; a < 2; ++a)
#pragma unroll
            for (int b = 0; b < 2; ++b)
#pragma unroll
                for (int m = 0; m < 4; ++m)
#pragma unroll
                    for (int n = 0; n < 2; ++n) acc[a][b][m][n] = (f32x4){0.f, 0.f, 0.f, 0.f};
        cur = nxt; cA = nA; cB = nB; ++ui;
        if constexpr (ALIGN_EPI) { if (wr == 1) PG8_BAR; }
    }
    PG8_WAIT_V(0);
    if constexpr (!ALIGN_EPI) { if (wr == 0) PG8_BAR; }
    PG8_BAR;
    if constexpr (Epi::AFTER_DRAIN) { E.fused(acc, cur, wr, wc, fr, fq, lds, wid, lane); S.done(cur); }
#undef PG8_SA
#undef PG8_SB
#undef PG8_STAGE
#undef PG8_LDA
#undef PG8_LDB
#undef PG8_MMA
#undef PG8_WAIT_V
#undef PG8_WAIT_L
#undef PG8_BAR
#undef PG8_SCHED
}
template <class Epi, class Sched, bool ALIGN_EPI = false, bool SP2 = false>
__device__ __forceinline__ void gemm_phase(PG8_LAS unsigned char* lds, const Gemm g, const Sched& S, const Epi& E) { gemm_phase_h<Epi, Sched, ALIGN_EPI, SP2, NoHook>(lds, g, S, E, NoHook{}); }
}


template <class F> struct EpiFn4 { static constexpr bool PERM = false, AFTER_DRAIN = false; F f;
    __device__ __forceinline__ void operator()(const f32x4 (&acc)[2][2][4][2], const pg8::Unit& u, int wr, int wc, int fr, int fq) const {
        const int row0 = u.pm * 256 + wr * 64 + fr, col0 = u.pn * 256 + wc * 32 + 4 * fq;
#pragma unroll
        for (int ai = 0; ai < 2; ++ai)
#pragma unroll
            for (int m = 0; m < 4; ++m)
#pragma unroll
                for (int bj = 0; bj < 2; ++bj)
#pragma unroll
                    for (int n = 0; n < 2; ++n) f(row0 + ai * 128 + m * 16, col0 + bj * 128 + n * 16, acc[ai][bj][m][n]);
    } };
template <class F> struct EpiFn8 { static constexpr bool PERM = true, AFTER_DRAIN = false; F f;
    __device__ __forceinline__ void operator()(const f32x4 (&acc)[2][2][4][2], const pg8::Unit& u, int wr, int wc, int fr, int fq) const {
        const int row0 = u.pm * 256 + wr * 64 + fr, col0 = u.pn * 256 + wc * 32 + 8 * fq;
#pragma unroll
        for (int ai = 0; ai < 2; ++ai)
#pragma unroll
            for (int m = 0; m < 4; ++m)
#pragma unroll
                for (int bj = 0; bj < 2; ++bj) f(row0 + ai * 128 + m * 16, col0 + bj * 128, acc[ai][bj][m][0], acc[ai][bj][m][1]);
    } };
template <class F> __device__ __forceinline__ void gemm_pg8_4(const Ctx& c, const bf16_t* A, int lda, const bf16_t* Bt, int ldb, int M, int N, int K, const F& f) {
    pg8::Gemm g{A, Bt, M, N, K, lda, ldb}; pg8::StaticOrder S; S.init(M, N, (int)gridDim.x, (int)blockIdx.x); EpiFn4<F> E{f};
    pg8::gemm_phase<EpiFn4<F>, pg8::StaticOrder, true, true>(c.lds, g, S, E);
}
template <class F> __device__ __forceinline__ void gemm_pg8_8(const Ctx& c, const bf16_t* A, int lda, const bf16_t* Bt, int ldb, int M, int N, int K, const F& f) {
    pg8::Gemm g{A, Bt, M, N, K, lda, ldb}; pg8::StaticOrder S; S.init(M, N, (int)gridDim.x, (int)blockIdx.x); EpiFn8<F> E{f};
    pg8::gemm_phase<EpiFn8<F>, pg8::StaticOrder, true, true>(c.lds, g, S, E);
}
__device__ __forceinline__ u32x4 pk8(f32x4 lo, f32x4 hi) { u32x4 w; w.x = pk2(lo[0], lo[1]); w.y = pk2(lo[2], lo[3]); w.z = pk2(hi[0], hi[1]); w.w = pk2(hi[2], hi[3]); return w; }
struct F8Store { bf16_t* O; int ld; __device__ __forceinline__ void operator()(int row, int col, f32x4 lo, f32x4 hi) const { *(u32x4*)(O + (size_t)row * ld + col) = pk8(lo, hi); } };
struct F8SigBias { bf16_t* O; int ld; const float* bias;
    __device__ __forceinline__ void operator()(int row, int col, f32x4 lo, f32x4 hi) const {
        lo += *(const f32x4*)(bias + col); hi += *(const f32x4*)(bias + col + 4);
#pragma unroll
        for (int j = 0; j < 4; ++j) { lo[j] = sigmoidf_(lo[j]); hi[j] = sigmoidf_(hi[j]); }
        *(u32x4*)(O + (size_t)row * ld + col) = pk8(lo, hi); } };
struct UpHook { const bf16_t* GT;
    __device__ __forceinline__ void operator()(f32x4 (&acc)[2][2][4][2], const pg8::Unit& u, int t, int wr, int wc, int fr, int fq) const {
        if (t != 8 && t != 12) return;
        const int sa = (t == 8) ? 0 : 1;
        const bf16_t* gp0 = GT + (size_t)(u.pm * 256 + wr * 64 + fr) * (3 * DM) + sa * DM + u.pn * 256 + wc * 32 + 8 * fq;
#pragma unroll
        for (int ai = 0; ai < 2; ++ai)
#pragma unroll
            for (int m = 0; m < 4; ++m) { const bf16_t* gp = gp0 + (size_t)(ai * 128 + m * 16) * (3 * DM);
#pragma unroll
                for (int bj = 0; bj < 2; ++bj) { const u32x4 ga = *(const u32x4*)(gp + bj * 128), gb = *(const u32x4*)(gp + DM + bj * 128);
                    const f32x4 a0 = unpk4((u32x2){ga.x, ga.y}), a1 = unpk4((u32x2){ga.z, ga.w}), b0 = unpk4((u32x2){gb.x, gb.y}), b1 = unpk4((u32x2){gb.z, gb.w});
#pragma unroll
                    for (int j = 0; j < 4; ++j) { acc[ai][bj][m][0][j] *= a0[j] * __builtin_amdgcn_rcpf(b0[j]); acc[ai][bj][m][1][j] *= a1[j] * __builtin_amdgcn_rcpf(b1[j]); } }
                asm volatile("" ::: "memory"); }
    } };
struct F8UpFinal { bf16_t* MG; const bf16_t* GT;
    __device__ __forceinline__ void operator()(int row, int col, f32x4 lo, f32x4 hi) const {
        const u32x4 g = *(const u32x4*)(GT + (size_t)row * (3 * DM) + 2 * DM + col);
        *(u32x4*)(MG + (size_t)row * DM + col) = pk8(lo * unpk4((u32x2){g.x, g.y}), hi * unpk4((u32x2){g.z, g.w})); } };

__device__ __forceinline__ f32x2 gelu_pk(f32x2 v) {
    const f32x2 av = __builtin_elementwise_abs(v), d = av * 0.2316418882f + 1.0f;
    f32x2 t; t.x = __builtin_amdgcn_rcpf(d.x); t.y = __builtin_amdgcn_rcpf(d.y);
    f32x2 q = t * 0.5307027145f + (-0.7265760135f); q = q * t + 0.7107068705f; q = q * t + (-0.142248368f); q = q * t + 0.127414796f; q = q * t;
    const f32x2 s = (v * v) * (-0.72134752044f);
    f32x2 e; e.x = __builtin_amdgcn_exp2f(s.x); e.y = __builtin_amdgcn_exp2f(s.y);
    const f32x2 m = v * (q * e), r = v - m;
    f32x2 o; o.x = v.x < 0.f ? m.x : r.x; o.y = v.y < 0.f ? m.y : r.y; return o;
}
struct EpiFfnAct { static constexpr bool PERM = true, AFTER_DRAIN = false;
    bf16_t* ACT; const float* rstd  ; const float* cw; const float* cb; float* TAILU; float* HEADU; float* HEADGV; LAS float* halo;
    __device__ __forceinline__ void operator()(const f32x4 (&acc)[2][2][4][2], const pg8::Unit& u, int wr, int wc, int fr, int fq) const {
        const int ch0 = u.pn * 128 + wc * 32 + 8 * fq, rowt = wr * 64 + fr, grow0 = u.pm * 256 + rowt;
        f32x4 c0[2], c1[2], c2[2], cbv[2];
#pragma unroll
        for (int n = 0; n < 2; ++n) { c0[n] = *(const f32x4*)(cw + ch0 + 4 * n); c1[n] = *(const f32x4*)(cw + FF + ch0 + 4 * n); c2[n] = *(const f32x4*)(cw + 2 * FF + ch0 + 4 * n); cbv[n] = *(const f32x4*)(cb + ch0 + 4 * n); }
#pragma unroll
        for (int ai = 0; ai < 2; ++ai) { const float rs3 = rsqrtf(rstd[grow0 + ai * 128 + 48] * (1.f / DM) + NORM_EPS);
            if (fr >= 14) {
#pragma unroll
                for (int n = 0; n < 2; ++n) *(LAS f32x4*)(halo + (((((ai * 2 + wr) * 2 + (fr - 14)) * 4 + wc) * 4 + fq) * 8 + 4 * n)) = acc[ai][0][3][n] * rs3; } }
        asm volatile("s_waitcnt lgkmcnt(0)" ::: "memory"); __builtin_amdgcn_s_barrier(); asm volatile("" ::: "memory");
#pragma unroll
        for (int ai = 0; ai < 2; ++ai) {
            f32x4 r1p[2], r2p[2];
            if (wr == 1 || ai == 1) { const int src = (wr == 1) ? (ai * 2) : ((ai - 1) * 2 + 1);
#pragma unroll
                for (int n = 0; n < 2; ++n) { const f32x4 hv0 = *(const LAS f32x4*)(halo + ((((src * 2 + 0) * 4 + wc) * 4 + fq) * 8 + 4 * n)), hv1 = *(const LAS f32x4*)(halo + ((((src * 2 + 1) * 4 + wc) * 4 + fq) * 8 + 4 * n));
                    r1p[n] = hv1; r2p[n] = (fr == 0) ? hv0 : hv1; } }
            else { r1p[0] = r1p[1] = r2p[0] = r2p[1] = (f32x4){0.f, 0.f, 0.f, 0.f}; }
#pragma unroll
            for (int m = 0; m < 4; ++m) {
                const int grow = grow0 + ai * 128 + 16 * m; const float rs = rsqrtf(rstd[grow] * (1.f / DM) + NORM_EPS);
                u32x4 w;
#pragma unroll
                for (int n = 0; n < 2; ++n) {
                    const f32x4 uu = acc[ai][0][m][n] * rs, gg = acc[ai][1][m][n] * rs;
                    f32x4 R1, R2;
#pragma unroll
                    for (int j = 0; j < 4; ++j) { R1[j] = dpp_f<0x121>(uu[j]); R2[j] = dpp_f<0x122>(uu[j]); }
                    const f32x4 p1 = (fr >= 1) ? R1 : r1p[n], p2 = (fr >= 2) ? R2 : r2p[n];
                    r1p[n] = R1; r2p[n] = R2;
                    const f32x4 uc = c0[n] * p2 + c1[n] * p1 + c2[n] * uu + cbv[n];
                    const f32x2 ga = gelu_pk((f32x2){uc[0], uc[1]}), gb = gelu_pk((f32x2){uc[2], uc[3]});
                    const unsigned lo = pk2(ga.x * gg[0], ga.y * gg[1]), hi = pk2(gb.x * gg[2], gb.y * gg[3]);
                    if (n == 0) { w.x = lo; w.y = hi; } else { w.z = lo; w.w = hi; }
                    if (ai == 0 && m == 0) { if (wr == 0 && fr < 2) { const size_t so = (size_t)(u.pm * 2 + fr) * FF + ch0 + 4 * n; *(f32x4*)(HEADU + so) = uu; *(f32x4*)(HEADGV + so) = gg; } }
                    if (ai == 1 && m == 3) { if (wr == 1 && fr >= 14) { const size_t so = (size_t)(u.pm * 2 + (fr - 14)) * FF + ch0 + 4 * n; *(f32x4*)(TAILU + so) = uu; } }
                }
                *(u32x4*)(ACT + (size_t)grow * FF + ch0) = w;
            }
        }
    } };
__device__ __forceinline__ void phase_ffn_fix(const Params& p, const Ctx& c) {
    unsigned char* ws = p.ws;
    const float* TAILU = (const float*)(ws + WS_TAILU); const float* HEADU = (const float*)(ws + WS_HEADU); const float* HEADGV = (const float*)(ws + WS_HEADGV); bf16_t* ACT = (bf16_t*)(ws + WS_ACT);
    const float* cw = p.in[I_CONVW]; const float* cb = p.in[I_CONVB];
    const int nit = (MTOK / 256) * 2 * (FF / 4);
    for (int idx = blockIdx.x * NTHREADS + c.tid; idx < nit; idx += gridDim.x * NTHREADS) {
        const int col = 4 * (idx % (FF / 4)), pr = idx / (FF / 4), pm = pr >> 1, rr = pr & 1;
        if ((pm & 15) == 0) continue;
        const f32x4 u0 = *(const f32x4*)(HEADU + (size_t)(pm * 2 + rr) * FF + col), gg = *(const f32x4*)(HEADGV + (size_t)(pm * 2 + rr) * FF + col);
        const f32x4 t1 = *(const f32x4*)(TAILU + (size_t)((pm - 1) * 2 + 1) * FF + col), t0 = *(const f32x4*)(TAILU + (size_t)((pm - 1) * 2 + 0) * FF + col);
        f32x4 u1, u2; if (rr == 0) { u1 = t1; u2 = t0; } else { u1 = *(const f32x4*)(HEADU + (size_t)(pm * 2) * FF + col); u2 = t1; }
        const f32x4 uc = *(const f32x4*)(cw + col) * u2 + *(const f32x4*)(cw + FF + col) * u1 + *(const f32x4*)(cw + 2 * FF + col) * u0 + *(const f32x4*)(cb + col);
        const f32x2 ga = gelu_pk((f32x2){uc[0], uc[1]}), gb = gelu_pk((f32x2){uc[2], uc[3]});
        u32x2 w; w.x = pk2(ga.x * gg[0], ga.y * gg[1]); w.y = pk2(gb.x * gg[2], gb.y * gg[3]);
        *(u32x2*)(ACT + (size_t)(pm * 256 + rr) * FF + col) = w;
    }
}

struct EpiOutB { static constexpr bool PERM = true, AFTER_DRAIN = false; const float* x; bf16_t* x1b; float* SS;
    __device__ __forceinline__ void operator()(const f32x4 (&acc)[2][2][4][2], const pg8::Unit& u, int wr, int wc, int fr, int fq) const {
        const int row0 = u.pm * 256 + wr * 64 + fr, col0 = u.pn * 256 + wc * 32 + 8 * fq;
#pragma unroll
        for (int ai = 0; ai < 2; ++ai)
#pragma unroll
            for (int m = 0; m < 4; ++m) { const int row = row0 + ai * 128 + m * 16; float ss = 0.f;
#pragma unroll
                for (int bj = 0; bj < 2; ++bj) { const size_t off = (size_t)row * DM + col0 + bj * 128;
                    const f32x4 lo = acc[ai][bj][m][0] + *(const f32x4*)(x + off), hi = acc[ai][bj][m][1] + *(const f32x4*)(x + off + 4);
                    ss += (lo[0] * lo[0] + lo[1] * lo[1]) + (lo[2] * lo[2] + lo[3] * lo[3]) + (hi[0] * hi[0] + hi[1] * hi[1]) + (hi[2] * hi[2] + hi[3] * hi[3]);
                    *(u32x4*)(x1b + off) = pk8(lo, hi); }
                ss += __shfl_xor(ss, 16); ss += __shfl_xor(ss, 32);
                if (fq == 0) atomicAdd(SS + row, ss); }
    } };
struct EpiFfnOut { static constexpr bool PERM = false, AFTER_DRAIN = false; const bf16_t* x1b; float* out; float* SS;
    __device__ __forceinline__ void operator()(const f32x4 (&acc)[2][2][4][2], const pg8::Unit& u, int wr, int wc, int fr, int fq) const {
        const int row0 = u.pm * 256 + wr * 64 + fr, col0 = u.pn * 256 + wc * 32 + 4 * fq;
#pragma unroll
        for (int ai = 0; ai < 2; ++ai)
#pragma unroll
            for (int m = 0; m < 4; ++m) { const int row = row0 + ai * 128 + m * 16; float ss = 0.f;
#pragma unroll
                for (int bj = 0; bj < 2; ++bj)
#pragma unroll
                    for (int n = 0; n < 2; ++n) { const size_t off = (size_t)row * DM + col0 + bj * 128 + n * 16;
                        const f32x4 v = acc[ai][bj][m][n] + unpk4(*(const u32x2*)(x1b + off));
                        ss += (v[0] * v[0] + v[1] * v[1]) + (v[2] * v[2] + v[3] * v[3]);
                        *(f32x4*)(out + off) = v; }
                ss += __shfl_xor(ss, 16); ss += __shfl_xor(ss, 32);
                if (fq == 0) atomicAdd(SS + row, ss); }
    } };

template <int KU> __device__ __forceinline__ void wave_gemm_32x64(const bf16_t* A, int lda, const bf16_t* Bt, int ldb, int K, int m0, int n0, int fr, int fq, f32x4 (&acc)[2][4]) {
    const bf16_t* ap = A + (size_t)(m0 + fr) * lda + 8 * fq;
    const bf16_t* bp = Bt + (size_t)(n0 + fr) * ldb + 8 * fq;
    if (KU > 0) {
        constexpr int NK = KU > 0 ? KU / 32 : 1;
        bf16x8 a0[NK], a1[NK], b[NK][4];
#pragma unroll
        for (int ks = 0; ks < NK; ++ks) { a0[ks] = *(const bf16x8*)(ap + 32 * ks); a1[ks] = *(const bf16x8*)(ap + (size_t)16 * lda + 32 * ks);
#pragma unroll
            for (int j = 0; j < 4; ++j) b[ks][j] = *(const bf16x8*)(bp + (size_t)(16 * j) * ldb + 32 * ks); }
#pragma unroll
        for (int ks = 0; ks < NK; ++ks)
#pragma unroll
            for (int j = 0; j < 4; ++j) { acc[0][j] = __builtin_amdgcn_mfma_f32_16x16x32_bf16(b[ks][j], a0[ks], acc[0][j], 0, 0, 0); acc[1][j] = __builtin_amdgcn_mfma_f32_16x16x32_bf16(b[ks][j], a1[ks], acc[1][j], 0, 0, 0); }
        return;
    }
    for (int k0 = 0; k0 < K; k0 += 32) {
        const bf16x8 a0 = *(const bf16x8*)(ap + k0), a1 = *(const bf16x8*)(ap + (size_t)16 * lda + k0);
        bf16x8 b[4];
#pragma unroll
        for (int j = 0; j < 4; ++j) b[j] = *(const bf16x8*)(bp + (size_t)(16 * j) * ldb + k0);
#pragma unroll
        for (int j = 0; j < 4; ++j) { acc[0][j] = __builtin_amdgcn_mfma_f32_16x16x32_bf16(b[j], a0, acc[0][j], 0, 0, 0); acc[1][j] = __builtin_amdgcn_mfma_f32_16x16x32_bf16(b[j], a1, acc[1][j], 0, 0, 0); }
    }
}
template <int KU = 0, class Epi>
__device__ __forceinline__ void gemm_simple(const Ctx& c, const bf16_t* A, int lda, const bf16_t* Bt, int ldb, int M, int N, int K, const Epi& epi) {
    const int nMt = M / 256, nNt = N / 64, ntiles = nMt * nNt;
    for (int tile = blockIdx.x; tile < ntiles; tile += gridDim.x) {
        const int tm = tile % nMt, tn = tile / nMt, m0 = tm * 256 + c.wave * 32, n0 = tn * 64;
        f32x4 acc[2][4];
#pragma unroll
        for (int i = 0; i < 2; ++i)
#pragma unroll
            for (int j = 0; j < 4; ++j) acc[i][j] = (f32x4){0.f, 0.f, 0.f, 0.f};
        wave_gemm_32x64<KU>(A, lda, Bt, ldb, K, m0, n0, c.fr, c.fq, acc);
#pragma unroll
        for (int i = 0; i < 2; ++i)
#pragma unroll
            for (int j = 0; j < 4; ++j) epi(m0 + 16 * i + c.fr, n0 + 16 * j + 4 * c.fq, acc[i][j]);
    }
}

template <int KU, class Epi>
__device__ __forceinline__ void gemm_panel(const Ctx& c, const bf16_t* A, int lda, const bf16_t* Bt, int ldb, int row0, int N, int K, const Epi& epi) {
    const int nct = N / 64, nt = 4 * nct;
    for (int t = c.wave; t < nt; t += NWAVES) {
        const int m0 = row0 + 32 * (t & 3), n0 = 64 * (t >> 2);
        f32x4 acc[2][4];
#pragma unroll
        for (int i = 0; i < 2; ++i)
#pragma unroll
            for (int j = 0; j < 4; ++j) acc[i][j] = (f32x4){0.f, 0.f, 0.f, 0.f};
        wave_gemm_32x64<KU>(A, lda, Bt, ldb, K, m0, n0, c.fr, c.fq, acc);
#pragma unroll
        for (int i = 0; i < 2; ++i)
#pragma unroll
            for (int j = 0; j < 4; ++j) epi(m0 + 16 * i + c.fr, n0 + 16 * j + 4 * c.fq, acc[i][j]);
    }
}
struct EpiBf16 { bf16_t* O; int ld; __device__ __forceinline__ void operator()(int row, int col, f32x4 v) const { *(u32x2*)(O + (size_t)row * ld + col) = pk4(v); } };
struct EpiKV { bf16_t* KB; bf16_t* VT;
    __device__ __forceinline__ void operator()(int row, int col, f32x4 v) const {
        if (col < 256) { *(u32x2*)(KB + (size_t)row * 256 + col) = pk4(v); }
        else { const int cc = col - 256, h = cc >> 6, d = cc & 63, b = row >> 8, key = row & 255;
#pragma unroll
            for (int j = 0; j < 4; ++j) VT[((size_t)((b * 4 + h) * 64 + d + j)) * 256 + key] = (bf16_t)f2bf(v[j]); }
    } };
struct EpiDecay { bf16_t* E; const float* w0;
    __device__ __forceinline__ void operator()(int row, int col, f32x4 v) const {
        const f32x4 z = v + *(const f32x4*)(w0 + col); f32x4 o;
#pragma unroll
        for (int j = 0; j < 4; ++j) o[j] = 0.60653065971f * sigmoidf_(z[j]);
        *(u32x2*)(E + (size_t)row * RD + col) = pk4(o); } };
struct EpiSigBias { bf16_t* O; int ld; const float* bias;
    __device__ __forceinline__ void operator()(int row, int col, f32x4 v) const {
        const f32x4 z = v + *(const f32x4*)(bias + col); f32x4 o;
#pragma unroll
        for (int j = 0; j < 4; ++j) o[j] = sigmoidf_(z[j]);
        *(u32x2*)(O + (size_t)row * ld + col) = pk4(o); } };
struct EpiPool { bf16_t* Y; const float* scale; int gi;
    __device__ __forceinline__ void operator()(int row, int col, f32x4 v) const {
        const f32x4 s = *(const f32x4*)(scale + 64 * gi + col); *(u32x2*)(Y + (size_t)row * DM + 512 + 64 * gi + col) = pk4(v * s); } };
struct EpiOut { const float* x; float* x1; bf16_t* x1b;
    __device__ __forceinline__ void operator()(int row, int col, f32x4 v) const {
        const size_t off = (size_t)row * DM + col; const f32x4 o = *(const f32x4*)(x + off) + v; *(f32x4*)(x1 + off) = o; *(u32x2*)(x1b + off) = pk4(o); } };
struct EpiAddOut { float* x;
    __device__ __forceinline__ void operator()(int row, int col, f32x4 v) const { const size_t off = (size_t)row * DM + col; *(f32x4*)(x + off) = *(const f32x4*)(x + off) + v; } };

__device__ __forceinline__ void phase_mix(const Params& p, const Ctx& c) {
    unsigned char* ws = p.ws;
    const bf16_t* P = (const bf16_t*)(ws + WS_P); const float* mu = p.in[I_MU];
    bf16_t* R = (bf16_t*)(ws + WS_R); bf16_t* KR = (bf16_t*)(ws + WS_KRAW); bf16_t* V = (bf16_t*)(ws + WS_V);
    bf16_t* LW = (bf16_t*)(ws + WS_LW); bf16_t* LA = (bf16_t*)(ws + WS_LA); bf16_t* LG = (bf16_t*)(ws + WS_LG);
    constexpr int RPW = 16;
    f32x4 m4[7];
#pragma unroll
    for (int i = 0; i < 7; ++i) m4[i] = *(const f32x4*)(mu + 4 * c.lane + 256 * i);
    for (int blk = c.gw; blk < MTOK / RPW; blk += c.ngw) {
        const int row0 = blk * RPW;
        f32x4 pv[7];
#pragma unroll
        for (int i = 0; i < 7; ++i) pv[i] = (row0 & (SEQ - 1)) ? unpk4(*(const u32x2*)(P + (size_t)(row0 - 1) * MIXIN + 4 * c.lane + 256 * i)) : (f32x4){0.f, 0.f, 0.f, 0.f};
#pragma unroll 2
        for (int rr = 0; rr < RPW; ++rr) {
            const int row = row0 + rr; const bf16_t* cur = P + (size_t)row * MIXIN;
            u32x2 cu[7];
#pragma unroll
            for (int i = 0; i < 7; ++i) cu[i] = *(const u32x2*)(cur + 4 * c.lane + 256 * i);
#pragma unroll
            for (int i = 0; i < 7; ++i) {
                const int col = 4 * c.lane + 256 * i;
                const f32x4 cv = unpk4(cu[i]);
                const f32x4 pm = cv + (pv[i] - cv) * m4[i];
                pv[i] = cv;
                if (i < 2) *(u32x2*)(R + (size_t)row * RD + col) = pk4(pm);
                else if (i < 4) *(u32x2*)(KR + (size_t)row * RD + (col - 512)) = pk4(pm);
                else if (i < 6) *(u32x2*)(V + (size_t)row * RD + (col - 1024)) = pk4(pm);
                else {
                    const int cc = col - 1536;
                    if (cc < 64) { f32x4 o; o[0] = tanhf(pm[0]); o[1] = tanhf(pm[1]); o[2] = tanhf(pm[2]); o[3] = tanhf(pm[3]); *(u32x2*)(LW + (size_t)row * 64 + cc) = pk4(o); }
                    else if (cc < 128) { *(u32x2*)(LA + (size_t)row * 64 + (cc - 64)) = pk4(pm); }
                    else { f32x4 o; o[0] = sigmoidf_(pm[0]); o[1] = sigmoidf_(pm[1]); o[2] = sigmoidf_(pm[2]); o[3] = sigmoidf_(pm[3]); *(u32x2*)(LG + (size_t)row * 128 + (cc - 128)) = pk4(o); }
                }
            }
        }
    }
}
__device__ __forceinline__ void phase_pooldiff(const Params& p, const Ctx& c) {
    unsigned char* ws = p.ws;
    const bf16_t* P = (const bf16_t*)(ws + WS_P); bf16_t* DP = (bf16_t*)(ws + WS_DPOOL);
    const int col = 4 * c.lane, gi = c.lane >> 4, win = 2 << gi;
    constexpr int RPW = 16;
    for (int blk = c.gw; blk < MTOK / RPW; blk += c.ngw) {
        const int row0 = blk * RPW, t0 = row0 & (SEQ - 1);
        const bf16_t* base = P + (size_t)row0 * MIXIN + RWKVIN + col;
        f32x4 s = (f32x4){0.f, 0.f, 0.f, 0.f};
#pragma unroll
        for (int j = 1; j < 16; ++j) if (j < win && j <= t0) s += unpk4(*(const u32x2*)(base - (size_t)j * MIXIN));
#pragma unroll 4
        for (int rr = 0; rr < RPW; ++rr) {
            const int t = t0 + rr; const bf16_t* cur = base + (size_t)rr * MIXIN;
            const f32x4 x0 = unpk4(*(const u32x2*)cur);
            f32x4 xo = (f32x4){0.f, 0.f, 0.f, 0.f}; if (t - win + 1 >= 0) xo = unpk4(*(const u32x2*)(cur - (size_t)(win - 1) * MIXIN));
            s += x0;
            const int cnt = (t + 1) < win ? (t + 1) : win;
            *(u32x2*)(DP + (size_t)(row0 + rr) * 256 + col) = pk4(s * (1.0f / (float)cnt) - x0);
            s -= xo;
        }
    }
}
__device__ __forceinline__ void phase_memattn(const Params& p, const Ctx& c) {
    unsigned char* ws = p.ws;
    const bf16_t* P = (const bf16_t*)(ws + WS_P); const bf16_t* KB = (const bf16_t*)(ws + WS_KB); const bf16_t* VT = (const bf16_t*)(ws + WS_VT); bf16_t* Y = (bf16_t*)(ws + WS_YCAT);
    constexpr int KS = 72, VS = 264;
    LAS bf16_t* LK = (LAS bf16_t*)c.lds; LAS bf16_t* LV = (LAS bf16_t*)(c.lds + 256 * KS * 2);
    const int fr = c.fr, fq = c.fq, tid = c.tid;
    for (int grp = blockIdx.x; grp < BATCH * 4 * 8; grp += gridDim.x) {
        const int pp = grp & 7, h = (grp >> 3) & 3, b = grp >> 5;
        __syncthreads();
        { const int row = tid >> 1, hf = tid & 1; const u32x4* src = (const u32x4*)(KB + (size_t)(b * 256 + row) * 256 + h * 64 + 32 * hf);
#pragma unroll
          for (int i = 0; i < 4; ++i) *(LAS u32x4*)(LK + row * KS + 32 * hf + 8 * i) = src[i];
          const int d = tid >> 3, sg = tid & 7; const u32x4* sv = (const u32x4*)(VT + ((size_t)((b * 4 + h) * 64 + d)) * 256 + 32 * sg);
#pragma unroll
          for (int i = 0; i < 4; ++i) *(LAS u32x4*)(LV + d * VS + 32 * sg + 8 * i) = sv[i]; }
        __syncthreads();
#pragma unroll 1
        for (int it = 0; it < 4; ++it) {
            const int qt = 2 * pp + (it >> 1), qg = it & 1;
            const int row = b * SEQ + qt * 256 + c.wave * 32 + 16 * qg + fr;
            const bf16x8 q0 = *(const bf16x8*)(P + (size_t)row * MIXIN + 2048 + h * 64 + 8 * fq), q1 = *(const bf16x8*)(P + (size_t)row * MIXIN + 2048 + h * 64 + 32 + 8 * fq);
            f32x4 sc[16];
#pragma unroll
            for (int kg = 0; kg < 16; ++kg) {
                const LAS bf16_t* kp = LK + (16 * kg + fr) * KS + 8 * fq;
                f32x4 a = (f32x4){0.f, 0.f, 0.f, 0.f};
                a = __builtin_amdgcn_mfma_f32_16x16x32_bf16(*(const LAS bf16x8*)kp, q0, a, 0, 0, 0); a = __builtin_amdgcn_mfma_f32_16x16x32_bf16(*(const LAS bf16x8*)(kp + 32), q1, a, 0, 0, 0); sc[kg] = a;
                if ((kg & 3) == 3) asm volatile("" ::: "memory");
            }
            float m = -1e30f;
#pragma unroll
            for (int kg = 0; kg < 16; ++kg) m = fmaxf(m, fmaxf(fmaxf(sc[kg][0], sc[kg][1]), fmaxf(sc[kg][2], sc[kg][3])));
            m = fmaxf(m, __shfl_xor(m, 16)); m = fmaxf(m, __shfl_xor(m, 32));
            float l = 0.f;
#pragma unroll
            for (int kg = 0; kg < 16; ++kg)
#pragma unroll
                for (int j = 0; j < 4; ++j) { const float e = __expf((sc[kg][j] - m) * 0.125f); sc[kg][j] = e; l += e; }
            l += __shfl_xor(l, 16); l += __shfl_xor(l, 32);
            const float linv = 1.0f / l;
            f32x4 o[4];
#pragma unroll
            for (int dg = 0; dg < 4; ++dg) o[dg] = (f32x4){0.f, 0.f, 0.f, 0.f};
#pragma unroll
            for (int s2 = 0; s2 < 8; ++s2) {
                u32x4 w; w.x = pk2(sc[2 * s2][0], sc[2 * s2][1]); w.y = pk2(sc[2 * s2][2], sc[2 * s2][3]); w.z = pk2(sc[2 * s2 + 1][0], sc[2 * s2 + 1][1]); w.w = pk2(sc[2 * s2 + 1][2], sc[2 * s2 + 1][3]);
                const bf16x8 pf = __builtin_bit_cast(bf16x8, w);
#pragma unroll
                for (int dg = 0; dg < 4; ++dg) {
                    const LAS bf16_t* vp = LV + (16 * dg + fr) * VS + 32 * s2 + 4 * fq;
                    u32x4 v; const u32x2 lo = *(const LAS u32x2*)vp, hi = *(const LAS u32x2*)(vp + 16); v.x = lo.x; v.y = lo.y; v.z = hi.x; v.w = hi.y;
                    o[dg] = __builtin_amdgcn_mfma_f32_16x16x32_bf16(__builtin_bit_cast(bf16x8, v), pf, o[dg], 0, 0, 0);
                }
                if (s2 & 1) asm volatile("" ::: "memory");
            }
#pragma unroll
            for (int dg = 0; dg < 4; ++dg) *(u32x2*)(Y + (size_t)row * DM + 768 + h * 64 + 16 * dg + 4 * fq) = pk4(o[dg] * linv);
        }
    }
}

#define MF16(a, b, c) __builtin_amdgcn_mfma_f32_16x16x32_bf16((a), (b), (c), 0, 0, 0)
__device__ __forceinline__ bf16x8 pack4z(f32x4 x) { u32x4 w; w.x = pk2(x[0], x[1]); w.y = pk2(x[2], x[3]); w.z = 0u; w.w = 0u; return __builtin_bit_cast(bf16x8, w); }
__device__ __forceinline__ bf16x8 frag4z(const LAS bf16_t* p) { const u32x2 v = *(const LAS u32x2*)p; u32x4 w; w.x = v.x; w.y = v.y; w.z = 0u; w.w = 0u; return __builtin_bit_cast(bf16x8, w); }
__device__ __forceinline__ bf16x8 raw4z(u32x2 v) { u32x4 w; w.x = v.x; w.y = v.y; w.z = 0u; w.w = 0u; return __builtin_bit_cast(bf16x8, w); }
__device__ __forceinline__ float sum8(float x) { x += dpp_f<0xB1>(x); x += dpp_f<0x4E>(x); x += dpp_f<0x141>(x); return x; }
constexpr int CH = 64, NCHUNK = SEQ / CH, NTASK = BATCH * 8 * NCHUNK;
constexpr int RS = 72;
constexpr int S1_QK = 0, S1_QR = 9216, S1_QB = 18432, S1_QKH = 27648, S1_BTN = 36864, S1_KHT = 46080, S1_VT = 55296;
constexpr int S1_AAB = 64512, S1_AAK = 73728, S1_ARB = 82944, S1_ARK = 92160, S1_EC = 101376, S1_DG = 117760, S1_DI = 121856, S1_GC = 124928, S1_SEG = 125184;
constexpr int DIS = 24;
template <int STOP> __device__ __forceinline__ void phase_s1(const Params& p, const Ctx& c) {
    unsigned char* ws = p.ws;
    const bf16_t* R = (const bf16_t*)(ws + WS_R); const bf16_t* KR = (const bf16_t*)(ws + WS_KRAW); const bf16_t* V = (const bf16_t*)(ws + WS_V); const bf16_t* AA = (const bf16_t*)(ws + WS_YCAT);
    const bf16_t* EW = (const bf16_t*)(ws + WS_E); float* BON = (float*)(ws + WS_BONUS);
    u32x2* RTT = (u32x2*)((unsigned char*)p.out + DO_RTT); u32x2* MTT = (u32x2*)((unsigned char*)p.out + DO_MTT); u32x2* Y0D = (u32x2*)((unsigned char*)p.out + DO_Y0D); u32x2* ND = (u32x2*)((unsigned char*)p.out + DO_ND);
    LAS unsigned char* L = c.lds;
    LAS bf16_t* QK = (LAS bf16_t*)(L + S1_QK); LAS bf16_t* QR = (LAS bf16_t*)(L + S1_QR); LAS bf16_t* QB = (LAS bf16_t*)(L + S1_QB); LAS bf16_t* QKH = (LAS bf16_t*)(L + S1_QKH);
    LAS bf16_t* BTN = (LAS bf16_t*)(L + S1_BTN); LAS bf16_t* KHT = (LAS bf16_t*)(L + S1_KHT); LAS bf16_t* VT = (LAS bf16_t*)(L + S1_VT);
    LAS bf16_t* AAB = (LAS bf16_t*)(L + S1_AAB); LAS bf16_t* AAK = (LAS bf16_t*)(L + S1_AAK); LAS bf16_t* ARB = (LAS bf16_t*)(L + S1_ARB); LAS bf16_t* ARK = (LAS bf16_t*)(L + S1_ARK);
    LAS float* EC = (LAS float*)(L + S1_EC); LAS float* DG = (LAS float*)(L + S1_DG); LAS bf16_t* DI = (LAS bf16_t*)(L + S1_DI); LAS float* GC = (LAS float*)(L + S1_GC); LAS float* SEG = (LAS float*)(L + S1_SEG);
    const int tid = c.tid, fr = c.fr, fq = c.fq, wave = c.wave, lane = c.lane;
    const int st = tid >> 3, cg = tid & 7;
    auto task_off = [&](int task) -> size_t { const int bh = task >> 6, ch = task & 63; return ((size_t)(bh >> 3) * SEQ + ch * CH + st) * RD + (bh & 7) * 64 + 8 * cg; };
    u32x4 ur, uk, uv, ua, ue;
    if ((int)blockIdx.x < NTASK) { const size_t o = task_off(blockIdx.x); ur = *(const u32x4*)(R + o); uk = *(const u32x4*)(KR + o); uv = *(const u32x4*)(V + o); ue = *(const u32x4*)(EW + o); ua = *(const u32x4*)(AA + o + (o / RD) * (DM - RD)); }
    for (int task = blockIdx.x; task < NTASK; task += gridDim.x) {
        const int bh = task >> 6, ch = task & 63, b = bh >> 3, h = bh & 7;
        const size_t grow = (size_t)b * SEQ + ch * CH + st;
        __syncthreads();
        float r8[8], k8[8], v8[8], a8[8], e8[8];
        { const unsigned wr_[4] = {ur.x, ur.y, ur.z, ur.w}, wk_[4] = {uk.x, uk.y, uk.z, uk.w}, wv_[4] = {uv.x, uv.y, uv.z, uv.w}, wa_[4] = {ua.x, ua.y, ua.z, ua.w}, we_[4] = {ue.x, ue.y, ue.z, ue.w};
#pragma unroll
          for (int i = 0; i < 4; ++i) { r8[2 * i] = bf2f(wr_[i] & 0xffffu); r8[2 * i + 1] = bf2f(wr_[i] >> 16); k8[2 * i] = bf2f(wk_[i] & 0xffffu); k8[2 * i + 1] = bf2f(wk_[i] >> 16);
              v8[2 * i] = bf2f(wv_[i] & 0xffffu); v8[2 * i + 1] = bf2f(wv_[i] >> 16); a8[2 * i] = bf2f(wa_[i] & 0xffffu); a8[2 * i + 1] = bf2f(wa_[i] >> 16); e8[2 * i] = bf2f(we_[i] & 0xffffu); e8[2 * i + 1] = bf2f(we_[i] >> 16); } }
        if (task + (int)gridDim.x < NTASK) { const size_t o = task_off(task + gridDim.x); ur = *(const u32x4*)(R + o); uk = *(const u32x4*)(KR + o); uv = *(const u32x4*)(V + o); ue = *(const u32x4*)(EW + o); ua = *(const u32x4*)(AA + o + (o / RD) * (DM - RD)); }
        float kap8[8], bb8[8], kf8[8]; float nrm = 0.f, bon = 0.f;
#pragma unroll
        for (int i = 0; i < 8; ++i) { const int col = h * 64 + 8 * cg + i; const float kkv = k8[i] * p.in[I_KK][col]; kap8[i] = kkv; nrm += kkv * kkv;
            kf8[i] = k8[i] * (1.0f + (a8[i] - 1.0f) * p.in[I_KA][col]); bon += r8[i] * kf8[i] * p.in[I_RK][col]; }
        nrm = sum8(nrm); bon = sum8(bon);
        const float rn = rsqrtf(nrm + 1e-12f);
#pragma unroll
        for (int i = 0; i < 8; ++i) { kap8[i] *= rn; bb8[i] = kap8[i] * a8[i]; }
        if (cg == 0) BON[grow * 8 + h] = bon;
        *(LAS f32x4*)(EC + st * 64 + 8 * cg) = (f32x4){e8[0], e8[1], e8[2], e8[3]}; *(LAS f32x4*)(EC + st * 64 + 8 * cg + 4) = (f32x4){e8[4], e8[5], e8[6], e8[7]};
        __syncthreads();
        { const int cc = tid & 63, sg = tid >> 6; float run = 0.f;
#pragma unroll
          for (int i = 0; i < 8; ++i) { run += EC[(8 * sg + i) * 64 + cc]; EC[(8 * sg + i) * 64 + cc] = run; }
          SEG[sg * 64 + cc] = run;
          __syncthreads();
          float off = 0.f;
#pragma unroll
          for (int s2 = 0; s2 < 7; ++s2) off += (s2 < sg) ? SEG[s2 * 64 + cc] : 0.f;
#pragma unroll
          for (int i = 0; i < 8; ++i) EC[(8 * sg + i) * 64 + cc] += off;
          if (sg == 7) GC[cc] = __expf(-(run + off)); }
        __syncthreads();
        { float cum[8]; const f32x4 c0 = *(const LAS f32x4*)(EC + st * 64 + 8 * cg), c1 = *(const LAS f32x4*)(EC + st * 64 + 8 * cg + 4);
#pragma unroll
          for (int i = 0; i < 4; ++i) { cum[i] = c0[i]; cum[4 + i] = c1[i]; }
          float kh[8], rh[8], bh8[8], kk8[8];
#pragma unroll
          for (int i = 0; i < 8; ++i) { const float gi = __expf(cum[i]); kh[i] = kap8[i] * __expf(e8[i] - cum[i]); rh[i] = r8[i] * __expf(-cum[i]); bh8[i] = bb8[i] * gi; kk8[i] = kf8[i] * gi; }
          u32x4 w;
          w.x = pk2(kh[0], kh[1]); w.y = pk2(kh[2], kh[3]); w.z = pk2(kh[4], kh[5]); w.w = pk2(kh[6], kh[7]); *(LAS u32x4*)(QK + st * RS + 8 * cg) = w;
          w.x = pk2(rh[0], rh[1]); w.y = pk2(rh[2], rh[3]); w.z = pk2(rh[4], rh[5]); w.w = pk2(rh[6], rh[7]); *(LAS u32x4*)(QR + st * RS + 8 * cg) = w;
          w.x = pk2(bh8[0], bh8[1]); w.y = pk2(bh8[2], bh8[3]); w.z = pk2(bh8[4], bh8[5]); w.w = pk2(bh8[6], bh8[7]); *(LAS u32x4*)(QB + st * RS + 8 * cg) = w;
          w.x = pk2(kk8[0], kk8[1]); w.y = pk2(kk8[2], kk8[3]); w.z = pk2(kk8[4], kk8[5]); w.w = pk2(kk8[6], kk8[7]); *(LAS u32x4*)(QKH + st * RS + 8 * cg) = w;
#pragma unroll
          for (int i = 0; i < 8; ++i) { const int o = (8 * cg + i) * RS + ((st + 8 * cg) & 63);
              BTN[o] = (bf16_t)f2bf(-bh8[i]); KHT[o] = (bf16_t)f2bf(kk8[i]); VT[o] = (bf16_t)f2bf(v8[i]); } }
        __syncthreads();
        if (STOP == 1) continue;
        { const int mat = wave >> 1; const LAS bf16_t* Am = (mat < 2) ? QK : QR; const LAS bf16_t* Bm = (mat & 1) ? QKH : QB; LAS bf16_t* Om = (mat == 0) ? AAB : (mat == 1) ? AAK : (mat == 2) ? ARB : ARK;
          const bool strict = mat < 2; const float sgn = (mat & 1) ? 1.0f : -1.0f;
#pragma unroll
          for (int jj = 0; jj < 2; ++jj) { const int j = 2 * (wave & 1) + jj;
              const bf16x8 bt0 = *(const LAS bf16x8*)(Am + (16 * j + fr) * RS + 8 * fq), bt1 = *(const LAS bf16x8*)(Am + (16 * j + fr) * RS + 32 + 8 * fq);
#pragma unroll
              for (int l = 0; l < 4; ++l) {
                  f32x4 d = (f32x4){0.f, 0.f, 0.f, 0.f};
                  d = MF16(*(const LAS bf16x8*)(Bm + (16 * l + fr) * RS + 8 * fq), bt0, d); d = MF16(*(const LAS bf16x8*)(Bm + (16 * l + fr) * RS + 32 + 8 * fq), bt1, d);
                  const int t = 16 * j + fr, i0 = 16 * l + 4 * fq;
#pragma unroll
                  for (int rg = 0; rg < 4; ++rg) { const bool keep = strict ? (i0 + rg < t) : (i0 + rg <= t); d[rg] = keep ? d[rg] : 0.f; }
                  if (mat == 0 && l == j) *(LAS f32x4*)(DG + (j * 16 + fr) * 16 + 4 * fq) = d;
                  *(LAS u32x2*)(Om + t * RS + i0) = pk4(d * sgn);
              } } }
        __syncthreads();
        if (STOP == 2) continue;
        f32x4 Z[4], Z1[4], Ee[4];
        if (wave == 0) {
            const int j = lane >> 4, col = lane & 15; float x[16];
#pragma unroll
            for (int t = 0; t < 16; ++t) x[t] = (t == col) ? 1.0f : 0.0f;
#pragma unroll
            for (int i = 0; i < 15; ++i) {
#pragma unroll
                for (int t = i + 1; t < 16; ++t) x[t] -= DG[(j * 16 + t) * 16 + i] * x[i]; }
#pragma unroll
            for (int t = 0; t < 16; ++t) DI[(j * 16 + t) * DIS + col] = (bf16_t)f2bf(x[t]);
        }
        if (wave >= 4) { const int vb = wave - 4;
#pragma unroll
            for (int j = 0; j < 4; ++j) { Z[j] = Z1[j] = Ee[j] = (f32x4){0.f, 0.f, 0.f, 0.f};
#pragma unroll
                for (int s2 = 0; s2 < 2; ++s2) { const bf16x8 bv = *(const LAS bf16x8*)(VT + (16 * vb + fr) * RS + ((32 * s2 + 8 * fq + 8 * (2 * vb + (fr >> 3))) & 63));
                    Z[j] = MF16(*(const LAS bf16x8*)(AAK + (16 * j + fr) * RS + 32 * s2 + 8 * fq), bv, Z[j]);
                    Z1[j] = MF16(*(const LAS bf16x8*)(ARK + (16 * j + fr) * RS + 32 * s2 + 8 * fq), bv, Z1[j]);
                    Ee[j] = MF16(*(const LAS bf16x8*)(KHT + (16 * j + fr) * RS + ((32 * s2 + 8 * fq + 8 * (2 * j + (fr >> 3))) & 63)), bv, Ee[j]); } } }
        else {
#pragma unroll
            for (int j = 0; j < 4; ++j)
#pragma unroll
                for (int rg = 0; rg < 4; ++rg) Z[j][rg] = bf2f(QK[(16 * j + 4 * fq + rg) * RS + 16 * wave + fr]); }
        __syncthreads();
        if (STOP == 3) { asm volatile("" :: "v"(Z[0]), "v"(Z[1]), "v"(Z[2]), "v"(Z[3])); if (wave >= 4) asm volatile("" :: "v"(Z1[0]), "v"(Z1[3]), "v"(Ee[0]), "v"(Ee[3])); continue; }
        f32x4 X[4];
#pragma unroll
        for (int j = 0; j < 4; ++j) { f32x4 acc = Z[j];
#pragma unroll
            for (int l = 0; l < 4; ++l) if (l < j) acc = MF16(frag4z(AAB + (16 * j + fr) * RS + 16 * l + 4 * fq), pack4z(X[l]), acc);
            X[j] = MF16(frag4z(DI + (j * 16 + fr) * DIS + 4 * fq), pack4z(acc), ((f32x4){0.f, 0.f, 0.f, 0.f})); }
        const size_t dbase = ((size_t)task * 4 + (wave & 3)) * 4 * 64 + lane;
        if (wave >= 4) {
#pragma unroll
            for (int j = 0; j < 4; ++j) { f32x4 y0 = Z1[j];
#pragma unroll
                for (int l = 0; l < 4; ++l) if (l <= j) y0 = MF16(frag4z(ARB + (16 * j + fr) * RS + 16 * l + 4 * fq), pack4z(X[l]), y0);
                Y0D[dbase + j * 64] = pk4(y0);
                f32x4 nn = Ee[j];
#pragma unroll
                for (int l = 0; l < 4; ++l) nn = MF16(frag4z(BTN + (16 * j + fr) * RS + ((16 * l + 4 * fq + 8 * (2 * j + (fr >> 3))) & 63)), pack4z(X[l]), nn);
#pragma unroll
                for (int rg = 0; rg < 4; ++rg) nn[rg] *= GC[16 * j + 4 * fq + rg];
                ND[dbase + j * 64] = pk4(nn); } }
        else {
#pragma unroll
            for (int j = 0; j < 4; ++j) { f32x4 rt = unpk4(*(const LAS u32x2*)(QR + (16 * j + fr) * RS + 16 * wave + 4 * fq));
#pragma unroll
                for (int l = 0; l < 4; ++l) if (l <= j) rt = MF16(pack4z(X[l]), frag4z(ARB + (16 * j + fr) * RS + 16 * l + 4 * fq), rt);
                RTT[dbase + j * 64] = pk4(rt);
                f32x4 mt;
#pragma unroll
                for (int rg = 0; rg < 4; ++rg) mt[rg] = (16 * wave + 4 * fq + rg == 16 * j + fr) ? 1.0f : 0.0f;
#pragma unroll
                for (int l = 0; l < 4; ++l) mt = MF16(pack4z(X[l]), frag4z(BTN + (16 * j + fr) * RS + ((16 * l + 4 * fq + 8 * (2 * j + (fr >> 3))) & 63)), mt);
                MTT[dbase + j * 64] = pk4(mt * GC[16 * j + fr]); } }
    }
}
__device__ __forceinline__ void phase_s2(const Params& p, const Ctx& c) {
    if (c.wave != 0) return;
    const u32x2* MTT = (const u32x2*)((unsigned char*)p.out + DO_MTT); const u32x2* ND = (const u32x2*)((unsigned char*)p.out + DO_ND); u32x2* SP = (u32x2*)(p.ws + WS_SP);
    const int lane = c.lane;
    for (int unit = blockIdx.x; unit < BATCH * 8 * 4; unit += gridDim.x) {
        const int vb = unit & 3, bh = unit >> 2;
        f32x4 S[4];
#pragma unroll
        for (int j = 0; j < 4; ++j) S[j] = (f32x4){0.f, 0.f, 0.f, 0.f};
        u32x2 m0[4][4], n0[4], m1[4][4], n1[4], m2[4][4], n2[4];
#define S2_LOAD(mm, nn, tk) do { const size_t t_ = (tk); _Pragma("unroll") for (int l = 0; l < 4; ++l) _Pragma("unroll") for (int j = 0; j < 4; ++j) mm[l][j] = MTT[((t_ * 4 + l) * 4 + j) * 64 + lane]; \
        _Pragma("unroll") for (int j = 0; j < 4; ++j) nn[j] = ND[((t_ * 4 + vb) * 4 + j) * 64 + lane]; } while (0)
#define S2_STEP(mm, nn, tk) do { const size_t t_ = (tk); bf16x8 sp[4]; _Pragma("unroll") for (int l = 0; l < 4; ++l) { const u32x2 w = pk4(S[l]); SP[((t_ * 4 + vb) * 4 + l) * 64 + lane] = w; sp[l] = raw4z(w); } \
        _Pragma("unroll") for (int j = 0; j < 4; ++j) { f32x4 acc = unpk4(nn[j]); _Pragma("unroll") for (int l = 0; l < 4; ++l) acc = MF16(raw4z(mm[l][j]), sp[l], acc); S[j] = acc; } } while (0)
        const size_t t0 = (size_t)bh * NCHUNK, tl = t0 + NCHUNK - 1;
        S2_LOAD(m0, n0, t0); S2_LOAD(m1, n1, t0 + 1);
        for (int ch = 0; ch < NCHUNK; ch += 3) {
            const size_t tk = t0 + ch;
            S2_LOAD(m2, n2, tk + 2 < tl ? tk + 2 : tl); S2_STEP(m0, n0, tk);
            if (ch + 1 < NCHUNK) { S2_LOAD(m0, n0, tk + 3 < tl ? tk + 3 : tl); S2_STEP(m1, n1, tk + 1); }
            if (ch + 2 < NCHUNK) { S2_LOAD(m1, n1, tk + 4 < tl ? tk + 4 : tl); S2_STEP(m2, n2, tk + 2); }
        }
#undef S2_LOAD
#undef S2_STEP
    }
}
__device__ __forceinline__ void phase_s3(const Params& p, const Ctx& c) {
    unsigned char* ws = p.ws;
    const u32x2* RTT = (const u32x2*)((unsigned char*)p.out + DO_RTT); const u32x2* Y0D = (const u32x2*)((unsigned char*)p.out + DO_Y0D); const u32x2* SP = (const u32x2*)(ws + WS_SP);
    const float* BON = (const float*)(ws + WS_BONUS); const bf16_t* V = (const bf16_t*)(ws + WS_V); const bf16_t* G = (const bf16_t*)(ws + WS_G); bf16_t* Y = (bf16_t*)(ws + WS_YCAT);
    const int lane = c.lane, fr = c.fr, fq = c.fq;
    for (int it = c.gw; it < NTASK * 4; it += c.ngw) {
        const size_t task = (size_t)(it >> 2); const int j = it & 3, bh = (int)(task >> 6), ch = (int)(task & 63), b = bh >> 3, h = bh & 7;
        bf16x8 rt[4];
#pragma unroll
        for (int l = 0; l < 4; ++l) rt[l] = raw4z(RTT[((task * 4 + l) * 4 + j) * 64 + lane]);
        f32x4 acc[4];
#pragma unroll
        for (int vb = 0; vb < 4; ++vb) { acc[vb] = unpk4(Y0D[((task * 4 + vb) * 4 + j) * 64 + lane]);
#pragma unroll
            for (int l = 0; l < 4; ++l) acc[vb] = MF16(rt[l], raw4z(SP[((task * 4 + vb) * 4 + l) * 64 + lane]), acc[vb]); }
#pragma unroll
        for (int rg = 0; rg < 4; ++rg) {
            const size_t row = (size_t)b * SEQ + ch * CH + 16 * j + 4 * fq + rg;
            const float mean = row_sum16((acc[0][rg] + acc[1][rg]) + (acc[2][rg] + acc[3][rg])) * (1.0f / 64.0f);
            float d[4], q = 0.f;
#pragma unroll
            for (int vb = 0; vb < 4; ++vb) { d[vb] = acc[vb][rg] - mean; q += d[vb] * d[vb]; }
            const float rstd = rsqrtf(row_sum16(q) * (1.0f / 64.0f) + GN_EPS), bon = BON[row * 8 + h];
#pragma unroll
            for (int vb = 0; vb < 4; ++vb) { const int col = h * 64 + 16 * vb + fr;
                const float yn = d[vb] * rstd * p.in[I_LNW][col] + p.in[I_LNB][col];
                Y[row * DM + col] = (bf16_t)f2bf((yn + bon * bf2f(V[row * RD + col])) * bf2f(G[row * RD + col])); }
        }
    }
}

__device__ __forceinline__ void phase_final_norm(const Params& p, const Ctx& c) {
    const float* g = p.in[I_NFING]; const float* SS = (const float*)(p.ws + WS_SS3);
    const f32x4 g0 = *((const f32x4*)g + c.lane), g1 = *((const f32x4*)g + c.lane + 64), g2 = *((const f32x4*)g + c.lane + 128), g3 = *((const f32x4*)g + c.lane + 192);
#pragma unroll 4
    for (int m = c.gw; m < MTOK; m += c.ngw) {
        f32x4* xr = (f32x4*)(p.out + (size_t)m * DM) + c.lane;
        const float rstd = rsqrtf(SS[m] * (1.f / DM) + NORM_EPS);
        const f32x4 v0 = xr[0], v1 = xr[64], v2 = xr[128], v3 = xr[192];
        xr[0] = v0 * rstd * g0; xr[64] = v1 * rstd * g1; xr[128] = v2 * rstd * g2; xr[192] = v3 * rstd * g3;
    }
}

constexpr int NPHASES = 14;
__global__ void __launch_bounds__(NTHREADS, 2) fwd_kernel(Params p) {
    extern __shared__ __attribute__((aligned(16))) unsigned char lds_raw[];
    Ctx c; c.tid = threadIdx.x; c.lane = c.tid & 63; c.wave = __builtin_amdgcn_readfirstlane(c.tid >> 6); c.fr = c.lane & 15; c.fq = c.lane >> 4;
    c.gw = blockIdx.x * NWAVES + c.wave; c.ngw = gridDim.x * NWAVES; c.lds = (LAS unsigned char*)lds_raw;
    unsigned char* ws = p.ws;
#if ONE_LAUNCH
    cg::grid_group grid = cg::this_grid();
    volatile LAS unsigned* misc = (volatile LAS unsigned*)(c.lds + LDS_MISC_OFF);
    if (c.tid < 4) misc[c.tid] = 0u;
    __syncthreads();
    const XcdBarrier xbar = xcd_barrier_post((unsigned*)(ws + WS_BAR), misc);
    bool first_seam = true;
#define SEAM() do { if (first_seam) { grid.sync(); first_seam = false; } else xcd_barrier(xbar); } while (0)
#else
#define SEAM() do {} while (0)
#endif
#define IN(k) (p.ph_lo <= (k) && (k) < p.ph_hi)
#define END(k) do { if (IN((k) + 1)) SEAM(); } while (0)
#define REP_ON(k) ((REP_MASK >> (k)) & 1u)
#define PHASE(k, ...) if (IN(k)) { __VA_ARGS__ if (REP_ON(k)) { SEAM(); __VA_ARGS__ } END(k); }
#define PHASE_NOREP(k, ...) if (IN(k)) { __VA_ARGS__ END(k); }
    PHASE(0, phase_prologue(p, c);)
    PHASE(1,
        gemm_pg8_8(c, (const bf16_t*)(ws + WS_H), DM, (const bf16_t*)(ws + WS_WG1T), DM, MTOK, MIXIN, DM, F8Store{(bf16_t*)(ws + WS_P), MIXIN});
        gemm_simple(c, (const bf16_t*)(ws + WS_MEMN), DM, (const bf16_t*)(ws + WS_WKVT), DM, BATCH * NMEM, 512, DM, EpiKV{(bf16_t*)(ws + WS_KB), (bf16_t*)(ws + WS_VT)});)
    PHASE(2, {
        phase_mix(p, c); phase_pooldiff(p, c);
        asm volatile("s_waitcnt vmcnt(0)" ::: "memory"); __syncthreads();
        for (int pb = blockIdx.x; pb < MTOK / 128; pb += gridDim.x) { const int r0 = 128 * pb;
            gemm_panel<64>(c, (const bf16_t*)(ws + WS_LW), 64, (const bf16_t*)(ws + WS_WLWT), 64, r0, RD, 64, EpiDecay{(bf16_t*)(ws + WS_E), p.in[I_W0]});
            gemm_panel<64>(c, (const bf16_t*)(ws + WS_LA), 64, (const bf16_t*)(ws + WS_WLAT), 64, r0, RD, 64, EpiSigBias{(bf16_t*)(ws + WS_YCAT), DM, p.in[I_A0]});
            gemm_panel<128>(c, (const bf16_t*)(ws + WS_LG), 128, (const bf16_t*)(ws + WS_WLGT), 128, r0, RD, 128, EpiBf16{(bf16_t*)(ws + WS_G), RD});
            _Pragma("unroll 1") for (int gi = 0; gi < 4; ++gi)
                gemm_panel<64>(c, (const bf16_t*)(ws + WS_DPOOL) + 64 * gi, 256, (const bf16_t*)(ws + WS_WPT) + 4096 * gi, 64, r0, 64, 64, EpiPool{(bf16_t*)(ws + WS_YCAT), p.in[I_POOLS], gi}); }
        phase_memattn(p, c); })
#ifndef S1_STOP
#define S1_STOP 0
#endif
    if (IN(4)) { phase_s1<0>(p, c); if (S1_STOP) { SEAM(); phase_s1<S1_STOP>(p, c); } END(4); }
    PHASE(5, phase_s2(p, c);)
    PHASE(6,
        phase_s3(p, c);
        gemm_pg8_8(c, (const bf16_t*)(ws + WS_H), DM, (const bf16_t*)(ws + WS_WG1T) + (size_t)MIXIN * DM, DM, MTOK, 3 * DM, DM, F8SigBias{(bf16_t*)(ws + WS_GATES), 3 * DM, p.in[I_BGATE]});)
    PHASE(8, {
        pg8::Gemm g{(const bf16_t*)(ws + WS_YCAT), (const bf16_t*)(ws + WS_WUPT), MTOK, DM, DM, DM, DM}; pg8::StaticOrder S; S.init(MTOK, DM, (int)gridDim.x, (int)blockIdx.x);
        EpiFn8<F8UpFinal> E{F8UpFinal{(bf16_t*)(ws + WS_MERGED), (const bf16_t*)(ws + WS_GATES)}};
        pg8::gemm_phase_h<EpiFn8<F8UpFinal>, pg8::StaticOrder, true, true, UpHook>(c.lds, g, S, E, UpHook{(const bf16_t*)(ws + WS_GATES)}); })
    PHASE_NOREP(9, {
        pg8::Gemm g{(const bf16_t*)(ws + WS_MERGED), (const bf16_t*)(ws + WS_WOT), MTOK, DM, DM, DM, DM}; pg8::StaticOrder S; S.init(MTOK, DM, (int)gridDim.x, (int)blockIdx.x);
        EpiOutB E{p.in[I_X], (bf16_t*)(ws + WS_X1B), (float*)(ws + WS_SS2)};
        pg8::gemm_phase<EpiOutB, pg8::StaticOrder, true, true>(c.lds, g, S, E);
        if (REP_ON(9)) { SEAM(); EpiOutB E2{p.in[I_X], (bf16_t*)(ws + WS_X1B), (float*)(ws + WS_SS2 + 512 * 1024)}; pg8::gemm_phase<EpiOutB, pg8::StaticOrder, true, true>(c.lds, g, S, E2); } })
    PHASE(10, {
        pg8::Gemm g{(const bf16_t*)(ws + WS_X1B), (const bf16_t*)(ws + WS_WF1T), MTOK, 2 * FF, DM, DM, DM}; pg8::StaticOrder S; S.init(MTOK, 2 * FF, (int)gridDim.x, (int)blockIdx.x);
        EpiFfnAct E{(bf16_t*)(ws + WS_ACT), (const float*)(ws + WS_SS2), p.in[I_CONVW], p.in[I_CONVB], (float*)(ws + WS_TAILU), (float*)(ws + WS_HEADU), (float*)(ws + WS_HEADGV), (LAS float*)(c.lds + LDS_HALO_OFF)};
        pg8::gemm_phase<EpiFfnAct, pg8::StaticOrder, true, true>(c.lds, g, S, E); })
    PHASE(11, phase_ffn_fix(p, c);)
    PHASE_NOREP(12, {
        pg8::Gemm g{(const bf16_t*)(ws + WS_ACT), (const bf16_t*)(ws + WS_WF2T), MTOK, DM, FF, FF, FF}; pg8::StaticOrder S; S.init(MTOK, DM, (int)gridDim.x, (int)blockIdx.x);
        EpiFfnOut E{(const bf16_t*)(ws + WS_X1B), p.out, (float*)(ws + WS_SS3)};
        pg8::gemm_phase<EpiFfnOut, pg8::StaticOrder, true, true>(c.lds, g, S, E);
        if (REP_ON(12)) { SEAM(); EpiFfnOut E2{(const bf16_t*)(ws + WS_X1B), p.out, (float*)(ws + WS_SS2 + 512 * 1024)}; pg8::gemm_phase<EpiFfnOut, pg8::StaticOrder, true, true>(c.lds, g, S, E2); } })
    if (IN(13)) { phase_final_norm(p, c); }
#undef IN
#undef END
}

__global__ void nan_fill(float* o, int n) { const int i = blockIdx.x * blockDim.x + threadIdx.x; if (i < n) o[i] = __builtin_nanf(""); }

extern "C" void kernel_launch(void* const* d_in, const int* in_sizes, int n_in, void* d_out, int out_size, void* d_ws, size_t ws_size, hipStream_t stream) {
    static int grid = 0;
    if (grid == 0) {
        int dev = 0, cus = 0, per_cu = 0;
        if (hipGetDevice(&dev) != hipSuccess || hipDeviceGetAttribute(&cus, hipDeviceAttributeMultiprocessorCount, dev) != hipSuccess) cus = 256;
        (void)hipFuncSetAttribute((const void*)fwd_kernel, hipFuncAttributeMaxDynamicSharedMemorySize, LDS_BYTES);
        if (hipOccupancyMaxActiveBlocksPerMultiprocessor(&per_cu, (const void*)fwd_kernel, NTHREADS, LDS_BYTES) != hipSuccess || per_cu < 1) per_cu = 1;
        (void)hipGetLastError();
        grid = cus;
        if (n_in != 31 || out_size != MTOK * DM || ws_size < WS_END) grid = -1;
    }
    if (grid < 0) { nan_fill<<<(out_size + 255) / 256, 256, 0, stream>>>((float*)d_out, out_size); return; }
    Params p{};
    for (int i = 0; i < 31; ++i) p.in[i] = (const float*)d_in[i];
    p.out = (float*)d_out; p.ws = (unsigned char*)d_ws;
#if ONE_LAUNCH
    (void)hipMemsetAsync((unsigned char*)d_ws + WS_BAR, 0, WS_CTL_BYTES, stream);
    p.ph_lo = 0; p.ph_hi = NPHASES;
    void* args[] = {&p};
    hipError_t e = hipLaunchCooperativeKernel((const void*)fwd_kernel, dim3(grid), dim3(NTHREADS), args, LDS_BYTES, stream);
    if (e != hipSuccess) fprintf(stderr, "cooperative launch failed: %s (grid %d)\n", hipGetErrorString(e), grid);
#else
    for (int ph = 0; ph < NPHASES; ++ph) { p.ph_lo = ph; p.ph_hi = ph + 1; hipLaunchKernelGGL(fwd_kernel, dim3(grid), dim3(NTHREADS), LDS_BYTES, stream, p); }
#endif
}
```
